# Optimizing an MI355X kernel written in HIP

```python
import math
import jax, jax.numpy as jnp
from jax import lax
import numpy as np

D_MODEL = 4096
BATCH = 2
SEQ = 4096
DEPTH = 2

CHUNK = 64
N_MIXERS = 2
EXPAND = 2
D_INNER = EXPAND * D_MODEL
HEAD_DIM = 128
N_HEADS = D_INNER // HEAD_DIM
HGRN_EXPAND = 128
HGRN_KEY = N_HEADS * HGRN_EXPAND
HGRN_BLOCK = CHUNK // 4
Q_BLOCK = 2 * CHUNK
N_A = (DEPTH + 1) // 2
N_B = DEPTH // 2
EPS = 1e-6

kernel_name = "hgrn2_fox_interleaved_hybrid"


def rms_norm(x, w):
    xf = x.astype(jnp.float32)
    y = xf * lax.rsqrt(jnp.mean(xf * xf, axis=-1, keepdims=True) + EPS)
    return (y * w.astype(jnp.float32)).astype(x.dtype)


def hgrn2_chunkwise(q, k, v, log_f):
    B, S, H, DK = q.shape
    DV = v.shape[-1]
    L = HGRN_BLOCK
    N = S // L

    def to_blocks(t):
        return t.reshape(B, N, L, H, t.shape[-1]).transpose(1, 0, 3, 2, 4)

    qb, kb, vb, gb = (to_blocks(t) for t in (q, k, v, log_f))
    mask = jnp.tril(jnp.ones((L, L), dtype=bool))

    def step(state, xs):
        qc, kc, vc, gc = xs
        G = jnp.cumsum(gc, axis=-2)
        q_dec = qc * jnp.exp(G)
        k_inv = kc * jnp.exp(-G)
        scores = jnp.where(mask, jnp.einsum('bhtd,bhsd->bhts', q_dec, k_inv), 0.0)
        o = (jnp.einsum('bhts,bhsv->bhtv', scores, vc)
             + jnp.einsum('bhtd,bhdv->bhtv', q_dec, state))
        G_last = G[:, :, -1:, :]
        k_end = kc * jnp.exp(G_last - G)
        state = (jnp.exp(G_last[:, :, 0, :])[..., None] * state
                 + jnp.einsum('bhsd,bhsv->bhdv', k_end, vc))
        return state, o

    state0 = jnp.zeros((B, H, DK, DV), jnp.float32)
    _, o = lax.scan(step, state0, (qb, kb, vb, gb))
    return o.transpose(1, 0, 3, 2, 4).reshape(B, S, H, DV)


def hgrn2_mixer(h, w_in, o_norm, lb):
    B, S, _ = h.shape
    proj = jnp.einsum('bsd,de->bse', h, w_in)
    q, f, i, gate = jnp.split(proj, 4, axis=-1)
    forget = lb + (1.0 - lb) * jax.nn.sigmoid(f.astype(jnp.float32))
    k = 1.0 - forget
    log_f = jnp.log(forget)
    qh = jax.nn.silu(q.astype(jnp.float32)).reshape(B, S, N_HEADS, HGRN_EXPAND)
    kh = k.reshape(B, S, N_HEADS, HGRN_EXPAND)
    gh = log_f.reshape(B, S, N_HEADS, HGRN_EXPAND)
    vh = i.astype(jnp.float32).reshape(B, S, N_HEADS, HEAD_DIM)
    o = hgrn2_chunkwise(qh, kh, vh, gh)
    o = o * lax.rsqrt(jnp.mean(o * o, axis=-1, keepdims=True) + EPS)
    o = o.reshape(B, S, D_INNER) * o_norm.astype(jnp.float32)
    return (o * jax.nn.silu(gate.astype(jnp.float32))).astype(h.dtype)


def fox_mixer(h, w_in, b_f):
    B, S, _ = h.shape
    proj = jnp.einsum('bsd,de->bse', h, w_in)
    q, k, v, gate = jnp.split(proj[..., :4 * D_INNER], 4, axis=-1)
    f_logit = proj[..., 4 * D_INNER:].astype(jnp.float32) + b_f.astype(jnp.float32)
    c = jnp.cumsum(jax.nn.log_sigmoid(f_logit), axis=1).transpose(0, 2, 1)
    qh = q.reshape(B, S, N_HEADS, HEAD_DIM)
    kh = k.reshape(B, S, N_HEADS, HEAD_DIM)
    vh = v.reshape(B, S, N_HEADS, HEAD_DIM)
    scale = 1.0 / math.sqrt(HEAD_DIM)
    outs = []
    for start in range(0, S, Q_BLOCK):
        end = start + Q_BLOCK
        logits = jnp.einsum('bqhd,bkhd->bhqk', qh[:, start:end], kh[:, :end]).astype(jnp.float32) * scale
        logits = logits + c[:, :, start:end, None] - c[:, :, None, :end]
        q_pos = start + jnp.arange(Q_BLOCK)[:, None]
        k_pos = jnp.arange(end)[None, :]
        logits = jnp.where(q_pos >= k_pos, logits, -jnp.inf)
        p = jax.nn.softmax(logits, axis=-1)
        outs.append(jnp.einsum('bhqk,bkhd->bqhd', p.astype(vh.dtype), vh[:, :end]))
    o = jnp.concatenate(outs, axis=1).reshape(B, S, D_INNER)
    return (o.astype(jnp.float32) * jax.nn.silu(gate.astype(jnp.float32))).astype(h.dtype)


def setup_inputs(seed: int = 0) -> dict:
    key = jax.random.key(seed)
    ks = jax.random.split(key, 12)
    f32 = jnp.float32
    x = jax.random.normal(ks[0], (BATCH, SEQ, D_MODEL), f32)
    norm_w = 1.0 + 0.02 * jax.random.normal(ks[1], (DEPTH, D_MODEL), f32)
    w_in_a = jax.random.normal(ks[2], (N_A, D_MODEL, 4 * D_INNER), f32) * D_MODEL ** -0.5
    lb_logits = 0.5 * jax.random.normal(ks[3], (N_A + 1, HGRN_KEY), f32)
    o_norm_a = 1.0 + 0.02 * jax.random.normal(ks[4], (N_A, D_INNER), f32)
    w_out_a = jax.random.normal(ks[5], (N_A, D_INNER, D_MODEL), f32) * D_INNER ** -0.5
    w_in_b = jax.random.normal(ks[6], (N_B, D_MODEL, 4 * D_INNER + N_HEADS), f32) * D_MODEL ** -0.5
    b_f = jax.random.uniform(ks[7], (N_B, N_HEADS), f32, 1.0, 4.0)
    w_out_b = jax.random.normal(ks[8], (N_B, D_INNER, D_MODEL), f32) * D_INNER ** -0.5
    final_norm = 1.0 + 0.02 * jax.random.normal(ks[9], (D_MODEL,), f32)
    return {"x": x, "norm_w": norm_w, "w_in_a": w_in_a, "lb_logits": lb_logits,
            "o_norm_a": o_norm_a, "w_out_a": w_out_a, "w_in_b": w_in_b, "b_f": b_f,
            "w_out_b": w_out_b, "final_norm": final_norm}


def reference(x, norm_w, w_in_a, lb_logits, o_norm_a, w_out_a, w_in_b, b_f, w_out_b, final_norm):
    lower_bounds = jnp.cumsum(jax.nn.softmax(lb_logits.astype(jnp.float32), axis=0), axis=0)
    for i in range(DEPTH):
        h = rms_norm(x, norm_w[i])
        j = i // N_MIXERS
        if i % N_MIXERS == 0:
            y = hgrn2_mixer(h, w_in_a[j], o_norm_a[j], lower_bounds[j])
            x = x + jnp.einsum('bse,ed->bsd', y, w_out_a[j])
        else:
            y = fox_mixer(h, w_in_b[j], b_f[j])
            x = x + jnp.einsum('bse,ed->bsd', y, w_out_b[j])
    return rms_norm(x, final_norm)
```

```cpp
#include <hip/hip_runtime.h>
#include <cstdio>
#include <cstdint>

constexpr int NB = 2, SEQ = 4096, D = 4096, DI = 8192, NH = 64, HD = 128;
constexpr int M = NB * SEQ;
constexpr int LDP = 4 * DI;
constexpr int NWB = 4 * DI + NH;
constexpr float EPS = 1e-6f;
namespace pg8 {
#define PG8_LAS __attribute__((address_space(3)))
typedef unsigned short bf16_t;
typedef short bf16x8 __attribute__((ext_vector_type(8)));
typedef float f32x4 __attribute__((ext_vector_type(4)));
typedef unsigned u32x4 __attribute__((ext_vector_type(4)));
constexpr int BM = 256, BK = 64, HALF = 128, HTB = HALF * BK * 2  , STAGE_BYTES = 8 * HTB, NXCD = 8, WGM = 8;

__host__ __device__ __forceinline__ int lds_byte(int r, int c) { const int st = (r >> 4) * 2 + (c >> 5), rr = r & 15, cc = c & 31, ob = rr * 64 + cc * 2; return st * 1024 + (ob ^ (((ob >> 9) & 1) << 5)); }
__host__ __device__ __forceinline__ void stage_rc(int b, int& R, int& C) { const int st = b / 1024, sb = b % 1024, swz = sb ^ (((sb >> 9) & 1) << 5); R = (st >> 1) * 16 + swz / 64; C = (st & 1) * 32 + (swz % 64) / 2; }
__host__ __device__ __forceinline__ int perm32(int rho) { const int n = rho >> 4, i = rho & 15; return 8 * (i >> 2) + 4 * n + (i & 3); }

struct Unit { int pm, pn; };
struct Gemm { const bf16_t* A; const bf16_t* Bt; int M, N, K, pad; };

struct StaticOrder {
    int nM, nN, nwg, G, c;
    __host__ __device__ void init(int M, int N, int G_, int c_) { nM = M / BM; nN = N / BM; nwg = nM * nN; G = G_; c = c_; }
    __host__ __device__ bool next(int i, Unit& u) const {
        const long L = (long)i * G + c; if (L >= nwg) return false;
        int wgid = (int)L; { const int q = nwg / NXCD, r = nwg % NXCD, xcd = wgid % NXCD, off = wgid / NXCD; wgid = (xcd < r ? xcd * (q + 1) : r * (q + 1) + (xcd - r) * q) + off; }
        const int nig = WGM * nN, gid = wgid / nig, fm = gid * WGM, gsz = (nM - fm) < WGM ? (nM - fm) : WGM;
        u.pm = fm + ((wgid % nig) % gsz); u.pn = (wgid % nig) / gsz; return true;
    }
    __device__ __forceinline__ void a_ready(const Unit&) const {}
    __device__ __forceinline__ void done(const Unit&) const {}
};

__device__ __forceinline__ unsigned cvt_pk_bf16(float lo, float hi) { unsigned r; asm volatile("v_cvt_pk_bf16_f32 %0, %1, %2" : "=v"(r) : "v"(lo), "v"(hi)); return r; }
__device__ __forceinline__ float silu_f(float x) { return x * __builtin_amdgcn_rcpf(1.0f + __builtin_amdgcn_exp2f(-1.4426950408889634f * x)); }

template <int LAYER> struct EpiAct {
    static constexpr bool PERM = true, AFTER_DRAIN = false;
    bf16_t* O; const float* lbl; int ldc, pad;
    __device__ __forceinline__ void operator()(const f32x4 (&acc)[2][2][4][2], const Unit& u, int wr, int wc, int fr, int fq) const {
        const int sec = u.pn >> 5;
        const int row0 = u.pm * BM + wr * 64 + fr, col0 = u.pn * BM + wc * 32 + 8 * fq;
        const int mode = (LAYER == 0) ? ((sec == 0 || sec == 3) ? 1 : (sec == 1 ? 2 : 0)) : (sec == 3 ? 1 : 0);
        if (mode == 2) {
            float lb[2][8], om[2][8];
#pragma unroll
            for (int bj = 0; bj < 2; ++bj) { const int c = col0 + bj * HALF - 8192;
                const f32x4 a0 = *(const f32x4*)(lbl + c), a1 = *(const f32x4*)(lbl + c + 4), b0 = *(const f32x4*)(lbl + 8192 + c), b1 = *(const f32x4*)(lbl + 8192 + c + 4);
#pragma unroll
                for (int e = 0; e < 4; ++e) { const float x0 = __builtin_amdgcn_rcpf(1.0f + __builtin_amdgcn_exp2f(1.4426950408889634f * (b0[e] - a0[e]))), x1 = __builtin_amdgcn_rcpf(1.0f + __builtin_amdgcn_exp2f(1.4426950408889634f * (b1[e] - a1[e])));
                    lb[bj][e] = x0; om[bj][e] = 1.0f - x0; lb[bj][4 + e] = x1; om[bj][4 + e] = 1.0f - x1; } }
#pragma unroll
            for (int ai = 0; ai < 2; ++ai)
#pragma unroll
                for (int m = 0; m < 4; ++m) { bf16_t* rowp = O + (size_t)(row0 + ai * HALF + m * 16) * ldc + col0;
#pragma unroll
                    for (int bj = 0; bj < 2; ++bj) { float v[8];
#pragma unroll
                        for (int e = 0; e < 8; ++e) { const float f = acc[ai][bj][m][e >> 2][e & 3];
                            const float sg = __builtin_amdgcn_rcpf(1.0f + __builtin_amdgcn_exp2f(-1.4426950408889634f * f));
                            v[e] = 0.6931471805599453f * __builtin_amdgcn_logf(lb[bj][e] + om[bj][e] * sg); }
                        u32x4 w; w.x = cvt_pk_bf16(v[0], v[1]); w.y = cvt_pk_bf16(v[2], v[3]); w.z = cvt_pk_bf16(v[4], v[5]); w.w = cvt_pk_bf16(v[6], v[7]);
                        *(u32x4*)(rowp + bj * HALF) = w; } }
        } else if (mode == 1) {
#pragma unroll
            for (int ai = 0; ai < 2; ++ai)
#pragma unroll
                for (int m = 0; m < 4; ++m) { bf16_t* rowp = O + (size_t)(row0 + ai * HALF + m * 16) * ldc + col0;
#pragma unroll
                    for (int bj = 0; bj < 2; ++bj) { float v[8];
#pragma unroll
                        for (int e = 0; e < 8; ++e) v[e] = silu_f(acc[ai][bj][m][e >> 2][e & 3]);
                        u32x4 w; w.x = cvt_pk_bf16(v[0], v[1]); w.y = cvt_pk_bf16(v[2], v[3]); w.z = cvt_pk_bf16(v[4], v[5]); w.w = cvt_pk_bf16(v[6], v[7]);
                        *(u32x4*)(rowp + bj * HALF) = w; } }
        } else {
#pragma unroll
            for (int ai = 0; ai < 2; ++ai)
#pragma unroll
                for (int m = 0; m < 4; ++m) { bf16_t* rowp = O + (size_t)(row0 + ai * HALF + m * 16) * ldc + col0;
#pragma unroll
                    for (int bj = 0; bj < 2; ++bj) { const f32x4 v0 = acc[ai][bj][m][0], v1 = acc[ai][bj][m][1];
                        u32x4 w; w.x = cvt_pk_bf16(v0[0], v0[1]); w.y = cvt_pk_bf16(v0[2], v0[3]); w.z = cvt_pk_bf16(v1[0], v1[1]); w.w = cvt_pk_bf16(v1[2], v1[3]);
                        *(u32x4*)(rowp + bj * HALF) = w; } }
        }
    }
};
struct EpiRes {
    static constexpr bool PERM = false, AFTER_DRAIN = false;
    const float* base; float* out; int ldc, pad;
    __device__ __forceinline__ void operator()(const f32x4 (&acc)[2][2][4][2], const Unit& u, int wr, int wc, int fr, int fq) const {
        const int row0 = u.pm * BM + wr * 64 + fr, col0 = u.pn * BM + wc * 32 + 4 * fq;
#pragma unroll
        for (int ai = 0; ai < 2; ++ai)
#pragma unroll
            for (int m = 0; m < 4; ++m) { const size_t off = (size_t)(row0 + ai * HALF + m * 16) * ldc + col0;
#pragma unroll
                for (int bj = 0; bj < 2; ++bj)
#pragma unroll
                    for (int n = 0; n < 2; ++n) { const f32x4 bs = *(const f32x4*)(base + off + bj * HALF + n * 16); *(f32x4*)(out + off + bj * HALF + n * 16) = bs + acc[ai][bj][m][n]; }
                asm volatile("" ::: "memory"); }
    }
};
template <class Epi, class Sched, bool ALIGN_EPI = false, bool SP2 = false>
__device__ __forceinline__ void gemm_phase(PG8_LAS unsigned char* lds, const Gemm g, const Sched& S, const Epi& E) {
    const int tid = threadIdx.x, wid = __builtin_amdgcn_readfirstlane(tid >> 6), lane = tid & 63, wr = wid >> 2, wc = wid & 3, fr = lane & 15, fq = lane >> 4;
    const int K = g.K, nt = K / BK;
    unsigned voffA[2], voffB[2];
#pragma unroll
    for (int i = 0; i < 2; ++i) { int R, C; stage_rc(tid * 16 + i * 8192, R, C); const int Rb = Epi::PERM ? ((R & ~31) + perm32(R & 31)) : R;
        voffA[i] = (unsigned)(R * K + C) * 2u; voffB[i] = (unsigned)(Rb * K + C) * 2u; }
    const size_t kstep = (size_t)(BK * 2);
    const size_t hstep = (size_t)HALF * K * 2;
    const size_t tstep = 2 * hstep;
    const unsigned ldsw = (unsigned)wid * 1024u;
    const int aoff = lds_byte(wr * 64 + fr, fq * 8), boff = lds_byte(wc * 32 + fr, fq * 8);
#define PG8_SA(b, h) (((b) * 2 + (h)) * HTB)
#define PG8_SB(b, h) ((4 + (b) * 2 + (h)) * HTB)
#define PG8_STAGE(bufoff, gbase, voff) do { _Pragma("unroll") for (int _i = 0; _i < 2; ++_i) \
        __builtin_amdgcn_global_load_lds((const unsigned*)((const char*)(gbase) + (voff)[_i]), (PG8_LAS unsigned*)(lds + (bufoff) + ldsw + _i * 8192), 16, 0, 0); } while (0)
#define PG8_LDA(dst, b, h) do { _Pragma("unroll") for (int m = 0; m < 4; ++m) _Pragma("unroll") for (int k = 0; k < 2; ++k) dst[m][k] = *(const PG8_LAS bf16x8*)(lds + PG8_SA(b, h) + aoff + m * 2048 + k * 1024); } while (0)
#define PG8_LDB(dst, b, h) do { _Pragma("unroll") for (int n = 0; n < 2; ++n) _Pragma("unroll") for (int k = 0; k < 2; ++k) dst[n][k] = *(const PG8_LAS bf16x8*)(lds + PG8_SB(b, h) + boff + n * 2048 + k * 1024); } while (0)
#define PG8_MMA(ai, bj, At, Bt) do { __builtin_amdgcn_s_setprio(1); _Pragma("unroll") for (int m = 0; m < 4; ++m) _Pragma("unroll") for (int n = 0; n < 2; ++n) _Pragma("unroll") for (int k = 0; k < 2; ++k) \
        acc[ai][bj][m][n] = __builtin_amdgcn_mfma_f32_16x16x32_bf16(Bt[n][k], At[m][k], acc[ai][bj][m][n], 0, 0, 0); __builtin_amdgcn_s_setprio(0); } while (0)
#define PG8_WAIT_V(n) asm volatile("s_waitcnt vmcnt(" #n ")" ::: "memory")
#define PG8_WAIT_L(n) asm volatile("s_waitcnt lgkmcnt(" #n ")" ::: "memory")
#define PG8_BAR __builtin_amdgcn_s_barrier()
#define PG8_SCHED __builtin_amdgcn_sched_barrier(0)
    Unit cur, nxt; int ui = 0;
    if (!S.next(0, cur)) return;
    f32x4 acc[2][2][4][2];
#pragma unroll
    for (int a = 0; a < 2; ++a)
#pragma unroll
        for (int b = 0; b < 2; ++b)
#pragma unroll
            for (int m = 0; m < 4; ++m)
#pragma unroll
                for (int n = 0; n < 2; ++n) acc[a][b][m][n] = (f32x4){0.f, 0.f, 0.f, 0.f};
    bf16x8 At[4][2], B0[2][2], B1[2][2];
    const char* cA = (const char*)g.A + (size_t)cur.pm * tstep; const char* cB = (const char*)g.Bt + (size_t)cur.pn * tstep;
    S.a_ready(cur);
    if constexpr (SP2) {
        PG8_STAGE(PG8_SB(0, 0), cB, voffB); PG8_STAGE(PG8_SB(0, 1), cB + hstep, voffB); PG8_STAGE(PG8_SA(0, 0), cA, voffA); PG8_STAGE(PG8_SA(0, 1), cA + hstep, voffA);
        if (wr == 1) PG8_BAR;
        PG8_WAIT_V(2); PG8_BAR;
        PG8_STAGE(PG8_SB(1, 0), cB + kstep, voffB); PG8_STAGE(PG8_SA(1, 0), cA + kstep, voffA); PG8_STAGE(PG8_SB(1, 1), cB + hstep + kstep, voffB);
        PG8_WAIT_V(6); PG8_BAR;
    } else {
        PG8_STAGE(PG8_SB(0, 0), cB, voffB); PG8_STAGE(PG8_SA(0, 0), cA, voffA); PG8_STAGE(PG8_SB(0, 1), cB + hstep, voffB); PG8_STAGE(PG8_SA(0, 1), cA + hstep, voffA);
        if (wr == 1) PG8_BAR;
        PG8_WAIT_V(4); PG8_BAR;
        PG8_STAGE(PG8_SB(1, 0), cB + kstep, voffB); PG8_STAGE(PG8_SA(1, 0), cA + kstep, voffA); PG8_STAGE(PG8_SB(1, 1), cB + hstep + kstep, voffB);
        PG8_WAIT_V(6); PG8_BAR;
    }
    for (;;) {
        const bool has_next = S.next(ui + 1, nxt);
        const char* nA = has_next ? (const char*)g.A + (size_t)nxt.pm * tstep : cA; const char* nB = has_next ? (const char*)g.Bt + (size_t)nxt.pn * tstep : cB;
        for (int t = 0; t < nt; t += 2) {
            const bool last = (t == nt - 2);
            const char* a1 = cA + (size_t)(t + 1) * kstep;
            const char* a2 = last ? nA : cA + (size_t)(t + 2) * kstep; const char* b2 = last ? nB : cB + (size_t)(t + 2) * kstep;
            const char* a3 = a2 + kstep; const char* b3 = b2 + kstep;
            if (last && has_next) S.a_ready(nxt);
            if constexpr (SP2) {
            PG8_LDB(B0, 0, 0); PG8_LDB(B1, 0, 1); PG8_SCHED; PG8_LDA(At, 0, 0); PG8_STAGE(PG8_SA(1, 1), a1 + hstep, voffA);
            PG8_WAIT_V(8); PG8_WAIT_L(0); PG8_BAR; PG8_MMA(0, 0, At, B0); PG8_MMA(0, 1, At, B1); PG8_BAR; PG8_SCHED;
            PG8_LDA(At, 0, 1); PG8_STAGE(PG8_SB(0, 0), b2, voffB); PG8_STAGE(PG8_SB(0, 1), b2 + hstep, voffB); PG8_STAGE(PG8_SA(0, 0), a2, voffA);
            PG8_WAIT_V(8); PG8_WAIT_L(0); PG8_BAR; PG8_MMA(1, 0, At, B0); PG8_MMA(1, 1, At, B1); PG8_BAR; PG8_SCHED;
            PG8_LDB(B0, 1, 0); PG8_LDB(B1, 1, 1); PG8_SCHED; PG8_LDA(At, 1, 0); PG8_STAGE(PG8_SA(0, 1), a2 + hstep, voffA);
            PG8_WAIT_V(8); PG8_WAIT_L(0); PG8_BAR; PG8_MMA(0, 0, At, B0); PG8_MMA(0, 1, At, B1); PG8_BAR; PG8_SCHED;
            PG8_LDA(At, 1, 1); PG8_STAGE(PG8_SB(1, 0), b3, voffB); PG8_STAGE(PG8_SB(1, 1), b3 + hstep, voffB); PG8_STAGE(PG8_SA(1, 0), a3, voffA);
            PG8_WAIT_V(8); PG8_WAIT_L(0); PG8_BAR; PG8_MMA(1, 0, At, B0); PG8_MMA(1, 1, At, B1); PG8_BAR; PG8_SCHED;
            } else {
            PG8_LDB(B0, 0, 0); PG8_SCHED; PG8_LDA(At, 0, 0); PG8_STAGE(PG8_SA(1, 1), a1 + hstep, voffA);
            PG8_WAIT_L(8); PG8_BAR; PG8_WAIT_L(0); PG8_MMA(0, 0, At, B0); PG8_BAR; PG8_SCHED;
            PG8_LDB(B1, 0, 1); PG8_STAGE(PG8_SB(0, 0), b2, voffB);
            PG8_BAR; PG8_WAIT_L(0); PG8_MMA(0, 1, At, B1); PG8_BAR;
            PG8_LDA(At, 0, 1); PG8_STAGE(PG8_SA(0, 0), a2, voffA);
            PG8_BAR; PG8_WAIT_L(0); PG8_MMA(1, 0, At, B0); PG8_BAR; PG8_SCHED;
            PG8_STAGE(PG8_SB(0, 1), b2 + hstep, voffB);
            PG8_WAIT_V(6); PG8_BAR; PG8_MMA(1, 1, At, B1); PG8_BAR;
            PG8_LDB(B0, 1, 0); PG8_SCHED; PG8_LDA(At, 1, 0); PG8_STAGE(PG8_SA(0, 1), a2 + hstep, voffA);
            PG8_WAIT_L(8); PG8_BAR; PG8_WAIT_L(0); PG8_MMA(0, 0, At, B0); PG8_BAR; PG8_SCHED;
            PG8_LDB(B1, 1, 1); PG8_STAGE(PG8_SB(1, 0), b3, voffB);
            PG8_BAR; PG8_WAIT_L(0); PG8_MMA(0, 1, At, B1); PG8_BAR;
            PG8_LDA(At, 1, 1); PG8_STAGE(PG8_SA(1, 0), a3, voffA);
            PG8_BAR; PG8_WAIT_L(0); PG8_MMA(1, 0, At, B0); PG8_BAR; PG8_SCHED;
            PG8_STAGE(PG8_SB(1, 1), b3 + hstep, voffB);
            PG8_WAIT_V(6); PG8_BAR; PG8_MMA(1, 1, At, B1); PG8_BAR;
            }
        }
        if constexpr (ALIGN_EPI) { if (wr == 0) PG8_BAR; }
        if constexpr (!Epi::AFTER_DRAIN) { E(acc, cur, wr, wc, fr, fq); S.done(cur); }
        if (!has_next) break;
#pragma unroll
        for (int a = 0; a < 2; ++a)
#pragma unroll
            for (int b = 0; b < 2; ++b)
#pragma unroll
                for (int m = 0; m < 4; ++m)
#pragma unroll
                    for (int n = 0; n < 2; ++n) acc[a][b][m][n] = (f32x4){0.f, 0.f, 0.f, 0.f};
        cur = nxt; cA = nA; cB = nB; ++ui;
        if constexpr (ALIGN_EPI) { if (wr == 1) PG8_BAR; }
    }
    PG8_WAIT_V(0);
    if constexpr (!ALIGN_EPI) { if (wr == 0) PG8_BAR; }
    PG8_BAR;
    if constexpr (Epi::AFTER_DRAIN) { E.fused(acc, cur, wr, wc, fr, fq, lds, wid, lane); S.done(cur); }
#undef PG8_SA
#undef PG8_SB
#undef PG8_STAGE
#undef PG8_LDA
#undef PG8_LDB
#undef PG8_MMA
#undef PG8_WAIT_V
#undef PG8_WAIT_L
#undef PG8_BAR
#undef PG8_SCHED
}
}

#define LAS __attribute__((address_space(3)))
typedef unsigned short bf16;
typedef unsigned v4u __attribute__((ext_vector_type(4)));
typedef unsigned v2u __attribute__((ext_vector_type(2)));
typedef float f32x4 __attribute__((ext_vector_type(4)));
__device__ __forceinline__ unsigned pk2(float lo, float hi) { unsigned r; asm volatile("v_cvt_pk_bf16_f32 %0, %1, %2" : "=v"(r) : "v"(lo), "v"(hi)); return r; }
__device__ __forceinline__ float bf2f(unsigned short b) { return __uint_as_float(((unsigned)b) << 16); }
__device__ __forceinline__ float bflo(unsigned w) { return __uint_as_float(w << 16); }
__device__ __forceinline__ float bfhi(unsigned w) { return __uint_as_float(w & 0xffff0000u); }
__device__ __forceinline__ float wave_sum(float v) {
#pragma unroll
    for (int o = 1; o < 64; o <<= 1) v += __shfl_xor(v, o);
    return v;
}
__device__ __forceinline__ float wave_max(float v) {
#pragma unroll
    for (int o = 1; o < 64; o <<= 1) v = fmaxf(v, __shfl_xor(v, o));
    return v;
}

__device__ __forceinline__ void transpose_tile(const float* W, size_t ldw, int K, int k0, int n0, bf16* WT, int nbase, LAS unsigned* scr, int lane) {
    const int g = lane & 15, ks = lane >> 4;
#pragma unroll
    for (int i = 0; i < 8; ++i) {
        const int k = k0 + 8 * i + 2 * ks;
        const f32x4 a = *(const f32x4*)(W + (size_t)k * ldw + n0 + 4 * g), b = *(const f32x4*)(W + (size_t)(k + 1) * ldw + n0 + 4 * g);
#pragma unroll
        for (int j = 0; j < 4; ++j) scr[(4 * g + j) * 33 + 4 * i + ks] = pk2(a[j], b[j]);
    }
    asm volatile("s_waitcnt lgkmcnt(0)" ::: "memory");
    const int c = lane & 7;
#pragma unroll
    for (int r = 0; r < 8; ++r) { const int n = 8 * r + (lane >> 3);
        v4u o; o.x = scr[n * 33 + 4 * c]; o.y = scr[n * 33 + 4 * c + 1]; o.z = scr[n * 33 + 4 * c + 2]; o.w = scr[n * 33 + 4 * c + 3];
        *(v4u*)(WT + (size_t)(n0 - nbase + n) * K + k0 + 8 * c) = o; }
    asm volatile("s_waitcnt lgkmcnt(0)" ::: "memory");
}
__device__ __forceinline__ void rms_row_bf16(const float* xrow, const float* w, bf16* orow, int lane) {
    const f32x4* xr = (const f32x4*)xrow + lane; const f32x4* wr = (const f32x4*)w + lane;
    f32x4 v[16]; float s = 0.f;
#pragma unroll
    for (int j = 0; j < 16; ++j) { v[j] = xr[64 * j]; s += (v[j].x * v[j].x + v[j].y * v[j].y) + (v[j].z * v[j].z + v[j].w * v[j].w); }
    const float rs = 1.0f / sqrtf(wave_sum(s) * (1.0f / D) + EPS);
    v2u* o8 = (v2u*)orow + lane;
#pragma unroll
    for (int j = 0; j < 16; ++j) { const f32x4 g = wr[64 * j]; v2u o; o.x = pk2(v[j].x * rs * g.x, v[j].y * rs * g.y); o.y = pk2(v[j].z * rs * g.z, v[j].w * rs * g.w); o8[64 * j] = o; }
}
__device__ __forceinline__ void rms_row_f32(const float* xrow, const float* w, float* orow, int lane) {
    const f32x4* xr = (const f32x4*)xrow + lane; const f32x4* wr = (const f32x4*)w + lane;
    f32x4 v[16]; float s = 0.f;
#pragma unroll
    for (int j = 0; j < 16; ++j) { v[j] = xr[64 * j]; s += (v[j].x * v[j].x + v[j].y * v[j].y) + (v[j].z * v[j].z + v[j].w * v[j].w); }
    const float rs = 1.0f / sqrtf(wave_sum(s) * (1.0f / D) + EPS);
    f32x4* o = (f32x4*)orow + lane;
#pragma unroll
    for (int j = 0; j < 16; ++j) { const f32x4 g = wr[64 * j]; o[64 * j] = (f32x4){v[j].x * rs * g.x, v[j].y * rs * g.y, v[j].z * rs * g.z, v[j].w * rs * g.w}; }
}

constexpr size_t MiB = 1u << 20;
constexpr size_t WS_CTL = 0;
constexpr size_t WS_WA  = 1 * MiB;
constexpr size_t WS_WB  = WS_WA + 256 * MiB;
constexpr size_t WS_WF  = WS_WB + 256 * MiB;
constexpr size_t WS_WOA = WS_WF + 1 * MiB;
constexpr size_t WS_WOB = WS_WOA + 64 * MiB;
constexpr size_t WS_HB  = WS_WOB + 64 * MiB;
constexpr size_t WS_X1  = WS_HB + 64 * MiB;
constexpr size_t WS_P   = WS_X1 + 128 * MiB;
constexpr size_t WS_Y   = WS_P + 512 * MiB;
constexpr size_t WS_LS  = WS_Y + 128 * MiB;
constexpr size_t WS_C   = WS_LS + 2 * MiB;
constexpr size_t WS_END = WS_C + 2 * MiB;

__device__ __forceinline__ void prologue_phase(LAS unsigned char* lds, const float* x, const float* norm_w, const float* w_in_a, const float* w_out_a, const float* w_in_b, const float* w_out_b,
                                               unsigned char* ws, int vcu, int G, int wave, int lane) {
    LAS unsigned* scr = (LAS unsigned*)(lds + wave * 8448);
    const int gw = vcu * 8 + wave, NGW = G * 8;
    bf16* WA = (bf16*)(ws + WS_WA); bf16* WB = (bf16*)(ws + WS_WB); bf16* WF = (bf16*)(ws + WS_WF); bf16* WOA = (bf16*)(ws + WS_WOA); bf16* WOB = (bf16*)(ws + WS_WOB);
    constexpr int T_IN = (D / 64) * (LDP / 64);
    constexpr int T_F = (D / 64) * 1;
    constexpr int T_OUT = (DI / 64) * (D / 64);
    constexpr int NT = 2 * T_IN + T_F + 2 * T_OUT;
    for (int it = gw; it < NT; it += NGW) {
        int r = it;
        if (r < T_IN) { const int kb = r / (LDP / 64), nb = r % (LDP / 64); transpose_tile(w_in_a, LDP, D, kb * 64, nb * 64, WA, 0, scr, lane); continue; } r -= T_IN;
        if (r < T_IN) { const int kb = r / (LDP / 64), nb = r % (LDP / 64); transpose_tile(w_in_b, NWB, D, kb * 64, nb * 64, WB, 0, scr, lane); continue; } r -= T_IN;
        if (r < T_F) { transpose_tile(w_in_b, NWB, D, r * 64, LDP, WF, LDP, scr, lane); continue; } r -= T_F;
        if (r < T_OUT) { const int kb = r / (D / 64), nb = r % (D / 64); transpose_tile(w_out_a, D, DI, kb * 64, nb * 64, WOA, 0, scr, lane); continue; } r -= T_OUT;
        { const int kb = r / (D / 64), nb = r % (D / 64); transpose_tile(w_out_b, D, DI, kb * 64, nb * 64, WOB, 0, scr, lane); }
    }
    bf16* HB = (bf16*)(ws + WS_HB);
    for (int m = gw; m < M; m += NGW) rms_row_bf16(x + (size_t)m * D, norm_w, HB + (size_t)m * D, lane);
}

__global__ void __launch_bounds__(512, 2) k_prologue(const float* x, const float* norm_w, const float* w_in_a, const float* w_out_a, const float* w_in_b, const float* w_out_b, unsigned char* ws) {
    extern __shared__ __attribute__((aligned(16))) unsigned char shm[];
    const int tid = threadIdx.x;
    prologue_phase((LAS unsigned char*)shm, x, norm_w, w_in_a, w_out_a, w_in_b, w_out_b, ws, blockIdx.x, gridDim.x, tid >> 6, tid & 63);
}
__global__ void __launch_bounds__(512, 2) k_norm_bf16(const float* X, const float* w, bf16* H) {
    const int gw = blockIdx.x * 8 + (threadIdx.x >> 6), NGW = gridDim.x * 8, lane = threadIdx.x & 63;
    for (int m = gw; m < M; m += NGW) rms_row_bf16(X + (size_t)m * D, w, H + (size_t)m * D, lane);
}
__global__ void __launch_bounds__(512, 2) k_norm_f32(float* X, const float* w) {
    const int gw = blockIdx.x * 8 + (threadIdx.x >> 6), NGW = gridDim.x * 8, lane = threadIdx.x & 63;
    for (int m = gw; m < M; m += NGW) rms_row_f32(X + (size_t)m * D, w, X + (size_t)m * D, lane);
}
template <class Epi> __global__ void __launch_bounds__(512, 2) k_gemm(pg8::Gemm g, Epi E) {
    extern __shared__ __attribute__((aligned(16))) unsigned char shm[];
    pg8::StaticOrder S; S.init(g.M, g.N, (int)gridDim.x, (int)blockIdx.x);
    pg8::gemm_phase<Epi, pg8::StaticOrder, true, true>((PG8_LAS unsigned char*)shm, g, S, E);
}

__global__ void __launch_bounds__(512, 2) k_scan_naive(const bf16* P, const float* onw, bf16* Y) {
    __shared__ float sq[128], sf[128], sk[128], sv[128], sg[128], so[4][128], sred[8];
    const int bh = blockIdx.x, b = bh / NH, h = bh % NH, tid = threadIdx.x, c = tid & 127, p = tid >> 7;
    float S[32];
#pragma unroll
    for (int i = 0; i < 32; ++i) S[i] = 0.f;
    const float gain = onw[h * HD + c];
    for (int t = 0; t < SEQ; ++t) {
        const bf16* row = P + (size_t)(b * SEQ + t) * LDP + h * HD;
        if (p == 0) { sq[c] = bf2f(row[c]); const float lf = bf2f(row[DI + c]); const float f = __expf(lf); sf[c] = f; sk[c] = 1.0f - f; }
        else if (p == 1) { sv[c] = bf2f(row[2 * DI + c]); sg[c] = bf2f(row[3 * DI + c]); }
        __syncthreads();
        const float v = sv[c]; float o = 0.f;
#pragma unroll
        for (int i = 0; i < 32; ++i) { const int dk = p * 32 + i; S[i] = sf[dk] * S[i] + sk[dk] * v; o += sq[dk] * S[i]; }
        so[p][c] = o;
        __syncthreads();
        if (p == 0) {
            const float ot = (so[0][c] + so[1][c]) + (so[2][c] + so[3][c]);
            const float ss = wave_sum(ot * ot);
            if ((tid & 63) == 0) sred[tid >> 6] = ss;
            so[0][c] = ot;
        }
        __syncthreads();
        if (p == 0) {
            const float tot = sred[0] + sred[1];
            const float rs = 1.0f / sqrtf(tot * (1.0f / HD) + EPS);
            const float y = so[0][c] * rs * gain * sg[c];
            Y[(size_t)(b * SEQ + t) * DI + h * HD + c] = (bf16)(pk2(y, 0.f) & 0xffffu);
        }
        __syncthreads();
    }
}
__global__ void __launch_bounds__(256) k_flogit_naive(const bf16* HB, const bf16* WF, const float* b_f, float* LS) {
    const int row = blockIdx.x * 4 + (threadIdx.x >> 6), lane = threadIdx.x & 63;
    const v4u* a = (const v4u*)(HB + (size_t)row * D); const v4u* w = (const v4u*)(WF + (size_t)lane * D);
    float acc = 0.f;
    for (int i = 0; i < D / 8; ++i) { const v4u av = a[i], wv = w[i];
        acc += bflo(av.x) * bflo(wv.x) + bfhi(av.x) * bfhi(wv.x) + bflo(av.y) * bflo(wv.y) + bfhi(av.y) * bfhi(wv.y)
             + bflo(av.z) * bflo(wv.z) + bfhi(av.z) * bfhi(wv.z) + bflo(av.w) * bflo(wv.w) + bfhi(av.w) * bfhi(wv.w); }
    const float z = acc + b_f[lane];
    const float ls = fminf(z, 0.f) - log1pf(__expf(-fabsf(z)));
    const int b = row / SEQ, s = row % SEQ;
    LS[((size_t)b * NH + lane) * SEQ + s] = ls;
}
__global__ void __launch_bounds__(64) k_cumsum_naive(const float* LS, float* C) {
    const int bh = blockIdx.x, lane = threadIdx.x;
    const float* src = LS + (size_t)bh * SEQ; float* dst = C + (size_t)bh * SEQ;
    float run = 0.f;
    for (int i0 = 0; i0 < SEQ; i0 += 64) {
        float v = src[i0 + lane];
#pragma unroll
        for (int o = 1; o < 64; o <<= 1) { const float t = __shfl_up(v, o); if (lane >= o) v += t; }
        dst[i0 + lane] = run + v;
        run += __shfl(v, 63);
    }
}
__global__ void __launch_bounds__(256) k_attn_naive(const bf16* P, const float* C, bf16* Y) {
    const int wv = threadIdx.x >> 6, lane = threadIdx.x & 63;
    const int gr = blockIdx.x * 4 + wv;
    const int bh = gr / SEQ, t = gr % SEQ, b = bh / NH, h = bh % NH;
    const bf16* qrow = P + (size_t)(b * SEQ + t) * LDP + h * HD;
    float q[HD];
#pragma unroll
    for (int i = 0; i < HD / 8; ++i) { const v4u w = ((const v4u*)qrow)[i]; q[8 * i] = bflo(w.x); q[8 * i + 1] = bfhi(w.x); q[8 * i + 2] = bflo(w.y); q[8 * i + 3] = bfhi(w.y); q[8 * i + 4] = bflo(w.z); q[8 * i + 5] = bfhi(w.z); q[8 * i + 6] = bflo(w.w); q[8 * i + 7] = bfhi(w.w); }
    const float* cc = C + (size_t)bh * SEQ; const float ct = cc[t];
    float m = -1e30f, l = 0.f, o0 = 0.f, o1 = 0.f;
    const float scale = 0.08838834764831845f;
    for (int k0 = 0; k0 <= t; k0 += 64) {
        const int key = k0 + lane;
        float s = -__builtin_inff();
        if (key <= t) {
            const v4u* kr = (const v4u*)(P + (size_t)(b * SEQ + key) * LDP + DI + h * HD);
            float acc = 0.f;
#pragma unroll
            for (int i = 0; i < HD / 8; ++i) { const v4u w = kr[i];
                acc += q[8 * i] * bflo(w.x) + q[8 * i + 1] * bfhi(w.x) + q[8 * i + 2] * bflo(w.y) + q[8 * i + 3] * bfhi(w.y) + q[8 * i + 4] * bflo(w.z) + q[8 * i + 5] * bfhi(w.z) + q[8 * i + 6] * bflo(w.w) + q[8 * i + 7] * bfhi(w.w); }
            s = acc * scale + ct - cc[key];
        }
        const float mn = fmaxf(m, wave_max(s));
        const float alpha = __expf(m - mn), pr = __expf(s - mn);
        l = l * alpha + wave_sum(pr); o0 *= alpha; o1 *= alpha; m = mn;
        const int nk = (t - k0 + 1) < 64 ? (t - k0 + 1) : 64;
        for (int j = 0; j < nk; ++j) { const float pj = __shfl(pr, j);
            const unsigned w = *(const unsigned*)(P + (size_t)(b * SEQ + k0 + j) * LDP + 2 * DI + h * HD + 2 * lane);
            o0 += pj * bflo(w); o1 += pj * bfhi(w); }
    }
    const unsigned gw = *(const unsigned*)(P + (size_t)(b * SEQ + t) * LDP + 3 * DI + h * HD + 2 * lane);
    const float inv = 1.0f / l;
    *(unsigned*)(Y + (size_t)(b * SEQ + t) * DI + h * HD + 2 * lane) = pk2(o0 * inv * bflo(gw), o1 * inv * bfhi(gw));
}

extern "C" void kernel_launch(void* const* d_in, const int* in_sizes, int n_in, void* d_out, int out_size, void* d_ws, size_t ws_size, hipStream_t stream) {
    if (n_in != 10 || in_sizes[0] != M * D || out_size != M * D || ws_size < WS_END) { fprintf(stderr, "kernel_launch: unexpected shapes (n_in %d, in0 %d, out %d, ws %zu < %zu)\n", n_in, n_in > 0 ? in_sizes[0] : -1, out_size, ws_size, (size_t)WS_END); return; }
    const float* x = (const float*)d_in[0]; const float* norm_w = (const float*)d_in[1]; const float* w_in_a = (const float*)d_in[2]; const float* lb_logits = (const float*)d_in[3];
    const float* o_norm_a = (const float*)d_in[4]; const float* w_out_a = (const float*)d_in[5]; const float* w_in_b = (const float*)d_in[6]; const float* b_f = (const float*)d_in[7];
    const float* w_out_b = (const float*)d_in[8]; const float* final_norm = (const float*)d_in[9];
    unsigned char* ws = (unsigned char*)d_ws; float* out = (float*)d_out;
    bf16* WA = (bf16*)(ws + WS_WA); bf16* WB = (bf16*)(ws + WS_WB); bf16* WF = (bf16*)(ws + WS_WF); bf16* WOA = (bf16*)(ws + WS_WOA); bf16* WOB = (bf16*)(ws + WS_WOB);
    bf16* HB = (bf16*)(ws + WS_HB); float* X1 = (float*)(ws + WS_X1); bf16* P = (bf16*)(ws + WS_P); bf16* Y = (bf16*)(ws + WS_Y); float* LS = (float*)(ws + WS_LS); float* C = (float*)(ws + WS_C);
    static bool attr = false;
    if (!attr) { attr = true;
        (void)hipFuncSetAttribute((const void*)k_prologue, hipFuncAttributeMaxDynamicSharedMemorySize, 8 * 8448);
        (void)hipFuncSetAttribute((const void*)k_gemm<pg8::EpiAct<0>>, hipFuncAttributeMaxDynamicSharedMemorySize, pg8::STAGE_BYTES);
        (void)hipFuncSetAttribute((const void*)k_gemm<pg8::EpiAct<1>>, hipFuncAttributeMaxDynamicSharedMemorySize, pg8::STAGE_BYTES);
        (void)hipFuncSetAttribute((const void*)k_gemm<pg8::EpiRes>, hipFuncAttributeMaxDynamicSharedMemorySize, pg8::STAGE_BYTES); }
    const int G = 256;
    hipLaunchKernelGGL(k_prologue, dim3(G), dim3(512), 8 * 8448, stream, x, norm_w, w_in_a, w_out_a, w_in_b, w_out_b, ws);
    { pg8::Gemm g{HB, WA, M, LDP, D, 0}; pg8::EpiAct<0> E{P, lb_logits, LDP, 0}; hipLaunchKernelGGL((k_gemm<pg8::EpiAct<0>>), dim3(G), dim3(512), pg8::STAGE_BYTES, stream, g, E); }
    hipLaunchKernelGGL(k_scan_naive, dim3(NB * NH), dim3(512), 0, stream, (const bf16*)P, o_norm_a, Y);
    { pg8::Gemm g{Y, WOA, M, D, DI, 0}; pg8::EpiRes E{x, X1, D, 0}; hipLaunchKernelGGL((k_gemm<pg8::EpiRes>), dim3(G), dim3(512), pg8::STAGE_BYTES, stream, g, E); }
    hipLaunchKernelGGL(k_norm_bf16, dim3(G), dim3(512), 0, stream, (const float*)X1, norm_w + D, HB);
    { pg8::Gemm g{HB, WB, M, LDP, D, 0}; pg8::EpiAct<1> E{P, nullptr, LDP, 0}; hipLaunchKernelGGL((k_gemm<pg8::EpiAct<1>>), dim3(G), dim3(512), pg8::STAGE_BYTES, stream, g, E); }
    hipLaunchKernelGGL(k_flogit_naive, dim3(M / 4), dim3(256), 0, stream, (const bf16*)HB, (const bf16*)WF, b_f, LS);
    hipLaunchKernelGGL(k_cumsum_naive, dim3(NB * NH), dim3(64), 0, stream, (const float*)LS, C);
    hipLaunchKernelGGL(k_attn_naive, dim3(NB * NH * SEQ / 4), dim3(256), 0, stream, (const bf16*)P, (const float*)C, Y);
    { pg8::Gemm g{Y, WOB, M, D, DI, 0}; pg8::EpiRes E{X1, out, D, 0}; hipLaunchKernelGGL((k_gemm<pg8::EpiRes>), dim3(G), dim3(512), pg8::STAGE_BYTES, stream, g, E); }
    hipLaunchKernelGGL(k_norm_f32, dim3(G), dim3(512), 0, stream, out, final_norm);
}
```

```cpp
#include <hip/hip_runtime.h>
#include <cstdio>
#include <cstdint>

constexpr int NB = 2, SEQ = 4096, D = 4096, DI = 8192, NH = 64, HD = 128;
constexpr int M = NB * SEQ;
constexpr int LDP = 4 * DI;
constexpr int NWB = 4 * DI + NH;
constexpr float EPS = 1e-6f;
namespace pg8 {
#define PG8_LAS __attribute__((address_space(3)))
typedef unsigned short bf16_t;
typedef short bf16x8 __attribute__((ext_vector_type(8)));
typedef float f32x4 __attribute__((ext_vector_type(4)));
typedef unsigned u32x4 __attribute__((ext_vector_type(4)));
constexpr int BM = 256, BK = 64, HALF = 128, HTB = HALF * BK * 2  , STAGE_BYTES = 8 * HTB, NXCD = 8, WGM = 8;

__host__ __device__ __forceinline__ int lds_byte(int r, int c) { const int st = (r >> 4) * 2 + (c >> 5), rr = r & 15, cc = c & 31, ob = rr * 64 + cc * 2; return st * 1024 + (ob ^ (((ob >> 9) & 1) << 5)); }
__host__ __device__ __forceinline__ void stage_rc(int b, int& R, int& C) { const int st = b / 1024, sb = b % 1024, swz = sb ^ (((sb >> 9) & 1) << 5); R = (st >> 1) * 16 + swz / 64; C = (st & 1) * 32 + (swz % 64) / 2; }
__host__ __device__ __forceinline__ int perm32(int rho) { const int n = rho >> 4, i = rho & 15; return 8 * (i >> 2) + 4 * n + (i & 3); }

struct Unit { int pm, pn; };
struct Gemm { const bf16_t* A; const bf16_t* Bt; int M, N, K, pad; };

struct StaticOrder {
    int nM, nN, nwg, G, c;
    __host__ __device__ void init(int M, int N, int G_, int c_) { nM = M / BM; nN = N / BM; nwg = nM * nN; G = G_; c = c_; }
    __host__ __device__ bool next(int i, Unit& u) const {
        const long L = (long)i * G + c; if (L >= nwg) return false;
        int wgid = (int)L; { const int q = nwg / NXCD, r = nwg % NXCD, xcd = wgid % NXCD, off = wgid / NXCD; wgid = (xcd < r ? xcd * (q + 1) : r * (q + 1) + (xcd - r) * q) + off; }
        const int nig = WGM * nN, gid = wgid / nig, fm = gid * WGM, gsz = (nM - fm) < WGM ? (nM - fm) : WGM;
        u.pm = fm + ((wgid % nig) % gsz); u.pn = (wgid % nig) / gsz; return true;
    }
    __device__ __forceinline__ void a_ready(const Unit&) const {}
    __device__ __forceinline__ void done(const Unit&) const {}
};

__device__ __forceinline__ unsigned cvt_pk_bf16(float lo, float hi) { unsigned r; asm volatile("v_cvt_pk_bf16_f32 %0, %1, %2" : "=v"(r) : "v"(lo), "v"(hi)); return r; }
__device__ __forceinline__ float silu_f(float x) { return x * __builtin_amdgcn_rcpf(1.0f + __builtin_amdgcn_exp2f(-1.4426950408889634f * x)); }

template <int LAYER> struct EpiAct {
    static constexpr bool PERM = true, AFTER_DRAIN = false;
    bf16_t* O; const float* lbl; int ldc, pad;
    __device__ __forceinline__ void operator()(const f32x4 (&acc)[2][2][4][2], const Unit& u, int wr, int wc, int fr, int fq) const {
        const int sec = u.pn >> 5;
        const int row0 = u.pm * BM + wr * 64 + fr, col0 = u.pn * BM + wc * 32 + 8 * fq;
        const int mode = (LAYER == 0) ? ((sec == 0 || sec == 3) ? 1 : (sec == 1 ? 2 : 0)) : (sec == 3 ? 1 : 0);
        if (mode == 2) {
            float lb[2][8], om[2][8];
#pragma unroll
            for (int bj = 0; bj < 2; ++bj) { const int c = col0 + bj * HALF - 8192;
                const f32x4 a0 = *(const f32x4*)(lbl + c), a1 = *(const f32x4*)(lbl + c + 4), b0 = *(const f32x4*)(lbl + 8192 + c), b1 = *(const f32x4*)(lbl + 8192 + c + 4);
#pragma unroll
                for (int e = 0; e < 4; ++e) { const float x0 = __builtin_amdgcn_rcpf(1.0f + __builtin_amdgcn_exp2f(1.4426950408889634f * (b0[e] - a0[e]))), x1 = __builtin_amdgcn_rcpf(1.0f + __builtin_amdgcn_exp2f(1.4426950408889634f * (b1[e] - a1[e])));
                    lb[bj][e] = x0; om[bj][e] = 1.0f - x0; lb[bj][4 + e] = x1; om[bj][4 + e] = 1.0f - x1; } }
#pragma unroll
            for (int ai = 0; ai < 2; ++ai)
#pragma unroll
                for (int m = 0; m < 4; ++m) { bf16_t* rowp = O + (size_t)(row0 + ai * HALF + m * 16) * ldc + col0;
#pragma unroll
                    for (int bj = 0; bj < 2; ++bj) { float v[8];
#pragma unroll
                        for (int e = 0; e < 8; ++e) { const float f = acc[ai][bj][m][e >> 2][e & 3];
                            const float sg = __builtin_amdgcn_rcpf(1.0f + __builtin_amdgcn_exp2f(-1.4426950408889634f * f));
                            v[e] = 0.6931471805599453f * __builtin_amdgcn_logf(lb[bj][e] + om[bj][e] * sg); }
                        u32x4 w; w.x = cvt_pk_bf16(v[0], v[1]); w.y = cvt_pk_bf16(v[2], v[3]); w.z = cvt_pk_bf16(v[4], v[5]); w.w = cvt_pk_bf16(v[6], v[7]);
                        *(u32x4*)(rowp + bj * HALF) = w; } }
        } else if (mode == 1) {
#pragma unroll
            for (int ai = 0; ai < 2; ++ai)
#pragma unroll
                for (int m = 0; m < 4; ++m) { bf16_t* rowp = O + (size_t)(row0 + ai * HALF + m * 16) * ldc + col0;
#pragma unroll
                    for (int bj = 0; bj < 2; ++bj) { float v[8];
#pragma unroll
                        for (int e = 0; e < 8; ++e) v[e] = silu_f(acc[ai][bj][m][e >> 2][e & 3]);
                        u32x4 w; w.x = cvt_pk_bf16(v[0], v[1]); w.y = cvt_pk_bf16(v[2], v[3]); w.z = cvt_pk_bf16(v[4], v[5]); w.w = cvt_pk_bf16(v[6], v[7]);
                        *(u32x4*)(rowp + bj * HALF) = w; } }
        } else {
#pragma unroll
            for (int ai = 0; ai < 2; ++ai)
#pragma unroll
                for (int m = 0; m < 4; ++m) { bf16_t* rowp = O + (size_t)(row0 + ai * HALF + m * 16) * ldc + col0;
#pragma unroll
                    for (int bj = 0; bj < 2; ++bj) { const f32x4 v0 = acc[ai][bj][m][0], v1 = acc[ai][bj][m][1];
                        u32x4 w; w.x = cvt_pk_bf16(v0[0], v0[1]); w.y = cvt_pk_bf16(v0[2], v0[3]); w.z = cvt_pk_bf16(v1[0], v1[1]); w.w = cvt_pk_bf16(v1[2], v1[3]);
                        *(u32x4*)(rowp + bj * HALF) = w; } }
        }
    }
};
struct EpiRes {
    static constexpr bool PERM = false, AFTER_DRAIN = false;
    const float* base; float* out; int ldc, pad;
    __device__ __forceinline__ void operator()(const f32x4 (&acc)[2][2][4][2], const Unit& u, int wr, int wc, int fr, int fq) const {
        const int row0 = u.pm * BM + wr * 64 + fr, col0 = u.pn * BM + wc * 32 + 4 * fq;
#pragma unroll
        for (int ai = 0; ai < 2; ++ai)
#pragma unroll
            for (int m = 0; m < 4; ++m) { const size_t off = (size_t)(row0 + ai * HALF + m * 16) * ldc + col0;
#pragma unroll
                for (int bj = 0; bj < 2; ++bj)
#pragma unroll
                    for (int n = 0; n < 2; ++n) { const f32x4 bs = *(const f32x4*)(base + off + bj * HALF + n * 16); *(f32x4*)(out + off + bj * HALF + n * 16) = bs + acc[ai][bj][m][n]; }
                asm volatile("" ::: "memory"); }
    }
};
template <class Epi, class Sched, bool ALIGN_EPI = false, bool SP2 = false>
__device__ __forceinline__ void gemm_phase(PG8_LAS unsigned char* lds, const Gemm g, const Sched& S, const Epi& E) {
    const int tid = threadIdx.x, wid = __builtin_amdgcn_readfirstlane(tid >> 6), lane = tid & 63, wr = wid >> 2, wc = wid & 3, fr = lane & 15, fq = lane >> 4;
    const int K = g.K, nt = K / BK;
    unsigned voffA[2], voffB[2];
#pragma unroll
    for (int i = 0; i < 2; ++i) { int R, C; stage_rc(tid * 16 + i * 8192, R, C); const int Rb = Epi::PERM ? ((R & ~31) + perm32(R & 31)) : R;
        voffA[i] = (unsigned)(R * K + C) * 2u; voffB[i] = (unsigned)(Rb * K + C) * 2u; }
    const size_t kstep = (size_t)(BK * 2);
    const size_t hstep = (size_t)HALF * K * 2;
    const size_t tstep = 2 * hstep;
    const unsigned ldsw = (unsigned)wid * 1024u;
    const int aoff = lds_byte(wr * 64 + fr, fq * 8), boff = lds_byte(wc * 32 + fr, fq * 8);
#define PG8_SA(b, h) (((b) * 2 + (h)) * HTB)
#define PG8_SB(b, h) ((4 + (b) * 2 + (h)) * HTB)
#define PG8_STAGE(bufoff, gbase, voff) do { _Pragma("unroll") for (int _i = 0; _i < 2; ++_i) \
        __builtin_amdgcn_global_load_lds((const unsigned*)((const char*)(gbase) + (voff)[_i]), (PG8_LAS unsigned*)(lds + (bufoff) + ldsw + _i * 8192), 16, 0, 0); } while (0)
#define PG8_LDA(dst, b, h) do { _Pragma("unroll") for (int m = 0; m < 4; ++m) _Pragma("unroll") for (int k = 0; k < 2; ++k) dst[m][k] = *(const PG8_LAS bf16x8*)(lds + PG8_SA(b, h) + aoff + m * 2048 + k * 1024); } while (0)
#define PG8_LDB(dst, b, h) do { _Pragma("unroll") for (int n = 0; n < 2; ++n) _Pragma("unroll") for (int k = 0; k < 2; ++k) dst[n][k] = *(const PG8_LAS bf16x8*)(lds + PG8_SB(b, h) + boff + n * 2048 + k * 1024); } while (0)
#define PG8_MMA(ai, bj, At, Bt) do { __builtin_amdgcn_s_setprio(1); _Pragma("unroll") for (int m = 0; m < 4; ++m) _Pragma("unroll") for (int n = 0; n < 2; ++n) _Pragma("unroll") for (int k = 0; k < 2; ++k) \
        acc[ai][bj][m][n] = __builtin_amdgcn_mfma_f32_16x16x32_bf16(Bt[n][k], At[m][k], acc[ai][bj][m][n], 0, 0, 0); __builtin_amdgcn_s_setprio(0); } while (0)
#define PG8_WAIT_V(n) asm volatile("s_waitcnt vmcnt(" #n ")" ::: "memory")
#define PG8_WAIT_L(n) asm volatile("s_waitcnt lgkmcnt(" #n ")" ::: "memory")
#define PG8_BAR __builtin_amdgcn_s_barrier()
#define PG8_SCHED __builtin_amdgcn_sched_barrier(0)
    Unit cur, nxt; int ui = 0;
    if (!S.next(0, cur)) return;
    f32x4 acc[2][2][4][2];
#pragma unroll
    for (int a = 0; a < 2; ++a)
#pragma unroll
        for (int b = 0; b < 2; ++b)
#pragma unroll
            for (int m = 0; m < 4; ++m)
#pragma unroll
                for (int n = 0; n < 2; ++n) acc[a][b][m][n] = (f32x4){0.f, 0.f, 0.f, 0.f};
    bf16x8 At[4][2], B0[2][2], B1[2][2];
    const char* cA = (const char*)g.A + (size_t)cur.pm * tstep; const char* cB = (const char*)g.Bt + (size_t)cur.pn * tstep;
    S.a_ready(cur);
    if constexpr (SP2) {
        PG8_STAGE(PG8_SB(0, 0), cB, voffB); PG8_STAGE(PG8_SB(0, 1), cB + hstep, voffB); PG8_STAGE(PG8_SA(0, 0), cA, voffA); PG8_STAGE(PG8_SA(0, 1), cA + hstep, voffA);
        if (wr == 1) PG8_BAR;
        PG8_WAIT_V(2); PG8_BAR;
        PG8_STAGE(PG8_SB(1, 0), cB + kstep, voffB); PG8_STAGE(PG8_SA(1, 0), cA + kstep, voffA); PG8_STAGE(PG8_SB(1, 1), cB + hstep + kstep, voffB);
        PG8_WAIT_V(6); PG8_BAR;
    } else {
        PG8_STAGE(PG8_SB(0, 0), cB, voffB); PG8_STAGE(PG8_SA(0, 0), cA, voffA); PG8_STAGE(PG8_SB(0, 1), cB + hstep, voffB); PG8_STAGE(PG8_SA(0, 1), cA + hstep, voffA);
        if (wr == 1) PG8_BAR;
        PG8_WAIT_V(4); PG8_BAR;
        PG8_STAGE(PG8_SB(1, 0), cB + kstep, voffB); PG8_STAGE(PG8_SA(1, 0), cA + kstep, voffA); PG8_STAGE(PG8_SB(1, 1), cB + hstep + kstep, voffB);
        PG8_WAIT_V(6); PG8_BAR;
    }
    for (;;) {
        const bool has_next = S.next(ui + 1, nxt);
        const char* nA = has_next ? (const char*)g.A + (size_t)nxt.pm * tstep : cA; const char* nB = has_next ? (const char*)g.Bt + (size_t)nxt.pn * tstep : cB;
        for (int t = 0; t < nt; t += 2) {
            const bool last = (t == nt - 2);
            const char* a1 = cA + (size_t)(t + 1) * kstep;
            const char* a2 = last ? nA : cA + (size_t)(t + 2) * kstep; const char* b2 = last ? nB : cB + (size_t)(t + 2) * kstep;
            const char* a3 = a2 + kstep; const char* b3 = b2 + kstep;
            if (last && has_next) S.a_ready(nxt);
            if constexpr (SP2) {
            PG8_LDB(B0, 0, 0); PG8_LDB(B1, 0, 1); PG8_SCHED; PG8_LDA(At, 0, 0); PG8_STAGE(PG8_SA(1, 1), a1 + hstep, voffA);
            PG8_WAIT_V(8); PG8_WAIT_L(0); PG8_BAR; PG8_MMA(0, 0, At, B0); PG8_MMA(0, 1, At, B1); PG8_BAR; PG8_SCHED;
            PG8_LDA(At, 0, 1); PG8_STAGE(PG8_SB(0, 0), b2, voffB); PG8_STAGE(PG8_SB(0, 1), b2 + hstep, voffB); PG8_STAGE(PG8_SA(0, 0), a2, voffA);
            PG8_WAIT_V(8); PG8_WAIT_L(0); PG8_BAR; PG8_MMA(1, 0, At, B0); PG8_MMA(1, 1, At, B1); PG8_BAR; PG8_SCHED;
            PG8_LDB(B0, 1, 0); PG8_LDB(B1, 1, 1); PG8_SCHED; PG8_LDA(At, 1, 0); PG8_STAGE(PG8_SA(0, 1), a2 + hstep, voffA);
            PG8_WAIT_V(8); PG8_WAIT_L(0); PG8_BAR; PG8_MMA(0, 0, At, B0); PG8_MMA(0, 1, At, B1); PG8_BAR; PG8_SCHED;
            PG8_LDA(At, 1, 1); PG8_STAGE(PG8_SB(1, 0), b3, voffB); PG8_STAGE(PG8_SB(1, 1), b3 + hstep, voffB); PG8_STAGE(PG8_SA(1, 0), a3, voffA);
            PG8_WAIT_V(8); PG8_WAIT_L(0); PG8_BAR; PG8_MMA(1, 0, At, B0); PG8_MMA(1, 1, At, B1); PG8_BAR; PG8_SCHED;
            } else {
            PG8_LDB(B0, 0, 0); PG8_SCHED; PG8_LDA(At, 0, 0); PG8_STAGE(PG8_SA(1, 1), a1 + hstep, voffA);
            PG8_WAIT_L(8); PG8_BAR; PG8_WAIT_L(0); PG8_MMA(0, 0, At, B0); PG8_BAR; PG8_SCHED;
            PG8_LDB(B1, 0, 1); PG8_STAGE(PG8_SB(0, 0), b2, voffB);
            PG8_BAR; PG8_WAIT_L(0); PG8_MMA(0, 1, At, B1); PG8_BAR;
            PG8_LDA(At, 0, 1); PG8_STAGE(PG8_SA(0, 0), a2, voffA);
            PG8_BAR; PG8_WAIT_L(0); PG8_MMA(1, 0, At, B0); PG8_BAR; PG8_SCHED;
            PG8_STAGE(PG8_SB(0, 1), b2 + hstep, voffB);
            PG8_WAIT_V(6); PG8_BAR; PG8_MMA(1, 1, At, B1); PG8_BAR;
            PG8_LDB(B0, 1, 0); PG8_SCHED; PG8_LDA(At, 1, 0); PG8_STAGE(PG8_SA(0, 1), a2 + hstep, voffA);
            PG8_WAIT_L(8); PG8_BAR; PG8_WAIT_L(0); PG8_MMA(0, 0, At, B0); PG8_BAR; PG8_SCHED;
            PG8_LDB(B1, 1, 1); PG8_STAGE(PG8_SB(1, 0), b3, voffB);
            PG8_BAR; PG8_WAIT_L(0); PG8_MMA(0, 1, At, B1); PG8_BAR;
            PG8_LDA(At, 1, 1); PG8_STAGE(PG8_SA(1, 0), a3, voffA);
            PG8_BAR; PG8_WAIT_L(0); PG8_MMA(1, 0, At, B0); PG8_BAR; PG8_SCHED;
            PG8_STAGE(PG8_SB(1, 1), b3 + hstep, voffB);
            PG8_WAIT_V(6); PG8_BAR; PG8_MMA(1, 1, At, B1); PG8_BAR;
            }
        }
        if constexpr (ALIGN_EPI) { if (wr == 0) PG8_BAR; }
        if constexpr (!Epi::AFTER_DRAIN) { E(acc, cur, wr, wc, fr, fq); S.done(cur); }
        if (!has_next) break;
#pragma unroll
        for (int a = 0; a < 2; ++a)
#pragma unroll
            for (int b = 0; b < 2; ++b)
#pragma unroll
                for (int m = 0; m < 4; ++m)
#pragma unroll
                    for (int n = 0; n < 2; ++n) acc[a][b][m][n] = (f32x4){0.f, 0.f, 0.f, 0.f};
        cur = nxt; cA = nA; cB = nB; ++ui;
        if constexpr (ALIGN_EPI) { if (wr == 1) PG8_BAR; }
    }
    PG8_WAIT_V(0);
    if constexpr (!ALIGN_EPI) { if (wr == 0) PG8_BAR; }
    PG8_BAR;
    if constexpr (Epi::AFTER_DRAIN) { E.fused(acc, cur, wr, wc, fr, fq, lds, wid, lane); S.done(cur); }
#undef PG8_SA
#undef PG8_SB
#undef PG8_STAGE
#undef PG8_LDA
#undef PG8_LDB
#undef PG8_MMA
#undef PG8_WAIT_V
#undef PG8_WAIT_L
#undef PG8_BAR
#undef PG8_SCHED
}
}

#define LAS __attribute__((address_space(3)))
typedef unsigned short bf16;
typedef unsigned v4u __attribute__((ext_vector_type(4)));
typedef unsigned v2u __attribute__((ext_vector_type(2)));
typedef float f32x4 __attribute__((ext_vector_type(4)));
__device__ __forceinline__ unsigned pk2(float lo, float hi) { unsigned r; asm volatile("v_cvt_pk_bf16_f32 %0, %1, %2" : "=v"(r) : "v"(lo), "v"(hi)); return r; }
__device__ __forceinline__ float bf2f(unsigned short b) { return __uint_as_float(((unsigned)b) << 16); }
__device__ __forceinline__ float bflo(unsigned w) { return __uint_as_float(w << 16); }
__device__ __forceinline__ float bfhi(unsigned w) { return __uint_as_float(w & 0xffff0000u); }
__device__ __forceinline__ float wave_sum(float v) {
#pragma unroll
    for (int o = 1; o < 64; o <<= 1) v += __shfl_xor(v, o);
    return v;
}
__device__ __forceinline__ float wave_max(float v) {
#pragma unroll
    for (int o = 1; o < 64; o <<= 1) v = fmaxf(v, __shfl_xor(v, o));
    return v;
}

__device__ __forceinline__ void transpose_tile(const float* W, size_t ldw, int K, int k0, int n0, bf16* WT, int nbase, LAS unsigned* scr, int lane) {
    const int g = lane & 15, ks = lane >> 4;
#pragma unroll
    for (int i = 0; i < 8; ++i) {
        const int k = k0 + 8 * i + 2 * ks;
        const f32x4 a = *(const f32x4*)(W + (size_t)k * ldw + n0 + 4 * g), b = *(const f32x4*)(W + (size_t)(k + 1) * ldw + n0 + 4 * g);
#pragma unroll
        for (int j = 0; j < 4; ++j) scr[(4 * g + j) * 33 + 4 * i + ks] = pk2(a[j], b[j]);
    }
    asm volatile("s_waitcnt lgkmcnt(0)" ::: "memory");
    const int c = lane & 7;
#pragma unroll
    for (int r = 0; r < 8; ++r) { const int n = 8 * r + (lane >> 3);
        v4u o; o.x = scr[n * 33 + 4 * c]; o.y = scr[n * 33 + 4 * c + 1]; o.z = scr[n * 33 + 4 * c + 2]; o.w = scr[n * 33 + 4 * c + 3];
        *(v4u*)(WT + (size_t)(n0 - nbase + n) * K + k0 + 8 * c) = o; }
    asm volatile("s_waitcnt lgkmcnt(0)" ::: "memory");
}
__device__ __forceinline__ void rms_row_bf16(const float* xrow, const float* w, bf16* orow, int lane) {
    const f32x4* xr = (const f32x4*)xrow + lane; const f32x4* wr = (const f32x4*)w + lane;
    f32x4 v[16]; float s = 0.f;
#pragma unroll
    for (int j = 0; j < 16; ++j) { v[j] = xr[64 * j]; s += (v[j].x * v[j].x + v[j].y * v[j].y) + (v[j].z * v[j].z + v[j].w * v[j].w); }
    const float rs = 1.0f / sqrtf(wave_sum(s) * (1.0f / D) + EPS);
    v2u* o8 = (v2u*)orow + lane;
#pragma unroll
    for (int j = 0; j < 16; ++j) { const f32x4 g = wr[64 * j]; v2u o; o.x = pk2(v[j].x * rs * g.x, v[j].y * rs * g.y); o.y = pk2(v[j].z * rs * g.z, v[j].w * rs * g.w); o8[64 * j] = o; }
}
__device__ __forceinline__ void rms_row_f32(const float* xrow, const float* w, float* orow, int lane) {
    const f32x4* xr = (const f32x4*)xrow + lane; const f32x4* wr = (const f32x4*)w + lane;
    f32x4 v[16]; float s = 0.f;
#pragma unroll
    for (int j = 0; j < 16; ++j) { v[j] = xr[64 * j]; s += (v[j].x * v[j].x + v[j].y * v[j].y) + (v[j].z * v[j].z + v[j].w * v[j].w); }
    const float rs = 1.0f / sqrtf(wave_sum(s) * (1.0f / D) + EPS);
    f32x4* o = (f32x4*)orow + lane;
#pragma unroll
    for (int j = 0; j < 16; ++j) { const f32x4 g = wr[64 * j]; o[64 * j] = (f32x4){v[j].x * rs * g.x, v[j].y * rs * g.y, v[j].z * rs * g.z, v[j].w * rs * g.w}; }
}

constexpr size_t MiB = 1u << 20;
constexpr size_t WS_CTL = 0;
constexpr size_t WS_WA  = 1 * MiB;
constexpr size_t WS_WB  = WS_WA + 256 * MiB;
constexpr size_t WS_WF  = WS_WB + 256 * MiB;
constexpr size_t WS_WOA = WS_WF + 1 * MiB;
constexpr size_t WS_WOB = WS_WOA + 64 * MiB;
constexpr size_t WS_HB  = WS_WOB + 64 * MiB;
constexpr size_t WS_X1  = WS_HB + 64 * MiB;
constexpr size_t WS_P   = WS_X1 + 128 * MiB;
constexpr size_t WS_Y   = WS_P + 512 * MiB;
constexpr size_t WS_LS  = WS_Y + 128 * MiB;
constexpr size_t WS_C   = WS_LS + 2 * MiB;
constexpr size_t WS_END = WS_C + 2 * MiB;

__device__ __forceinline__ void prologue_phase(LAS unsigned char* lds, const float* x, const float* norm_w, const float* w_in_a, const float* w_out_a, const float* w_in_b, const float* w_out_b,
                                               unsigned char* ws, int vcu, int G, int wave, int lane) {
    LAS unsigned* scr = (LAS unsigned*)(lds + wave * 8448);
    const int gw = vcu * 8 + wave, NGW = G * 8;
    bf16* WA = (bf16*)(ws + WS_WA); bf16* WB = (bf16*)(ws + WS_WB); bf16* WF = (bf16*)(ws + WS_WF); bf16* WOA = (bf16*)(ws + WS_WOA); bf16* WOB = (bf16*)(ws + WS_WOB);
    constexpr int T_IN = (D / 64) * (LDP / 64);
    constexpr int T_F = (D / 64) * 1;
    constexpr int T_OUT = (DI / 64) * (D / 64);
    constexpr int NT = 2 * T_IN + T_F + 2 * T_OUT;
    for (int it = gw; it < NT; it += NGW) {
        int r = it;
        if (r < T_IN) { const int kb = r / (LDP / 64), nb = r % (LDP / 64); transpose_tile(w_in_a, LDP, D, kb * 64, nb * 64, WA, 0, scr, lane); continue; } r -= T_IN;
        if (r < T_IN) { const int kb = r / (LDP / 64), nb = r % (LDP / 64); transpose_tile(w_in_b, NWB, D, kb * 64, nb * 64, WB, 0, scr, lane); continue; } r -= T_IN;
        if (r < T_F) { transpose_tile(w_in_b, NWB, D, r * 64, LDP, WF, LDP, scr, lane); continue; } r -= T_F;
        if (r < T_OUT) { const int kb = r / (D / 64), nb = r % (D / 64); transpose_tile(w_out_a, D, DI, kb * 64, nb * 64, WOA, 0, scr, lane); continue; } r -= T_OUT;
        { const int kb = r / (D / 64), nb = r % (D / 64); transpose_tile(w_out_b, D, DI, kb * 64, nb * 64, WOB, 0, scr, lane); }
    }
    bf16* HB = (bf16*)(ws + WS_HB);
    for (int m = gw; m < M; m += NGW) rms_row_bf16(x + (size_t)m * D, norm_w, HB + (size_t)m * D, lane);
}


namespace scan {
typedef short s16x4 __attribute__((ext_vector_type(4)));
typedef short bf16x8 __attribute__((ext_vector_type(8)));
typedef float f32x4 __attribute__((ext_vector_type(4)));
typedef unsigned u32x2 __attribute__((ext_vector_type(2)));
constexpr int R = 4, NSTEP = SEQ / 16;
constexpr int RAW = 0, QDT = R * 16384, KIT = QDT + 4096, KE = KIT + 4096, DEC = KE + 4096, SSQ = DEC + 512, LDS_BYTES = SSQ + 1024;
constexpr float L2E = 1.4426950408889634f;
__device__ __forceinline__ s16x4 trd(LAS const unsigned char* p) { return __builtin_bit_cast(s16x4, __builtin_amdgcn_ds_read_tr16_b64_v4i16((LAS s16x4*)p)); }
__device__ __forceinline__ s16x4 pk4(float a, float b, float c, float d) { u32x2 w; w.x = pk2(a, b); w.y = pk2(c, d); return __builtin_bit_cast(s16x4, w); }
__device__ __forceinline__ bf16x8 cat8(s16x4 a, s16x4 b) { return __builtin_shufflevector(a, b, 0, 1, 2, 3, 4, 5, 6, 7); }
#define SC_BAR() do { asm volatile("" ::: "memory"); __builtin_amdgcn_s_barrier(); asm volatile("" ::: "memory"); } while (0)

__device__ __forceinline__ void scan_unit(LAS unsigned char* lds, const bf16* __restrict__ P, const float* __restrict__ onw, bf16* __restrict__ Y, int bh) {
    const int tid = threadIdx.x, wid = __builtin_amdgcn_readfirstlane(tid >> 6), lane = tid & 63, n = lane & 15, g = lane >> 4, tq = n >> 2, tp = n & 3;
    const int b = bh / NH, h = bh % NH;
    const bf16* base = P + (size_t)b * SEQ * LDP + h * HD;
    size_t goff[2]; int ldst[2];
#pragma unroll
    for (int ii = 0; ii < 2; ++ii) { const int i = 2 * wid + ii, ti = i >> 2, rg = i & 3, row = 4 * rg + (lane >> 4), pc = lane & 15, c = pc ^ ((row & 7) << 1);
        const int sec = (ti == 0) ? 1 : ((ti == 1) ? 0 : ti);
        goff[ii] = (size_t)row * LDP + (size_t)sec * DI + c * 8; ldst[ii] = ti * 4096 + rg * 1024; }
#define SC_DMA(step) do { const int st_ = (step) < NSTEP ? (step) : NSTEP - 1; const int sl_ = ((step) & (R - 1)) * 16384; _Pragma("unroll") for (int ii = 0; ii < 2; ++ii) \
        __builtin_amdgcn_global_load_lds((const unsigned*)(base + (size_t)st_ * 16 * LDP + goff[ii]), (LAS unsigned*)(lds + RAW + sl_ + ldst[ii]), 16, 0, 0); } while (0)
    const int rrow = 4 * g + tq;
    const int rtr = rrow * 256 + ((2 * wid + (tp >> 1)) ^ ((rrow & 7) << 1)) * 16 + 8 * (tp & 1);
    const int rsg = n * 256 + ((2 * wid + (g >> 1)) ^ ((n & 7) << 1)) * 16 + 8 * (g & 1);
    const int wq = (16 * wid + n) * 32 + g * 8;
    const int wk = (g >> 1) * 2048 + (16 * wid + n) * 16 + (g & 1) * 8;
    const int rqt = (4 * g + tq) * 32 + 8 * tp;
    const int rke = (g >> 1) * 2048 + n * 16 + (g & 1) * 8;
    const int rdec = (4 * g) * 4;
    s16x4 ltri; { short one = (short)0x3F80; ltri[0] = (4 * g + 0 <= n) ? one : (short)0; ltri[1] = (4 * g + 1 <= n) ? one : (short)0; ltri[2] = (4 * g + 2 <= n) ? one : (short)0; ltri[3] = (4 * g + 3 <= n) ? one : (short)0; }
    const f32x4 gain = *(const f32x4*)(onw + h * HD + 16 * wid + 4 * g);
    f32x4 S[8];
#pragma unroll
    for (int t = 0; t < 8; ++t) S[t] = (f32x4){0.f, 0.f, 0.f, 0.f};
    f32x4 oprev = (f32x4){0.f, 0.f, 0.f, 0.f};
    SC_DMA(0); SC_DMA(1); SC_DMA(2);
    for (int st = 0; st <= NSTEP; ++st) {
        if (st < 3) asm volatile("s_waitcnt vmcnt(4) lgkmcnt(0)" ::: "memory"); else asm volatile("s_waitcnt vmcnt(6) lgkmcnt(0)" ::: "memory");
        SC_BAR();
        const LAS unsigned char* raw = lds + RAW + (st & (R - 1)) * 16384;
        if (st < NSTEP) {
            const s16x4 lfB = trd(raw + rtr), qsB = trd(raw + 4096 + rtr);
            f32x4 G = __builtin_amdgcn_mfma_f32_16x16x16bf16_1k(ltri, lfB, (f32x4){0.f, 0.f, 0.f, 0.f}, 0, 0, 0);
            const float Glast = __shfl(G[3], 48 + n);
            float qd[4], ki[4], ke[4];
#pragma unroll
            for (int j = 0; j < 4; ++j) { const float lf = bf2f((unsigned short)lfB[j]), qs = bf2f((unsigned short)qsB[j]);
                const float E = __builtin_amdgcn_exp2f(G[j] * L2E), Ei = __builtin_amdgcn_exp2f(-G[j] * L2E), Ee = __builtin_amdgcn_exp2f((Glast - G[j]) * L2E);
                const float kk = 1.0f - __builtin_amdgcn_exp2f(lf * L2E);
                qd[j] = qs * E; ki[j] = kk * Ei; ke[j] = kk * Ee; }
            *(LAS s16x4*)(lds + QDT + wq) = pk4(qd[0], qd[1], qd[2], qd[3]);
            *(LAS s16x4*)(lds + KIT + wq) = pk4(ki[0], ki[1], ki[2], ki[3]);
            *(LAS s16x4*)(lds + KE + wk) = pk4(ke[0], ke[1], ke[2], ke[3]);
            if (g == 0) *(LAS float*)(lds + DEC + (16 * wid + n) * 4) = __builtin_amdgcn_exp2f(Glast * L2E);
        }
        if (st > 0) {
            const LAS unsigned char* rawp = lds + RAW + ((st - 1) & (R - 1)) * 16384;
            const LAS unsigned char* sq = lds + SSQ + ((st - 1) & 1) * 512 + n * 32;
            const f32x4 a = *(const LAS f32x4*)sq, c = *(const LAS f32x4*)(sq + 16);
            const float tot = ((a[0] + a[1]) + (a[2] + a[3])) + ((c[0] + c[1]) + (c[2] + c[3]));
            const float rs = 1.0f / sqrtf(tot * (1.0f / HD) + EPS);
            const s16x4 sgv = *(const LAS s16x4*)(rawp + 3 * 4096 + rsg);
            const float y0 = oprev[0] * rs * gain[0] * bf2f((unsigned short)sgv[0]), y1 = oprev[1] * rs * gain[1] * bf2f((unsigned short)sgv[1]);
            const float y2 = oprev[2] * rs * gain[2] * bf2f((unsigned short)sgv[2]), y3 = oprev[3] * rs * gain[3] * bf2f((unsigned short)sgv[3]);
            u32x2 w; w.x = pk2(y0, y1); w.y = pk2(y2, y3);
            *(u32x2*)(Y + (size_t)(b * SEQ + 16 * (st - 1) + n) * DI + h * HD + 16 * wid + 4 * g) = w;
        }
        if (st == NSTEP) break;
        asm volatile("s_waitcnt lgkmcnt(0)" ::: "memory");
        SC_BAR();
        SC_DMA(st + 3);
        s16x4 qf[8], kf[8];
#pragma unroll
        for (int t = 0; t < 8; ++t) { qf[t] = trd(lds + QDT + rqt + 512 * t); kf[t] = trd(lds + KIT + rqt + 512 * t); }
        const s16x4 vf = trd(raw + 2 * 4096 + rtr);
        f32x4 sc = (f32x4){0.f, 0.f, 0.f, 0.f};
#pragma unroll
        for (int u = 0; u < 4; ++u) sc = __builtin_amdgcn_mfma_f32_16x16x32_bf16(cat8(kf[2 * u], kf[2 * u + 1]), cat8(qf[2 * u], qf[2 * u + 1]), sc, 0, 0, 0);
#pragma unroll
        for (int j = 0; j < 4; ++j) sc[j] = (4 * g + j <= n) ? sc[j] : 0.f;
        f32x4 o = (f32x4){0.f, 0.f, 0.f, 0.f};
#pragma unroll
        for (int u = 0; u < 4; ++u) { const s16x4 s0 = pk4(S[2 * u][0], S[2 * u][1], S[2 * u][2], S[2 * u][3]), s1 = pk4(S[2 * u + 1][0], S[2 * u + 1][1], S[2 * u + 1][2], S[2 * u + 1][3]);
            o = __builtin_amdgcn_mfma_f32_16x16x32_bf16(cat8(s0, s1), cat8(qf[2 * u], qf[2 * u + 1]), o, 0, 0, 0); }
        o = __builtin_amdgcn_mfma_f32_16x16x16bf16_1k(vf, pk4(sc[0], sc[1], sc[2], sc[3]), o, 0, 0, 0);
#pragma unroll
        for (int t = 0; t < 8; ++t) { const s16x4 kef = *(const LAS s16x4*)(lds + KE + rke + 256 * t); const f32x4 dv = *(const LAS f32x4*)(lds + DEC + rdec + 64 * t);
            S[t] = __builtin_amdgcn_mfma_f32_16x16x16bf16_1k(kef, vf, S[t] * dv, 0, 0, 0); }
        float ss = (o[0] * o[0] + o[1] * o[1]) + (o[2] * o[2] + o[3] * o[3]);
        ss += __shfl_xor(ss, 16); ss += __shfl_xor(ss, 32);
        if (g == 0) *(LAS float*)(lds + SSQ + (st & 1) * 512 + (n * 8 + wid) * 4) = ss;
        oprev = o;
    }
    asm volatile("s_waitcnt vmcnt(0) lgkmcnt(0)" ::: "memory");
    SC_BAR();
#undef SC_DMA
}
#undef SC_BAR
}

namespace fox {
enum { ORDER_NATURAL = 0, ORDER_REVERSED = 1, ORDER_PAIRED = 2, ORDER_XCD = 4 };
constexpr int B = NB, H = NH, HKV = NH, SQ = SEQ, SKV = SEQ, D = HD, QOFF = 0, WINDOW = SEQ;
constexpr int LDQ = LDP, LDO = DI;
constexpr float THR = 8.f;
constexpr int ORDER = ORDER_PAIRED | ORDER_XCD;
constexpr bool WSKIP = false;
constexpr float ISCALE = 11.313708498984761f;
constexpr int STG_ROW = 272;
constexpr float SCALE = 0.08838834764831845f;
constexpr int NW = 8, QBLK = 32, KVBLK = 64, QB = NW * QBLK;
constexpr int SHM_V = KVBLK * D * 2, SHM_K = KVBLK * D * 2;
constexpr int LDS_BYTES = 2 * SHM_V + 2 * SHM_K + NW * 64 * 4;
constexpr int C_OFF = LDS_BYTES, STG_OFF = C_OFF + SEQ * 4;
static_assert(D == 128 && SQ % QB == 0 && SKV % KVBLK == 0 && H % HKV == 0 && QOFF >= 0 && QOFF + SQ <= SKV && WINDOW >= 1, "geometry");

using bf16 = unsigned short;
typedef short bf16x8 __attribute__((ext_vector_type(8)));
typedef short s16x4 __attribute__((ext_vector_type(4)));
typedef float f32x16 __attribute__((ext_vector_type(16)));
typedef float f32x4 __attribute__((ext_vector_type(4)));
typedef unsigned u32x4 __attribute__((ext_vector_type(4)));
template <class A, class Bt> struct same_t { static constexpr bool v = false; };
template <class A> struct same_t<A, A> { static constexpr bool v = true; };

#define KSWZ(row, colB) ((row) * 256 + ((colB) ^ (((row) & 7) << 4)))
#define SBAR() __builtin_amdgcn_sched_barrier(0)
__device__ __forceinline__ int v_st(int k, int c) { const int kk = (k & ~0xC) | ((k & 4) << 1) | ((k & 8) >> 1); return ((kk >> 3) * 4 + (c >> 5)) * 512 + ((kk & 7) * 32 + (c & 31)) * 2; }
__device__ __forceinline__ int v_rd_base(int lane) { return ((lane & 3) << 3) | (((lane >> 2) & 3) << 6) | (((lane >> 4) & 1) << 5) | (((lane >> 5) & 1) << 8); }
constexpr int v_rd_off(int d0, int ks, int half) { return d0 * 512 + ks * 4096 + half * 2048; }
__device__ __forceinline__ int crow(int r, int hi) { return (r & 3) + 8 * (r >> 2) + 4 * hi; }
__device__ __forceinline__ unsigned cvtpk(float lo, float hi) {
    unsigned r; asm volatile("v_cvt_pk_bf16_f32 %0, %1, %2" : "=v"(r) : "v"(lo), "v"(hi)); return r;
}
__device__ __forceinline__ bf16x8 pack8(f32x4 a, f32x4 b) {
    u32x4 w = {cvtpk(a[0], a[1]), cvtpk(a[2], a[3]), cvtpk(b[0], b[1]), cvtpk(b[2], b[3])};
    return *reinterpret_cast<bf16x8*>(&w);
}
template <class T> __device__ __forceinline__ bf16x8 load8(const T* p) {
    if constexpr (same_t<T, float>::v) { return pack8(*(const f32x4*)p, *(const f32x4*)(p + 4)); }
    else { return *reinterpret_cast<const bf16x8*>(p); }
}
__device__ __forceinline__ void mask_tile(f32x16& p0, f32x16& p1, int dq, unsigned W) {
    const float NEG = -__builtin_inff();
#pragma unroll
    for (int r = 0; r < 16; ++r) {
        const int c = (r & 3) + 8 * (r >> 2);
        if ((unsigned)(dq - c) >= W) p0[r] = NEG;
        if ((unsigned)(dq - c - 32) >= W) p1[r] = NEG;
    }
}
__device__ __forceinline__ void partialSM(f32x16& p0, f32x16& p1, float& m_reg, float& mn, float& alpha) {
    float pmax = p0[0]; for (int r = 1; r < 16; ++r) pmax = fmaxf(pmax, p0[r]); for (int r = 0; r < 16; ++r) pmax = fmaxf(pmax, p1[r]);
    { auto rr = __builtin_amdgcn_permlane32_swap(__float_as_uint(pmax), __float_as_uint(pmax), false, false);
      pmax = fmaxf(__uint_as_float(rr[0]), __uint_as_float(rr[1])); }
    constexpr float C2 = 1.4426950408889634f * SCALE;
    if (__builtin_expect(__all((pmax - m_reg) * SCALE <= THR), 1)) { mn = m_reg; alpha = 1.f; }
    else { mn = fmaxf(m_reg, pmax); alpha = __builtin_amdgcn_exp2f((m_reg - mn) * C2); m_reg = mn; }
    const float mnL = -mn * C2;
    for (int r = 0; r < 16; ++r) p0[r] = fmaf(p0[r], C2, mnL); for (int r = 0; r < 16; ++r) p1[r] = fmaf(p1[r], C2, mnL);
    for (int r = 0; r < 16; ++r) p0[r] = __builtin_amdgcn_exp2f(p0[r]);
}
__device__ __forceinline__ void finishSM(f32x16& p0, f32x16& p1, float alpha, float& l_reg, bf16x8& pa0, bf16x8& pa1, bf16x8& pa2, bf16x8& pa3) {
    for (int r = 0; r < 16; ++r) p1[r] = __builtin_amdgcn_exp2f(p1[r]);
    float ps = 0; for (int r = 0; r < 16; ++r) ps += p0[r]; for (int r = 0; r < 16; ++r) ps += p1[r];
    { auto rr = __builtin_amdgcn_permlane32_swap(__float_as_uint(ps), __float_as_uint(ps), false, false);
      ps = __uint_as_float(rr[0]) + __uint_as_float(rr[1]); }
    l_reg = l_reg * alpha + ps;
#define PK4(P, B_, OUT) do { unsigned a0 = cvtpk(P[B_+0], P[B_+1]), a1 = cvtpk(P[B_+2], P[B_+3]);                          \
        unsigned b0 = cvtpk(P[B_+4], P[B_+5]), b1 = cvtpk(P[B_+6], P[B_+7]);                                             \
        auto r0 = __builtin_amdgcn_permlane32_swap(a0, b0, false, false); auto r1 = __builtin_amdgcn_permlane32_swap(a1, b1, false, false); \
        u32x4 w = {r0[0], r1[0], r0[1], r1[1]}; OUT = *reinterpret_cast<bf16x8*>(&w); } while (0)
    PK4(p0, 0, pa0); PK4(p0, 8, pa1); PK4(p1, 0, pa2); PK4(p1, 8, pa3);
#undef PK4
}
__device__ __forceinline__ void bias_tile(f32x16& p0, f32x16& p1, const float* cl, int kb, int hi) {
    const f32x4* cp = (const f32x4*)(cl + kb + 4 * hi);
#pragma unroll
    for (int j = 0; j < 4; ++j) { const f32x4 c0 = cp[2 * j], c1 = cp[8 + 2 * j];
#pragma unroll
        for (int e = 0; e < 4; ++e) { p0[4 * j + e] = fmaf(c0[e], -ISCALE, p0[4 * j + e]); p1[4 * j + e] = fmaf(c1[e], -ISCALE, p1[4 * j + e]); } }
}
template <int KB, bool SK>
__device__ __forceinline__ void qkt(f32x16& p0, f32x16& p1, const char* K_lds, int r32, int hi, const bf16x8* qr, bool act) {
    if (SK && !act) { const float NEG = -__builtin_inff();
#pragma unroll
        for (int r = 0; r < 16; ++r) { p0[r] = NEG; p1[r] = NEG; } return; }
    p0 = f32x16{}; p1 = f32x16{};
    const char* kb[4];
#pragma unroll
    for (int dd = 0; dd < 4; ++dd) kb[dd] = K_lds + KB * SHM_K + KSWZ(r32, (dd * 16 + hi * 8) * 2);
#pragma unroll
    for (int d0 = 0; d0 < 8; ++d0) { const char* a = kb[d0 & 3] + (d0 >> 2) * 128;
        bf16x8 b0 = *reinterpret_cast<const bf16x8*>(a);
        bf16x8 b1 = *reinterpret_cast<const bf16x8*>(a + 32 * 256);
        p0 = __builtin_amdgcn_mfma_f32_32x32x16_bf16(b0, qr[d0], p0, 0, 0, 0);
        p1 = __builtin_amdgcn_mfma_f32_32x32x16_bf16(b1, qr[d0], p1, 0, 0, 0); }
}
template <int VB, bool SK>
__device__ __forceinline__ void pv_tile(f32x16* o, int vb0, bf16x8 pa0, bf16x8 pa1, bf16x8 pa2, bf16x8 pa3, bool act) {
    if (SK && !act) return;
#define TRRD(dst, off) asm volatile("ds_read_b64_tr_b16 %0, %1 offset:%2" : "=&v"(dst) : "v"(vb0), "i"(off) : "memory")
#define PV_D0(d0) do { s16x4 l0, l1, l2, l3, h0, h1, h2, h3; constexpr int b_ = VB * SHM_V + v_rd_off(d0, 0, 0);     \
        TRRD(l0, b_); TRRD(h0, b_ + 2048); TRRD(l1, b_ + 4096); TRRD(h1, b_ + 6144); TRRD(l2, b_ + 8192); TRRD(h2, b_ + 10240); TRRD(l3, b_ + 12288); TRRD(h3, b_ + 14336); \
        asm volatile("s_waitcnt lgkmcnt(0)" ::: "memory"); SBAR();                 \
        o[d0] = __builtin_amdgcn_mfma_f32_32x32x16_bf16(pa0, (bf16x8){l0[0], l0[1], l0[2], l0[3], h0[0], h0[1], h0[2], h0[3]}, o[d0], 0, 0, 0);   \
        o[d0] = __builtin_amdgcn_mfma_f32_32x32x16_bf16(pa1, (bf16x8){l1[0], l1[1], l1[2], l1[3], h1[0], h1[1], h1[2], h1[3]}, o[d0], 0, 0, 0);   \
        o[d0] = __builtin_amdgcn_mfma_f32_32x32x16_bf16(pa2, (bf16x8){l2[0], l2[1], l2[2], l2[3], h2[0], h2[1], h2[2], h2[3]}, o[d0], 0, 0, 0);   \
        o[d0] = __builtin_amdgcn_mfma_f32_32x32x16_bf16(pa3, (bf16x8){l3[0], l3[1], l3[2], l3[3], h3[0], h3[1], h3[2], h3[3]}, o[d0], 0, 0, 0); } while (0)
    PV_D0(0); PV_D0(1); PV_D0(2); PV_D0(3);
#undef PV_D0
#undef TRRD
}

template <class TIn, class TOut> struct BlockRef { const TIn* Q; const TIn* K; const TIn* V; const TIn* G; TOut* O; int P0; };
template <class TIn> struct Seam {
    bf16x8 qr[8];
    bf16x8 st_v0, st_v1, st_k0, st_k1; f32x4 sf0, sf1, sf2, sf3;
    f32x4 tq[16];
};
__device__ __forceinline__ int swa_jlo(int P0, int W) { const int lowk = P0 - W + 1; return lowk > 0 ? lowk / KVBLK : 0; }
__device__ __forceinline__ int swa_jhi(int P0, int skv) { int j = (P0 + QB - 1) / KVBLK + 1; return j > skv / KVBLK ? skv / KVBLK : j; }
#define ROW(p, k0, rr) ((p) + (size_t)((k0) + (rr)) * LDQ + sc)
#define VMW() asm volatile("s_waitcnt vmcnt(0)" ::: "memory")
#define VMWN(n) asm volatile("s_waitcnt vmcnt(%0)" :: "i"(n) : "memory")
#define SLOAD_H(Kp, Vp, k0) do { const char* kb__ = (const char*)((Kp) + (size_t)(k0) * LDQ); const char* vb__ = (const char*)((Vp) + (size_t)(k0) * LDQ);     \
                         S.st_v0 = *(const bf16x8*)(vb__ + svoff); S.st_v1 = *(const bf16x8*)(vb__ + (size_t)32 * LDQ * 2 + svoff);              \
                         S.st_k0 = *(const bf16x8*)(kb__ + svoff); S.st_k1 = *(const bf16x8*)(kb__ + (size_t)32 * LDQ * 2 + svoff); } while (0)
#define SWRITE_HK(bf) do { *(bf16x8*)(K_lds + (bf) * SHM_K + kws) = S.st_k0; *(bf16x8*)(K_lds + (bf) * SHM_K + kws + 32 * 256) = S.st_k1; } while (0)
#define SWRITE_HV(bf) do { *(bf16x8*)(V_lds + (bf) * SHM_V + vst0) = S.st_v0; *(bf16x8*)(V_lds + (bf) * SHM_V + vst1) = S.st_v1; } while (0)
#define SWRITE_H(bf) do { SWRITE_HV(bf); SWRITE_HK(bf); } while (0)
#define SLOAD_F(p, k0) do { S.sf0 = *(const f32x4*)ROW(p, k0, sr); S.sf1 = *(const f32x4*)(ROW(p, k0, sr) + 4);                \
                            S.sf2 = *(const f32x4*)ROW(p, k0, 32 + sr); S.sf3 = *(const f32x4*)(ROW(p, k0, 32 + sr) + 4); } while (0)
#define SWRITE_KF(bf) do { *(bf16x8*)(K_lds + (bf) * SHM_K + kws) = pack8(S.sf0, S.sf1); *(bf16x8*)(K_lds + (bf) * SHM_K + kws + 32 * 256) = pack8(S.sf2, S.sf3); } while (0)
#define SWRITE_VF(bf) do { *(bf16x8*)(V_lds + (bf) * SHM_V + vst0) = pack8(S.sf0, S.sf1); *(bf16x8*)(V_lds + (bf) * SHM_V + vst1) = pack8(S.sf2, S.sf3); } while (0)
template <class TIn, class TOut>
__device__ __forceinline__ void causal_swa_prime(const BlockRef<TIn, TOut>& cur, int skv, int W, char* lds, Seam<TIn>& S) {
    constexpr bool F32 = same_t<TIn, float>::v;
    const int tid = threadIdx.x, wid = __builtin_amdgcn_readfirstlane(tid >> 6), lane = tid & 63, r32 = lane & 31, hi = lane >> 5;
    const int sr = tid >> 4, sc = (tid & 15) * 8, kws = KSWZ(sr, sc * 2); char* K_lds = lds + 2 * SHM_V;
    const unsigned svoff = (unsigned)(sr * LDQ + sc) * 2u, qvoff = (unsigned)(r32 * LDQ + hi * 8) * 2u;
    const int kb0 = (swa_jhi(cur.P0, skv) - 1) * KVBLK; (void)W;
    for (int d0 = 0; d0 < 8; ++d0) S.qr[d0] = *(const bf16x8*)((const char*)(cur.Q + (size_t)(wid * QBLK) * LDQ) + d0 * 32 + qvoff);
    if constexpr (F32) { SLOAD_F((const float*)cur.K, kb0); VMW(); SWRITE_KF(0); SBAR(); SLOAD_F((const float*)cur.V, kb0); }
    else { SLOAD_H(cur.K, cur.V, kb0); VMW(); SWRITE_HK(0); }
    __syncthreads();
}
template <class TIn, class TOut>
__device__ __forceinline__ void causal_swa_block(const BlockRef<TIn, TOut>& cur, const BlockRef<TIn, TOut>& nxt, int skv, int W, char* lds, Seam<TIn>& S) {
    constexpr bool F32 = same_t<TIn, float>::v;
    const int tid = threadIdx.x, wid = __builtin_amdgcn_readfirstlane(tid >> 6), lane = tid & 63, r32 = lane & 31, hi = lane >> 5;
    const int j_lo = swa_jlo(cur.P0, W);
    int j_hi = (cur.P0 + QB - 1) / KVBLK + 1; if (j_hi > skv / KVBLK) j_hi = skv / KVBLK;
    const int NT = j_hi - j_lo;
    const int kbn = (swa_jhi(nxt.P0, skv) - 1) * KVBLK;
    const int qlo = cur.P0 + wid * QBLK, qm = qlo + r32 - 4 * hi;
    char* V_lds = lds; char* K_lds = lds + 2 * SHM_V;
    const float* cl = (const float*)(lds + C_OFF);
    float* ws = (float*)(lds + 2 * SHM_V + 2 * SHM_K) + wid * 64; float* li_l = ws, * al_l = ws + 32;
    float m_reg = -1e30f, l_reg = 0; f32x16 o[4] = {};
    const int sr = tid >> 4, sc = (tid & 15) * 8, vst0 = v_st(sr, sc), vst1 = v_st(32 + sr, sc), kws = KSWZ(sr, sc * 2);
    const unsigned svoff = (unsigned)(sr * LDQ + sc) * 2u, qvoff = (unsigned)(r32 * LDQ + hi * 8) * 2u;
    const int vb0 = (int)(uintptr_t)V_lds + v_rd_base(lane);
    const TIn* Kh = cur.K; const TIn* Vh = cur.V;
#define RESC(a) do { if (__any((a) < 1.f)) { if (hi == 0) al_l[r32] = (a); asm volatile("s_waitcnt lgkmcnt(0)" ::: "memory");              \
                     for (int d_ = 0; d_ < 4; ++d_) for (int r = 0; r < 16; ++r) o[d_][r] *= al_l[crow(r, hi)]; } } while (0)
#define KBASE(t) ((j_hi - 1 - (t)) * KVBLK)
#define ACT(t) (KBASE(t) <= qlo + QBLK - 1 && KBASE(t) + KVBLK - 1 >= qlo - W + 1)
#define MASKT(P0_, P1_, t) do { const int kb_ = KBASE(t); bias_tile(P0_, P1_, cl, kb_, hi); if ((!SK || ACT(t)) && (kb_ + KVBLK - 1 > qlo || kb_ <= qlo + QBLK - 1 - W)) mask_tile(P0_, P1_, qm - kb_, (unsigned)W); } while (0)
    constexpr int NQL = F32 ? 16 : 8;
    constexpr bool SK = WSKIP && !F32;
#define SEAM_K0() do { VMWN(NQL); if constexpr (F32) { SWRITE_KF(0); SBAR(); SLOAD_F((const float*)nxt.V, kbn); } else { SWRITE_HK(0); } SBAR(); } while (0)
    f32x16 pA0, pA1, pB0, pB1; float mnA, mnB, alA, alB; bf16x8 pa0, pa1, pa2, pa3;
    if constexpr (F32) { VMW(); SWRITE_VF(0); SBAR(); } else { SWRITE_HV(0); SBAR(); }
    if (NT > 1) { if constexpr (F32) SLOAD_F((const float*)Kh, KBASE(1)); else SLOAD_H(Kh, Vh, KBASE(1)); }
    SBAR(); qkt<0, SK>(pA0, pA1, K_lds, r32, hi, S.qr, ACT(0));
    if constexpr (F32) { if (NT > 1) { VMW(); SWRITE_KF(1); SBAR(); SLOAD_F((const float*)Vh, KBASE(1)); } }
    MASKT(pA0, pA1, 0); partialSM(pA0, pA1, m_reg, mnA, alA);
    if (NT > 1) { VMW(); if constexpr (F32) { SWRITE_VF(1); SBAR(); if (NT > 2) SLOAD_F((const float*)Kh, KBASE(2)); } else SWRITE_H(1); }
    __syncthreads();
#define HALF_STEP(PX0, PX1, mnX, alX, PY0, PY1, alY, t, KB, VB, SB) do {                                                      \
        SBAR(); qkt<KB, SK>(PX0, PX1, K_lds, r32, hi, S.qr, ACT(t));                                             \
        finishSM(PY0, PY1, alY, l_reg, pa0, pa1, pa2, pa3); SBAR();                                                           \
        if ((t) + 1 < NT) { if constexpr (F32) { VMW(); SWRITE_KF(SB); SBAR(); SLOAD_F((const float*)Vh, KBASE((t) + 1)); }  \
                            else { SLOAD_H(Kh, Vh, KBASE((t) + 1)); } SBAR(); }                                               \
        pv_tile<VB, SK>(o, vb0, pa0, pa1, pa2, pa3, ACT((t) - 1)); MASKT(PX0, PX1, (t)); partialSM(PX0, PX1, m_reg, mnX, alX);                                        \
        __syncthreads();                                                                                                      \
        if ((t) + 1 < NT) { VMW(); if constexpr (F32) { SWRITE_VF(SB); SBAR(); if ((t) + 2 < NT) SLOAD_F((const float*)Kh, KBASE((t) + 2)); } \
                            else { SWRITE_H(SB); } }                                                                          \
        RESC(alX); __syncthreads(); } while (0)
    for (int t = 1; t + 1 < NT; t += 2) {
        HALF_STEP(pB0, pB1, mnB, alB, pA0, pA1, alA, t, 1, 0, 0);
        HALF_STEP(pA0, pA1, mnA, alA, pB0, pB1, alB, t + 1, 0, 1, 1);
    }
    const bool even = (NT & 1) == 0;
    if (even) { SBAR(); qkt<1, SK>(pB0, pB1, K_lds, r32, hi, S.qr, ACT(NT - 1)); SBAR(); }
#define QROW(e) (nxt.Q + (size_t)(wid * QBLK + r32) * LDQ + ((e) >> 1) * 16 + hi * 8 + ((e) & 1) * 4)
    if constexpr (F32) { SLOAD_F((const float*)nxt.K, kbn); SBAR();
#pragma unroll
        for (int e = 0; e < 8; ++e) S.tq[e] = *(const f32x4*)QROW(e); }
    else { SLOAD_H(nxt.K, nxt.V, kbn); SBAR();
#pragma unroll
        for (int d0 = 0; d0 < 8; ++d0) S.qr[d0] = *(const bf16x8*)((const char*)(nxt.Q + (size_t)(wid * QBLK) * LDQ) + d0 * 32 + qvoff); }
    SBAR();
    finishSM(pA0, pA1, alA, l_reg, pa0, pa1, pa2, pa3); SBAR();
    if constexpr (F32) {
#pragma unroll
        for (int e = 8; e < 16; ++e) S.tq[e] = *(const f32x4*)QROW(e); SBAR(); }
#undef QROW
    pv_tile<0, SK>(o, vb0, pa0, pa1, pa2, pa3, ACT(even ? NT - 2 : NT - 1));
    if (even) { MASKT(pB0, pB1, NT - 1); partialSM(pB0, pB1, m_reg, mnB, alB); __syncthreads(); RESC(alB);
        finishSM(pB0, pB1, alB, l_reg, pa0, pa1, pa2, pa3); SBAR(); pv_tile<1, SK>(o, vb0, pa0, pa1, pa2, pa3, ACT(NT - 1)); }
    SBAR(); SEAM_K0();
    if (hi == 0) li_l[r32] = l_reg; asm volatile("s_waitcnt lgkmcnt(0)" ::: "memory");
    float rli[16];
#pragma unroll
    for (int r = 0; r < 16; ++r) rli[r] = __builtin_amdgcn_rcpf(li_l[crow(r, hi)]);
    { char* stg = lds + STG_OFF + wid * (QBLK * STG_ROW);
      int loff = (lane >> 4) * LDQ + (lane & 15) * 8, yoff = (lane >> 4) * LDO + (lane & 15) * 8;
      asm volatile("" : "+v"(loff), "+v"(yoff));
      const TIn* Gw = cur.G + (size_t)(wid * QBLK) * LDQ + loff; TOut* Ow = cur.O + (size_t)(wid * QBLK) * LDO + yoff;
#pragma unroll
      for (int r = 0; r < 16; ++r) { const int orow = crow(r, hi);
#pragma unroll
          for (int d0 = 0; d0 < 4; ++d0) { const float v = o[d0][r] * rli[r]; const float vn = __shfl_xor(v, 1);
              if ((r32 & 1) == 0) *(unsigned*)(stg + orow * STG_ROW + (d0 * 32 + r32) * 2) = cvtpk(v, vn); } }
      asm volatile("s_waitcnt lgkmcnt(0)" ::: "memory");
#pragma unroll
      for (int hf = 0; hf < 2; ++hf) { u32x4 gv[4];
#pragma unroll
          for (int i = 0; i < 4; ++i) gv[i] = *(const u32x4*)(Gw + (size_t)(16 * hf + 4 * i) * LDQ);
#pragma unroll
          for (int i = 0; i < 4; ++i) { const u32x4 ov = *(const u32x4*)(stg + (16 * hf + 4 * i + (lane >> 4)) * STG_ROW + (lane & 15) * 16); const u32x4 g4 = gv[i]; u32x4 w;
#pragma unroll
              for (int e = 0; e < 4; ++e) w[e] = cvtpk(__uint_as_float(ov[e] << 16) * __uint_as_float(g4[e] << 16), __uint_as_float(ov[e] & 0xffff0000u) * __uint_as_float(g4[e] & 0xffff0000u));
              *(u32x4*)(Ow + (size_t)(16 * hf + 4 * i) * LDO) = w; }
          asm volatile("" ::: "memory"); } }
    if constexpr (F32) {
#pragma unroll
        for (int d0 = 0; d0 < 8; ++d0) S.qr[d0] = pack8(S.tq[2 * d0], S.tq[2 * d0 + 1]); }
    __syncthreads();
#undef RESC
#undef KBASE
#undef ACT
#undef MASKT
#undef SEAM_K0
#undef HALF_STEP
}
#undef ROW
#undef VMW
#undef VMWN
#undef SLOAD_H
#undef SWRITE_HK
#undef SWRITE_HV
#undef SWRITE_H
#undef SLOAD_F
#undef SWRITE_KF
#undef SWRITE_VF

__host__ __device__ inline int swa_nramp(int nqb, int W, int qoff) { const int t = W - 1 - qoff; const int n = t < 0 ? 0 : t / QB + 1; return n > nqb ? nqb : n; }
__host__ __device__ inline int swa_nx(int nqb, int nramp, int order) { return (order & ORDER_PAIRED) ? (nramp + 1) / 2 + (nqb - nramp) : nqb; }
struct SwaItem { int bh, qb0, qb1; };
__device__ __forceinline__ SwaItem swa_decode(int L, int nb, int nh, int nhkv, int nqb, int nx, int nramp, int order) {
    const int G = nh / nhkv; SwaItem it; int x;
    if ((order & ORDER_XCD) && (nb * nhkv) % 8 == 0) { const int xcd = L & 7, k = L >> 3, per = G * nx, gi = k / per, r = k - gi * per;
        it.bh = (gi * 8 + xcd) * G + r / nx; x = r % nx; }
    else { it.bh = L / nx; x = L - it.bh * nx; }
    if (order & ORDER_PAIRED) { const int ns = nqb - nramp;
        if (x < ns) { it.qb0 = it.qb1 = nqb - 1 - x; } else { it.qb0 = x - ns; it.qb1 = nramp - 1 - it.qb0; } }
    else { it.qb0 = it.qb1 = ((order & 3) == ORDER_REVERSED) ? nqb - 1 - x : x; }
    return it;
}
template <class TIn, class TOut>
__device__ __forceinline__ BlockRef<TIn, TOut> swa_ref(const SwaItem& it, int pass, const TIn* Q, const TIn* K, const TIn* V, TOut* O,
                                                    int nh, int nhkv, int sq, int skv, int qoff) {
    const int qb = pass ? it.qb1 : it.qb0, kvh = it.bh / (nh / nhkv);
    BlockRef<TIn, TOut> r;
    const int b_ = it.bh / nh, h_ = it.bh % nh; (void)kvh; (void)K; (void)V;
    const TIn* rowb = Q + (size_t)b_ * sq * LDQ + h_ * D;
    r.Q = rowb + (size_t)qb * QB * LDQ; r.K = rowb + DI; r.V = rowb + 2 * DI; r.G = r.Q + 3 * DI;
    r.O = O + ((size_t)b_ * sq + (size_t)qb * QB) * LDO + h_ * D; r.P0 = qoff + qb * QB;
    return r;
}

constexpr int WT_OFF = STG_OFF + NW * QBLK * STG_ROW, ATT_LDS = WT_OFF + 64;
__device__ __forceinline__ void load_c(char* lds, const float* LS, int bh) {
    int tid = threadIdx.x; asm volatile("" : "+v"(tid));
    const int lane = tid & 63, wv = tid >> 6;
    const f32x4* src = (const f32x4*)(LS + (size_t)bh * SEQ) + 2 * tid;
    const f32x4 a = src[0], b = src[1];
    float v[8]; v[0] = a[0]; v[1] = v[0] + a[1]; v[2] = v[1] + a[2]; v[3] = v[2] + a[3]; v[4] = v[3] + b[0]; v[5] = v[4] + b[1]; v[6] = v[5] + b[2]; v[7] = v[6] + b[3];
    float inc = v[7];
#pragma unroll
    for (int o = 1; o < 64; o <<= 1) { const float t = __uint_as_float(__builtin_amdgcn_ds_bpermute(((lane - o) & 63) << 2, __float_as_uint(inc))); if (lane >= o) inc += t; }
    float* wt = (float*)(lds + WT_OFF);
    if (lane == 63) wt[wv] = inc;
    __syncthreads();
    float base = inc - v[7];
#pragma unroll
    for (int w = 0; w < 7; ++w) if (w < wv) base += wt[w];
    f32x4* dst = (f32x4*)(lds + C_OFF) + 2 * tid;
    dst[0] = (f32x4){base + v[0], base + v[1], base + v[2], base + v[3]}; dst[1] = (f32x4){base + v[4], base + v[5], base + v[6], base + v[7]};
}
__device__ __forceinline__ void attn_phase(char* lds, const bf16* P, const float* LS, bf16* Y, int blk, int nblk) {
    constexpr int nqb = SQ / QB, nramp = nqb, nx = (nramp + 1) / 2, total = nx * B * H;
    int L = blk; if (L >= total) return;
    SwaItem it = swa_decode(L, B, H, HKV, nqb, nx, nramp, ORDER); int pass = 0;
    BlockRef<bf16, bf16> cur = swa_ref<bf16, bf16>(it, 0, P, P, P, Y, H, HKV, SQ, SKV, QOFF);
    Seam<bf16> S;
    load_c(lds, LS, it.bh);
    causal_swa_prime<bf16, bf16>(cur, SKV, WINDOW, lds, S);
    for (;;) {
        const bool more_pass = pass == 0 && it.qb1 != it.qb0, more_item = L + nblk < total, last = !more_pass && !more_item;
        SwaItem itn = it; int passn = pass + 1, Ln = L;
        if (!more_pass) { passn = 0; Ln = more_item ? L + nblk : L; itn = swa_decode(Ln, B, H, HKV, nqb, nx, nramp, ORDER); }
        const BlockRef<bf16, bf16> nxt = last ? cur : swa_ref<bf16, bf16>(itn, passn, P, P, P, Y, H, HKV, SQ, SKV, QOFF);
        causal_swa_block<bf16, bf16>(cur, nxt, SKV, WINDOW, lds, S);
        if (last) break;
        if (itn.bh != it.bh) { load_c(lds, LS, itn.bh); __syncthreads(); }
        cur = nxt; it = itn; pass = passn; L = Ln;
    }
}
}

__device__ __forceinline__ void flogit_phase(const bf16* __restrict__ HB, const bf16* __restrict__ WF, const float* __restrict__ b_f, float* __restrict__ LS, int blk, int nblk) {
    typedef short bf16x8_t __attribute__((ext_vector_type(8)));
    const int tid = threadIdx.x, wid = __builtin_amdgcn_readfirstlane(tid >> 6), lane = tid & 63, n = lane & 15, g = lane >> 4;
    for (int rb = blk; rb < M / 32; rb += nblk) {
        const int r0 = rb * 32 + (wid >> 2) * 16, h0 = (wid & 3) * 16;
        const bf16x8_t* ap = (const bf16x8_t*)(HB + (size_t)(r0 + n) * D + 8 * g);
        const bf16x8_t* bp = (const bf16x8_t*)(WF + (size_t)(h0 + n) * D + 8 * g);
        f32x4 acc = (f32x4){0.f, 0.f, 0.f, 0.f};
#pragma unroll 8
        for (int k = 0; k < D / 32; ++k) acc = __builtin_amdgcn_mfma_f32_16x16x32_bf16(ap[4 * k], bp[4 * k], acc, 0, 0, 0);
        const float bias = b_f[h0 + n];
        f32x4 o;
#pragma unroll
        for (int j = 0; j < 4; ++j) { const float z = acc[j] + bias; const float e = __builtin_amdgcn_exp2f(-1.4426950408889634f * fabsf(z));
            o[j] = fminf(z, 0.f) - 0.6931471805599453f * __builtin_amdgcn_logf(1.0f + e); }
        const int row = r0 + 4 * g, b = row / SEQ, s = row % SEQ;
        *(f32x4*)(LS + ((size_t)b * NH + h0 + n) * SEQ + s) = o;
    }
}

#define XB_TMO      128
#define XB_XCNT(j)  (256  + 64 * (j))
#define XB_XSUB(j)  (1280 + 64 * (j))
#define XB_XGEN(j)  (2304 + 64 * (j))
#define XB_TOP      3328
#define XB_TOPGEN   3392
#define XCD_BAR_WORDS 3456
#define XB_SPIN_CAP (1u << 18)

__device__ __forceinline__ unsigned xb_ld(unsigned* p)              { return __hip_atomic_load(p, __ATOMIC_RELAXED, __HIP_MEMORY_SCOPE_AGENT); }
__device__ __forceinline__ unsigned xb_add(unsigned* p, unsigned v) { return __hip_atomic_fetch_add(p, v, __ATOMIC_RELAXED, __HIP_MEMORY_SCOPE_AGENT); }
__device__ __forceinline__ unsigned xb_xcc_id() { return (unsigned)__builtin_amdgcn_s_getreg((3 << 11) | 20) & 0xFu; }
#define XB_SPIN(cond, bar) do { unsigned _sp = 0; while (cond) { __builtin_amdgcn_s_sleep(1); \
    if ((++_sp & 255u) == 0u) { if (xb_ld(&(bar)[XB_TMO])) break; if (_sp > XB_SPIN_CAP) { atomicAdd(&(bar)[XB_TMO], 1u); break; } } } } while (0)

struct XcdBarrier {
    unsigned* bar; unsigned x;
    volatile LAS unsigned* st;
};

__device__ __forceinline__ XcdBarrier xcd_barrier_post(unsigned* bar, volatile LAS unsigned* st) {
    XcdBarrier b; b.bar = bar; b.x = xb_xcc_id(); b.st = st;
    if (threadIdx.x == 0) (void)xb_add(&bar[XB_XCNT(b.x)], 1u);
    return b;
}
__device__ __forceinline__ void xcd_barrier_complete(unsigned* bar, unsigned x, unsigned& nloc, unsigned& nx) {
    const unsigned G = gridDim.x * gridDim.y * gridDim.z;
    unsigned sum, cnt, mine, sp = 0u;
    for (;;) {
        sum = 0u; cnt = 0u; mine = 0u;
#pragma unroll
        for (unsigned j = 0; j < 16; ++j) { const unsigned c = xb_ld(&bar[XB_XCNT(j)]); sum += c; cnt += (c > 0u) ? 1u : 0u; mine = (j == x) ? c : mine; }
        if (sum == G) break;
        __builtin_amdgcn_s_sleep(1);
        if ((++sp & 255u) == 0u) { if (xb_ld(&bar[XB_TMO])) break; if (sp > XB_SPIN_CAP) { atomicAdd(&bar[XB_TMO], 1u); break; } }
    }
    nloc = mine > 0u ? mine : 1u; nx = cnt > 0u ? cnt : 1u;
}

__device__ __forceinline__ void xcd_barrier(const XcdBarrier& b) {
    asm volatile("s_waitcnt vmcnt(0)" ::: "memory");
    __syncthreads();
    if (threadIdx.x == 0) {
        unsigned* bar = b.bar;
        __builtin_amdgcn_s_waitcnt(0);
        unsigned nloc = b.st[0], nx = b.st[1];
        if (nloc == 0u) { xcd_barrier_complete(bar, b.x, nloc, nx); b.st[0] = nloc; b.st[1] = nx; }
        const unsigned old = xb_add(&bar[XB_XSUB(b.x)], 1u);
        const unsigned gen = old / nloc;
        if (old + 1u == (gen + 1u) * nloc) {
            __builtin_amdgcn_fence(__ATOMIC_RELEASE, "agent");
            asm volatile("s_waitcnt vmcnt(0)" ::: "memory");
            const unsigned og = xb_add(&bar[XB_TOP], 1u);
            const unsigned tg = og / nx;
            if (og + 1u == (tg + 1u) * nx) xb_add(&bar[XB_TOPGEN], 1u);
            else XB_SPIN(xb_ld(&bar[XB_TOPGEN]) == tg, bar);
            __builtin_amdgcn_fence(__ATOMIC_ACQUIRE, "agent");
            xb_add(&bar[XB_XGEN(b.x)], 1u);
            asm volatile("s_waitcnt vmcnt(0)" ::: "memory");
        } else {
            XB_SPIN(xb_ld(&bar[XB_XGEN(b.x)]) == gen, bar);
            __builtin_amdgcn_fence(__ATOMIC_ACQUIRE, "agent");
            asm volatile("s_waitcnt vmcnt(0)" ::: "memory");
        }
    }
    __syncthreads();
}

constexpr int CW_BAR = 1024;
constexpr size_t CTL_ZERO_BYTES = 32768;
constexpr int LDS_TOTAL = 163840;
constexpr int MISC_OFF = LDS_TOTAL - 64;
static_assert(fox::ATT_LDS <= MISC_OFF && scan::LDS_BYTES <= MISC_OFF && pg8::STAGE_BYTES <= MISC_OFF && 8 * 8448 <= MISC_OFF, "LDS map");
#ifndef MK_N_LAUNCHES
#define MK_N_LAUNCHES 1
#endif
constexpr int N_PHASES = 9;
struct Args { const float* in[10]; float* out; unsigned char* ws; int ph_lo, ph_hi; };
__global__ void __launch_bounds__(512, 2) mega_fwd(Args args) {
    extern __shared__ __attribute__((aligned(16))) unsigned char lds[];
    LAS unsigned char* L = (LAS unsigned char*)lds;
    volatile LAS unsigned* MISC = (volatile LAS unsigned*)(L + MISC_OFF);
    const int tid = threadIdx.x, lane = tid & 63, wave = __builtin_amdgcn_readfirstlane(tid >> 6);
    const int G = gridDim.x, bx = blockIdx.x;
    if (tid < 16) MISC[tid] = 0u;
    __syncthreads();
    unsigned char* ws = args.ws;
    XcdBarrier bar; bar.bar = (unsigned*)(ws + WS_CTL) + CW_BAR; bar.x = 0; bar.st = nullptr;
    if (MK_N_LAUNCHES != N_PHASES) bar = xcd_barrier_post((unsigned*)(ws + WS_CTL) + CW_BAR, MISC + 8);
    const float* x = args.in[0]; const float* norm_w = args.in[1]; const float* w_in_a = args.in[2]; const float* lb_logits = args.in[3]; const float* o_norm_a = args.in[4];
    const float* w_out_a = args.in[5]; const float* w_in_b = args.in[6]; const float* b_f = args.in[7]; const float* w_out_b = args.in[8]; const float* final_norm = args.in[9];
    float* out = args.out;
    bf16* WA = (bf16*)(ws + WS_WA); bf16* WB = (bf16*)(ws + WS_WB); bf16* WF = (bf16*)(ws + WS_WF); bf16* WOA = (bf16*)(ws + WS_WOA); bf16* WOB = (bf16*)(ws + WS_WOB);
    bf16* HB = (bf16*)(ws + WS_HB); float* X1 = (float*)(ws + WS_X1); bf16* P = (bf16*)(ws + WS_P); bf16* Y = (bf16*)(ws + WS_Y); float* LS = (float*)(ws + WS_LS);
    const int lo = args.ph_lo, hi = args.ph_hi;
#define IN(k) (lo <= (k) && (k) < hi)
#define SEAM(k) do { if (IN(k) && IN((k) + 1)) xcd_barrier(bar); } while (0)

    if (IN(0)) { prologue_phase(L, x, norm_w, w_in_a, w_out_a, w_in_b, w_out_b, ws, bx, G, wave, lane); }
    SEAM(0);
    if (IN(1)) { pg8::Gemm g{HB, WA, M, LDP, D, 0}; pg8::StaticOrder S; S.init(M, LDP, G, bx); pg8::EpiAct<0> E{P, lb_logits, LDP, 0};
        pg8::gemm_phase<pg8::EpiAct<0>, pg8::StaticOrder, true, true>(L, g, S, E); }
    SEAM(1);
    if (IN(2)) { for (int bh = bx; bh < NB * NH; bh += G) scan::scan_unit(L, P, o_norm_a, Y, bh); }
    SEAM(2);
    if (IN(3)) { pg8::Gemm g{Y, WOA, M, D, DI, 0}; pg8::StaticOrder S; S.init(M, D, G, bx); pg8::EpiRes E{x, X1, D, 0};
        pg8::gemm_phase<pg8::EpiRes, pg8::StaticOrder, true, true>(L, g, S, E); }
    SEAM(3);
    if (IN(4)) { const int gw = bx * 8 + wave, NGW = G * 8; for (int m = gw; m < M; m += NGW) rms_row_bf16(X1 + (size_t)m * D, norm_w + D, HB + (size_t)m * D, lane); }
    SEAM(4);
    if (IN(5)) { flogit_phase(HB, WF, b_f, LS, bx, G);
        pg8::Gemm g{HB, WB, M, LDP, D, 0}; pg8::StaticOrder S; S.init(M, LDP, G, bx); pg8::EpiAct<1> E{P, nullptr, LDP, 0};
        pg8::gemm_phase<pg8::EpiAct<1>, pg8::StaticOrder, true, true>(L, g, S, E); }
    SEAM(5);
    if (IN(6)) { fox::attn_phase((char*)lds, P, LS, Y, bx, G); }
    SEAM(6);
    if (IN(7)) { pg8::Gemm g{Y, WOB, M, D, DI, 0}; pg8::StaticOrder S; S.init(M, D, G, bx); pg8::EpiRes E{X1, out, D, 0};
        pg8::gemm_phase<pg8::EpiRes, pg8::StaticOrder, true, true>(L, g, S, E); }
    SEAM(7);
    if (IN(8)) { const int gw = bx * 8 + wave, NGW = G * 8; for (int m = gw; m < M; m += NGW) rms_row_f32(out + (size_t)m * D, final_norm, out + (size_t)m * D, lane); }
#undef IN
#undef SEAM
}

extern "C" void kernel_launch(void* const* d_in, const int* in_sizes, int n_in, void* d_out, int out_size, void* d_ws, size_t ws_size, hipStream_t stream) {
    static int grid = 0;
    if (grid == 0) {
        if (n_in != 10 || in_sizes[0] != M * D || out_size != M * D || ws_size < WS_END) { fprintf(stderr, "kernel_launch: unexpected shapes (n_in %d, in0 %d, out %d, ws %zu < %zu); nothing launched\n", n_in, n_in > 0 ? in_sizes[0] : -1, out_size, ws_size, (size_t)WS_END); grid = -1; return; }
        int dev = 0, cus = 0, per_cu = 0;
        if (hipGetDevice(&dev) != hipSuccess || hipDeviceGetAttribute(&cus, hipDeviceAttributeMultiprocessorCount, dev) != hipSuccess) { fprintf(stderr, "kernel_launch: device query failed\n"); grid = -1; return; }
        if (hipFuncSetAttribute((const void*)mega_fwd, hipFuncAttributeMaxDynamicSharedMemorySize, LDS_TOTAL) != hipSuccess) { fprintf(stderr, "kernel_launch: hipFuncSetAttribute(%d B LDS) failed\n", LDS_TOTAL); grid = -1; return; }
        if (hipOccupancyMaxActiveBlocksPerMultiprocessor(&per_cu, (const void*)mega_fwd, 512, LDS_TOTAL) != hipSuccess || per_cu < 1)
            fprintf(stderr, "kernel_launch: note: occupancy query reports %d workgroups per CU\n", per_cu);
        (void)hipGetLastError();
        grid = cus;
    }
    if (grid < 0) return;
    if (hipMemsetAsync((char*)d_ws + WS_CTL, 0, CTL_ZERO_BYTES, stream) != hipSuccess) { fprintf(stderr, "kernel_launch: hipMemsetAsync failed\n"); return; }
    Args a{};
    for (int i = 0; i < 10; ++i) a.in[i] = (const float*)d_in[i];
    a.out = (float*)d_out; a.ws = (unsigned char*)d_ws;
#if MK_N_LAUNCHES == 1
    a.ph_lo = 0; a.ph_hi = N_PHASES;
    hipLaunchKernelGGL(mega_fwd, dim3(grid), dim3(512), LDS_TOTAL, stream, a);
#else
    for (int p = 0; p < N_PHASES; ++p) { a.ph_lo = p; a.ph_hi = p + 1; hipLaunchKernelGGL(mega_fwd, dim3(grid), dim3(512), LDS_TOTAL, stream, a); }
#endif
    const hipError_t le = hipPeekAtLastError();
    if (le != hipSuccess) fprintf(stderr, "kernel_launch: launch failed: %s\n", hipGetErrorName(le));
}
```

```cpp
#include <hip/hip_runtime.h>
#include <cstdio>
#include <cstdint>

constexpr int NB = 2, SEQ = 4096, D = 4096, DI = 8192, NH = 64, HD = 128;
constexpr int M = NB * SEQ;
constexpr int LDP = 4 * DI;
constexpr int NWB = 4 * DI + NH;
constexpr float EPS = 1e-6f;
namespace pg8 {
#define PG8_LAS __attribute__((address_space(3)))
typedef unsigned short bf16_t;
typedef short bf16x8 __attribute__((ext_vector_type(8)));
typedef float f32x4 __attribute__((ext_vector_type(4)));
typedef unsigned u32x4 __attribute__((ext_vector_type(4)));
constexpr int BM = 256, BK = 64, HALF = 128, HTB = HALF * BK * 2  , STAGE_BYTES = 8 * HTB, NXCD = 8, WGM = 8;

__host__ __device__ __forceinline__ int lds_byte(int r, int c) { const int st = (r >> 4) * 2 + (c >> 5), rr = r & 15, cc = c & 31, ob = rr * 64 + cc * 2; return st * 1024 + (ob ^ (((ob >> 9) & 1) << 5)); }
__host__ __device__ __forceinline__ void stage_rc(int b, int& R, int& C) { const int st = b / 1024, sb = b % 1024, swz = sb ^ (((sb >> 9) & 1) << 5); R = (st >> 1) * 16 + swz / 64; C = (st & 1) * 32 + (swz % 64) / 2; }
__host__ __device__ __forceinline__ int perm32(int rho) { const int n = rho >> 4, i = rho & 15; return 8 * (i >> 2) + 4 * n + (i & 3); }

struct Unit { int pm, pn; };
struct Gemm { const bf16_t* A; const bf16_t* Bt; int M, N, K, pad; };

struct StaticOrder {
    int nM, nN, nwg, G, c;
    __host__ __device__ void init(int M, int N, int G_, int c_) { nM = M / BM; nN = N / BM; nwg = nM * nN; G = G_; c = c_; }
    __host__ __device__ bool next(int i, Unit& u) const {
        const long L = (long)i * G + c; if (L >= nwg) return false;
        int wgid = (int)L; { const int q = nwg / NXCD, r = nwg % NXCD, xcd = wgid % NXCD, off = wgid / NXCD; wgid = (xcd < r ? xcd * (q + 1) : r * (q + 1) + (xcd - r) * q) + off; }
        const int nig = WGM * nN, gid = wgid / nig, fm = gid * WGM, gsz = (nM - fm) < WGM ? (nM - fm) : WGM;
        u.pm = fm + ((wgid % nig) % gsz); u.pn = (wgid % nig) / gsz; return true;
    }
    __device__ __forceinline__ void a_ready(const Unit&) const {}
    __device__ __forceinline__ void done(const Unit&) const {}
};

typedef float f32x2_t __attribute__((ext_vector_type(2)));
typedef __bf16 bf16x2_t __attribute__((ext_vector_type(2)));
__device__ __forceinline__ unsigned cvt_pk_bf16(float lo, float hi) { f32x2_t v = {lo, hi}; bf16x2_t b = __builtin_convertvector(v, bf16x2_t); return __builtin_bit_cast(unsigned, b); }
__device__ __forceinline__ float silu_f(float x) { return x * __builtin_amdgcn_rcpf(1.0f + __builtin_amdgcn_exp2f(-1.4426950408889634f * x)); }

template <int LAYER> struct EpiAct {
    static constexpr bool PERM = true, AFTER_DRAIN = false;
    bf16_t* O; const float* lbl; int ldc, pad;
    __device__ __forceinline__ void operator()(const f32x4 (&acc)[2][2][4][2], const Unit& u, int wr, int wc, int fr, int fq) const {
        const int sec = u.pn >> 5;
        const int row0 = u.pm * BM + wr * 64 + fr, col0 = u.pn * BM + wc * 32 + 8 * fq;
        const int mode = (LAYER == 0) ? ((sec == 0 || sec == 3) ? 1 : (sec == 1 ? 2 : 0)) : (sec == 3 ? 1 : 0);
        const int rb = row0 >> 12, rs = row0 & 4095, hh = (2 * u.pn) & 63;
        bf16_t* hm = O + ((size_t)((sec * 2 + rb) * 64 + hh) * 4096 + rs) * 128 + wc * 32 + 8 * fq;
        if (mode == 2) {
            float lb[2][8], om[2][8];
#pragma unroll
            for (int bj = 0; bj < 2; ++bj) { const int c = col0 + bj * HALF - 8192;
                const f32x4 a0 = *(const f32x4*)(lbl + c), a1 = *(const f32x4*)(lbl + c + 4), b0 = *(const f32x4*)(lbl + 8192 + c), b1 = *(const f32x4*)(lbl + 8192 + c + 4);
#pragma unroll
                for (int e = 0; e < 4; ++e) { const float x0 = __builtin_amdgcn_rcpf(1.0f + __builtin_amdgcn_exp2f(1.4426950408889634f * (b0[e] - a0[e]))), x1 = __builtin_amdgcn_rcpf(1.0f + __builtin_amdgcn_exp2f(1.4426950408889634f * (b1[e] - a1[e])));
                    lb[bj][e] = x0; om[bj][e] = 1.0f - x0; lb[bj][4 + e] = x1; om[bj][4 + e] = 1.0f - x1; } }
#pragma unroll
            for (int ai = 0; ai < 2; ++ai)
#pragma unroll
                for (int m = 0; m < 4; ++m) { bf16_t* rowp = hm + (size_t)(ai * HALF + m * 16) * 128;
#pragma unroll
                    for (int bj = 0; bj < 2; ++bj) { float v[8];
#pragma unroll
                        for (int e = 0; e < 8; ++e) { const float f = acc[ai][bj][m][e >> 2][e & 3];
                            const float sg = __builtin_amdgcn_rcpf(1.0f + __builtin_amdgcn_exp2f(-1.4426950408889634f * f));
                            v[e] = __builtin_amdgcn_logf(lb[bj][e] + om[bj][e] * sg); }
                        u32x4 w; w.x = cvt_pk_bf16(v[0], v[1]); w.y = cvt_pk_bf16(v[2], v[3]); w.z = cvt_pk_bf16(v[4], v[5]); w.w = cvt_pk_bf16(v[6], v[7]);
                        *(u32x4*)(rowp + (size_t)bj * (4096 * 128)) = w; } }
        } else if (mode == 1) {
#pragma unroll
            for (int ai = 0; ai < 2; ++ai)
#pragma unroll
                for (int m = 0; m < 4; ++m) { bf16_t* rowp = hm + (size_t)(ai * HALF + m * 16) * 128;
#pragma unroll
                    for (int bj = 0; bj < 2; ++bj) { float v[8];
#pragma unroll
                        for (int e = 0; e < 8; ++e) v[e] = silu_f(acc[ai][bj][m][e >> 2][e & 3]);
                        u32x4 w; w.x = cvt_pk_bf16(v[0], v[1]); w.y = cvt_pk_bf16(v[2], v[3]); w.z = cvt_pk_bf16(v[4], v[5]); w.w = cvt_pk_bf16(v[6], v[7]);
                        *(u32x4*)(rowp + (size_t)bj * (4096 * 128)) = w; } }
        } else {
#pragma unroll
            for (int ai = 0; ai < 2; ++ai)
#pragma unroll
                for (int m = 0; m < 4; ++m) { bf16_t* rowp = hm + (size_t)(ai * HALF + m * 16) * 128;
#pragma unroll
                    for (int bj = 0; bj < 2; ++bj) { const f32x4 v0 = acc[ai][bj][m][0], v1 = acc[ai][bj][m][1];
                        u32x4 w; w.x = cvt_pk_bf16(v0[0], v0[1]); w.y = cvt_pk_bf16(v0[2], v0[3]); w.z = cvt_pk_bf16(v1[0], v1[1]); w.w = cvt_pk_bf16(v1[2], v1[3]);
                        *(u32x4*)(rowp + (size_t)bj * (4096 * 128)) = w; } }
        }
    }
};
#ifndef EPIRES_FENCE
#define EPIRES_FENCE 0
#endif
struct EpiNull { static constexpr bool PERM = true, AFTER_DRAIN = false; int a, b;
    __device__ __forceinline__ void operator()(const f32x4 (&acc)[2][2][4][2], const Unit& u, int wr, int wc, int fr, int fq) const {
#pragma unroll
        for (int ai = 0; ai < 2; ++ai)
#pragma unroll
            for (int bj = 0; bj < 2; ++bj)
#pragma unroll
                for (int m = 0; m < 4; ++m) asm volatile("" :: "v"(acc[ai][bj][m][0]), "v"(acc[ai][bj][m][1])); } };
struct EpiRes {
    static constexpr bool PERM = false, AFTER_DRAIN = false;
    const float* base; float* out; int ldc, pad;
    __device__ __forceinline__ void operator()(const f32x4 (&acc)[2][2][4][2], const Unit& u, int wr, int wc, int fr, int fq) const {
        const int row0 = u.pm * BM + wr * 64 + fr, col0 = u.pn * BM + wc * 32 + 4 * fq;
#pragma unroll
        for (int ai = 0; ai < 2; ++ai)
#pragma unroll
            for (int m = 0; m < 4; ++m) { const size_t off = (size_t)(row0 + ai * HALF + m * 16) * ldc + col0;
#pragma unroll
                for (int bj = 0; bj < 2; ++bj)
#pragma unroll
                    for (int n = 0; n < 2; ++n) { const f32x4 bs = *(const f32x4*)(base + off + bj * HALF + n * 16); *(f32x4*)(out + off + bj * HALF + n * 16) = bs + acc[ai][bj][m][n]; }
                if (EPIRES_FENCE) asm volatile("" ::: "memory"); }
    }
};
template <class Epi, class Sched, bool ALIGN_EPI = false, bool SP2 = false>
__device__ __forceinline__ void gemm_phase(PG8_LAS unsigned char* lds, const Gemm g, const Sched& S, const Epi& E) {
    const int tid = threadIdx.x, wid = __builtin_amdgcn_readfirstlane(tid >> 6), lane = tid & 63, wr = wid >> 2, wc = wid & 3, fr = lane & 15, fq = lane >> 4;
    const int K = g.K, nt = K / BK;
    unsigned voffA[2], voffB[2];
#pragma unroll
    for (int i = 0; i < 2; ++i) { int R, C; stage_rc(tid * 16 + i * 8192, R, C); const int Rb = Epi::PERM ? ((R & ~31) + perm32(R & 31)) : R;
        voffA[i] = (unsigned)(R * K + C) * 2u; voffB[i] = (unsigned)(Rb * K + C) * 2u; }
    const size_t kstep = (size_t)(BK * 2);
    const size_t hstep = (size_t)HALF * K * 2;
    const size_t tstep = 2 * hstep;
    const unsigned ldsw = (unsigned)wid * 1024u;
    const int aoff = lds_byte(wr * 64 + fr, fq * 8), boff = lds_byte(wc * 32 + fr, fq * 8);
#define PG8_SA(b, h) (((b) * 2 + (h)) * HTB)
#define PG8_SB(b, h) ((4 + (b) * 2 + (h)) * HTB)
#define PG8_STAGE(bufoff, gbase, voff) do { _Pragma("unroll") for (int _i = 0; _i < 2; ++_i) \
        __builtin_amdgcn_global_load_lds((const unsigned*)((const char*)(gbase) + (voff)[_i]), (PG8_LAS unsigned*)(lds + (bufoff) + ldsw + _i * 8192), 16, 0, 0); } while (0)
#define PG8_LDA(dst, b, h) do { _Pragma("unroll") for (int m = 0; m < 4; ++m) _Pragma("unroll") for (int k = 0; k < 2; ++k) dst[m][k] = *(const PG8_LAS bf16x8*)(lds + PG8_SA(b, h) + aoff + m * 2048 + k * 1024); } while (0)
#define PG8_LDB(dst, b, h) do { _Pragma("unroll") for (int n = 0; n < 2; ++n) _Pragma("unroll") for (int k = 0; k < 2; ++k) dst[n][k] = *(const PG8_LAS bf16x8*)(lds + PG8_SB(b, h) + boff + n * 2048 + k * 1024); } while (0)
#define PG8_MMA(ai, bj, At, Bt) do { __builtin_amdgcn_s_setprio(1); _Pragma("unroll") for (int m = 0; m < 4; ++m) _Pragma("unroll") for (int n = 0; n < 2; ++n) _Pragma("unroll") for (int k = 0; k < 2; ++k) \
        acc[ai][bj][m][n] = __builtin_amdgcn_mfma_f32_16x16x32_bf16(Bt[n][k], At[m][k], acc[ai][bj][m][n], 0, 0, 0); __builtin_amdgcn_s_setprio(0); } while (0)
#define PG8_WAIT_V(n) asm volatile("s_waitcnt vmcnt(" #n ")" ::: "memory")
#define PG8_WAIT_L(n) asm volatile("s_waitcnt lgkmcnt(" #n ")" ::: "memory")
#define PG8_BAR __builtin_amdgcn_s_barrier()
#define PG8_SCHED __builtin_amdgcn_sched_barrier(0)
    Unit cur, nxt; int ui = 0;
    if (!S.next(0, cur)) return;
    f32x4 acc[2][2][4][2];
#pragma unroll
    for (int a = 0; a < 2; ++a)
#pragma unroll
        for (int b = 0; b < 2; ++b)
#pragma unroll
            for (int m = 0; m < 4; ++m)
#pragma unroll
                for (int n = 0; n < 2; ++n) acc[a][b][m][n] = (f32x4){0.f, 0.f, 0.f, 0.f};
    bf16x8 At[4][2], B0[2][2], B1[2][2];
    const char* cA = (const char*)g.A + (size_t)cur.pm * tstep; const char* cB = (const char*)g.Bt + (size_t)cur.pn * tstep;
    S.a_ready(cur);
    if constexpr (SP2) {
        PG8_STAGE(PG8_SB(0, 0), cB, voffB); PG8_STAGE(PG8_SB(0, 1), cB + hstep, voffB); PG8_STAGE(PG8_SA(0, 0), cA, voffA); PG8_STAGE(PG8_SA(0, 1), cA + hstep, voffA);
        if (wr == 1) PG8_BAR;
        PG8_WAIT_V(2); PG8_BAR;
        PG8_STAGE(PG8_SB(1, 0), cB + kstep, voffB); PG8_STAGE(PG8_SA(1, 0), cA + kstep, voffA); PG8_STAGE(PG8_SB(1, 1), cB + hstep + kstep, voffB);
        PG8_WAIT_V(6); PG8_BAR;
    } else {
        PG8_STAGE(PG8_SB(0, 0), cB, voffB); PG8_STAGE(PG8_SA(0, 0), cA, voffA); PG8_STAGE(PG8_SB(0, 1), cB + hstep, voffB); PG8_STAGE(PG8_SA(0, 1), cA + hstep, voffA);
        if (wr == 1) PG8_BAR;
        PG8_WAIT_V(4); PG8_BAR;
        PG8_STAGE(PG8_SB(1, 0), cB + kstep, voffB); PG8_STAGE(PG8_SA(1, 0), cA + kstep, voffA); PG8_STAGE(PG8_SB(1, 1), cB + hstep + kstep, voffB);
        PG8_WAIT_V(6); PG8_BAR;
    }
    for (;;) {
        const bool has_next = S.next(ui + 1, nxt);
        const char* nA = has_next ? (const char*)g.A + (size_t)nxt.pm * tstep : cA; const char* nB = has_next ? (const char*)g.Bt + (size_t)nxt.pn * tstep : cB;
        for (int t = 0; t < nt; t += 2) {
            const bool last = (t == nt - 2);
            const char* a1 = cA + (size_t)(t + 1) * kstep;
            const char* a2 = last ? nA : cA + (size_t)(t + 2) * kstep; const char* b2 = last ? nB : cB + (size_t)(t + 2) * kstep;
            const char* a3 = a2 + kstep; const char* b3 = b2 + kstep;
            if (last && has_next) S.a_ready(nxt);
            if constexpr (SP2) {
            PG8_LDB(B0, 0, 0); PG8_LDB(B1, 0, 1); PG8_SCHED; PG8_LDA(At, 0, 0); PG8_STAGE(PG8_SA(1, 1), a1 + hstep, voffA);
            PG8_WAIT_V(8); PG8_WAIT_L(0); PG8_BAR; PG8_MMA(0, 0, At, B0); PG8_MMA(0, 1, At, B1); PG8_BAR; PG8_SCHED;
            PG8_LDA(At, 0, 1); PG8_STAGE(PG8_SB(0, 0), b2, voffB); PG8_STAGE(PG8_SB(0, 1), b2 + hstep, voffB); PG8_STAGE(PG8_SA(0, 0), a2, voffA);
            PG8_WAIT_V(8); PG8_WAIT_L(0); PG8_BAR; PG8_MMA(1, 0, At, B0); PG8_MMA(1, 1, At, B1); PG8_BAR; PG8_SCHED;
            PG8_LDB(B0, 1, 0); PG8_LDB(B1, 1, 1); PG8_SCHED; PG8_LDA(At, 1, 0); PG8_STAGE(PG8_SA(0, 1), a2 + hstep, voffA);
            PG8_WAIT_V(8); PG8_WAIT_L(0); PG8_BAR; PG8_MMA(0, 0, At, B0); PG8_MMA(0, 1, At, B1); PG8_BAR; PG8_SCHED;
            PG8_LDA(At, 1, 1); PG8_STAGE(PG8_SB(1, 0), b3, voffB); PG8_STAGE(PG8_SB(1, 1), b3 + hstep, voffB); PG8_STAGE(PG8_SA(1, 0), a3, voffA);
            PG8_WAIT_V(8); PG8_WAIT_L(0); PG8_BAR; PG8_MMA(1, 0, At, B0); PG8_MMA(1, 1, At, B1); PG8_BAR; PG8_SCHED;
            } else {
            PG8_LDB(B0, 0, 0); PG8_SCHED; PG8_LDA(At, 0, 0); PG8_STAGE(PG8_SA(1, 1), a1 + hstep, voffA);
            PG8_WAIT_L(8); PG8_BAR; PG8_WAIT_L(0); PG8_MMA(0, 0, At, B0); PG8_BAR; PG8_SCHED;
            PG8_LDB(B1, 0, 1); PG8_STAGE(PG8_SB(0, 0), b2, voffB);
            PG8_BAR; PG8_WAIT_L(0); PG8_MMA(0, 1, At, B1); PG8_BAR;
            PG8_LDA(At, 0, 1); PG8_STAGE(PG8_SA(0, 0), a2, voffA);
            PG8_BAR; PG8_WAIT_L(0); PG8_MMA(1, 0, At, B0); PG8_BAR; PG8_SCHED;
            PG8_STAGE(PG8_SB(0, 1), b2 + hstep, voffB);
            PG8_WAIT_V(6); PG8_BAR; PG8_MMA(1, 1, At, B1); PG8_BAR;
            PG8_LDB(B0, 1, 0); PG8_SCHED; PG8_LDA(At, 1, 0); PG8_STAGE(PG8_SA(0, 1), a2 + hstep, voffA);
            PG8_WAIT_L(8); PG8_BAR; PG8_WAIT_L(0); PG8_MMA(0, 0, At, B0); PG8_BAR; PG8_SCHED;
            PG8_LDB(B1, 1, 1); PG8_STAGE(PG8_SB(1, 0), b3, voffB);
            PG8_BAR; PG8_WAIT_L(0); PG8_MMA(0, 1, At, B1); PG8_BAR;
            PG8_LDA(At, 1, 1); PG8_STAGE(PG8_SA(1, 0), a3, voffA);
            PG8_BAR; PG8_WAIT_L(0); PG8_MMA(1, 0, At, B0); PG8_BAR; PG8_SCHED;
            PG8_STAGE(PG8_SB(1, 1), b3 + hstep, voffB);
            PG8_WAIT_V(6); PG8_BAR; PG8_MMA(1, 1, At, B1); PG8_BAR;
            }
        }
        if constexpr (ALIGN_EPI) { if (wr == 0) PG8_BAR; }
        if constexpr (!Epi::AFTER_DRAIN) { E(acc, cur, wr, wc, fr, fq); S.done(cur); }
        if (!has_next) break;
#pragma unroll
        for (int a = 0; a < 2; ++a)
#pragma unroll
            for (int b = 0; b < 2; ++b)
#pragma unroll
                for (int m = 0; m < 4; ++m)
#pragma unroll
                    for (int n = 0; n < 2; ++n) acc[a][b][m][n] = (f32x4){0.f, 0.f, 0.f, 0.f};
        cur = nxt; cA = nA; cB = nB; ++ui;
        if constexpr (ALIGN_EPI) { if (wr == 1) PG8_BAR; }
    }
    PG8_WAIT_V(0);
    if constexpr (!ALIGN_EPI) { if (wr == 0) PG8_BAR; }
    PG8_BAR;
    if constexpr (Epi::AFTER_DRAIN) { E.fused(acc, cur, wr, wc, fr, fq, lds, wid, lane); S.done(cur); }
#undef PG8_SA
#undef PG8_SB
#undef PG8_STAGE
#undef PG8_LDA
#undef PG8_LDB
#undef PG8_MMA
#undef PG8_WAIT_V
#undef PG8_WAIT_L
#undef PG8_BAR
#undef PG8_SCHED
}
}

#define LAS __attribute__((address_space(3)))
typedef unsigned short bf16;
typedef unsigned v4u __attribute__((ext_vector_type(4)));
typedef unsigned v2u __attribute__((ext_vector_type(2)));
typedef float f32x4 __attribute__((ext_vector_type(4)));
__device__ __forceinline__ unsigned pk2(float lo, float hi) { return pg8::cvt_pk_bf16(lo, hi); }
__device__ __forceinline__ float bf2f(unsigned short b) { return __uint_as_float(((unsigned)b) << 16); }
__device__ __forceinline__ float bflo(unsigned w) { return __uint_as_float(w << 16); }
__device__ __forceinline__ float bfhi(unsigned w) { return __uint_as_float(w & 0xffff0000u); }
__device__ __forceinline__ float wave_sum(float v) {
#pragma unroll
    for (int o = 1; o < 64; o <<= 1) v += __shfl_xor(v, o);
    return v;
}
__device__ __forceinline__ float wave_max(float v) {
#pragma unroll
    for (int o = 1; o < 64; o <<= 1) v = fmaxf(v, __shfl_xor(v, o));
    return v;
}

__device__ __forceinline__ void transpose_tile(const float* W, size_t ldw, int K, int k0, int n0, bf16* WT, int nbase, LAS unsigned* scr, int lane) {
    const int g = lane & 15, ks = lane >> 4;
#pragma unroll
    for (int i = 0; i < 8; ++i) {
        const int k = k0 + 8 * i + 2 * ks;
        const f32x4 a = *(const f32x4*)(W + (size_t)k * ldw + n0 + 4 * g), b = *(const f32x4*)(W + (size_t)(k + 1) * ldw + n0 + 4 * g);
#pragma unroll
        for (int j = 0; j < 4; ++j) scr[(4 * g + j) * 33 + 4 * i + ks] = pk2(a[j], b[j]);
    }
    asm volatile("s_waitcnt lgkmcnt(0)" ::: "memory");
    const int c = lane & 7;
#pragma unroll
    for (int r = 0; r < 8; ++r) { const int n = 8 * r + (lane >> 3);
        v4u o; o.x = scr[n * 33 + 4 * c]; o.y = scr[n * 33 + 4 * c + 1]; o.z = scr[n * 33 + 4 * c + 2]; o.w = scr[n * 33 + 4 * c + 3];
        *(v4u*)(WT + (size_t)(n0 - nbase + n) * K + k0 + 8 * c) = o; }
    asm volatile("s_waitcnt lgkmcnt(0)" ::: "memory");
}
__device__ __forceinline__ void rms_row_bf16(const float* xrow, const float* w, bf16* orow, int lane) {
    const f32x4* xr = (const f32x4*)xrow + lane; const f32x4* wr = (const f32x4*)w + lane;
    f32x4 v[16]; float s = 0.f;
#pragma unroll
    for (int j = 0; j < 16; ++j) { v[j] = xr[64 * j]; s += (v[j].x * v[j].x + v[j].y * v[j].y) + (v[j].z * v[j].z + v[j].w * v[j].w); }
    const float rs = 1.0f / sqrtf(wave_sum(s) * (1.0f / D) + EPS);
    v2u* o8 = (v2u*)orow + lane;
#pragma unroll
    for (int j = 0; j < 16; ++j) { const f32x4 g = wr[64 * j]; v2u o; o.x = pk2(v[j].x * rs * g.x, v[j].y * rs * g.y); o.y = pk2(v[j].z * rs * g.z, v[j].w * rs * g.w); o8[64 * j] = o; }
}
__device__ __forceinline__ void rms_row_f32(const float* xrow, const float* w, float* orow, int lane) {
    const f32x4* xr = (const f32x4*)xrow + lane; const f32x4* wr = (const f32x4*)w + lane;
    f32x4 v[16]; float s = 0.f;
#pragma unroll
    for (int j = 0; j < 16; ++j) { v[j] = xr[64 * j]; s += (v[j].x * v[j].x + v[j].y * v[j].y) + (v[j].z * v[j].z + v[j].w * v[j].w); }
    const float rs = 1.0f / sqrtf(wave_sum(s) * (1.0f / D) + EPS);
    f32x4* o = (f32x4*)orow + lane;
#pragma unroll
    for (int j = 0; j < 16; ++j) { const f32x4 g = wr[64 * j]; o[64 * j] = (f32x4){v[j].x * rs * g.x, v[j].y * rs * g.y, v[j].z * rs * g.z, v[j].w * rs * g.w}; }
}

constexpr size_t MiB = 1u << 20;
constexpr size_t WS_CTL = 0;
constexpr size_t WS_WA  = 1 * MiB;
constexpr size_t WS_WB  = WS_WA + 256 * MiB;
constexpr size_t WS_WF  = WS_WB + 256 * MiB;
constexpr size_t WS_WOA = WS_WF + 1 * MiB;
constexpr size_t WS_WOB = WS_WOA + 64 * MiB;
constexpr size_t WS_HB  = WS_WOB + 64 * MiB;
constexpr size_t WS_X1  = WS_HB + 64 * MiB;
constexpr size_t WS_P   = WS_X1 + 128 * MiB;
constexpr size_t WS_Y   = WS_P + 512 * MiB;
constexpr size_t WS_LS  = WS_Y + 128 * MiB;
constexpr size_t WS_C   = WS_LS + 2 * MiB;
constexpr size_t WS_END = WS_C + 2 * MiB;

#ifndef CONV_P0_PCT
#define CONV_P0_PCT 0
#endif
__device__ __forceinline__ void prologue_phase(LAS unsigned char* lds, int part, const float* x, const float* norm_w, const float* w_in_a, const float* w_out_a, const float* w_in_b, const float* w_out_b,
                                               unsigned char* ws, int vcu, int G, int wave, int lane) {
    LAS unsigned* scr = (LAS unsigned*)(lds + wave * 8448);
    const int gw = vcu * 8 + wave, NGW = G * 8;
    bf16* WA = (bf16*)(ws + WS_WA); bf16* WB = (bf16*)(ws + WS_WB); bf16* WF = (bf16*)(ws + WS_WF); bf16* WOA = (bf16*)(ws + WS_WOA); bf16* WOB = (bf16*)(ws + WS_WOB);
    constexpr int T_IN = (D / 64) * (LDP / 64);
    constexpr int T_F = (D / 64) * 1;
    constexpr int T_OUT = (DI / 64) * (D / 64);
    constexpr int T_DEF = T_OUT + T_IN + T_F + T_OUT, SPLIT = (int)((long)T_DEF * CONV_P0_PCT / 100);
    if (part == 0) {
        for (int it = gw; it < T_IN; it += NGW) { const int kb = it / (LDP / 64), nb = it % (LDP / 64); transpose_tile(w_in_a, LDP, D, kb * 64, nb * 64, WA, 0, scr, lane); }
        bf16* HB = (bf16*)(ws + WS_HB);
        for (int m = gw; m < M; m += NGW) rms_row_bf16(x + (size_t)m * D, norm_w, HB + (size_t)m * D, lane);
    }
    {
        const int i0 = (part == 0) ? 0 : SPLIT, i1 = (part == 0) ? SPLIT : T_DEF;
        for (int it = i0 + gw; it < i1; it += NGW) {
            int r = it;
            if (r < T_OUT) { const int kb = r / (D / 64), nb = r % (D / 64); transpose_tile(w_out_a, D, DI, kb * 64, nb * 64, WOA, 0, scr, lane); continue; } r -= T_OUT;
            if (r < T_IN) { const int kb = r / (LDP / 64), nb = r % (LDP / 64); transpose_tile(w_in_b, NWB, D, kb * 64, nb * 64, WB, 0, scr, lane); continue; } r -= T_IN;
            if (r < T_F) { transpose_tile(w_in_b, NWB, D, r * 64, LDP, WF, LDP, scr, lane); continue; } r -= T_F;
            { const int kb = r / (D / 64), nb = r % (D / 64); transpose_tile(w_out_b, D, DI, kb * 64, nb * 64, WOB, 0, scr, lane); }
        }
    }
}

namespace scan {
typedef short s16x4 __attribute__((ext_vector_type(4)));
typedef short bf16x8 __attribute__((ext_vector_type(8)));
typedef float f32x4 __attribute__((ext_vector_type(4)));
typedef unsigned u32x2 __attribute__((ext_vector_type(2)));
#ifndef SCAN_STAGGER
#define SCAN_STAGGER 1
#endif
constexpr int R = 8, NSTEP = SEQ / 16;
constexpr int RAW = 0, PRD = R * 16384, PRD_SZ = 3 * 4096 + 512, QDT = 0, KIT = 4096, KE = 8192, DEC = 12288, SSQ = PRD + 2 * PRD_SZ, LDS_BYTES = SSQ + 1024;
__device__ __forceinline__ s16x4 trd(LAS const unsigned char* p) { return __builtin_bit_cast(s16x4, __builtin_amdgcn_ds_read_tr16_b64_v4i16((LAS s16x4*)p)); }
__device__ __forceinline__ s16x4 pk4(float a, float b, float c, float d) { u32x2 w; w.x = pk2(a, b); w.y = pk2(c, d); return __builtin_bit_cast(s16x4, w); }
__device__ __forceinline__ bf16x8 cat8(s16x4 a, s16x4 b) { return __builtin_shufflevector(a, b, 0, 1, 2, 3, 4, 5, 6, 7); }
#define SC_BAR() do { asm volatile("" ::: "memory"); __builtin_amdgcn_s_barrier(); asm volatile("" ::: "memory"); } while (0)

__device__ __forceinline__ void scan_unit(LAS unsigned char* lds, const bf16* __restrict__ P, const float* __restrict__ onw, bf16* __restrict__ Y, int bh) {
    const int tid = threadIdx.x, wid = __builtin_amdgcn_readfirstlane(tid >> 6), lane = tid & 63, n = lane & 15, g = lane >> 4, tq = n >> 2, tp = n & 3;
    const int b = bh / NH, h = bh % NH;
    const bf16* base = P + (size_t)(b * NH + h) * SEQ * HD;
    size_t goff[2]; int ldst[2];
#pragma unroll
    for (int ii = 0; ii < 2; ++ii) { const int i = 2 * wid + ii, ti = i >> 2, rg = i & 3, row = 4 * rg + (lane >> 4), pc = lane & 15, c = pc ^ ((row & 7) << 1);
        const int sec = (ti == 0) ? 1 : ((ti == 1) ? 0 : ti);
        goff[ii] = (size_t)row * HD + (size_t)sec * ((size_t)NB * NH * SEQ * HD) + c * 8; ldst[ii] = ti * 4096 + rg * 1024; }
#define SC_DMA(step) do { const int st_ = (step) < NSTEP ? (step) : NSTEP - 1; const int sl_ = ((step) & (R - 1)) * 16384; _Pragma("unroll") for (int ii = 0; ii < 2; ++ii) \
        __builtin_amdgcn_global_load_lds((const unsigned*)(base + (size_t)st_ * 16 * HD + goff[ii]), (LAS unsigned*)(lds + RAW + sl_ + ldst[ii]), 16, 0, 0); } while (0)
    const int rrow = 4 * g + tq;
    const int rtr = rrow * 256 + ((2 * wid + (tp >> 1)) ^ ((rrow & 7) << 1)) * 16 + 8 * (tp & 1);
    const int rsg = n * 256 + ((2 * wid + (g >> 1)) ^ ((n & 7) << 1)) * 16 + 8 * (g & 1);
    const int wq = (16 * wid + n) * 32 + g * 8;
    const int wk = (g >> 1) * 2048 + (16 * wid + n) * 16 + (g & 1) * 8;
    const int rqt = (4 * g + tq) * 32 + 8 * tp;
    const int rke = (g >> 1) * 2048 + n * 16 + (g & 1) * 8;
    const int rdec = (4 * g) * 4;
    s16x4 ltri; { short one = (short)0x3F80; ltri[0] = (4 * g + 0 <= n) ? one : (short)0; ltri[1] = (4 * g + 1 <= n) ? one : (short)0; ltri[2] = (4 * g + 2 <= n) ? one : (short)0; ltri[3] = (4 * g + 3 <= n) ? one : (short)0; }
    f32x4 gain = *(const f32x4*)(onw + h * HD + 16 * wid + 4 * g);
    asm volatile("" : "+v"(gain[0]), "+v"(gain[1]), "+v"(gain[2]), "+v"(gain[3]));
    f32x4 S[8];
#pragma unroll
    for (int t = 0; t < 8; ++t) S[t] = (f32x4){0.f, 0.f, 0.f, 0.f};
    f32x4 oprev = (f32x4){0.f, 0.f, 0.f, 0.f};
#define SC_PREP(s_) do { const LAS unsigned char* raw_ = lds + RAW + ((s_) & (R - 1)) * 16384; LAS unsigned char* img_ = lds + PRD + ((s_) & 1) * PRD_SZ; \
        const s16x4 lfB = trd(raw_ + rtr), qsB = trd(raw_ + 4096 + rtr); \
        const f32x4 G = __builtin_amdgcn_mfma_f32_16x16x16bf16_1k(ltri, lfB, (f32x4){0.f, 0.f, 0.f, 0.f}, 0, 0, 0); \
        const float dec_ = __builtin_amdgcn_exp2f(__shfl(G[3], 48 + n)); \
        float qd[4], ki[4], ke[4]; \
        _Pragma("unroll") for (int j = 0; j < 4; ++j) { const float lf = bf2f((unsigned short)lfB[j]), qs = bf2f((unsigned short)qsB[j]); \
            const float E = __builtin_amdgcn_exp2f(G[j]), Ei = __builtin_amdgcn_exp2f(-G[j]); \
            const float kk = 1.0f - __builtin_amdgcn_exp2f(lf); \
            qd[j] = qs * E; ki[j] = kk * Ei; ke[j] = ki[j] * dec_; } \
        *(LAS s16x4*)(img_ + QDT + wq) = pk4(qd[0], qd[1], qd[2], qd[3]); \
        *(LAS s16x4*)(img_ + KIT + wq) = pk4(ki[0], ki[1], ki[2], ki[3]); \
        *(LAS s16x4*)(img_ + KE + wk) = pk4(ke[0], ke[1], ke[2], ke[3]); \
        if (g == 0) *(LAS float*)(img_ + DEC + (16 * wid + n) * 4) = dec_; } while (0)
#define SC_OUT(s_) do { const LAS unsigned char* rawp = lds + RAW + ((s_) & (R - 1)) * 16384; const LAS unsigned char* sq = lds + SSQ + ((s_) & 1) * 512 + n * 32; \
        const f32x4 a = *(const LAS f32x4*)sq, c = *(const LAS f32x4*)(sq + 16); \
        const float tot = ((a[0] + a[1]) + (a[2] + a[3])) + ((c[0] + c[1]) + (c[2] + c[3])); \
        const float rs = __builtin_amdgcn_rsqf(tot * (1.0f / HD) + EPS); \
        const s16x4 sgv = *(const LAS s16x4*)(rawp + 3 * 4096 + rsg); \
        const float y0 = oprev[0] * rs * gain[0] * bf2f((unsigned short)sgv[0]), y1 = oprev[1] * rs * gain[1] * bf2f((unsigned short)sgv[1]); \
        const float y2 = oprev[2] * rs * gain[2] * bf2f((unsigned short)sgv[2]), y3 = oprev[3] * rs * gain[3] * bf2f((unsigned short)sgv[3]); \
        u32x2 w; w.x = pk2(y0, y1); w.y = pk2(y2, y3); \
        *(u32x2*)(Y + (size_t)(b * SEQ + 16 * (s_) + n) * DI + h * HD + 16 * wid + 4 * g) = w; } while (0)
    SC_DMA(0); SC_DMA(1); SC_DMA(2); SC_DMA(3); SC_DMA(4); SC_DMA(5);
    asm volatile("s_waitcnt vmcnt(10)" ::: "memory");
    SC_BAR();
    SC_PREP(0);
    for (int st = 0; st < NSTEP; ++st) {
        if (st < 6) asm volatile("s_waitcnt vmcnt(8) lgkmcnt(0)" ::: "memory"); else asm volatile("s_waitcnt vmcnt(12) lgkmcnt(0)" ::: "memory");
        SC_BAR();
        SC_DMA(st + 6);
        if (SCAN_STAGGER && wid >= 4 && st + 1 < NSTEP) SC_PREP(st + 1);
        if (st > 0) SC_OUT(st - 1);
        {
            const LAS unsigned char* raw = lds + RAW + (st & (R - 1)) * 16384; const LAS unsigned char* img = lds + PRD + (st & 1) * PRD_SZ;
            s16x4 qf[8], kf[8];
#pragma unroll
            for (int t = 0; t < 8; ++t) { qf[t] = trd(img + QDT + rqt + 512 * t); kf[t] = trd(img + KIT + rqt + 512 * t); }
            const s16x4 vf = trd(raw + 2 * 4096 + rtr);
            f32x4 sc = (f32x4){0.f, 0.f, 0.f, 0.f};
#pragma unroll
            for (int u = 0; u < 4; ++u) sc = __builtin_amdgcn_mfma_f32_16x16x32_bf16(cat8(kf[2 * u], kf[2 * u + 1]), cat8(qf[2 * u], qf[2 * u + 1]), sc, 0, 0, 0);
#pragma unroll
            for (int j = 0; j < 4; ++j) sc[j] = (4 * g + j <= n) ? sc[j] : 0.f;
            f32x4 o = (f32x4){0.f, 0.f, 0.f, 0.f};
#pragma unroll
            for (int u = 0; u < 4; ++u) { const s16x4 s0 = pk4(S[2 * u][0], S[2 * u][1], S[2 * u][2], S[2 * u][3]), s1 = pk4(S[2 * u + 1][0], S[2 * u + 1][1], S[2 * u + 1][2], S[2 * u + 1][3]);
                o = __builtin_amdgcn_mfma_f32_16x16x32_bf16(cat8(s0, s1), cat8(qf[2 * u], qf[2 * u + 1]), o, 0, 0, 0); }
            o = __builtin_amdgcn_mfma_f32_16x16x16bf16_1k(vf, pk4(sc[0], sc[1], sc[2], sc[3]), o, 0, 0, 0);
#pragma unroll
            for (int t = 0; t < 8; ++t) { const s16x4 kef = *(const LAS s16x4*)(img + KE + rke + 256 * t); const f32x4 dv = *(const LAS f32x4*)(img + DEC + rdec + 64 * t);
                S[t] = __builtin_amdgcn_mfma_f32_16x16x16bf16_1k(kef, vf, S[t] * dv, 0, 0, 0); }
            float ss = (o[0] * o[0] + o[1] * o[1]) + (o[2] * o[2] + o[3] * o[3]);
            ss += __shfl_xor(ss, 16); ss += __shfl_xor(ss, 32);
            if (g == 0) *(LAS float*)(lds + SSQ + (st & 1) * 512 + (n * 8 + wid) * 4) = ss;
            oprev = o;
        }
        if ((!SCAN_STAGGER || wid < 4) && st + 1 < NSTEP) SC_PREP(st + 1);
    }
    asm volatile("s_waitcnt lgkmcnt(0)" ::: "memory");
    SC_BAR();
    SC_OUT(NSTEP - 1);
    asm volatile("s_waitcnt vmcnt(0) lgkmcnt(0)" ::: "memory");
    SC_BAR();
#undef SC_DMA
#undef SC_PREP
#undef SC_OUT
}
#undef SC_BAR
}

namespace fox {
enum { ORDER_NATURAL = 0, ORDER_REVERSED = 1, ORDER_PAIRED = 2, ORDER_XCD = 4 };
constexpr int B = NB, H = NH, HKV = NH, SQ = SEQ, SKV = SEQ, D = HD, QOFF = 0, WINDOW = SEQ;
constexpr int LDQ = HD, LDO = DI;
constexpr size_t SECSZ = (size_t)NB * NH * SEQ * HD;
constexpr float THR = 8.f;
constexpr int ORDER = ORDER_PAIRED | ORDER_XCD;
constexpr bool WSKIP = false;
constexpr float ISCALE = 11.313708498984761f;
constexpr int STG_ROW = 272;
constexpr float SCALE = 0.08838834764831845f;
constexpr int NW = 8, QBLK = 32, KVBLK = 64, QB = NW * QBLK;
constexpr int SHM_V = KVBLK * D * 2, SHM_K = KVBLK * D * 2;
constexpr int LDS_BYTES = 2 * SHM_V + 2 * SHM_K + NW * 64 * 4;
constexpr int C_OFF = LDS_BYTES, STG_OFF = C_OFF + SEQ * 4;
static_assert(D == 128 && SQ % QB == 0 && SKV % KVBLK == 0 && H % HKV == 0 && QOFF >= 0 && QOFF + SQ <= SKV && WINDOW >= 1, "geometry");

using bf16 = unsigned short;
typedef short bf16x8 __attribute__((ext_vector_type(8)));
typedef short s16x4 __attribute__((ext_vector_type(4)));
typedef float f32x16 __attribute__((ext_vector_type(16)));
typedef float f32x4 __attribute__((ext_vector_type(4)));
typedef unsigned u32x4 __attribute__((ext_vector_type(4)));
template <class A, class Bt> struct same_t { static constexpr bool v = false; };
template <class A> struct same_t<A, A> { static constexpr bool v = true; };

#define KSWZ(row, colB) ((row) * 256 + ((colB) ^ (((row) & 7) << 4)))
#define SBAR() __builtin_amdgcn_sched_barrier(0)
__device__ __forceinline__ int v_st(int k, int c) { const int kk = (k & ~0xC) | ((k & 4) << 1) | ((k & 8) >> 1); return ((kk >> 3) * 4 + (c >> 5)) * 512 + ((kk & 7) * 32 + (c & 31)) * 2; }
__device__ __forceinline__ int v_rd_base(int lane) { return ((lane & 3) << 3) | (((lane >> 2) & 3) << 6) | (((lane >> 4) & 1) << 5) | (((lane >> 5) & 1) << 8); }
constexpr int v_rd_off(int d0, int ks, int half) { return d0 * 512 + ks * 4096 + half * 2048; }
__device__ __forceinline__ int crow(int r, int hi) { return (r & 3) + 8 * (r >> 2) + 4 * hi; }
__device__ __forceinline__ unsigned cvtpk(float lo, float hi) {
    unsigned r; asm volatile("v_cvt_pk_bf16_f32 %0, %1, %2" : "=v"(r) : "v"(lo), "v"(hi)); return r;
}
__device__ __forceinline__ bf16x8 pack8(f32x4 a, f32x4 b) {
    u32x4 w = {cvtpk(a[0], a[1]), cvtpk(a[2], a[3]), cvtpk(b[0], b[1]), cvtpk(b[2], b[3])};
    return *reinterpret_cast<bf16x8*>(&w);
}
template <class T> __device__ __forceinline__ bf16x8 load8(const T* p) {
    if constexpr (same_t<T, float>::v) { return pack8(*(const f32x4*)p, *(const f32x4*)(p + 4)); }
    else { return *reinterpret_cast<const bf16x8*>(p); }
}
__device__ __forceinline__ void mask_tile(f32x16& p0, f32x16& p1, int dq, unsigned W) {
    const float NEG = -__builtin_inff();
#pragma unroll
    for (int r = 0; r < 16; ++r) {
        const int c = (r & 3) + 8 * (r >> 2);
        if ((unsigned)(dq - c) >= W) p0[r] = NEG;
        if ((unsigned)(dq - c - 32) >= W) p1[r] = NEG;
    }
}
__device__ __forceinline__ void partialSM(f32x16& p0, f32x16& p1, float& m_reg, float& mn, float& alpha) {
    float pmax = p0[0]; for (int r = 1; r < 16; ++r) pmax = fmaxf(pmax, p0[r]); for (int r = 0; r < 16; ++r) pmax = fmaxf(pmax, p1[r]);
    { auto rr = __builtin_amdgcn_permlane32_swap(__float_as_uint(pmax), __float_as_uint(pmax), false, false);
      pmax = fmaxf(__uint_as_float(rr[0]), __uint_as_float(rr[1])); }
    constexpr float C2 = 1.4426950408889634f * SCALE;
    if (__builtin_expect(__all((pmax - m_reg) * SCALE <= THR), 1)) { mn = m_reg; alpha = 1.f; }
    else { mn = fmaxf(m_reg, pmax); alpha = __builtin_amdgcn_exp2f((m_reg - mn) * C2); m_reg = mn; }
    const float mnL = -mn * C2;
    for (int r = 0; r < 16; ++r) p0[r] = fmaf(p0[r], C2, mnL); for (int r = 0; r < 16; ++r) p1[r] = fmaf(p1[r], C2, mnL);
    for (int r = 0; r < 16; ++r) p0[r] = __builtin_amdgcn_exp2f(p0[r]);
}
__device__ __forceinline__ void finishSM(f32x16& p0, f32x16& p1, float alpha, float& l_reg, bf16x8& pa0, bf16x8& pa1, bf16x8& pa2, bf16x8& pa3) {
    for (int r = 0; r < 16; ++r) p1[r] = __builtin_amdgcn_exp2f(p1[r]);
    float ps = 0; for (int r = 0; r < 16; ++r) ps += p0[r]; for (int r = 0; r < 16; ++r) ps += p1[r];
    { auto rr = __builtin_amdgcn_permlane32_swap(__float_as_uint(ps), __float_as_uint(ps), false, false);
      ps = __uint_as_float(rr[0]) + __uint_as_float(rr[1]); }
    l_reg = l_reg * alpha + ps;
#define PK4(P, B_, OUT) do { unsigned a0 = cvtpk(P[B_+0], P[B_+1]), a1 = cvtpk(P[B_+2], P[B_+3]);                          \
        unsigned b0 = cvtpk(P[B_+4], P[B_+5]), b1 = cvtpk(P[B_+6], P[B_+7]);                                             \
        auto r0 = __builtin_amdgcn_permlane32_swap(a0, b0, false, false); auto r1 = __builtin_amdgcn_permlane32_swap(a1, b1, false, false); \
        u32x4 w = {r0[0], r1[0], r0[1], r1[1]}; OUT = *reinterpret_cast<bf16x8*>(&w); } while (0)
    PK4(p0, 0, pa0); PK4(p0, 8, pa1); PK4(p1, 0, pa2); PK4(p1, 8, pa3);
#undef PK4
}
__device__ __forceinline__ void bias_tile(f32x16& p0, f32x16& p1, const float* cl, int kb, int hi) {
    const f32x4* cp = (const f32x4*)(cl + kb + 4 * hi);
#pragma unroll
    for (int j = 0; j < 4; ++j) { const f32x4 c0 = cp[2 * j], c1 = cp[8 + 2 * j];
#pragma unroll
        for (int e = 0; e < 4; ++e) { p0[4 * j + e] = fmaf(c0[e], -ISCALE, p0[4 * j + e]); p1[4 * j + e] = fmaf(c1[e], -ISCALE, p1[4 * j + e]); } }
}
template <int KB, bool SK>
__device__ __forceinline__ void qkt(f32x16& p0, f32x16& p1, const char* K_lds, int r32, int hi, const bf16x8* qr, bool act) {
    if (SK && !act) { const float NEG = -__builtin_inff();
#pragma unroll
        for (int r = 0; r < 16; ++r) { p0[r] = NEG; p1[r] = NEG; } return; }
    p0 = f32x16{}; p1 = f32x16{};
    const char* kb[4];
#pragma unroll
    for (int dd = 0; dd < 4; ++dd) kb[dd] = K_lds + KB * SHM_K + KSWZ(r32, (dd * 16 + hi * 8) * 2);
#pragma unroll
    for (int d0 = 0; d0 < 8; ++d0) { const char* a = kb[d0 & 3] + (d0 >> 2) * 128;
        bf16x8 b0 = *reinterpret_cast<const bf16x8*>(a);
        bf16x8 b1 = *reinterpret_cast<const bf16x8*>(a + 32 * 256);
        p0 = __builtin_amdgcn_mfma_f32_32x32x16_bf16(b0, qr[d0], p0, 0, 0, 0);
        p1 = __builtin_amdgcn_mfma_f32_32x32x16_bf16(b1, qr[d0], p1, 0, 0, 0); }
}
template <int VB, bool SK>
__device__ __forceinline__ void pv_tile(f32x16* o, int vb0, bf16x8 pa0, bf16x8 pa1, bf16x8 pa2, bf16x8 pa3, bool act) {
    if (SK && !act) return;
#define TRRD(dst, off) asm volatile("ds_read_b64_tr_b16 %0, %1 offset:%2" : "=&v"(dst) : "v"(vb0), "i"(off) : "memory")
#define PV_D0(d0) do { s16x4 l0, l1, l2, l3, h0, h1, h2, h3; constexpr int b_ = VB * SHM_V + v_rd_off(d0, 0, 0);     \
        TRRD(l0, b_); TRRD(h0, b_ + 2048); TRRD(l1, b_ + 4096); TRRD(h1, b_ + 6144); TRRD(l2, b_ + 8192); TRRD(h2, b_ + 10240); TRRD(l3, b_ + 12288); TRRD(h3, b_ + 14336); \
        asm volatile("s_waitcnt lgkmcnt(0)" ::: "memory"); SBAR();                 \
        o[d0] = __builtin_amdgcn_mfma_f32_32x32x16_bf16(pa0, (bf16x8){l0[0], l0[1], l0[2], l0[3], h0[0], h0[1], h0[2], h0[3]}, o[d0], 0, 0, 0);   \
        o[d0] = __builtin_amdgcn_mfma_f32_32x32x16_bf16(pa1, (bf16x8){l1[0], l1[1], l1[2], l1[3], h1[0], h1[1], h1[2], h1[3]}, o[d0], 0, 0, 0);   \
        o[d0] = __builtin_amdgcn_mfma_f32_32x32x16_bf16(pa2, (bf16x8){l2[0], l2[1], l2[2], l2[3], h2[0], h2[1], h2[2], h2[3]}, o[d0], 0, 0, 0);   \
        o[d0] = __builtin_amdgcn_mfma_f32_32x32x16_bf16(pa3, (bf16x8){l3[0], l3[1], l3[2], l3[3], h3[0], h3[1], h3[2], h3[3]}, o[d0], 0, 0, 0); } while (0)
    PV_D0(0); PV_D0(1); PV_D0(2); PV_D0(3);
#undef PV_D0
#undef TRRD
}

template <class TIn, class TOut> struct BlockRef { const TIn* Q; const TIn* K; const TIn* V; const TIn* G; TOut* O; int P0; };
template <class TIn> struct Seam {
    bf16x8 qr[8];
    bf16x8 st_v0, st_v1, st_k0, st_k1; f32x4 sf0, sf1, sf2, sf3;
    f32x4 tq[16];
};
__device__ __forceinline__ int swa_jlo(int P0, int W) { const int lowk = P0 - W + 1; return lowk > 0 ? lowk / KVBLK : 0; }
__device__ __forceinline__ int swa_jhi(int P0, int skv) { int j = (P0 + QB - 1) / KVBLK + 1; return j > skv / KVBLK ? skv / KVBLK : j; }
#define ROW(p, k0, rr) ((p) + (size_t)((k0) + (rr)) * LDQ + sc)
#define VMW() asm volatile("s_waitcnt vmcnt(0)" ::: "memory")
#define VMWN(n) asm volatile("s_waitcnt vmcnt(%0)" :: "i"(n) : "memory")
#define SLOAD_H(Kp, Vp, k0) do { const char* kb__ = (const char*)((Kp) + (size_t)(k0) * LDQ); const char* vb__ = (const char*)((Vp) + (size_t)(k0) * LDQ);     \
                         S.st_v0 = *(const bf16x8*)(vb__ + svoff); S.st_v1 = *(const bf16x8*)(vb__ + (size_t)32 * LDQ * 2 + svoff);              \
                         S.st_k0 = *(const bf16x8*)(kb__ + svoff); S.st_k1 = *(const bf16x8*)(kb__ + (size_t)32 * LDQ * 2 + svoff); } while (0)
#define SWRITE_HK(bf) do { *(bf16x8*)(K_lds + (bf) * SHM_K + kws) = S.st_k0; *(bf16x8*)(K_lds + (bf) * SHM_K + kws + 32 * 256) = S.st_k1; } while (0)
#define SWRITE_HV(bf) do { *(bf16x8*)(V_lds + (bf) * SHM_V + vst0) = S.st_v0; *(bf16x8*)(V_lds + (bf) * SHM_V + vst1) = S.st_v1; } while (0)
#define SWRITE_H(bf) do { SWRITE_HV(bf); SWRITE_HK(bf); } while (0)
#define SLOAD_F(p, k0) do { S.sf0 = *(const f32x4*)ROW(p, k0, sr); S.sf1 = *(const f32x4*)(ROW(p, k0, sr) + 4);                \
                            S.sf2 = *(const f32x4*)ROW(p, k0, 32 + sr); S.sf3 = *(const f32x4*)(ROW(p, k0, 32 + sr) + 4); } while (0)
#define SWRITE_KF(bf) do { *(bf16x8*)(K_lds + (bf) * SHM_K + kws) = pack8(S.sf0, S.sf1); *(bf16x8*)(K_lds + (bf) * SHM_K + kws + 32 * 256) = pack8(S.sf2, S.sf3); } while (0)
#define SWRITE_VF(bf) do { *(bf16x8*)(V_lds + (bf) * SHM_V + vst0) = pack8(S.sf0, S.sf1); *(bf16x8*)(V_lds + (bf) * SHM_V + vst1) = pack8(S.sf2, S.sf3); } while (0)
template <class TIn, class TOut>
__device__ __forceinline__ void causal_swa_prime(const BlockRef<TIn, TOut>& cur, int skv, int W, char* lds, Seam<TIn>& S) {
    constexpr bool F32 = same_t<TIn, float>::v;
    const int tid = threadIdx.x, wid = __builtin_amdgcn_readfirstlane(tid >> 6), lane = tid & 63, r32 = lane & 31, hi = lane >> 5;
    const int sr = tid >> 4, sc = (tid & 15) * 8, kws = KSWZ(sr, sc * 2); char* K_lds = lds + 2 * SHM_V;
    const unsigned svoff = (unsigned)(sr * LDQ + sc) * 2u, qvoff = (unsigned)(r32 * LDQ + hi * 8) * 2u;
    const int kb0 = (swa_jhi(cur.P0, skv) - 1) * KVBLK; (void)W;
    for (int d0 = 0; d0 < 8; ++d0) S.qr[d0] = *(const bf16x8*)((const char*)(cur.Q + (size_t)(wid * QBLK) * LDQ) + d0 * 32 + qvoff);
    if constexpr (F32) { SLOAD_F((const float*)cur.K, kb0); VMW(); SWRITE_KF(0); SBAR(); SLOAD_F((const float*)cur.V, kb0); }
    else { SLOAD_H(cur.K, cur.V, kb0); VMW(); SWRITE_HK(0); }
    __syncthreads();
}
template <class TIn, class TOut>
__device__ __forceinline__ void causal_swa_block(const BlockRef<TIn, TOut>& cur, const BlockRef<TIn, TOut>& nxt, int skv, int W, char* lds, Seam<TIn>& S) {
    constexpr bool F32 = same_t<TIn, float>::v;
    const int tid = threadIdx.x, wid = __builtin_amdgcn_readfirstlane(tid >> 6), lane = tid & 63, r32 = lane & 31, hi = lane >> 5;
    const int j_lo = swa_jlo(cur.P0, W);
    int j_hi = (cur.P0 + QB - 1) / KVBLK + 1; if (j_hi > skv / KVBLK) j_hi = skv / KVBLK;
    const int NT = j_hi - j_lo;
    const int kbn = (swa_jhi(nxt.P0, skv) - 1) * KVBLK;
    const int qlo = cur.P0 + wid * QBLK, qm = qlo + r32 - 4 * hi;
    char* V_lds = lds; char* K_lds = lds + 2 * SHM_V;
    const float* cl = (const float*)(lds + C_OFF);
    float* ws = (float*)(lds + 2 * SHM_V + 2 * SHM_K) + wid * 64; float* li_l = ws, * al_l = ws + 32;
    float m_reg = -1e30f, l_reg = 0; f32x16 o[4] = {};
    const int sr = tid >> 4, sc = (tid & 15) * 8, vst0 = v_st(sr, sc), vst1 = v_st(32 + sr, sc), kws = KSWZ(sr, sc * 2);
    const unsigned svoff = (unsigned)(sr * LDQ + sc) * 2u, qvoff = (unsigned)(r32 * LDQ + hi * 8) * 2u;
    const int vb0 = (int)(uintptr_t)V_lds + v_rd_base(lane);
    const TIn* Kh = cur.K; const TIn* Vh = cur.V;
#define RESC(a) do { if (__any((a) < 1.f)) { if (hi == 0) al_l[r32] = (a); asm volatile("s_waitcnt lgkmcnt(0)" ::: "memory");              \
                     for (int d_ = 0; d_ < 4; ++d_) for (int r = 0; r < 16; ++r) o[d_][r] *= al_l[crow(r, hi)]; } } while (0)
#define KBASE(t) ((j_hi - 1 - (t)) * KVBLK)
#define ACT(t) (KBASE(t) <= qlo + QBLK - 1 && KBASE(t) + KVBLK - 1 >= qlo - W + 1)
#define MASKT(P0_, P1_, t) do { const int kb_ = KBASE(t); bias_tile(P0_, P1_, cl, kb_, hi); if ((!SK || ACT(t)) && (kb_ + KVBLK - 1 > qlo || kb_ <= qlo + QBLK - 1 - W)) mask_tile(P0_, P1_, qm - kb_, (unsigned)W); } while (0)
    constexpr int NQL = F32 ? 16 : 8;
    constexpr bool SK = WSKIP && !F32;
#define SEAM_K0() do { VMWN(NQL); if constexpr (F32) { SWRITE_KF(0); SBAR(); SLOAD_F((const float*)nxt.V, kbn); } else { SWRITE_HK(0); } SBAR(); } while (0)
    f32x16 pA0, pA1, pB0, pB1; float mnA, mnB, alA, alB; bf16x8 pa0, pa1, pa2, pa3;
    if constexpr (F32) { VMW(); SWRITE_VF(0); SBAR(); } else { SWRITE_HV(0); SBAR(); }
    if (NT > 1) { if constexpr (F32) SLOAD_F((const float*)Kh, KBASE(1)); else SLOAD_H(Kh, Vh, KBASE(1)); }
    SBAR(); qkt<0, SK>(pA0, pA1, K_lds, r32, hi, S.qr, ACT(0));
    if constexpr (F32) { if (NT > 1) { VMW(); SWRITE_KF(1); SBAR(); SLOAD_F((const float*)Vh, KBASE(1)); } }
    MASKT(pA0, pA1, 0); partialSM(pA0, pA1, m_reg, mnA, alA);
    if (NT > 1) { VMW(); if constexpr (F32) { SWRITE_VF(1); SBAR(); if (NT > 2) SLOAD_F((const float*)Kh, KBASE(2)); } else SWRITE_H(1); }
    __syncthreads();
#define HALF_STEP(PX0, PX1, mnX, alX, PY0, PY1, alY, t, KB, VB, SB) do {                                                      \
        SBAR(); qkt<KB, SK>(PX0, PX1, K_lds, r32, hi, S.qr, ACT(t));                                             \
        finishSM(PY0, PY1, alY, l_reg, pa0, pa1, pa2, pa3); SBAR();                                                           \
        if ((t) + 1 < NT) { if constexpr (F32) { VMW(); SWRITE_KF(SB); SBAR(); SLOAD_F((const float*)Vh, KBASE((t) + 1)); }  \
                            else { SLOAD_H(Kh, Vh, KBASE((t) + 1)); } SBAR(); }                                               \
        pv_tile<VB, SK>(o, vb0, pa0, pa1, pa2, pa3, ACT((t) - 1)); MASKT(PX0, PX1, (t)); partialSM(PX0, PX1, m_reg, mnX, alX);                                        \
        __syncthreads();                                                                                                      \
        if ((t) + 1 < NT) { VMW(); if constexpr (F32) { SWRITE_VF(SB); SBAR(); if ((t) + 2 < NT) SLOAD_F((const float*)Kh, KBASE((t) + 2)); } \
                            else { SWRITE_H(SB); } }                                                                          \
        RESC(alX); __syncthreads(); } while (0)
    for (int t = 1; t + 1 < NT; t += 2) {
        HALF_STEP(pB0, pB1, mnB, alB, pA0, pA1, alA, t, 1, 0, 0);
        HALF_STEP(pA0, pA1, mnA, alA, pB0, pB1, alB, t + 1, 0, 1, 1);
    }
    const bool even = (NT & 1) == 0;
    if (even) { SBAR(); qkt<1, SK>(pB0, pB1, K_lds, r32, hi, S.qr, ACT(NT - 1)); SBAR(); }
#define QROW(e) (nxt.Q + (size_t)(wid * QBLK + r32) * LDQ + ((e) >> 1) * 16 + hi * 8 + ((e) & 1) * 4)
    if constexpr (F32) { SLOAD_F((const float*)nxt.K, kbn); SBAR();
#pragma unroll
        for (int e = 0; e < 8; ++e) S.tq[e] = *(const f32x4*)QROW(e); }
    else { SLOAD_H(nxt.K, nxt.V, kbn); SBAR();
#pragma unroll
        for (int d0 = 0; d0 < 8; ++d0) S.qr[d0] = *(const bf16x8*)((const char*)(nxt.Q + (size_t)(wid * QBLK) * LDQ) + d0 * 32 + qvoff); }
    SBAR();
    finishSM(pA0, pA1, alA, l_reg, pa0, pa1, pa2, pa3); SBAR();
    if constexpr (F32) {
#pragma unroll
        for (int e = 8; e < 16; ++e) S.tq[e] = *(const f32x4*)QROW(e); SBAR(); }
#undef QROW
    pv_tile<0, SK>(o, vb0, pa0, pa1, pa2, pa3, ACT(even ? NT - 2 : NT - 1));
    if (even) { MASKT(pB0, pB1, NT - 1); partialSM(pB0, pB1, m_reg, mnB, alB); __syncthreads(); RESC(alB);
        finishSM(pB0, pB1, alB, l_reg, pa0, pa1, pa2, pa3); SBAR(); pv_tile<1, SK>(o, vb0, pa0, pa1, pa2, pa3, ACT(NT - 1)); }
    SBAR(); SEAM_K0();
    if (hi == 0) li_l[r32] = l_reg; asm volatile("s_waitcnt lgkmcnt(0)" ::: "memory");
    float rli[16];
#pragma unroll
    for (int r = 0; r < 16; ++r) rli[r] = __builtin_amdgcn_rcpf(li_l[crow(r, hi)]);
    { char* stg = lds + STG_OFF + wid * (QBLK * STG_ROW);
      int loff = (lane >> 4) * LDQ + (lane & 15) * 8, yoff = (lane >> 4) * LDO + (lane & 15) * 8;
      asm volatile("" : "+v"(loff), "+v"(yoff));
      const TIn* Gw = cur.G + (size_t)(wid * QBLK) * LDQ + loff; TOut* Ow = cur.O + (size_t)(wid * QBLK) * LDO + yoff;
#pragma unroll
      for (int r = 0; r < 16; ++r) { const int orow = crow(r, hi);
#pragma unroll
          for (int d0 = 0; d0 < 4; ++d0) { const float v = o[d0][r] * rli[r]; const float vn = __shfl_xor(v, 1);
              if ((r32 & 1) == 0) *(unsigned*)(stg + orow * STG_ROW + (d0 * 32 + r32) * 2) = cvtpk(v, vn); } }
      asm volatile("s_waitcnt lgkmcnt(0)" ::: "memory");
#pragma unroll
      for (int hf = 0; hf < 2; ++hf) { u32x4 gv[4];
#pragma unroll
          for (int i = 0; i < 4; ++i) gv[i] = *(const u32x4*)(Gw + (size_t)(16 * hf + 4 * i) * LDQ);
#pragma unroll
          for (int i = 0; i < 4; ++i) { const u32x4 ov = *(const u32x4*)(stg + (16 * hf + 4 * i + (lane >> 4)) * STG_ROW + (lane & 15) * 16); const u32x4 g4 = gv[i]; u32x4 w;
#pragma unroll
              for (int e = 0; e < 4; ++e) w[e] = cvtpk(__uint_as_float(ov[e] << 16) * __uint_as_float(g4[e] << 16), __uint_as_float(ov[e] & 0xffff0000u) * __uint_as_float(g4[e] & 0xffff0000u));
              *(u32x4*)(Ow + (size_t)(16 * hf + 4 * i) * LDO) = w; }
          asm volatile("" ::: "memory"); } }
    if constexpr (F32) {
#pragma unroll
        for (int d0 = 0; d0 < 8; ++d0) S.qr[d0] = pack8(S.tq[2 * d0], S.tq[2 * d0 + 1]); }
    __syncthreads();
#undef RESC
#undef KBASE
#undef ACT
#undef MASKT
#undef SEAM_K0
#undef HALF_STEP
}
#undef ROW
#undef VMW
#undef VMWN
#undef SLOAD_H
#undef SWRITE_HK
#undef SWRITE_HV
#undef SWRITE_H
#undef SLOAD_F
#undef SWRITE_KF
#undef SWRITE_VF

__host__ __device__ inline int swa_nramp(int nqb, int W, int qoff) { const int t = W - 1 - qoff; const int n = t < 0 ? 0 : t / QB + 1; return n > nqb ? nqb : n; }
__host__ __device__ inline int swa_nx(int nqb, int nramp, int order) { return (order & ORDER_PAIRED) ? (nramp + 1) / 2 + (nqb - nramp) : nqb; }
struct SwaItem { int bh, qb0, qb1; };
__device__ __forceinline__ SwaItem swa_decode(int L, int nb, int nh, int nhkv, int nqb, int nx, int nramp, int order) {
    const int G = nh / nhkv; SwaItem it; int x;
    if ((order & ORDER_XCD) && (nb * nhkv) % 8 == 0) { const int xcd = L & 7, k = L >> 3, per = G * nx, gi = k / per, r = k - gi * per;
        it.bh = (gi * 8 + xcd) * G + r / nx; x = r % nx; }
    else { it.bh = L / nx; x = L - it.bh * nx; }
    if (order & ORDER_PAIRED) { const int ns = nqb - nramp;
        if (x < ns) { it.qb0 = it.qb1 = nqb - 1 - x; } else { it.qb0 = x - ns; it.qb1 = nramp - 1 - it.qb0; } }
    else { it.qb0 = it.qb1 = ((order & 3) == ORDER_REVERSED) ? nqb - 1 - x : x; }
    return it;
}
template <class TIn, class TOut>
__device__ __forceinline__ BlockRef<TIn, TOut> swa_ref(const SwaItem& it, int pass, const TIn* Q, const TIn* K, const TIn* V, TOut* O,
                                                    int nh, int nhkv, int sq, int skv, int qoff) {
    const int qb = pass ? it.qb1 : it.qb0, kvh = it.bh / (nh / nhkv);
    BlockRef<TIn, TOut> r;
    const int b_ = it.bh / nh, h_ = it.bh % nh; (void)kvh; (void)K; (void)V;
    const TIn* rowb = Q + (size_t)(b_ * nh + h_) * sq * LDQ;
    r.Q = rowb + (size_t)qb * QB * LDQ; r.K = rowb + SECSZ; r.V = rowb + 2 * SECSZ; r.G = r.Q + 3 * SECSZ;
    r.O = O + ((size_t)b_ * sq + (size_t)qb * QB) * LDO + h_ * D; r.P0 = qoff + qb * QB;
    return r;
}

constexpr int WT_OFF = STG_OFF + NW * QBLK * STG_ROW, ATT_LDS = WT_OFF + 64;
__device__ __forceinline__ void load_c(char* lds, const float* LS, int bh) {
    int tid = threadIdx.x; asm volatile("" : "+v"(tid));
    const int lane = tid & 63, wv = tid >> 6;
    const f32x4* src = (const f32x4*)(LS + (size_t)bh * SEQ) + 2 * tid;
    const f32x4 a = src[0], b = src[1];
    float v[8]; v[0] = a[0]; v[1] = v[0] + a[1]; v[2] = v[1] + a[2]; v[3] = v[2] + a[3]; v[4] = v[3] + b[0]; v[5] = v[4] + b[1]; v[6] = v[5] + b[2]; v[7] = v[6] + b[3];
    float inc = v[7];
#pragma unroll
    for (int o = 1; o < 64; o <<= 1) { const float t = __uint_as_float(__builtin_amdgcn_ds_bpermute(((lane - o) & 63) << 2, __float_as_uint(inc))); if (lane >= o) inc += t; }
    float* wt = (float*)(lds + WT_OFF);
    if (lane == 63) wt[wv] = inc;
    __syncthreads();
    float base = inc - v[7];
#pragma unroll
    for (int w = 0; w < 7; ++w) if (w < wv) base += wt[w];
    f32x4* dst = (f32x4*)(lds + C_OFF) + 2 * tid;
    dst[0] = (f32x4){base + v[0], base + v[1], base + v[2], base + v[3]}; dst[1] = (f32x4){base + v[4], base + v[5], base + v[6], base + v[7]};
}
__device__ __forceinline__ void attn_phase(char* lds, const bf16* P, const float* LS, bf16* Y, int blk, int nblk) {
    constexpr int nqb = SQ / QB, nramp = nqb, nx = (nramp + 1) / 2, total = nx * B * H;
    int L = blk; if (L >= total) return;
    SwaItem it = swa_decode(L, B, H, HKV, nqb, nx, nramp, ORDER); int pass = 0;
    BlockRef<bf16, bf16> cur = swa_ref<bf16, bf16>(it, 0, P, P, P, Y, H, HKV, SQ, SKV, QOFF);
    Seam<bf16> S;
    load_c(lds, LS, it.bh);
    causal_swa_prime<bf16, bf16>(cur, SKV, WINDOW, lds, S);
    for (;;) {
        const bool more_pass = pass == 0 && it.qb1 != it.qb0, more_item = L + nblk < total, last = !more_pass && !more_item;
        SwaItem itn = it; int passn = pass + 1, Ln = L;
        if (!more_pass) { passn = 0; Ln = more_item ? L + nblk : L; itn = swa_decode(Ln, B, H, HKV, nqb, nx, nramp, ORDER); }
        const BlockRef<bf16, bf16> nxt = last ? cur : swa_ref<bf16, bf16>(itn, passn, P, P, P, Y, H, HKV, SQ, SKV, QOFF);
        causal_swa_block<bf16, bf16>(cur, nxt, SKV, WINDOW, lds, S);
        if (last) break;
        if (itn.bh != it.bh) { load_c(lds, LS, itn.bh); __syncthreads(); }
        cur = nxt; it = itn; pass = passn; L = Ln;
    }
}
}

__device__ __forceinline__ void flogit_phase(const bf16* __restrict__ HB, const bf16* __restrict__ WF, const float* __restrict__ b_f, float* __restrict__ LS, int blk, int nblk) {
    typedef short bf16x8_t __attribute__((ext_vector_type(8)));
    const int tid = threadIdx.x, wid = __builtin_amdgcn_readfirstlane(tid >> 6), lane = tid & 63, n = lane & 15, g = lane >> 4;
    for (int rb = blk; rb < M / 32; rb += nblk) {
        const int r0 = rb * 32 + (wid >> 2) * 16, h0 = (wid & 3) * 16;
        const bf16x8_t* ap = (const bf16x8_t*)(HB + (size_t)(r0 + n) * D + 8 * g);
        const bf16x8_t* bp = (const bf16x8_t*)(WF + (size_t)(h0 + n) * D + 8 * g);
        f32x4 acc = (f32x4){0.f, 0.f, 0.f, 0.f};
#pragma unroll 8
        for (int k = 0; k < D / 32; ++k) acc = __builtin_amdgcn_mfma_f32_16x16x32_bf16(ap[4 * k], bp[4 * k], acc, 0, 0, 0);
        const float bias = b_f[h0 + n];
        f32x4 o;
#pragma unroll
        for (int j = 0; j < 4; ++j) { const float z = acc[j] + bias; const float e = __builtin_amdgcn_exp2f(-1.4426950408889634f * fabsf(z));
            o[j] = fminf(z, 0.f) - 0.6931471805599453f * __builtin_amdgcn_logf(1.0f + e); }
        const int row = r0 + 4 * g, b = row / SEQ, s = row % SEQ;
        *(f32x4*)(LS + ((size_t)b * NH + h0 + n) * SEQ + s) = o;
    }
}

#define XB_TMO      128
#define XB_XCNT(j)  (256  + 64 * (j))
#define XB_XSUB(j)  (1280 + 64 * (j))
#define XB_XGEN(j)  (2304 + 64 * (j))
#define XB_TOP      3328
#define XB_TOPGEN   3392
#define XCD_BAR_WORDS 3456
#define XB_SPIN_CAP (1u << 18)

__device__ __forceinline__ unsigned xb_ld(unsigned* p)              { return __hip_atomic_load(p, __ATOMIC_RELAXED, __HIP_MEMORY_SCOPE_AGENT); }
__device__ __forceinline__ unsigned xb_add(unsigned* p, unsigned v) { return __hip_atomic_fetch_add(p, v, __ATOMIC_RELAXED, __HIP_MEMORY_SCOPE_AGENT); }
__device__ __forceinline__ unsigned xb_xcc_id() { return (unsigned)__builtin_amdgcn_s_getreg((3 << 11) | 20) & 0xFu; }
#define XB_SPIN(cond, bar) do { unsigned _sp = 0; while (cond) { __builtin_amdgcn_s_sleep(1); \
    if ((++_sp & 255u) == 0u) { if (xb_ld(&(bar)[XB_TMO])) break; if (_sp > XB_SPIN_CAP) { atomicAdd(&(bar)[XB_TMO], 1u); break; } } } } while (0)

struct XcdBarrier {
    unsigned* bar; unsigned x;
    volatile LAS unsigned* st;
};

__device__ __forceinline__ XcdBarrier xcd_barrier_post(unsigned* bar, volatile LAS unsigned* st) {
    XcdBarrier b; b.bar = bar; b.x = xb_xcc_id(); b.st = st;
    if (threadIdx.x == 0) (void)xb_add(&bar[XB_XCNT(b.x)], 1u);
    return b;
}
__device__ __forceinline__ void xcd_barrier_complete(unsigned* bar, unsigned x, unsigned& nloc, unsigned& nx) {
    const unsigned G = gridDim.x * gridDim.y * gridDim.z;
    unsigned sum, cnt, mine, sp = 0u;
    for (;;) {
        sum = 0u; cnt = 0u; mine = 0u;
#pragma unroll
        for (unsigned j = 0; j < 16; ++j) { const unsigned c = xb_ld(&bar[XB_XCNT(j)]); sum += c; cnt += (c > 0u) ? 1u : 0u; mine = (j == x) ? c : mine; }
        if (sum == G) break;
        __builtin_amdgcn_s_sleep(1);
        if ((++sp & 255u) == 0u) { if (xb_ld(&bar[XB_TMO])) break; if (sp > XB_SPIN_CAP) { atomicAdd(&bar[XB_TMO], 1u); break; } }
    }
    nloc = mine > 0u ? mine : 1u; nx = cnt > 0u ? cnt : 1u;
}

__device__ __forceinline__ void xcd_barrier(const XcdBarrier& b) {
    asm volatile("s_waitcnt vmcnt(0)" ::: "memory");
    __syncthreads();
    if (threadIdx.x == 0) {
        unsigned* bar = b.bar;
        __builtin_amdgcn_s_waitcnt(0);
        unsigned nloc = b.st[0], nx = b.st[1];
        if (nloc == 0u) { xcd_barrier_complete(bar, b.x, nloc, nx); b.st[0] = nloc; b.st[1] = nx; }
        const unsigned old = xb_add(&bar[XB_XSUB(b.x)], 1u);
        const unsigned gen = old / nloc;
        if (old + 1u == (gen + 1u) * nloc) {
            __builtin_amdgcn_fence(__ATOMIC_RELEASE, "agent");
            asm volatile("s_waitcnt vmcnt(0)" ::: "memory");
            const unsigned og = xb_add(&bar[XB_TOP], 1u);
            const unsigned tg = og / nx;
            if (og + 1u == (tg + 1u) * nx) xb_add(&bar[XB_TOPGEN], 1u);
            else XB_SPIN(xb_ld(&bar[XB_TOPGEN]) == tg, bar);
            __builtin_amdgcn_fence(__ATOMIC_ACQUIRE, "agent");
            xb_add(&bar[XB_XGEN(b.x)], 1u);
            asm volatile("s_waitcnt vmcnt(0)" ::: "memory");
        } else {
            XB_SPIN(xb_ld(&bar[XB_XGEN(b.x)]) == gen, bar);
            __builtin_amdgcn_fence(__ATOMIC_ACQUIRE, "agent");
            asm volatile("s_waitcnt vmcnt(0)" ::: "memory");
        }
    }
    __syncthreads();
}

constexpr int CW_BAR = 1024;
constexpr size_t CTL_ZERO_BYTES = 32768;
constexpr int LDS_TOTAL = 163840;
constexpr int MISC_OFF = LDS_TOTAL - 64;
static_assert(fox::ATT_LDS <= MISC_OFF && scan::LDS_BYTES <= MISC_OFF && pg8::STAGE_BYTES <= MISC_OFF && 8 * 8448 <= MISC_OFF, "LDS map");
#ifndef MK_N_LAUNCHES
#define MK_N_LAUNCHES 1
#endif
constexpr int N_PHASES = 9;
struct Args { const float* in[10]; float* out; unsigned char* ws; int ph_lo, ph_hi; };
__global__ void __launch_bounds__(512, 2) mega_fwd(Args args) {
    extern __shared__ __attribute__((aligned(16))) unsigned char lds[];
    LAS unsigned char* L = (LAS unsigned char*)lds;
    volatile LAS unsigned* MISC = (volatile LAS unsigned*)(L + MISC_OFF);
    const int tid = threadIdx.x, lane = tid & 63, wave = __builtin_amdgcn_readfirstlane(tid >> 6);
    const int G = gridDim.x, bx = blockIdx.x;
    if (tid < 16) MISC[tid] = 0u;
    __syncthreads();
    unsigned char* ws = args.ws;
    XcdBarrier bar; bar.bar = (unsigned*)(ws + WS_CTL) + CW_BAR; bar.x = 0; bar.st = nullptr;
    if (MK_N_LAUNCHES != N_PHASES) bar = xcd_barrier_post((unsigned*)(ws + WS_CTL) + CW_BAR, MISC + 8);
    const float* x = args.in[0]; const float* norm_w = args.in[1]; const float* w_in_a = args.in[2]; const float* lb_logits = args.in[3]; const float* o_norm_a = args.in[4];
    const float* w_out_a = args.in[5]; const float* w_in_b = args.in[6]; const float* b_f = args.in[7]; const float* w_out_b = args.in[8]; const float* final_norm = args.in[9];
    float* out = args.out;
    bf16* WA = (bf16*)(ws + WS_WA); bf16* WB = (bf16*)(ws + WS_WB); bf16* WF = (bf16*)(ws + WS_WF); bf16* WOA = (bf16*)(ws + WS_WOA); bf16* WOB = (bf16*)(ws + WS_WOB);
    bf16* HB = (bf16*)(ws + WS_HB); float* X1 = (float*)(ws + WS_X1); bf16* P = (bf16*)(ws + WS_P); bf16* Y = (bf16*)(ws + WS_Y); float* LS = (float*)(ws + WS_LS);
    const int lo = args.ph_lo, hi = args.ph_hi;
#define IN(k) (lo <= (k) && (k) < hi)
#define SEAM(k) do { if (IN(k) && IN((k) + 1)) xcd_barrier(bar); } while (0)
#ifndef REPEAT_PHASE
#define REPEAT_PHASE (-1)
#endif
#define RUN(k, ...) do { if (IN(k)) { __VA_ARGS__ if (REPEAT_PHASE == (k)) { xcd_barrier(bar); __VA_ARGS__ } } } while (0)
#ifdef PROBE_NULL_GEMM1
#define PROBE_EXTRA() do { xcd_barrier(bar); pg8::Gemm g{HB, WA, M, LDP, D, 0}; pg8::StaticOrder S; S.init(M, LDP, G, bx); pg8::EpiNull E{0, 0}; pg8::gemm_phase<pg8::EpiNull, pg8::StaticOrder, true, true>(L, g, S, E); } while (0)
#else
#define PROBE_EXTRA() do { } while (0)
#endif

    RUN(0, { prologue_phase(L, 0, x, norm_w, w_in_a, w_out_a, w_in_b, w_out_b, ws, bx, G, wave, lane); } );
    SEAM(0);
    RUN(1, { pg8::Gemm g{HB, WA, M, LDP, D, 0}; pg8::StaticOrder S; S.init(M, LDP, G, bx); pg8::EpiAct<0> E{P, lb_logits, LDP, 0};
        pg8::gemm_phase<pg8::EpiAct<0>, pg8::StaticOrder, true, true>(L, g, S, E); } );
    if (IN(1)) PROBE_EXTRA();
    SEAM(1);
    RUN(2, { if (G >= 2 * NB * NH) { if (bx < NB * NH) scan::scan_unit(L, P, o_norm_a, Y, bx); else prologue_phase(L, 1, x, norm_w, w_in_a, w_out_a, w_in_b, w_out_b, ws, bx - NB * NH, G - NB * NH, wave, lane); }
              else { for (int bh = bx; bh < NB * NH; bh += G) scan::scan_unit(L, P, o_norm_a, Y, bh); prologue_phase(L, 1, x, norm_w, w_in_a, w_out_a, w_in_b, w_out_b, ws, bx, G, wave, lane); } } );
    SEAM(2);
    RUN(3, { pg8::Gemm g{Y, WOA, M, D, DI, 0}; pg8::StaticOrder S; S.init(M, D, G, bx); pg8::EpiRes E{x, X1, D, 0};
        pg8::gemm_phase<pg8::EpiRes, pg8::StaticOrder, true, true>(L, g, S, E); } );
    SEAM(3);
    RUN(4, { const int gw = bx * 8 + wave, NGW = G * 8; for (int m = gw; m < M; m += NGW) rms_row_bf16(X1 + (size_t)m * D, norm_w + D, HB + (size_t)m * D, lane); } );
    SEAM(4);
    RUN(5, { flogit_phase(HB, WF, b_f, LS, bx, G);
        pg8::Gemm g{HB, WB, M, LDP, D, 0}; pg8::StaticOrder S; S.init(M, LDP, G, bx); pg8::EpiAct<1> E{P, nullptr, LDP, 0};
        pg8::gemm_phase<pg8::EpiAct<1>, pg8::StaticOrder, true, true>(L, g, S, E); } );
    SEAM(5);
    RUN(6, { fox::attn_phase((char*)lds, P, LS, Y, bx, G); } );
    SEAM(6);
    RUN(7, { pg8::Gemm g{Y, WOB, M, D, DI, 0}; pg8::StaticOrder S; S.init(M, D, G, bx); pg8::EpiRes E{X1, out, D, 0};
        pg8::gemm_phase<pg8::EpiRes, pg8::StaticOrder, true, true>(L, g, S, E); } );
    SEAM(7);
    RUN(8, { const int gw = bx * 8 + wave, NGW = G * 8; for (int m = gw; m < M; m += NGW) rms_row_f32(out + (size_t)m * D, final_norm, out + (size_t)m * D, lane); } );
#undef IN
#undef SEAM
}

extern "C" void kernel_launch(void* const* d_in, const int* in_sizes, int n_in, void* d_out, int out_size, void* d_ws, size_t ws_size, hipStream_t stream) {
    static int grid = 0;
    if (grid == 0) {
        if (n_in != 10 || in_sizes[0] != M * D || out_size != M * D || ws_size < WS_END) { fprintf(stderr, "kernel_launch: unexpected shapes (n_in %d, in0 %d, out %d, ws %zu < %zu); nothing launched\n", n_in, n_in > 0 ? in_sizes[0] : -1, out_size, ws_size, (size_t)WS_END); grid = -1; return; }
        int dev = 0, cus = 0, per_cu = 0;
        if (hipGetDevice(&dev) != hipSuccess || hipDeviceGetAttribute(&cus, hipDeviceAttributeMultiprocessorCount, dev) != hipSuccess) { fprintf(stderr, "kernel_launch: device query failed\n"); grid = -1; return; }
        if (hipFuncSetAttribute((const void*)mega_fwd, hipFuncAttributeMaxDynamicSharedMemorySize, LDS_TOTAL) != hipSuccess) { fprintf(stderr, "kernel_launch: hipFuncSetAttribute(%d B LDS) failed\n", LDS_TOTAL); grid = -1; return; }
        if (hipOccupancyMaxActiveBlocksPerMultiprocessor(&per_cu, (const void*)mega_fwd, 512, LDS_TOTAL) != hipSuccess || per_cu < 1)
            fprintf(stderr, "kernel_launch: note: occupancy query reports %d workgroups per CU\n", per_cu);
        (void)hipGetLastError();
        grid = cus;
    }
    if (grid < 0) return;
    if (hipMemsetAsync((char*)d_ws + WS_CTL, 0, CTL_ZERO_BYTES, stream) != hipSuccess) { fprintf(stderr, "kernel_launch: hipMemsetAsync failed\n"); return; }
    Args a{};
    for (int i = 0; i < 10; ++i) a.in[i] = (const float*)d_in[i];
    a.out = (float*)d_out; a.ws = (unsigned char*)d_ws;
#if MK_N_LAUNCHES == 1
    a.ph_lo = 0; a.ph_hi = N_PHASES;
    hipLaunchKernelGGL(mega_fwd, dim3(grid), dim3(512), LDS_TOTAL, stream, a);
#else
    for (int p = 0; p < N_PHASES; ++p) { a.ph_lo = p; a.ph_hi = p + 1; hipLaunchKernelGGL(mega_fwd, dim3(grid), dim3(512), LDS_TOTAL, stream, a); }
#endif
    const hipError_t le = hipPeekAtLastError();
    if (le != hipSuccess) fprintf(stderr, "kernel_launch: launch failed: %s\n", hipGetErrorName(le));
}
```

```cpp
#include <hip/hip_runtime.h>
#include <cstdio>
#include <cstdint>

constexpr int NB = 2, SEQ = 4096, D = 4096, DI = 8192, NH = 64, HD = 128;
constexpr int M = NB * SEQ;
constexpr int LDP = 4 * DI;
constexpr int NWB = 4 * DI + NH;
constexpr float EPS = 1e-6f;
namespace pg8 {
#define PG8_LAS __attribute__((address_space(3)))
typedef unsigned short bf16_t;
typedef short bf16x8 __attribute__((ext_vector_type(8)));
typedef float f32x4 __attribute__((ext_vector_type(4)));
typedef unsigned u32x4 __attribute__((ext_vector_type(4)));
constexpr int BM = 256, BK = 64, HALF = 128, HTB = HALF * BK * 2  , STAGE_BYTES = 8 * HTB, NXCD = 8, WGM = 8;

__host__ __device__ __forceinline__ int lds_byte(int r, int c) { const int st = (r >> 4) * 2 + (c >> 5), rr = r & 15, cc = c & 31, ob = rr * 64 + cc * 2; return st * 1024 + (ob ^ (((ob >> 9) & 1) << 5)); }
__host__ __device__ __forceinline__ void stage_rc(int b, int& R, int& C) { const int st = b / 1024, sb = b % 1024, swz = sb ^ (((sb >> 9) & 1) << 5); R = (st >> 1) * 16 + swz / 64; C = (st & 1) * 32 + (swz % 64) / 2; }
__host__ __device__ __forceinline__ int perm32(int rho) { const int n = rho >> 4, i = rho & 15; return 8 * (i >> 2) + 4 * n + (i & 3); }

struct Unit { int pm, pn; };
struct Gemm { const bf16_t* A; const bf16_t* Bt; int M, N, K, pad; };

struct StaticOrder {
    int nM, nN, nwg, G, c;
    __host__ __device__ void init(int M, int N, int G_, int c_) { nM = M / BM; nN = N / BM; nwg = nM * nN; G = G_; c = c_; }
    __host__ __device__ bool next(int i, Unit& u) const {
        const long L = (long)i * G + c; if (L >= nwg) return false;
        int wgid = (int)L; { const int q = nwg / NXCD, r = nwg % NXCD, xcd = wgid % NXCD, off = wgid / NXCD; wgid = (xcd < r ? xcd * (q + 1) : r * (q + 1) + (xcd - r) * q) + off; }
        const int nig = WGM * nN, gid = wgid / nig, fm = gid * WGM, gsz = (nM - fm) < WGM ? (nM - fm) : WGM;
        u.pm = fm + ((wgid % nig) % gsz); u.pn = (wgid % nig) / gsz; return true;
    }
    __device__ __forceinline__ void a_ready(const Unit&) const {}
    __device__ __forceinline__ void done(const Unit&) const {}
};

typedef float f32x2_t __attribute__((ext_vector_type(2)));
typedef __bf16 bf16x2_t __attribute__((ext_vector_type(2)));
__device__ __forceinline__ unsigned cvt_pk_bf16(float lo, float hi) { f32x2_t v = {lo, hi}; bf16x2_t b = __builtin_convertvector(v, bf16x2_t); return __builtin_bit_cast(unsigned, b); }
__device__ __forceinline__ float silu_f(float x) { return x * __builtin_amdgcn_rcpf(1.0f + __builtin_amdgcn_exp2f(-1.4426950408889634f * x)); }

template <int LAYER> struct EpiAct {
    static constexpr bool PERM = true, AFTER_DRAIN = false;
    bf16_t* O; const float* lbl; unsigned* nrm; int ldc, pad;
    __device__ __forceinline__ void operator()(const f32x4 (&acc)[2][2][4][2], const Unit& u, int wr, int wc, int fr, int fq) const {
        const int sec = u.pn >> 5;
        const int row0 = u.pm * BM + wr * 64 + fr, col0 = u.pn * BM + wc * 32 + 8 * fq;
        const int mode = (LAYER == 0) ? ((sec == 0 || sec == 3) ? 1 : (sec == 1 ? 2 : 0)) : (sec == 3 ? 1 : 0);
        const int rb = row0 >> 12, rs = row0 & 4095, hh = (2 * u.pn) & 63;
        bf16_t* hm = O + ((size_t)((sec * 2 + rb) * 64 + hh) * 4096 + rs) * 128 + wc * 32 + 8 * fq;
        if (mode == 2) {
            float lb[2][8], om[2][8];
#pragma unroll
            for (int bj = 0; bj < 2; ++bj) { const int c = col0 + bj * HALF - 8192;
                const f32x4 a0 = *(const f32x4*)(lbl + c), a1 = *(const f32x4*)(lbl + c + 4), b0 = *(const f32x4*)(lbl + 8192 + c), b1 = *(const f32x4*)(lbl + 8192 + c + 4);
#pragma unroll
                for (int e = 0; e < 4; ++e) { const float x0 = __builtin_amdgcn_rcpf(1.0f + __builtin_amdgcn_exp2f(1.4426950408889634f * (b0[e] - a0[e]))), x1 = __builtin_amdgcn_rcpf(1.0f + __builtin_amdgcn_exp2f(1.4426950408889634f * (b1[e] - a1[e])));
                    lb[bj][e] = x0; om[bj][e] = 1.0f - x0; lb[bj][4 + e] = x1; om[bj][4 + e] = 1.0f - x1; } }
#pragma unroll
            for (int ai = 0; ai < 2; ++ai)
#pragma unroll
                for (int m = 0; m < 4; ++m) { bf16_t* rowp = hm + (size_t)(ai * HALF + m * 16) * 128;
#pragma unroll
                    for (int bj = 0; bj < 2; ++bj) { float v[8];
#pragma unroll
                        for (int e = 0; e < 8; ++e) { const float f = acc[ai][bj][m][e >> 2][e & 3];
                            const float sg = __builtin_amdgcn_rcpf(1.0f + __builtin_amdgcn_exp2f(-1.4426950408889634f * f));
                            v[e] = __builtin_amdgcn_logf(lb[bj][e] + om[bj][e] * sg); }
                        u32x4 w; w.x = cvt_pk_bf16(v[0], v[1]); w.y = cvt_pk_bf16(v[2], v[3]); w.z = cvt_pk_bf16(v[4], v[5]); w.w = cvt_pk_bf16(v[6], v[7]);
                        *(u32x4*)(rowp + (size_t)bj * (4096 * 128)) = w; } }
        } else if (mode == 1) {
#pragma unroll
            for (int ai = 0; ai < 2; ++ai)
#pragma unroll
                for (int m = 0; m < 4; ++m) { bf16_t* rowp = hm + (size_t)(ai * HALF + m * 16) * 128;
#pragma unroll
                    for (int bj = 0; bj < 2; ++bj) { float v[8];
#pragma unroll
                        for (int e = 0; e < 8; ++e) v[e] = silu_f(acc[ai][bj][m][e >> 2][e & 3]);
                        u32x4 w; w.x = cvt_pk_bf16(v[0], v[1]); w.y = cvt_pk_bf16(v[2], v[3]); w.z = cvt_pk_bf16(v[4], v[5]); w.w = cvt_pk_bf16(v[6], v[7]);
                        *(u32x4*)(rowp + (size_t)bj * (4096 * 128)) = w; } }
        } else {
            float nmax[2] = {0.f, 0.f};
#pragma unroll
            for (int ai = 0; ai < 2; ++ai)
#pragma unroll
                for (int m = 0; m < 4; ++m) { bf16_t* rowp = hm + (size_t)(ai * HALF + m * 16) * 128;
#pragma unroll
                    for (int bj = 0; bj < 2; ++bj) { const f32x4 v0 = acc[ai][bj][m][0], v1 = acc[ai][bj][m][1];
                        u32x4 w; w.x = cvt_pk_bf16(v0[0], v0[1]); w.y = cvt_pk_bf16(v0[2], v0[3]); w.z = cvt_pk_bf16(v1[0], v1[1]); w.w = cvt_pk_bf16(v1[2], v1[3]);
                        *(u32x4*)(rowp + (size_t)bj * (4096 * 128)) = w;
                        if (LAYER == 1 && sec < 2) { float ss = (v0[0] * v0[0] + v0[1] * v0[1]) + (v0[2] * v0[2] + v0[3] * v0[3]) + (v1[0] * v1[0] + v1[1] * v1[1]) + (v1[2] * v1[2] + v1[3] * v1[3]);
                            ss += __shfl_xor(ss, 16); ss += __shfl_xor(ss, 32); nmax[bj] = fmaxf(nmax[bj], ss); } } }
            if (LAYER == 1 && sec < 2) {
#pragma unroll
                for (int bj = 0; bj < 2; ++bj) { float v = nmax[bj];
#pragma unroll
                    for (int o = 1; o < 16; o <<= 1) v = fmaxf(v, __shfl_xor(v, o));
                    if (fr == 0 && fq == 0) atomicMax(nrm + ((size_t)(sec * 128 + rb * 64 + hh + bj)) * 4 + wc, __float_as_uint(v)); }
            }
        }
    }
};
#ifndef EPIRES_FENCE
#define EPIRES_FENCE 0
#endif
struct EpiNull { static constexpr bool PERM = true, AFTER_DRAIN = false; int a, b;
    __device__ __forceinline__ void operator()(const f32x4 (&acc)[2][2][4][2], const Unit& u, int wr, int wc, int fr, int fq) const {
#pragma unroll
        for (int ai = 0; ai < 2; ++ai)
#pragma unroll
            for (int bj = 0; bj < 2; ++bj)
#pragma unroll
                for (int m = 0; m < 4; ++m) asm volatile("" :: "v"(acc[ai][bj][m][0]), "v"(acc[ai][bj][m][1])); } };
struct EpiRes {
    static constexpr bool PERM = false, AFTER_DRAIN = false;
    const float* base; float* out; int ldc, pad;
    __device__ __forceinline__ void operator()(const f32x4 (&acc)[2][2][4][2], const Unit& u, int wr, int wc, int fr, int fq) const {
        const int row0 = u.pm * BM + wr * 64 + fr, col0 = u.pn * BM + wc * 32 + 4 * fq;
#pragma unroll
        for (int ai = 0; ai < 2; ++ai)
#pragma unroll
            for (int m = 0; m < 4; ++m) { const size_t off = (size_t)(row0 + ai * HALF + m * 16) * ldc + col0;
#pragma unroll
                for (int bj = 0; bj < 2; ++bj)
#pragma unroll
                    for (int n = 0; n < 2; ++n) { const f32x4 bs = *(const f32x4*)(base + off + bj * HALF + n * 16); *(f32x4*)(out + off + bj * HALF + n * 16) = bs + acc[ai][bj][m][n]; }
                if (EPIRES_FENCE) asm volatile("" ::: "memory"); }
    }
};
template <class Epi, class Sched, bool ALIGN_EPI = false, bool SP2 = false>
__device__ __forceinline__ void gemm_phase(PG8_LAS unsigned char* lds, const Gemm g, const Sched& S, const Epi& E) {
    const int tid = threadIdx.x, wid = __builtin_amdgcn_readfirstlane(tid >> 6), lane = tid & 63, wr = wid >> 2, wc = wid & 3, fr = lane & 15, fq = lane >> 4;
    const int K = g.K, nt = K / BK;
    unsigned voffA[2], voffB[2];
#pragma unroll
    for (int i = 0; i < 2; ++i) { int R, C; stage_rc(tid * 16 + i * 8192, R, C); const int Rb = Epi::PERM ? ((R & ~31) + perm32(R & 31)) : R;
        voffA[i] = (unsigned)(R * K + C) * 2u; voffB[i] = (unsigned)(Rb * K + C) * 2u; }
    const size_t kstep = (size_t)(BK * 2);
    const size_t hstep = (size_t)HALF * K * 2;
    const size_t tstep = 2 * hstep;
    const unsigned ldsw = (unsigned)wid * 1024u;
    const int aoff = lds_byte(wr * 64 + fr, fq * 8), boff = lds_byte(wc * 32 + fr, fq * 8);
#define PG8_SA(b, h) (((b) * 2 + (h)) * HTB)
#define PG8_SB(b, h) ((4 + (b) * 2 + (h)) * HTB)
#define PG8_STAGE(bufoff, gbase, voff) do { _Pragma("unroll") for (int _i = 0; _i < 2; ++_i) \
        __builtin_amdgcn_global_load_lds((const unsigned*)((const char*)(gbase) + (voff)[_i]), (PG8_LAS unsigned*)(lds + (bufoff) + ldsw + _i * 8192), 16, 0, 0); } while (0)
#define PG8_LDA(dst, b, h) do { _Pragma("unroll") for (int m = 0; m < 4; ++m) _Pragma("unroll") for (int k = 0; k < 2; ++k) dst[m][k] = *(const PG8_LAS bf16x8*)(lds + PG8_SA(b, h) + aoff + m * 2048 + k * 1024); } while (0)
#define PG8_LDB(dst, b, h) do { _Pragma("unroll") for (int n = 0; n < 2; ++n) _Pragma("unroll") for (int k = 0; k < 2; ++k) dst[n][k] = *(const PG8_LAS bf16x8*)(lds + PG8_SB(b, h) + boff + n * 2048 + k * 1024); } while (0)
#define PG8_MMA(ai, bj, At, Bt) do { __builtin_amdgcn_s_setprio(1); _Pragma("unroll") for (int m = 0; m < 4; ++m) _Pragma("unroll") for (int n = 0; n < 2; ++n) _Pragma("unroll") for (int k = 0; k < 2; ++k) \
        acc[ai][bj][m][n] = __builtin_amdgcn_mfma_f32_16x16x32_bf16(Bt[n][k], At[m][k], acc[ai][bj][m][n], 0, 0, 0); __builtin_amdgcn_s_setprio(0); } while (0)
#define PG8_WAIT_V(n) asm volatile("s_waitcnt vmcnt(" #n ")" ::: "memory")
#define PG8_WAIT_L(n) asm volatile("s_waitcnt lgkmcnt(" #n ")" ::: "memory")
#define PG8_BAR __builtin_amdgcn_s_barrier()
#define PG8_SCHED __builtin_amdgcn_sched_barrier(0)
    Unit cur, nxt; int ui = 0;
    if (!S.next(0, cur)) return;
    f32x4 acc[2][2][4][2];
#pragma unroll
    for (int a = 0; a < 2; ++a)
#pragma unroll
        for (int b = 0; b < 2; ++b)
#pragma unroll
            for (int m = 0; m < 4; ++m)
#pragma unroll
                for (int n = 0; n < 2; ++n) acc[a][b][m][n] = (f32x4){0.f, 0.f, 0.f, 0.f};
    bf16x8 At[4][2], B0[2][2], B1[2][2];
    const char* cA = (const char*)g.A + (size_t)cur.pm * tstep; const char* cB = (const char*)g.Bt + (size_t)cur.pn * tstep;
    S.a_ready(cur);
    if constexpr (SP2) {
        PG8_STAGE(PG8_SB(0, 0), cB, voffB); PG8_STAGE(PG8_SB(0, 1), cB + hstep, voffB); PG8_STAGE(PG8_SA(0, 0), cA, voffA); PG8_STAGE(PG8_SA(0, 1), cA + hstep, voffA);
        if (wr == 1) PG8_BAR;
        PG8_WAIT_V(2); PG8_BAR;
        PG8_STAGE(PG8_SB(1, 0), cB + kstep, voffB); PG8_STAGE(PG8_SA(1, 0), cA + kstep, voffA); PG8_STAGE(PG8_SB(1, 1), cB + hstep + kstep, voffB);
        PG8_WAIT_V(6); PG8_BAR;
    } else {
        PG8_STAGE(PG8_SB(0, 0), cB, voffB); PG8_STAGE(PG8_SA(0, 0), cA, voffA); PG8_STAGE(PG8_SB(0, 1), cB + hstep, voffB); PG8_STAGE(PG8_SA(0, 1), cA + hstep, voffA);
        if (wr == 1) PG8_BAR;
        PG8_WAIT_V(4); PG8_BAR;
        PG8_STAGE(PG8_SB(1, 0), cB + kstep, voffB); PG8_STAGE(PG8_SA(1, 0), cA + kstep, voffA); PG8_STAGE(PG8_SB(1, 1), cB + hstep + kstep, voffB);
        PG8_WAIT_V(6); PG8_BAR;
    }
    for (;;) {
        const bool has_next = S.next(ui + 1, nxt);
        const char* nA = has_next ? (const char*)g.A + (size_t)nxt.pm * tstep : cA; const char* nB = has_next ? (const char*)g.Bt + (size_t)nxt.pn * tstep : cB;
        for (int t = 0; t < nt; t += 2) {
            const bool last = (t == nt - 2);
            const char* a1 = cA + (size_t)(t + 1) * kstep;
            const char* a2 = last ? nA : cA + (size_t)(t + 2) * kstep; const char* b2 = last ? nB : cB + (size_t)(t + 2) * kstep;
            const char* a3 = a2 + kstep; const char* b3 = b2 + kstep;
            if (last && has_next) S.a_ready(nxt);
            if constexpr (SP2) {
            PG8_LDB(B0, 0, 0); PG8_LDB(B1, 0, 1); PG8_SCHED; PG8_LDA(At, 0, 0); PG8_STAGE(PG8_SA(1, 1), a1 + hstep, voffA);
            PG8_WAIT_V(8); PG8_WAIT_L(0); PG8_BAR; PG8_MMA(0, 0, At, B0); PG8_MMA(0, 1, At, B1); PG8_BAR; PG8_SCHED;
            PG8_LDA(At, 0, 1); PG8_STAGE(PG8_SB(0, 0), b2, voffB); PG8_STAGE(PG8_SB(0, 1), b2 + hstep, voffB); PG8_STAGE(PG8_SA(0, 0), a2, voffA);
            PG8_WAIT_V(8); PG8_WAIT_L(0); PG8_BAR; PG8_MMA(1, 0, At, B0); PG8_MMA(1, 1, At, B1); PG8_BAR; PG8_SCHED;
            PG8_LDB(B0, 1, 0); PG8_LDB(B1, 1, 1); PG8_SCHED; PG8_LDA(At, 1, 0); PG8_STAGE(PG8_SA(0, 1), a2 + hstep, voffA);
            PG8_WAIT_V(8); PG8_WAIT_L(0); PG8_BAR; PG8_MMA(0, 0, At, B0); PG8_MMA(0, 1, At, B1); PG8_BAR; PG8_SCHED;
            PG8_LDA(At, 1, 1); PG8_STAGE(PG8_SB(1, 0), b3, voffB); PG8_STAGE(PG8_SB(1, 1), b3 + hstep, voffB); PG8_STAGE(PG8_SA(1, 0), a3, voffA);
            PG8_WAIT_V(8); PG8_WAIT_L(0); PG8_BAR; PG8_MMA(1, 0, At, B0); PG8_MMA(1, 1, At, B1); PG8_BAR; PG8_SCHED;
            } else {
            PG8_LDB(B0, 0, 0); PG8_SCHED; PG8_LDA(At, 0, 0); PG8_STAGE(PG8_SA(1, 1), a1 + hstep, voffA);
            PG8_WAIT_L(8); PG8_BAR; PG8_WAIT_L(0); PG8_MMA(0, 0, At, B0); PG8_BAR; PG8_SCHED;
            PG8_LDB(B1, 0, 1); PG8_STAGE(PG8_SB(0, 0), b2, voffB);
            PG8_BAR; PG8_WAIT_L(0); PG8_MMA(0, 1, At, B1); PG8_BAR;
            PG8_LDA(At, 0, 1); PG8_STAGE(PG8_SA(0, 0), a2, voffA);
            PG8_BAR; PG8_WAIT_L(0); PG8_MMA(1, 0, At, B0); PG8_BAR; PG8_SCHED;
            PG8_STAGE(PG8_SB(0, 1), b2 + hstep, voffB);
            PG8_WAIT_V(6); PG8_BAR; PG8_MMA(1, 1, At, B1); PG8_BAR;
            PG8_LDB(B0, 1, 0); PG8_SCHED; PG8_LDA(At, 1, 0); PG8_STAGE(PG8_SA(0, 1), a2 + hstep, voffA);
            PG8_WAIT_L(8); PG8_BAR; PG8_WAIT_L(0); PG8_MMA(0, 0, At, B0); PG8_BAR; PG8_SCHED;
            PG8_LDB(B1, 1, 1); PG8_STAGE(PG8_SB(1, 0), b3, voffB);
            PG8_BAR; PG8_WAIT_L(0); PG8_MMA(0, 1, At, B1); PG8_BAR;
            PG8_LDA(At, 1, 1); PG8_STAGE(PG8_SA(1, 0), a3, voffA);
            PG8_BAR; PG8_WAIT_L(0); PG8_MMA(1, 0, At, B0); PG8_BAR; PG8_SCHED;
            PG8_STAGE(PG8_SB(1, 1), b3 + hstep, voffB);
            PG8_WAIT_V(6); PG8_BAR; PG8_MMA(1, 1, At, B1); PG8_BAR;
            }
        }
        if constexpr (ALIGN_EPI) { if (wr == 0) PG8_BAR; }
        if constexpr (!Epi::AFTER_DRAIN) { E(acc, cur, wr, wc, fr, fq); S.done(cur); }
        if (!has_next) break;
#pragma unroll
        for (int a = 0; a < 2; ++a)
#pragma unroll
            for (int b = 0; b < 2; ++b)
#pragma unroll
                for (int m = 0; m < 4; ++m)
#pragma unroll
                    for (int n = 0; n < 2; ++n) acc[a][b][m][n] = (f32x4){0.f, 0.f, 0.f, 0.f};
        cur = nxt; cA = nA; cB = nB; ++ui;
        if constexpr (ALIGN_EPI) { if (wr == 1) PG8_BAR; }
    }
    PG8_WAIT_V(0);
    if constexpr (!ALIGN_EPI) { if (wr == 0) PG8_BAR; }
    PG8_BAR;
    if constexpr (Epi::AFTER_DRAIN) { E.fused(acc, cur, wr, wc, fr, fq, lds, wid, lane); S.done(cur); }
#undef PG8_SA
#undef PG8_SB
#undef PG8_STAGE
#undef PG8_LDA
#undef PG8_LDB
#undef PG8_MMA
#undef PG8_WAIT_V
#undef PG8_WAIT_L
#undef PG8_BAR
#undef PG8_SCHED
}
}

#define LAS __attribute__((address_space(3)))
typedef unsigned short bf16;
typedef unsigned v4u __attribute__((ext_vector_type(4)));
typedef unsigned v2u __attribute__((ext_vector_type(2)));
typedef float f32x4 __attribute__((ext_vector_type(4)));
__device__ __forceinline__ unsigned pk2(float lo, float hi) { return pg8::cvt_pk_bf16(lo, hi); }
__device__ __forceinline__ float bf2f(unsigned short b) { return __uint_as_float(((unsigned)b) << 16); }
__device__ __forceinline__ float bflo(unsigned w) { return __uint_as_float(w << 16); }
__device__ __forceinline__ float bfhi(unsigned w) { return __uint_as_float(w & 0xffff0000u); }
__device__ __forceinline__ float wave_sum(float v) {
#pragma unroll
    for (int o = 1; o < 64; o <<= 1) v += __shfl_xor(v, o);
    return v;
}
__device__ __forceinline__ float wave_max(float v) {
#pragma unroll
    for (int o = 1; o < 64; o <<= 1) v = fmaxf(v, __shfl_xor(v, o));
    return v;
}

__device__ __forceinline__ void transpose_tile(const float* W, size_t ldw, int K, int k0, int n0, bf16* WT, int nbase, LAS unsigned* scr, int lane) {
    const int g = lane & 15, ks = lane >> 4;
#pragma unroll
    for (int i = 0; i < 8; ++i) {
        const int k = k0 + 8 * i + 2 * ks;
        const f32x4 a = *(const f32x4*)(W + (size_t)k * ldw + n0 + 4 * g), b = *(const f32x4*)(W + (size_t)(k + 1) * ldw + n0 + 4 * g);
#pragma unroll
        for (int j = 0; j < 4; ++j) scr[(4 * g + j) * 33 + 4 * i + ks] = pk2(a[j], b[j]);
    }
    asm volatile("s_waitcnt lgkmcnt(0)" ::: "memory");
    const int c = lane & 7;
#pragma unroll
    for (int r = 0; r < 8; ++r) { const int n = 8 * r + (lane >> 3);
        v4u o; o.x = scr[n * 33 + 4 * c]; o.y = scr[n * 33 + 4 * c + 1]; o.z = scr[n * 33 + 4 * c + 2]; o.w = scr[n * 33 + 4 * c + 3];
        *(v4u*)(WT + (size_t)(n0 - nbase + n) * K + k0 + 8 * c) = o; }
    asm volatile("s_waitcnt lgkmcnt(0)" ::: "memory");
}
__device__ __forceinline__ void rms_row_bf16(const float* xrow, const float* w, bf16* orow, int lane) {
    const f32x4* xr = (const f32x4*)xrow + lane; const f32x4* wr = (const f32x4*)w + lane;
    f32x4 v[16]; float s = 0.f;
#pragma unroll
    for (int j = 0; j < 16; ++j) { v[j] = xr[64 * j]; s += (v[j].x * v[j].x + v[j].y * v[j].y) + (v[j].z * v[j].z + v[j].w * v[j].w); }
    const float rs = 1.0f / sqrtf(wave_sum(s) * (1.0f / D) + EPS);
    v2u* o8 = (v2u*)orow + lane;
#pragma unroll
    for (int j = 0; j < 16; ++j) { const f32x4 g = wr[64 * j]; v2u o; o.x = pk2(v[j].x * rs * g.x, v[j].y * rs * g.y); o.y = pk2(v[j].z * rs * g.z, v[j].w * rs * g.w); o8[64 * j] = o; }
}
__device__ __forceinline__ void rms_row_f32(const float* xrow, const float* w, float* orow, int lane) {
    const f32x4* xr = (const f32x4*)xrow + lane; const f32x4* wr = (const f32x4*)w + lane;
    f32x4 v[16]; float s = 0.f;
#pragma unroll
    for (int j = 0; j < 16; ++j) { v[j] = xr[64 * j]; s += (v[j].x * v[j].x + v[j].y * v[j].y) + (v[j].z * v[j].z + v[j].w * v[j].w); }
    const float rs = 1.0f / sqrtf(wave_sum(s) * (1.0f / D) + EPS);
    f32x4* o = (f32x4*)orow + lane;
#pragma unroll
    for (int j = 0; j < 16; ++j) { const f32x4 g = wr[64 * j]; o[64 * j] = (f32x4){v[j].x * rs * g.x, v[j].y * rs * g.y, v[j].z * rs * g.z, v[j].w * rs * g.w}; }
}

constexpr size_t MiB = 1u << 20;
constexpr size_t WS_CTL = 0;
constexpr size_t WS_WA  = 1 * MiB;
constexpr size_t WS_WB  = WS_WA + 256 * MiB;
constexpr size_t WS_WF  = WS_WB + 256 * MiB;
constexpr size_t WS_WOA = WS_WF + 1 * MiB;
constexpr size_t WS_WOB = WS_WOA + 64 * MiB;
constexpr size_t WS_HB  = WS_WOB + 64 * MiB;
constexpr size_t WS_X1  = WS_HB + 64 * MiB;
constexpr size_t WS_P   = WS_X1 + 128 * MiB;
constexpr size_t WS_Y   = WS_P + 512 * MiB;
constexpr size_t WS_LS  = WS_Y + 128 * MiB;
constexpr size_t WS_C   = WS_LS + 2 * MiB;
constexpr size_t WS_END = WS_C + 2 * MiB;

#ifndef CONV_P0_PCT
#define CONV_P0_PCT 0
#endif
__device__ __forceinline__ void prologue_phase(LAS unsigned char* lds, int part, const float* x, const float* norm_w, const float* w_in_a, const float* w_out_a, const float* w_in_b, const float* w_out_b,
                                               unsigned char* ws, int vcu, int G, int wave, int lane) {
    LAS unsigned* scr = (LAS unsigned*)(lds + wave * 8448);
    const int gw = vcu * 8 + wave, NGW = G * 8;
    bf16* WA = (bf16*)(ws + WS_WA); bf16* WB = (bf16*)(ws + WS_WB); bf16* WF = (bf16*)(ws + WS_WF); bf16* WOA = (bf16*)(ws + WS_WOA); bf16* WOB = (bf16*)(ws + WS_WOB);
    constexpr int T_IN = (D / 64) * (LDP / 64);
    constexpr int T_F = (D / 64) * 1;
    constexpr int T_OUT = (DI / 64) * (D / 64);
    constexpr int T_DEF = T_OUT + T_IN + T_F + T_OUT, SPLIT = (int)((long)T_DEF * CONV_P0_PCT / 100);
    if (part == 0) {
        for (int it = gw; it < T_IN; it += NGW) { const int kb = it / (LDP / 64), nb = it % (LDP / 64); transpose_tile(w_in_a, LDP, D, kb * 64, nb * 64, WA, 0, scr, lane); }
        bf16* HB = (bf16*)(ws + WS_HB);
        for (int m = gw; m < M; m += NGW) rms_row_bf16(x + (size_t)m * D, norm_w, HB + (size_t)m * D, lane);
    }
    {
        const int i0 = (part == 0) ? 0 : SPLIT, i1 = (part == 0) ? SPLIT : T_DEF;
        for (int it = i0 + gw; it < i1; it += NGW) {
            int r = it;
            if (r < T_OUT) { const int kb = r / (D / 64), nb = r % (D / 64); transpose_tile(w_out_a, D, DI, kb * 64, nb * 64, WOA, 0, scr, lane); continue; } r -= T_OUT;
            if (r < T_IN) { const int kb = r / (LDP / 64), nb = r % (LDP / 64); transpose_tile(w_in_b, NWB, D, kb * 64, nb * 64, WB, 0, scr, lane); continue; } r -= T_IN;
            if (r < T_F) { transpose_tile(w_in_b, NWB, D, r * 64, LDP, WF, LDP, scr, lane); continue; } r -= T_F;
            { const int kb = r / (D / 64), nb = r % (D / 64); transpose_tile(w_out_b, D, DI, kb * 64, nb * 64, WOB, 0, scr, lane); }
        }
    }
}

namespace scan {
typedef short s16x4 __attribute__((ext_vector_type(4)));
typedef short bf16x8 __attribute__((ext_vector_type(8)));
typedef float f32x4 __attribute__((ext_vector_type(4)));
typedef unsigned u32x2 __attribute__((ext_vector_type(2)));
#ifndef SCAN_STAGGER
#define SCAN_STAGGER 1
#endif
constexpr int R = 8, NSTEP = SEQ / 16;
constexpr int RAW = 0, PRD = R * 16384, PRD_SZ = 3 * 4096 + 512, QDT = 0, KIT = 4096, KE = 8192, DEC = 12288, SSQ = PRD + 2 * PRD_SZ, LDS_BYTES = SSQ + 1024;
__device__ __forceinline__ s16x4 trd(LAS const unsigned char* p) { return __builtin_bit_cast(s16x4, __builtin_amdgcn_ds_read_tr16_b64_v4i16((LAS s16x4*)p)); }
__device__ __forceinline__ s16x4 pk4(float a, float b, float c, float d) { u32x2 w; w.x = pk2(a, b); w.y = pk2(c, d); return __builtin_bit_cast(s16x4, w); }
__device__ __forceinline__ bf16x8 cat8(s16x4 a, s16x4 b) { return __builtin_shufflevector(a, b, 0, 1, 2, 3, 4, 5, 6, 7); }
#define SC_BAR() do { asm volatile("" ::: "memory"); __builtin_amdgcn_s_barrier(); asm volatile("" ::: "memory"); } while (0)

__device__ __forceinline__ void scan_unit(LAS unsigned char* lds, const bf16* __restrict__ P, const float* __restrict__ onw, bf16* __restrict__ Y, int bh) {
    const int tid = threadIdx.x, wid = __builtin_amdgcn_readfirstlane(tid >> 6), lane = tid & 63, n = lane & 15, g = lane >> 4, tq = n >> 2, tp = n & 3;
    const int b = bh / NH, h = bh % NH;
    const bf16* base = P + (size_t)(b * NH + h) * SEQ * HD;
    size_t goff[2]; int ldst[2];
#pragma unroll
    for (int ii = 0; ii < 2; ++ii) { const int i = 2 * wid + ii, ti = i >> 2, rg = i & 3, row = 4 * rg + (lane >> 4), pc = lane & 15, c = pc ^ ((row & 7) << 1);
        const int sec = (ti == 0) ? 1 : ((ti == 1) ? 0 : ti);
        goff[ii] = (size_t)row * HD + (size_t)sec * ((size_t)NB * NH * SEQ * HD) + c * 8; ldst[ii] = ti * 4096 + rg * 1024; }
#define SC_DMA(step) do { const int st_ = (step) < NSTEP ? (step) : NSTEP - 1; const int sl_ = ((step) & (R - 1)) * 16384; _Pragma("unroll") for (int ii = 0; ii < 2; ++ii) \
        __builtin_amdgcn_global_load_lds((const unsigned*)(base + (size_t)st_ * 16 * HD + goff[ii]), (LAS unsigned*)(lds + RAW + sl_ + ldst[ii]), 16, 0, 0); } while (0)
    const int rrow = 4 * g + tq;
    const int rtr = rrow * 256 + ((2 * wid + (tp >> 1)) ^ ((rrow & 7) << 1)) * 16 + 8 * (tp & 1);
    const int rsg = n * 256 + ((2 * wid + (g >> 1)) ^ ((n & 7) << 1)) * 16 + 8 * (g & 1);
    const int wq = (16 * wid + n) * 32 + g * 8;
    const int wk = (g >> 1) * 2048 + (16 * wid + n) * 16 + (g & 1) * 8;
    const int rqt = (4 * g + tq) * 32 + 8 * tp;
    const int rke = (g >> 1) * 2048 + n * 16 + (g & 1) * 8;
    const int rdec = (4 * g) * 4;
    s16x4 ltri; { short one = (short)0x3F80; ltri[0] = (4 * g + 0 <= n) ? one : (short)0; ltri[1] = (4 * g + 1 <= n) ? one : (short)0; ltri[2] = (4 * g + 2 <= n) ? one : (short)0; ltri[3] = (4 * g + 3 <= n) ? one : (short)0; }
    f32x4 gain = *(const f32x4*)(onw + h * HD + 16 * wid + 4 * g);
    asm volatile("" : "+v"(gain[0]), "+v"(gain[1]), "+v"(gain[2]), "+v"(gain[3]));
    f32x4 S[8];
#pragma unroll
    for (int t = 0; t < 8; ++t) S[t] = (f32x4){0.f, 0.f, 0.f, 0.f};
    f32x4 oprev = (f32x4){0.f, 0.f, 0.f, 0.f};
#define SC_PREP(s_) do { const LAS unsigned char* raw_ = lds + RAW + ((s_) & (R - 1)) * 16384; LAS unsigned char* img_ = lds + PRD + ((s_) & 1) * PRD_SZ; \
        const s16x4 lfB = trd(raw_ + rtr), qsB = trd(raw_ + 4096 + rtr); \
        const f32x4 G = __builtin_amdgcn_mfma_f32_16x16x16bf16_1k(ltri, lfB, (f32x4){0.f, 0.f, 0.f, 0.f}, 0, 0, 0); \
        const float dec_ = __builtin_amdgcn_exp2f(__shfl(G[3], 48 + n)); \
        float qd[4], ki[4], ke[4]; \
        _Pragma("unroll") for (int j = 0; j < 4; ++j) { const float lf = bf2f((unsigned short)lfB[j]), qs = bf2f((unsigned short)qsB[j]); \
            const float E = __builtin_amdgcn_exp2f(G[j]), Ei = __builtin_amdgcn_exp2f(-G[j]); \
            const float kk = 1.0f - __builtin_amdgcn_exp2f(lf); \
            qd[j] = qs * E; ki[j] = kk * Ei; ke[j] = ki[j] * dec_; } \
        *(LAS s16x4*)(img_ + QDT + wq) = pk4(qd[0], qd[1], qd[2], qd[3]); \
        *(LAS s16x4*)(img_ + KIT + wq) = pk4(ki[0], ki[1], ki[2], ki[3]); \
        *(LAS s16x4*)(img_ + KE + wk) = pk4(ke[0], ke[1], ke[2], ke[3]); \
        if (g == 0) *(LAS float*)(img_ + DEC + (16 * wid + n) * 4) = dec_; } while (0)
#define SC_OUT(s_) do { const LAS unsigned char* rawp = lds + RAW + ((s_) & (R - 1)) * 16384; const LAS unsigned char* sq = lds + SSQ + ((s_) & 1) * 512 + n * 32; \
        const f32x4 a = *(const LAS f32x4*)sq, c = *(const LAS f32x4*)(sq + 16); \
        const float tot = ((a[0] + a[1]) + (a[2] + a[3])) + ((c[0] + c[1]) + (c[2] + c[3])); \
        const float rs = __builtin_amdgcn_rsqf(tot * (1.0f / HD) + EPS); \
        const s16x4 sgv = *(const LAS s16x4*)(rawp + 3 * 4096 + rsg); \
        const float y0 = oprev[0] * rs * gain[0] * bf2f((unsigned short)sgv[0]), y1 = oprev[1] * rs * gain[1] * bf2f((unsigned short)sgv[1]); \
        const float y2 = oprev[2] * rs * gain[2] * bf2f((unsigned short)sgv[2]), y3 = oprev[3] * rs * gain[3] * bf2f((unsigned short)sgv[3]); \
        u32x2 w; w.x = pk2(y0, y1); w.y = pk2(y2, y3); \
        *(u32x2*)(Y + (size_t)(b * SEQ + 16 * (s_) + n) * DI + h * HD + 16 * wid + 4 * g) = w; } while (0)
    SC_DMA(0); SC_DMA(1); SC_DMA(2); SC_DMA(3); SC_DMA(4); SC_DMA(5);
    asm volatile("s_waitcnt vmcnt(10)" ::: "memory");
    SC_BAR();
    SC_PREP(0);
    for (int st = 0; st < NSTEP; ++st) {
        if (st < 6) asm volatile("s_waitcnt vmcnt(8) lgkmcnt(0)" ::: "memory"); else asm volatile("s_waitcnt vmcnt(12) lgkmcnt(0)" ::: "memory");
        SC_BAR();
        SC_DMA(st + 6);
        if (SCAN_STAGGER && wid >= 4 && st + 1 < NSTEP) SC_PREP(st + 1);
        if (st > 0) SC_OUT(st - 1);
        {
            const LAS unsigned char* raw = lds + RAW + (st & (R - 1)) * 16384; const LAS unsigned char* img = lds + PRD + (st & 1) * PRD_SZ;
            s16x4 qf[8], kf[8];
#pragma unroll
            for (int t = 0; t < 8; ++t) { qf[t] = trd(img + QDT + rqt + 512 * t); kf[t] = trd(img + KIT + rqt + 512 * t); }
            const s16x4 vf = trd(raw + 2 * 4096 + rtr);
            f32x4 sc = (f32x4){0.f, 0.f, 0.f, 0.f};
#pragma unroll
            for (int u = 0; u < 4; ++u) sc = __builtin_amdgcn_mfma_f32_16x16x32_bf16(cat8(kf[2 * u], kf[2 * u + 1]), cat8(qf[2 * u], qf[2 * u + 1]), sc, 0, 0, 0);
#pragma unroll
            for (int j = 0; j < 4; ++j) sc[j] = (4 * g + j <= n) ? sc[j] : 0.f;
            f32x4 o = (f32x4){0.f, 0.f, 0.f, 0.f};
#pragma unroll
            for (int u = 0; u < 4; ++u) { const s16x4 s0 = pk4(S[2 * u][0], S[2 * u][1], S[2 * u][2], S[2 * u][3]), s1 = pk4(S[2 * u + 1][0], S[2 * u + 1][1], S[2 * u + 1][2], S[2 * u + 1][3]);
                o = __builtin_amdgcn_mfma_f32_16x16x32_bf16(cat8(s0, s1), cat8(qf[2 * u], qf[2 * u + 1]), o, 0, 0, 0); }
            o = __builtin_amdgcn_mfma_f32_16x16x16bf16_1k(vf, pk4(sc[0], sc[1], sc[2], sc[3]), o, 0, 0, 0);
#pragma unroll
            for (int t = 0; t < 8; ++t) { const s16x4 kef = *(const LAS s16x4*)(img + KE + rke + 256 * t); const f32x4 dv = *(const LAS f32x4*)(img + DEC + rdec + 64 * t);
                S[t] = __builtin_amdgcn_mfma_f32_16x16x16bf16_1k(kef, vf, S[t] * dv, 0, 0, 0); }
            float ss = (o[0] * o[0] + o[1] * o[1]) + (o[2] * o[2] + o[3] * o[3]);
            ss += __shfl_xor(ss, 16); ss += __shfl_xor(ss, 32);
            if (g == 0) *(LAS float*)(lds + SSQ + (st & 1) * 512 + (n * 8 + wid) * 4) = ss;
            oprev = o;
        }
        if ((!SCAN_STAGGER || wid < 4) && st + 1 < NSTEP) SC_PREP(st + 1);
    }
    asm volatile("s_waitcnt lgkmcnt(0)" ::: "memory");
    SC_BAR();
    SC_OUT(NSTEP - 1);
    asm volatile("s_waitcnt vmcnt(0) lgkmcnt(0)" ::: "memory");
    SC_BAR();
#undef SC_DMA
#undef SC_PREP
#undef SC_OUT
}
#undef SC_BAR
}

namespace fox {
enum { ORDER_NATURAL = 0, ORDER_REVERSED = 1, ORDER_PAIRED = 2, ORDER_XCD = 4 };
constexpr int B = NB, H = NH, HKV = NH, SQ = SEQ, SKV = SEQ, D = HD, QOFF = 0, WINDOW = SEQ;
constexpr int LDQ = HD, LDO = DI;
constexpr size_t SECSZ = (size_t)NB * NH * SEQ * HD;
constexpr float THR = 8.f;
constexpr int ORDER = ORDER_PAIRED | ORDER_XCD;
constexpr bool WSKIP = false;
constexpr float ISCALE = 11.313708498984761f;
constexpr int STG_ROW = 272;
constexpr float SCALE = 0.08838834764831845f;
constexpr int NW = 8, QBLK = 32, KVBLK = 64, QB = NW * QBLK;
constexpr int SHM_V = KVBLK * D * 2, SHM_K = KVBLK * D * 2;
constexpr int LDS_BYTES = 2 * SHM_V + 2 * SHM_K + NW * 64 * 4;
constexpr int C_OFF = LDS_BYTES, STG_OFF = C_OFF + SEQ * 4;
static_assert(D == 128 && SQ % QB == 0 && SKV % KVBLK == 0 && H % HKV == 0 && QOFF >= 0 && QOFF + SQ <= SKV && WINDOW >= 1, "geometry");

using bf16 = unsigned short;
typedef short bf16x8 __attribute__((ext_vector_type(8)));
typedef short s16x4 __attribute__((ext_vector_type(4)));
typedef float f32x16 __attribute__((ext_vector_type(16)));
typedef float f32x4 __attribute__((ext_vector_type(4)));
typedef unsigned u32x4 __attribute__((ext_vector_type(4)));
template <class A, class Bt> struct same_t { static constexpr bool v = false; };
template <class A> struct same_t<A, A> { static constexpr bool v = true; };

#define KSWZ(row, colB) ((row) * 256 + ((colB) ^ (((row) & 7) << 4)))
#define SBAR() __builtin_amdgcn_sched_barrier(0)
__device__ __forceinline__ int v_st(int k, int c) { const int kk = (k & ~0xC) | ((k & 4) << 1) | ((k & 8) >> 1); return ((kk >> 3) * 4 + (c >> 5)) * 512 + ((kk & 7) * 32 + (c & 31)) * 2; }
__device__ __forceinline__ int v_rd_base(int lane) { return ((lane & 3) << 3) | (((lane >> 2) & 3) << 6) | (((lane >> 4) & 1) << 5) | (((lane >> 5) & 1) << 8); }
constexpr int v_rd_off(int d0, int ks, int half) { return d0 * 512 + ks * 4096 + half * 2048; }
__device__ __forceinline__ int crow(int r, int hi) { return (r & 3) + 8 * (r >> 2) + 4 * hi; }
__device__ __forceinline__ unsigned cvtpk(float lo, float hi) {
    unsigned r; asm volatile("v_cvt_pk_bf16_f32 %0, %1, %2" : "=v"(r) : "v"(lo), "v"(hi)); return r;
}
__device__ __forceinline__ bf16x8 pack8(f32x4 a, f32x4 b) {
    u32x4 w = {cvtpk(a[0], a[1]), cvtpk(a[2], a[3]), cvtpk(b[0], b[1]), cvtpk(b[2], b[3])};
    return *reinterpret_cast<bf16x8*>(&w);
}
template <class T> __device__ __forceinline__ bf16x8 load8(const T* p) {
    if constexpr (same_t<T, float>::v) { return pack8(*(const f32x4*)p, *(const f32x4*)(p + 4)); }
    else { return *reinterpret_cast<const bf16x8*>(p); }
}
__device__ __forceinline__ void mask_tile(f32x16& p0, f32x16& p1, int dq, unsigned W) {
    const float NEG = -__builtin_inff();
#pragma unroll
    for (int r = 0; r < 16; ++r) {
        const int c = (r & 3) + 8 * (r >> 2);
        if ((unsigned)(dq - c) >= W) p0[r] = NEG;
        if ((unsigned)(dq - c - 32) >= W) p1[r] = NEG;
    }
}
__device__ __forceinline__ void partialSM(f32x16& p0, f32x16& p1, float& m_reg, float& mn, float& alpha) {
    float pmax = p0[0]; for (int r = 1; r < 16; ++r) pmax = fmaxf(pmax, p0[r]); for (int r = 0; r < 16; ++r) pmax = fmaxf(pmax, p1[r]);
    { auto rr = __builtin_amdgcn_permlane32_swap(__float_as_uint(pmax), __float_as_uint(pmax), false, false);
      pmax = fmaxf(__uint_as_float(rr[0]), __uint_as_float(rr[1])); }
    constexpr float C2 = 1.4426950408889634f * SCALE;
    if (__builtin_expect(__all((pmax - m_reg) * SCALE <= THR), 1)) { mn = m_reg; alpha = 1.f; }
    else { mn = fmaxf(m_reg, pmax); alpha = __builtin_amdgcn_exp2f((m_reg - mn) * C2); m_reg = mn; }
    const float mnL = -mn * C2;
    for (int r = 0; r < 16; ++r) p0[r] = fmaf(p0[r], C2, mnL); for (int r = 0; r < 16; ++r) p1[r] = fmaf(p1[r], C2, mnL);
    for (int r = 0; r < 16; ++r) p0[r] = __builtin_amdgcn_exp2f(p0[r]);
}
__device__ __forceinline__ void finishSM(f32x16& p0, f32x16& p1, float alpha, float& l_reg, bf16x8& pa0, bf16x8& pa1, bf16x8& pa2, bf16x8& pa3) {
    for (int r = 0; r < 16; ++r) p1[r] = __builtin_amdgcn_exp2f(p1[r]);
    float ps = 0; for (int r = 0; r < 16; ++r) ps += p0[r]; for (int r = 0; r < 16; ++r) ps += p1[r];
    { auto rr = __builtin_amdgcn_permlane32_swap(__float_as_uint(ps), __float_as_uint(ps), false, false);
      ps = __uint_as_float(rr[0]) + __uint_as_float(rr[1]); }
    l_reg = l_reg * alpha + ps;
#define PK4(P, B_, OUT) do { unsigned a0 = cvtpk(P[B_+0], P[B_+1]), a1 = cvtpk(P[B_+2], P[B_+3]);                          \
        unsigned b0 = cvtpk(P[B_+4], P[B_+5]), b1 = cvtpk(P[B_+6], P[B_+7]);                                             \
        auto r0 = __builtin_amdgcn_permlane32_swap(a0, b0, false, false); auto r1 = __builtin_amdgcn_permlane32_swap(a1, b1, false, false); \
        u32x4 w = {r0[0], r1[0], r0[1], r1[1]}; OUT = *reinterpret_cast<bf16x8*>(&w); } while (0)
    PK4(p0, 0, pa0); PK4(p0, 8, pa1); PK4(p1, 0, pa2); PK4(p1, 8, pa3);
#undef PK4
}
__device__ __forceinline__ void bias_tile(f32x16& p0, f32x16& p1, const float* cl, int kb, int hi) {
    const f32x4* cp = (const f32x4*)(cl + kb + 4 * hi);
#pragma unroll
    for (int j = 0; j < 4; ++j) { const f32x4 c0 = cp[2 * j], c1 = cp[8 + 2 * j];
#pragma unroll
        for (int e = 0; e < 4; ++e) { p0[4 * j + e] = fmaf(c0[e], -ISCALE, p0[4 * j + e]); p1[4 * j + e] = fmaf(c1[e], -ISCALE, p1[4 * j + e]); } }
}
template <int KB, bool SK>
__device__ __forceinline__ void qkt(f32x16& p0, f32x16& p1, const char* K_lds, int r32, int hi, const bf16x8* qr, bool act) {
    if (SK && !act) { const float NEG = -__builtin_inff();
#pragma unroll
        for (int r = 0; r < 16; ++r) { p0[r] = NEG; p1[r] = NEG; } return; }
    p0 = f32x16{}; p1 = f32x16{};
    const char* kb[4];
#pragma unroll
    for (int dd = 0; dd < 4; ++dd) kb[dd] = K_lds + KB * SHM_K + KSWZ(r32, (dd * 16 + hi * 8) * 2);
#pragma unroll
    for (int d0 = 0; d0 < 8; ++d0) { const char* a = kb[d0 & 3] + (d0 >> 2) * 128;
        bf16x8 b0 = *reinterpret_cast<const bf16x8*>(a);
        bf16x8 b1 = *reinterpret_cast<const bf16x8*>(a + 32 * 256);
        p0 = __builtin_amdgcn_mfma_f32_32x32x16_bf16(b0, qr[d0], p0, 0, 0, 0);
        p1 = __builtin_amdgcn_mfma_f32_32x32x16_bf16(b1, qr[d0], p1, 0, 0, 0); }
}
template <int VB, bool SK>
__device__ __forceinline__ void pv_tile(f32x16* o, int vb0, bf16x8 pa0, bf16x8 pa1, bf16x8 pa2, bf16x8 pa3, bool act) {
    if (SK && !act) return;
#define TRRD(dst, off) asm volatile("ds_read_b64_tr_b16 %0, %1 offset:%2" : "=&v"(dst) : "v"(vb0), "i"(off) : "memory")
#define PV_D0(d0) do { s16x4 l0, l1, l2, l3, h0, h1, h2, h3; constexpr int b_ = VB * SHM_V + v_rd_off(d0, 0, 0);     \
        TRRD(l0, b_); TRRD(h0, b_ + 2048); TRRD(l1, b_ + 4096); TRRD(h1, b_ + 6144); TRRD(l2, b_ + 8192); TRRD(h2, b_ + 10240); TRRD(l3, b_ + 12288); TRRD(h3, b_ + 14336); \
        asm volatile("s_waitcnt lgkmcnt(0)" ::: "memory"); SBAR();                 \
        o[d0] = __builtin_amdgcn_mfma_f32_32x32x16_bf16(pa0, (bf16x8){l0[0], l0[1], l0[2], l0[3], h0[0], h0[1], h0[2], h0[3]}, o[d0], 0, 0, 0);   \
        o[d0] = __builtin_amdgcn_mfma_f32_32x32x16_bf16(pa1, (bf16x8){l1[0], l1[1], l1[2], l1[3], h1[0], h1[1], h1[2], h1[3]}, o[d0], 0, 0, 0);   \
        o[d0] = __builtin_amdgcn_mfma_f32_32x32x16_bf16(pa2, (bf16x8){l2[0], l2[1], l2[2], l2[3], h2[0], h2[1], h2[2], h2[3]}, o[d0], 0, 0, 0);   \
        o[d0] = __builtin_amdgcn_mfma_f32_32x32x16_bf16(pa3, (bf16x8){l3[0], l3[1], l3[2], l3[3], h3[0], h3[1], h3[2], h3[3]}, o[d0], 0, 0, 0); } while (0)
    PV_D0(0); PV_D0(1); PV_D0(2); PV_D0(3);
#undef PV_D0
#undef TRRD
}

template <class TIn, class TOut> struct BlockRef { const TIn* Q; const TIn* K; const TIn* V; const TIn* G; TOut* O; int P0; };
template <class TIn> struct Seam {
    bf16x8 qr[8];
    bf16x8 st_v0, st_v1, st_k0, st_k1; f32x4 sf0, sf1, sf2, sf3;
    f32x4 tq[16];
};
__device__ __forceinline__ int swa_jlo(int P0, int W) { const int lowk = P0 - W + 1; return lowk > 0 ? lowk / KVBLK : 0; }
__device__ __forceinline__ int swa_jhi(int P0, int skv) { int j = (P0 + QB - 1) / KVBLK + 1; return j > skv / KVBLK ? skv / KVBLK : j; }
#define ROW(p, k0, rr) ((p) + (size_t)((k0) + (rr)) * LDQ + sc)
#define VMW() asm volatile("s_waitcnt vmcnt(0)" ::: "memory")
#define VMWN(n) asm volatile("s_waitcnt vmcnt(%0)" :: "i"(n) : "memory")
#define SLOAD_H(Kp, Vp, k0) do { const char* kb__ = (const char*)((Kp) + (size_t)(k0) * LDQ); const char* vb__ = (const char*)((Vp) + (size_t)(k0) * LDQ);     \
                         S.st_v0 = *(const bf16x8*)(vb__ + svoff); S.st_v1 = *(const bf16x8*)(vb__ + (size_t)32 * LDQ * 2 + svoff);              \
                         S.st_k0 = *(const bf16x8*)(kb__ + svoff); S.st_k1 = *(const bf16x8*)(kb__ + (size_t)32 * LDQ * 2 + svoff); } while (0)
#define SWRITE_HK(bf) do { *(bf16x8*)(K_lds + (bf) * SHM_K + kws) = S.st_k0; *(bf16x8*)(K_lds + (bf) * SHM_K + kws + 32 * 256) = S.st_k1; } while (0)
#define SWRITE_HV(bf) do { *(bf16x8*)(V_lds + (bf) * SHM_V + vst0) = S.st_v0; *(bf16x8*)(V_lds + (bf) * SHM_V + vst1) = S.st_v1; } while (0)
#define SWRITE_H(bf) do { SWRITE_HV(bf); SWRITE_HK(bf); } while (0)
#define SLOAD_F(p, k0) do { S.sf0 = *(const f32x4*)ROW(p, k0, sr); S.sf1 = *(const f32x4*)(ROW(p, k0, sr) + 4);                \
                            S.sf2 = *(const f32x4*)ROW(p, k0, 32 + sr); S.sf3 = *(const f32x4*)(ROW(p, k0, 32 + sr) + 4); } while (0)
#define SWRITE_KF(bf) do { *(bf16x8*)(K_lds + (bf) * SHM_K + kws) = pack8(S.sf0, S.sf1); *(bf16x8*)(K_lds + (bf) * SHM_K + kws + 32 * 256) = pack8(S.sf2, S.sf3); } while (0)
#define SWRITE_VF(bf) do { *(bf16x8*)(V_lds + (bf) * SHM_V + vst0) = pack8(S.sf0, S.sf1); *(bf16x8*)(V_lds + (bf) * SHM_V + vst1) = pack8(S.sf2, S.sf3); } while (0)
template <class TIn, class TOut>
__device__ __forceinline__ void causal_swa_prime(const BlockRef<TIn, TOut>& cur, int skv, int W, char* lds, Seam<TIn>& S) {
    constexpr bool F32 = same_t<TIn, float>::v;
    const int tid = threadIdx.x, wid = __builtin_amdgcn_readfirstlane(tid >> 6), lane = tid & 63, r32 = lane & 31, hi = lane >> 5;
    const int sr = tid >> 4, sc = (tid & 15) * 8, kws = KSWZ(sr, sc * 2); char* K_lds = lds + 2 * SHM_V;
    const unsigned svoff = (unsigned)(sr * LDQ + sc) * 2u, qvoff = (unsigned)(r32 * LDQ + hi * 8) * 2u;
    const int kb0 = (swa_jhi(cur.P0, skv) - 1) * KVBLK; (void)W;
    for (int d0 = 0; d0 < 8; ++d0) S.qr[d0] = *(const bf16x8*)((const char*)(cur.Q + (size_t)(wid * QBLK) * LDQ) + d0 * 32 + qvoff);
    if constexpr (F32) { SLOAD_F((const float*)cur.K, kb0); VMW(); SWRITE_KF(0); SBAR(); SLOAD_F((const float*)cur.V, kb0); }
    else { SLOAD_H(cur.K, cur.V, kb0); VMW(); SWRITE_HK(0); }
    __syncthreads();
}
template <class TIn, class TOut>
__device__ __forceinline__ void causal_swa_block(const BlockRef<TIn, TOut>& cur, const BlockRef<TIn, TOut>& nxt, int skv, int W, char* lds, Seam<TIn>& S, float thr) {
    constexpr bool F32 = same_t<TIn, float>::v;
    const int tid = threadIdx.x, wid = __builtin_amdgcn_readfirstlane(tid >> 6), lane = tid & 63, r32 = lane & 31, hi = lane >> 5;
    int j_hi = (cur.P0 + QB - 1) / KVBLK + 1; if (j_hi > skv / KVBLK) j_hi = skv / KVBLK;
    const int kbn = (swa_jhi(nxt.P0, skv) - 1) * KVBLK;
    const int qlo = cur.P0 + wid * QBLK, qm = qlo + r32 - 4 * hi;
    char* V_lds = lds; char* K_lds = lds + 2 * SHM_V;
    const float* cl = (const float*)(lds + C_OFF);
    int j_lo; { const int lastk = 64 * lane + 63; const bool skip = (lastk < cur.P0) && (cl[cur.P0] - cl[lastk] < -thr);
        const unsigned long long keep = __ballot(!skip); j_lo = keep ? (int)__builtin_ctzll(keep) : 0; (void)W; }
    const int NT = j_hi - j_lo;
    float* ws = (float*)(lds + 2 * SHM_V + 2 * SHM_K) + wid * 64; float* li_l = ws, * al_l = ws + 32;
    float m_reg = -1e30f, l_reg = 0; f32x16 o[4] = {};
    const int sr = tid >> 4, sc = (tid & 15) * 8, vst0 = v_st(sr, sc), vst1 = v_st(32 + sr, sc), kws = KSWZ(sr, sc * 2);
    const unsigned svoff = (unsigned)(sr * LDQ + sc) * 2u, qvoff = (unsigned)(r32 * LDQ + hi * 8) * 2u;
    const int vb0 = (int)(uintptr_t)V_lds + v_rd_base(lane);
    const TIn* Kh = cur.K; const TIn* Vh = cur.V;
#define RESC(a) do { if (__any((a) < 1.f)) { if (hi == 0) al_l[r32] = (a); asm volatile("s_waitcnt lgkmcnt(0)" ::: "memory");              \
                     for (int d_ = 0; d_ < 4; ++d_) for (int r = 0; r < 16; ++r) o[d_][r] *= al_l[crow(r, hi)]; } } while (0)
#define KBASE(t) ((j_hi - 1 - (t)) * KVBLK)
#define ACT(t) (KBASE(t) <= qlo + QBLK - 1 && KBASE(t) + KVBLK - 1 >= qlo - W + 1)
#define MASKT(P0_, P1_, t) do { const int kb_ = KBASE(t); bias_tile(P0_, P1_, cl, kb_, hi); if ((!SK || ACT(t)) && (kb_ + KVBLK - 1 > qlo || kb_ <= qlo + QBLK - 1 - W)) mask_tile(P0_, P1_, qm - kb_, (unsigned)W); } while (0)
    constexpr int NQL = F32 ? 16 : 8;
    constexpr bool SK = WSKIP && !F32;
#define SEAM_K0() do { VMWN(NQL); if constexpr (F32) { SWRITE_KF(0); SBAR(); SLOAD_F((const float*)nxt.V, kbn); } else { SWRITE_HK(0); } SBAR(); } while (0)
    f32x16 pA0, pA1, pB0, pB1; float mnA, mnB, alA, alB; bf16x8 pa0, pa1, pa2, pa3;
    if constexpr (F32) { VMW(); SWRITE_VF(0); SBAR(); } else { SWRITE_HV(0); SBAR(); }
    if (NT > 1) { if constexpr (F32) SLOAD_F((const float*)Kh, KBASE(1)); else SLOAD_H(Kh, Vh, KBASE(1)); }
    SBAR(); qkt<0, SK>(pA0, pA1, K_lds, r32, hi, S.qr, ACT(0));
    if constexpr (F32) { if (NT > 1) { VMW(); SWRITE_KF(1); SBAR(); SLOAD_F((const float*)Vh, KBASE(1)); } }
    MASKT(pA0, pA1, 0); partialSM(pA0, pA1, m_reg, mnA, alA);
    if (NT > 1) { VMW(); if constexpr (F32) { SWRITE_VF(1); SBAR(); if (NT > 2) SLOAD_F((const float*)Kh, KBASE(2)); } else SWRITE_H(1); }
    __syncthreads();
#define HALF_STEP(PX0, PX1, mnX, alX, PY0, PY1, alY, t, KB, VB, SB) do {                                                      \
        SBAR(); qkt<KB, SK>(PX0, PX1, K_lds, r32, hi, S.qr, ACT(t));                                             \
        finishSM(PY0, PY1, alY, l_reg, pa0, pa1, pa2, pa3); SBAR();                                                           \
        if ((t) + 1 < NT) { if constexpr (F32) { VMW(); SWRITE_KF(SB); SBAR(); SLOAD_F((const float*)Vh, KBASE((t) + 1)); }  \
                            else { SLOAD_H(Kh, Vh, KBASE((t) + 1)); } SBAR(); }                                               \
        pv_tile<VB, SK>(o, vb0, pa0, pa1, pa2, pa3, ACT((t) - 1)); MASKT(PX0, PX1, (t)); partialSM(PX0, PX1, m_reg, mnX, alX);                                        \
        __syncthreads();                                                                                                      \
        if ((t) + 1 < NT) { VMW(); if constexpr (F32) { SWRITE_VF(SB); SBAR(); if ((t) + 2 < NT) SLOAD_F((const float*)Kh, KBASE((t) + 2)); } \
                            else { SWRITE_H(SB); } }                                                                          \
        RESC(alX); __syncthreads(); } while (0)
    for (int t = 1; t + 1 < NT; t += 2) {
        HALF_STEP(pB0, pB1, mnB, alB, pA0, pA1, alA, t, 1, 0, 0);
        HALF_STEP(pA0, pA1, mnA, alA, pB0, pB1, alB, t + 1, 0, 1, 1);
    }
    const bool even = (NT & 1) == 0;
    if (even) { SBAR(); qkt<1, SK>(pB0, pB1, K_lds, r32, hi, S.qr, ACT(NT - 1)); SBAR(); }
#define QROW(e) (nxt.Q + (size_t)(wid * QBLK + r32) * LDQ + ((e) >> 1) * 16 + hi * 8 + ((e) & 1) * 4)
    if constexpr (F32) { SLOAD_F((const float*)nxt.K, kbn); SBAR();
#pragma unroll
        for (int e = 0; e < 8; ++e) S.tq[e] = *(const f32x4*)QROW(e); }
    else { SLOAD_H(nxt.K, nxt.V, kbn); SBAR();
#pragma unroll
        for (int d0 = 0; d0 < 8; ++d0) S.qr[d0] = *(const bf16x8*)((const char*)(nxt.Q + (size_t)(wid * QBLK) * LDQ) + d0 * 32 + qvoff); }
    SBAR();
    finishSM(pA0, pA1, alA, l_reg, pa0, pa1, pa2, pa3); SBAR();
    if constexpr (F32) {
#pragma unroll
        for (int e = 8; e < 16; ++e) S.tq[e] = *(const f32x4*)QROW(e); SBAR(); }
#undef QROW
    pv_tile<0, SK>(o, vb0, pa0, pa1, pa2, pa3, ACT(even ? NT - 2 : NT - 1));
    if (even) { MASKT(pB0, pB1, NT - 1); partialSM(pB0, pB1, m_reg, mnB, alB); __syncthreads(); RESC(alB);
        finishSM(pB0, pB1, alB, l_reg, pa0, pa1, pa2, pa3); SBAR(); pv_tile<1, SK>(o, vb0, pa0, pa1, pa2, pa3, ACT(NT - 1)); }
    SBAR(); SEAM_K0();
    if (hi == 0) li_l[r32] = l_reg; asm volatile("s_waitcnt lgkmcnt(0)" ::: "memory");
    float rli[16];
#pragma unroll
    for (int r = 0; r < 16; ++r) rli[r] = __builtin_amdgcn_rcpf(li_l[crow(r, hi)]);
    { char* stg = lds + STG_OFF + wid * (QBLK * STG_ROW);
      int loff = (lane >> 4) * LDQ + (lane & 15) * 8, yoff = (lane >> 4) * LDO + (lane & 15) * 8;
      asm volatile("" : "+v"(loff), "+v"(yoff));
      const TIn* Gw = cur.G + (size_t)(wid * QBLK) * LDQ + loff; TOut* Ow = cur.O + (size_t)(wid * QBLK) * LDO + yoff;
#pragma unroll
      for (int r = 0; r < 16; ++r) { const int orow = crow(r, hi);
#pragma unroll
          for (int d0 = 0; d0 < 4; ++d0) { const float v = o[d0][r] * rli[r]; const float vn = __shfl_xor(v, 1);
              if ((r32 & 1) == 0) *(unsigned*)(stg + orow * STG_ROW + (d0 * 32 + r32) * 2) = cvtpk(v, vn); } }
      asm volatile("s_waitcnt lgkmcnt(0)" ::: "memory");
#pragma unroll
      for (int hf = 0; hf < 2; ++hf) { u32x4 gv[4];
#pragma unroll
          for (int i = 0; i < 4; ++i) gv[i] = *(const u32x4*)(Gw + (size_t)(16 * hf + 4 * i) * LDQ);
#pragma unroll
          for (int i = 0; i < 4; ++i) { const u32x4 ov = *(const u32x4*)(stg + (16 * hf + 4 * i + (lane >> 4)) * STG_ROW + (lane & 15) * 16); const u32x4 g4 = gv[i]; u32x4 w;
#pragma unroll
              for (int e = 0; e < 4; ++e) w[e] = cvtpk(__uint_as_float(ov[e] << 16) * __uint_as_float(g4[e] << 16), __uint_as_float(ov[e] & 0xffff0000u) * __uint_as_float(g4[e] & 0xffff0000u));
              *(u32x4*)(Ow + (size_t)(16 * hf + 4 * i) * LDO) = w; }
          asm volatile("" ::: "memory"); } }
    if constexpr (F32) {
#pragma unroll
        for (int d0 = 0; d0 < 8; ++d0) S.qr[d0] = pack8(S.tq[2 * d0], S.tq[2 * d0 + 1]); }
    __syncthreads();
#undef RESC
#undef KBASE
#undef ACT
#undef MASKT
#undef SEAM_K0
#undef HALF_STEP
}
#undef ROW
#undef VMW
#undef VMWN
#undef SLOAD_H
#undef SWRITE_HK
#undef SWRITE_HV
#undef SWRITE_H
#undef SLOAD_F
#undef SWRITE_KF
#undef SWRITE_VF

__host__ __device__ inline int swa_nramp(int nqb, int W, int qoff) { const int t = W - 1 - qoff; const int n = t < 0 ? 0 : t / QB + 1; return n > nqb ? nqb : n; }
__host__ __device__ inline int swa_nx(int nqb, int nramp, int order) { return (order & ORDER_PAIRED) ? (nramp + 1) / 2 + (nqb - nramp) : nqb; }
struct SwaItem { int bh, qb0, qb1; };
__device__ __forceinline__ SwaItem swa_decode(int L, int nb, int nh, int nhkv, int nqb, int nx, int nramp, int order) {
    const int G = nh / nhkv; SwaItem it; int x;
    if ((order & ORDER_XCD) && (nb * nhkv) % 8 == 0) { const int xcd = L & 7, k = L >> 3, per = G * nx, gi = k / per, r = k - gi * per;
        it.bh = (gi * 8 + xcd) * G + r / nx; x = r % nx; }
    else { it.bh = L / nx; x = L - it.bh * nx; }
    if (order & ORDER_PAIRED) { const int ns = nqb - nramp;
        if (x < ns) { it.qb0 = it.qb1 = nqb - 1 - x; } else { it.qb0 = x - ns; it.qb1 = nramp - 1 - it.qb0; } }
    else { it.qb0 = it.qb1 = ((order & 3) == ORDER_REVERSED) ? nqb - 1 - x : x; }
    return it;
}
template <class TIn, class TOut>
__device__ __forceinline__ BlockRef<TIn, TOut> swa_ref(const SwaItem& it, int pass, const TIn* Q, const TIn* K, const TIn* V, TOut* O,
                                                    int nh, int nhkv, int sq, int skv, int qoff) {
    const int qb = pass ? it.qb1 : it.qb0, kvh = it.bh / (nh / nhkv);
    BlockRef<TIn, TOut> r;
    const int b_ = it.bh / nh, h_ = it.bh % nh; (void)kvh; (void)K; (void)V;
    const TIn* rowb = Q + (size_t)(b_ * nh + h_) * sq * LDQ;
    r.Q = rowb + (size_t)qb * QB * LDQ; r.K = rowb + SECSZ; r.V = rowb + 2 * SECSZ; r.G = r.Q + 3 * SECSZ;
    r.O = O + ((size_t)b_ * sq + (size_t)qb * QB) * LDO + h_ * D; r.P0 = qoff + qb * QB;
    return r;
}

constexpr int WT_OFF = STG_OFF + NW * QBLK * STG_ROW, ATT_LDS = WT_OFF + 64;
__device__ __forceinline__ void load_c(char* lds, const float* LS, int bh) {
    int tid = threadIdx.x; asm volatile("" : "+v"(tid));
    const int lane = tid & 63, wv = tid >> 6;
    const f32x4* src = (const f32x4*)(LS + (size_t)bh * SEQ) + 2 * tid;
    const f32x4 a = src[0], b = src[1];
    float v[8]; v[0] = a[0]; v[1] = v[0] + a[1]; v[2] = v[1] + a[2]; v[3] = v[2] + a[3]; v[4] = v[3] + b[0]; v[5] = v[4] + b[1]; v[6] = v[5] + b[2]; v[7] = v[6] + b[3];
    float inc = v[7];
#pragma unroll
    for (int o = 1; o < 64; o <<= 1) { const float t = __uint_as_float(__builtin_amdgcn_ds_bpermute(((lane - o) & 63) << 2, __float_as_uint(inc))); if (lane >= o) inc += t; }
    float* wt = (float*)(lds + WT_OFF);
    if (lane == 63) wt[wv] = inc;
    __syncthreads();
    float base = inc - v[7];
#pragma unroll
    for (int w = 0; w < 7; ++w) if (w < wv) base += wt[w];
    f32x4* dst = (f32x4*)(lds + C_OFF) + 2 * tid;
    dst[0] = (f32x4){base + v[0], base + v[1], base + v[2], base + v[3]}; dst[1] = (f32x4){base + v[4], base + v[5], base + v[6], base + v[7]};
}
__device__ __forceinline__ BlockRef<bf16, bf16> blk_ref(int id, const bf16* P, bf16* Y, int& bh) {
    constexpr int nqb = SQ / QB; bh = id % (B * H); const int qb = nqb - 1 - id / (B * H);
    SwaItem it; it.bh = bh; it.qb0 = it.qb1 = qb;
    return swa_ref<bf16, bf16>(it, 0, P, P, P, Y, H, HKV, SQ, SKV, QOFF);
}
__device__ __forceinline__ float skip_thr(const float* NRM, int bh) {
    const float* nq = NRM + (size_t)bh * 4; const float* nk = NRM + (size_t)(B * H + bh) * 4;
    const float q2 = (nq[0] + nq[1]) + (nq[2] + nq[3]), k2 = (nk[0] + nk[1]) + (nk[2] + nk[3]);
    return 118.0f + 2.04f * SCALE * sqrtf(q2 * k2);
}
__device__ __forceinline__ void attn_phase(char* lds, const bf16* P, const float* LS, const float* NRM, bf16* Y, unsigned* qctr, int blk, int nblk) {
    constexpr int total = B * H * (SQ / QB);
    volatile int* qslot = (volatile int*)(lds + WT_OFF + 32);
    (void)blk; (void)nblk;
    if (threadIdx.x == 0) { qslot[0] = (int)atomicAdd(qctr, 1u); qslot[1] = (int)atomicAdd(qctr, 1u); }
    __syncthreads();
    int id0 = __builtin_amdgcn_readfirstlane(qslot[0]), id1 = __builtin_amdgcn_readfirstlane(qslot[1]);
    if (id0 >= total) return;
    int bh0, bh1 = 0;
    BlockRef<bf16, bf16> cur = blk_ref(id0, P, Y, bh0);
    Seam<bf16> S;
    load_c(lds, LS, bh0);
    causal_swa_prime<bf16, bf16>(cur, SKV, WINDOW, lds, S);
    for (;;) {
        const bool last = id1 >= total;
        const BlockRef<bf16, bf16> nxt = last ? cur : blk_ref(id1, P, Y, bh1);
        int id2 = total;
        if (threadIdx.x == 0 && !last) id2 = (int)atomicAdd(qctr, 1u);
        const float thr = skip_thr(NRM, bh0);
        causal_swa_block<bf16, bf16>(cur, nxt, SKV, WINDOW, lds, S, thr);
        if (last) break;
        if (threadIdx.x == 0) qslot[0] = id2;
        load_c(lds, LS, bh1); __syncthreads();
        id1 = __builtin_amdgcn_readfirstlane(qslot[0]);
        cur = nxt; bh0 = bh1;
    }
}
}

__device__ __forceinline__ void flogit_phase(const bf16* __restrict__ HB, const bf16* __restrict__ WF, const float* __restrict__ b_f, float* __restrict__ LS, int blk, int nblk) {
    typedef short bf16x8_t __attribute__((ext_vector_type(8)));
    const int tid = threadIdx.x, wid = __builtin_amdgcn_readfirstlane(tid >> 6), lane = tid & 63, n = lane & 15, g = lane >> 4;
    for (int rb = blk; rb < M / 32; rb += nblk) {
        const int r0 = rb * 32 + (wid >> 2) * 16, h0 = (wid & 3) * 16;
        const bf16x8_t* ap = (const bf16x8_t*)(HB + (size_t)(r0 + n) * D + 8 * g);
        const bf16x8_t* bp = (const bf16x8_t*)(WF + (size_t)(h0 + n) * D + 8 * g);
        f32x4 acc = (f32x4){0.f, 0.f, 0.f, 0.f};
#pragma unroll 8
        for (int k = 0; k < D / 32; ++k) acc = __builtin_amdgcn_mfma_f32_16x16x32_bf16(ap[4 * k], bp[4 * k], acc, 0, 0, 0);
        const float bias = b_f[h0 + n];
        f32x4 o;
#pragma unroll
        for (int j = 0; j < 4; ++j) { const float z = acc[j] + bias; const float e = __builtin_amdgcn_exp2f(-1.4426950408889634f * fabsf(z));
            o[j] = fminf(z, 0.f) - 0.6931471805599453f * __builtin_amdgcn_logf(1.0f + e); }
        const int row = r0 + 4 * g, b = row / SEQ, s = row % SEQ;
        *(f32x4*)(LS + ((size_t)b * NH + h0 + n) * SEQ + s) = o;
    }
}

#define XB_TMO      128
#define XB_XCNT(j)  (256  + 64 * (j))
#define XB_XSUB(j)  (1280 + 64 * (j))
#define XB_XGEN(j)  (2304 + 64 * (j))
#define XB_TOP      3328
#define XB_TOPGEN   3392
#define XCD_BAR_WORDS 3456
#define XB_SPIN_CAP (1u << 18)

__device__ __forceinline__ unsigned xb_ld(unsigned* p)              { return __hip_atomic_load(p, __ATOMIC_RELAXED, __HIP_MEMORY_SCOPE_AGENT); }
__device__ __forceinline__ unsigned xb_add(unsigned* p, unsigned v) { return __hip_atomic_fetch_add(p, v, __ATOMIC_RELAXED, __HIP_MEMORY_SCOPE_AGENT); }
__device__ __forceinline__ unsigned xb_xcc_id() { return (unsigned)__builtin_amdgcn_s_getreg((3 << 11) | 20) & 0xFu; }
#define XB_SPIN(cond, bar) do { unsigned _sp = 0; while (cond) { __builtin_amdgcn_s_sleep(1); \
    if ((++_sp & 255u) == 0u) { if (xb_ld(&(bar)[XB_TMO])) break; if (_sp > XB_SPIN_CAP) { atomicAdd(&(bar)[XB_TMO], 1u); break; } } } } while (0)

struct XcdBarrier {
    unsigned* bar; unsigned x;
    volatile LAS unsigned* st;
};

__device__ __forceinline__ XcdBarrier xcd_barrier_post(unsigned* bar, volatile LAS unsigned* st) {
    XcdBarrier b; b.bar = bar; b.x = xb_xcc_id(); b.st = st;
    if (threadIdx.x == 0) (void)xb_add(&bar[XB_XCNT(b.x)], 1u);
    return b;
}
__device__ __forceinline__ void xcd_barrier_complete(unsigned* bar, unsigned x, unsigned& nloc, unsigned& nx) {
    const unsigned G = gridDim.x * gridDim.y * gridDim.z;
    unsigned sum, cnt, mine, sp = 0u;
    for (;;) {
        sum = 0u; cnt = 0u; mine = 0u;
#pragma unroll
        for (unsigned j = 0; j < 16; ++j) { const unsigned c = xb_ld(&bar[XB_XCNT(j)]); sum += c; cnt += (c > 0u) ? 1u : 0u; mine = (j == x) ? c : mine; }
        if (sum == G) break;
        __builtin_amdgcn_s_sleep(1);
        if ((++sp & 255u) == 0u) { if (xb_ld(&bar[XB_TMO])) break; if (sp > XB_SPIN_CAP) { atomicAdd(&bar[XB_TMO], 1u); break; } }
    }
    nloc = mine > 0u ? mine : 1u; nx = cnt > 0u ? cnt : 1u;
}

__device__ __forceinline__ void xcd_barrier(const XcdBarrier& b) {
    asm volatile("s_waitcnt vmcnt(0)" ::: "memory");
    __syncthreads();
    if (threadIdx.x == 0) {
        unsigned* bar = b.bar;
        __builtin_amdgcn_s_waitcnt(0);
        unsigned nloc = b.st[0], nx = b.st[1];
        if (nloc == 0u) { xcd_barrier_complete(bar, b.x, nloc, nx); b.st[0] = nloc; b.st[1] = nx; }
        const unsigned old = xb_add(&bar[XB_XSUB(b.x)], 1u);
        const unsigned gen = old / nloc;
        if (old + 1u == (gen + 1u) * nloc) {
            __builtin_amdgcn_fence(__ATOMIC_RELEASE, "agent");
            asm volatile("s_waitcnt vmcnt(0)" ::: "memory");
            const unsigned og = xb_add(&bar[XB_TOP], 1u);
            const unsigned tg = og / nx;
            if (og + 1u == (tg + 1u) * nx) xb_add(&bar[XB_TOPGEN], 1u);
            else XB_SPIN(xb_ld(&bar[XB_TOPGEN]) == tg, bar);
            __builtin_amdgcn_fence(__ATOMIC_ACQUIRE, "agent");
            xb_add(&bar[XB_XGEN(b.x)], 1u);
            asm volatile("s_waitcnt vmcnt(0)" ::: "memory");
        } else {
            XB_SPIN(xb_ld(&bar[XB_XGEN(b.x)]) == gen, bar);
            __builtin_amdgcn_fence(__ATOMIC_ACQUIRE, "agent");
            asm volatile("s_waitcnt vmcnt(0)" ::: "memory");
        }
    }
    __syncthreads();
}

constexpr int CW_BAR = 1024;
constexpr size_t CTL_ZERO_BYTES = 32768;
constexpr size_t QCTR_OFF = 28672;
constexpr size_t NRM_OFF = 24576;
constexpr int LDS_TOTAL = 163840;
constexpr int MISC_OFF = LDS_TOTAL - 64;
static_assert(fox::ATT_LDS <= MISC_OFF && scan::LDS_BYTES <= MISC_OFF && pg8::STAGE_BYTES <= MISC_OFF && 8 * 8448 <= MISC_OFF, "LDS map");
#ifndef MK_N_LAUNCHES
#define MK_N_LAUNCHES 1
#endif
constexpr int N_PHASES = 9;
struct Args { const float* in[10]; float* out; unsigned char* ws; int ph_lo, ph_hi; };
__global__ void __launch_bounds__(512, 2) mega_fwd(Args args) {
    extern __shared__ __attribute__((aligned(16))) unsigned char lds[];
    LAS unsigned char* L = (LAS unsigned char*)lds;
    volatile LAS unsigned* MISC = (volatile LAS unsigned*)(L + MISC_OFF);
    const int tid = threadIdx.x, lane = tid & 63, wave = __builtin_amdgcn_readfirstlane(tid >> 6);
    const int G = gridDim.x, bx = blockIdx.x;
    if (tid < 16) MISC[tid] = 0u;
    __syncthreads();
    unsigned char* ws = args.ws;
    XcdBarrier bar; bar.bar = (unsigned*)(ws + WS_CTL) + CW_BAR; bar.x = 0; bar.st = nullptr;
    if (MK_N_LAUNCHES != N_PHASES) bar = xcd_barrier_post((unsigned*)(ws + WS_CTL) + CW_BAR, MISC + 8);
    const float* x = args.in[0]; const float* norm_w = args.in[1]; const float* w_in_a = args.in[2]; const float* lb_logits = args.in[3]; const float* o_norm_a = args.in[4];
    const float* w_out_a = args.in[5]; const float* w_in_b = args.in[6]; const float* b_f = args.in[7]; const float* w_out_b = args.in[8]; const float* final_norm = args.in[9];
    float* out = args.out;
    bf16* WA = (bf16*)(ws + WS_WA); bf16* WB = (bf16*)(ws + WS_WB); bf16* WF = (bf16*)(ws + WS_WF); bf16* WOA = (bf16*)(ws + WS_WOA); bf16* WOB = (bf16*)(ws + WS_WOB);
    bf16* HB = (bf16*)(ws + WS_HB); float* X1 = (float*)(ws + WS_X1); bf16* P = (bf16*)(ws + WS_P); bf16* Y = (bf16*)(ws + WS_Y); float* LS = (float*)(ws + WS_LS);
    const int lo = args.ph_lo, hi = args.ph_hi;
#define IN(k) (lo <= (k) && (k) < hi)
#define SEAM(k) do { if (IN(k) && IN((k) + 1)) xcd_barrier(bar); } while (0)
#ifndef REPEAT_PHASE
#define REPEAT_PHASE (-1)
#endif
#define RUN(k, ...) do { if (IN(k)) { __VA_ARGS__ if (REPEAT_PHASE == (k)) { xcd_barrier(bar); __VA_ARGS__ } } } while (0)
#ifdef PROBE_NULL_GEMM1
#define PROBE_EXTRA() do { xcd_barrier(bar); pg8::Gemm g{HB, WA, M, LDP, D, 0}; pg8::StaticOrder S; S.init(M, LDP, G, bx); pg8::EpiNull E{0, 0}; pg8::gemm_phase<pg8::EpiNull, pg8::StaticOrder, true, true>(L, g, S, E); } while (0)
#else
#define PROBE_EXTRA() do { } while (0)
#endif

    RUN(0, { prologue_phase(L, 0, x, norm_w, w_in_a, w_out_a, w_in_b, w_out_b, ws, bx, G, wave, lane); } );
    SEAM(0);
    RUN(1, { pg8::Gemm g{HB, WA, M, LDP, D, 0}; pg8::StaticOrder S; S.init(M, LDP, G, bx); pg8::EpiAct<0> E{P, lb_logits, nullptr, LDP, 0};
        pg8::gemm_phase<pg8::EpiAct<0>, pg8::StaticOrder, true, true>(L, g, S, E); } );
    if (IN(1)) PROBE_EXTRA();
    SEAM(1);
    RUN(2, { if (G >= 2 * NB * NH) { if (bx < NB * NH) scan::scan_unit(L, P, o_norm_a, Y, bx); else prologue_phase(L, 1, x, norm_w, w_in_a, w_out_a, w_in_b, w_out_b, ws, bx - NB * NH, G - NB * NH, wave, lane); }
              else { for (int bh = bx; bh < NB * NH; bh += G) scan::scan_unit(L, P, o_norm_a, Y, bh); prologue_phase(L, 1, x, norm_w, w_in_a, w_out_a, w_in_b, w_out_b, ws, bx, G, wave, lane); } } );
    SEAM(2);
    RUN(3, { pg8::Gemm g{Y, WOA, M, D, DI, 0}; pg8::StaticOrder S; S.init(M, D, G, bx); pg8::EpiRes E{x, X1, D, 0};
        pg8::gemm_phase<pg8::EpiRes, pg8::StaticOrder, true, true>(L, g, S, E); } );
    SEAM(3);
    RUN(4, { const int gw = bx * 8 + wave, NGW = G * 8; for (int m = gw; m < M; m += NGW) rms_row_bf16(X1 + (size_t)m * D, norm_w + D, HB + (size_t)m * D, lane); } );
    SEAM(4);
    RUN(5, { flogit_phase(HB, WF, b_f, LS, bx, G);
        pg8::Gemm g{HB, WB, M, LDP, D, 0}; pg8::StaticOrder S; S.init(M, LDP, G, bx); pg8::EpiAct<1> E{P, nullptr, (unsigned*)(ws + WS_CTL + NRM_OFF), LDP, 0};
        pg8::gemm_phase<pg8::EpiAct<1>, pg8::StaticOrder, true, true>(L, g, S, E); } );
    SEAM(5);
    RUN(6, { fox::attn_phase((char*)lds, P, LS, (const float*)(ws + WS_CTL + NRM_OFF), Y, (unsigned*)(ws + WS_CTL + QCTR_OFF), bx, G); } );
    SEAM(6);
    RUN(7, { pg8::Gemm g{Y, WOB, M, D, DI, 0}; pg8::StaticOrder S; S.init(M, D, G, bx); pg8::EpiRes E{X1, out, D, 0};
        pg8::gemm_phase<pg8::EpiRes, pg8::StaticOrder, true, true>(L, g, S, E); } );
    SEAM(7);
    RUN(8, { const int gw = bx * 8 + wave, NGW = G * 8; for (int m = gw; m < M; m += NGW) rms_row_f32(out + (size_t)m * D, final_norm, out + (size_t)m * D, lane); } );
#undef IN
#undef SEAM
}

extern "C" void kernel_launch(void* const* d_in, const int* in_sizes, int n_in, void* d_out, int out_size, void* d_ws, size_t ws_size, hipStream_t stream) {
    static int grid = 0;
    if (grid == 0) {
        if (n_in != 10 || in_sizes[0] != M * D || out_size != M * D || ws_size < WS_END) { fprintf(stderr, "kernel_launch: unexpected shapes (n_in %d, in0 %d, out %d, ws %zu < %zu); nothing launched\n", n_in, n_in > 0 ? in_sizes[0] : -1, out_size, ws_size, (size_t)WS_END); grid = -1; return; }
        int dev = 0, cus = 0, per_cu = 0;
        if (hipGetDevice(&dev) != hipSuccess || hipDeviceGetAttribute(&cus, hipDeviceAttributeMultiprocessorCount, dev) != hipSuccess) { fprintf(stderr, "kernel_launch: device query failed\n"); grid = -1; return; }
        if (hipFuncSetAttribute((const void*)mega_fwd, hipFuncAttributeMaxDynamicSharedMemorySize, LDS_TOTAL) != hipSuccess) { fprintf(stderr, "kernel_launch: hipFuncSetAttribute(%d B LDS) failed\n", LDS_TOTAL); grid = -1; return; }
        if (hipOccupancyMaxActiveBlocksPerMultiprocessor(&per_cu, (const void*)mega_fwd, 512, LDS_TOTAL) != hipSuccess || per_cu < 1)
            fprintf(stderr, "kernel_launch: note: occupancy query reports %d workgroups per CU\n", per_cu);
        (void)hipGetLastError();
        grid = cus;
    }
    if (grid < 0) return;
    if (hipMemsetAsync((char*)d_ws + WS_CTL, 0, CTL_ZERO_BYTES, stream) != hipSuccess) { fprintf(stderr, "kernel_launch: hipMemsetAsync failed\n"); return; }
    Args a{};
    for (int i = 0; i < 10; ++i) a.in[i] = (const float*)d_in[i];
    a.out = (float*)d_out; a.ws = (unsigned char*)d_ws;
#if MK_N_LAUNCHES == 1
    a.ph_lo = 0; a.ph_hi = N_PHASES;
    hipLaunchKernelGGL(mega_fwd, dim3(grid), dim3(512), LDS_TOTAL, stream, a);
#else
    for (int p = 0; p < N_PHASES; ++p) { a.ph_lo = p; a.ph_hi = p + 1; hipLaunchKernelGGL(mega_fwd, dim3(grid), dim3(512), LDS_TOTAL, stream, a); }
#endif
    const hipError_t le = hipPeekAtLastError();
    if (le != hipSuccess) fprintf(stderr, "kernel_launch: launch failed: %s\n", hipGetErrorName(le));
}
```

```cpp
#include <hip/hip_runtime.h>
#include <cstdio>
#include <cstdint>

constexpr int NB = 2, SEQ = 4096, D = 4096, DI = 8192, NH = 64, HD = 128;
constexpr int M = NB * SEQ;
constexpr int LDP = 4 * DI;
constexpr int NWB = 4 * DI + NH;
constexpr float EPS = 1e-6f;
namespace pg8 {
#define PG8_LAS __attribute__((address_space(3)))
typedef unsigned short bf16_t;
typedef short bf16x8 __attribute__((ext_vector_type(8)));
typedef float f32x4 __attribute__((ext_vector_type(4)));
typedef unsigned u32x4 __attribute__((ext_vector_type(4)));
constexpr int BM = 256, BK = 64, HALF = 128, HTB = HALF * BK * 2  , STAGE_BYTES = 8 * HTB, NXCD = 8, WGM = 8;

__host__ __device__ __forceinline__ int lds_byte(int r, int c) { const int st = (r >> 4) * 2 + (c >> 5), rr = r & 15, cc = c & 31, ob = rr * 64 + cc * 2; return st * 1024 + (ob ^ (((ob >> 9) & 1) << 5)); }
__host__ __device__ __forceinline__ void stage_rc(int b, int& R, int& C) { const int st = b / 1024, sb = b % 1024, swz = sb ^ (((sb >> 9) & 1) << 5); R = (st >> 1) * 16 + swz / 64; C = (st & 1) * 32 + (swz % 64) / 2; }
__host__ __device__ __forceinline__ int perm32(int rho) { const int n = rho >> 4, i = rho & 15; return 8 * (i >> 2) + 4 * n + (i & 3); }

struct Unit { int pm, pn; };
struct Gemm { const bf16_t* A; const bf16_t* Bt; int M, N, K, pad; };

struct StaticOrder {
    int nM, nN, nwg, G, c;
    __host__ __device__ void init(int M, int N, int G_, int c_) { nM = M / BM; nN = N / BM; nwg = nM * nN; G = G_; c = c_; }
    __host__ __device__ bool next(int i, Unit& u) const {
        const long L = (long)i * G + c; if (L >= nwg) return false;
        int wgid = (int)L; { const int q = nwg / NXCD, r = nwg % NXCD, xcd = wgid % NXCD, off = wgid / NXCD; wgid = (xcd < r ? xcd * (q + 1) : r * (q + 1) + (xcd - r) * q) + off; }
        const int nig = WGM * nN, gid = wgid / nig, fm = gid * WGM, gsz = (nM - fm) < WGM ? (nM - fm) : WGM;
        u.pm = fm + ((wgid % nig) % gsz); u.pn = (wgid % nig) / gsz; return true;
    }
    __device__ __forceinline__ void a_ready(const Unit&) const {}
    __device__ __forceinline__ void done(const Unit&) const {}
};

typedef float f32x2_t __attribute__((ext_vector_type(2)));
typedef __bf16 bf16x2_t __attribute__((ext_vector_type(2)));
__device__ __forceinline__ unsigned cvt_pk_bf16(float lo, float hi) { f32x2_t v = {lo, hi}; bf16x2_t b = __builtin_convertvector(v, bf16x2_t); return __builtin_bit_cast(unsigned, b); }
__device__ __forceinline__ float silu_f(float x) { return x * __builtin_amdgcn_rcpf(1.0f + __builtin_amdgcn_exp2f(-1.4426950408889634f * x)); }

#define PG8_PSTORE(p, v) (*(p) = (v))
template <int LAYER> struct EpiAct {
    static constexpr bool PERM = true, AFTER_DRAIN = false;
    bf16_t* O; const float* lbl; unsigned* nrm; int ldc, pad;
    __device__ __forceinline__ void operator()(const f32x4 (&acc)[2][2][4][2], const Unit& u, int wr, int wc, int fr, int fq) const {
        const int sec = u.pn >> 5;
        const int row0 = u.pm * BM + wr * 64 + fr, col0 = u.pn * BM + wc * 32 + 8 * fq;
        const int mode = (LAYER == 0) ? ((sec == 0 || sec == 3) ? 1 : (sec == 1 ? 2 : 0)) : (sec == 3 ? 1 : 0);
        const int rb = row0 >> 12, rs = row0 & 4095, hh = (2 * u.pn) & 63;
        bf16_t* hm = O + ((size_t)((sec * 2 + rb) * 64 + hh) * 4096 + rs) * 128 + wc * 32 + 8 * fq;
        if (mode == 2) {
            float lb[2][8], om[2][8];
#pragma unroll
            for (int bj = 0; bj < 2; ++bj) { const int c = col0 + bj * HALF - 8192;
                const f32x4 a0 = *(const f32x4*)(lbl + c), a1 = *(const f32x4*)(lbl + c + 4), b0 = *(const f32x4*)(lbl + 8192 + c), b1 = *(const f32x4*)(lbl + 8192 + c + 4);
#pragma unroll
                for (int e = 0; e < 4; ++e) { const float x0 = __builtin_amdgcn_rcpf(1.0f + __builtin_amdgcn_exp2f(1.4426950408889634f * (b0[e] - a0[e]))), x1 = __builtin_amdgcn_rcpf(1.0f + __builtin_amdgcn_exp2f(1.4426950408889634f * (b1[e] - a1[e])));
                    lb[bj][e] = x0; om[bj][e] = 1.0f - x0; lb[bj][4 + e] = x1; om[bj][4 + e] = 1.0f - x1; } }
#pragma unroll
            for (int ai = 0; ai < 2; ++ai)
#pragma unroll
                for (int m = 0; m < 4; ++m) { bf16_t* rowp = hm + (size_t)(ai * HALF + m * 16) * 128;
#pragma unroll
                    for (int bj = 0; bj < 2; ++bj) { float v[8];
#pragma unroll
                        for (int e = 0; e < 8; ++e) { const float f = acc[ai][bj][m][e >> 2][e & 3];
                            const float sg = __builtin_amdgcn_rcpf(1.0f + __builtin_amdgcn_exp2f(-1.4426950408889634f * f));
                            v[e] = __builtin_amdgcn_logf(lb[bj][e] + om[bj][e] * sg); }
                        u32x4 w; w.x = cvt_pk_bf16(v[0], v[1]); w.y = cvt_pk_bf16(v[2], v[3]); w.z = cvt_pk_bf16(v[4], v[5]); w.w = cvt_pk_bf16(v[6], v[7]);
                        PG8_PSTORE((u32x4*)(rowp + (size_t)bj * (4096 * 128)), w); } }
        } else if (mode == 1) {
#pragma unroll
            for (int ai = 0; ai < 2; ++ai)
#pragma unroll
                for (int m = 0; m < 4; ++m) { bf16_t* rowp = hm + (size_t)(ai * HALF + m * 16) * 128;
#pragma unroll
                    for (int bj = 0; bj < 2; ++bj) { float v[8];
#pragma unroll
                        for (int e = 0; e < 8; ++e) v[e] = silu_f(acc[ai][bj][m][e >> 2][e & 3]);
                        u32x4 w; w.x = cvt_pk_bf16(v[0], v[1]); w.y = cvt_pk_bf16(v[2], v[3]); w.z = cvt_pk_bf16(v[4], v[5]); w.w = cvt_pk_bf16(v[6], v[7]);
                        PG8_PSTORE((u32x4*)(rowp + (size_t)bj * (4096 * 128)), w); } }
        } else {
            float nmax[2] = {0.f, 0.f};
#pragma unroll
            for (int ai = 0; ai < 2; ++ai)
#pragma unroll
                for (int m = 0; m < 4; ++m) { bf16_t* rowp = hm + (size_t)(ai * HALF + m * 16) * 128;
#pragma unroll
                    for (int bj = 0; bj < 2; ++bj) { const f32x4 v0 = acc[ai][bj][m][0], v1 = acc[ai][bj][m][1];
                        u32x4 w; w.x = cvt_pk_bf16(v0[0], v0[1]); w.y = cvt_pk_bf16(v0[2], v0[3]); w.z = cvt_pk_bf16(v1[0], v1[1]); w.w = cvt_pk_bf16(v1[2], v1[3]);
                        PG8_PSTORE((u32x4*)(rowp + (size_t)bj * (4096 * 128)), w);
                        if (LAYER == 1 && sec < 2) { float ss = (v0[0] * v0[0] + v0[1] * v0[1]) + (v0[2] * v0[2] + v0[3] * v0[3]) + (v1[0] * v1[0] + v1[1] * v1[1]) + (v1[2] * v1[2] + v1[3] * v1[3]);
                            ss += __shfl_xor(ss, 16); ss += __shfl_xor(ss, 32); nmax[bj] = fmaxf(nmax[bj], ss); } } }
            if (LAYER == 1 && sec < 2) {
#pragma unroll
                for (int bj = 0; bj < 2; ++bj) { float v = nmax[bj];
#pragma unroll
                    for (int o = 1; o < 16; o <<= 1) v = fmaxf(v, __shfl_xor(v, o));
                    if (fr == 0 && fq == 0) atomicMax(nrm + ((size_t)(sec * 128 + rb * 64 + hh + bj)) * 4 + wc, __float_as_uint(v)); }
            }
        }
    }
};
struct EpiRes {
    static constexpr bool PERM = false, AFTER_DRAIN = false;
    const float* base; float* out; int ldc, pad;
    __device__ __forceinline__ void operator()(const f32x4 (&acc)[2][2][4][2], const Unit& u, int wr, int wc, int fr, int fq) const {
        const int row0 = u.pm * BM + wr * 64 + fr, col0 = u.pn * BM + wc * 32 + 4 * fq;
#pragma unroll
        for (int ai = 0; ai < 2; ++ai)
#pragma unroll
            for (int m = 0; m < 4; ++m) { const size_t off = (size_t)(row0 + ai * HALF + m * 16) * ldc + col0;
#pragma unroll
                for (int bj = 0; bj < 2; ++bj)
#pragma unroll
                    for (int n = 0; n < 2; ++n) { const f32x4 bs = *(const f32x4*)(base + off + bj * HALF + n * 16); *(f32x4*)(out + off + bj * HALF + n * 16) = bs + acc[ai][bj][m][n]; }
                }
    }
};

template <class Epi, class Sched, bool ALIGN_EPI = false, bool SP2 = false>
__device__ __forceinline__ void gemm_phase(PG8_LAS unsigned char* lds, const Gemm g, const Sched& S, const Epi& E) {
    const int tid = threadIdx.x, wid = __builtin_amdgcn_readfirstlane(tid >> 6), lane = tid & 63, wr = wid >> 2, wc = wid & 3, fr = lane & 15, fq = lane >> 4;
    const int K = g.K, nt = K / BK;
    unsigned voffA[2], voffB[2];
#pragma unroll
    for (int i = 0; i < 2; ++i) { int R, C; stage_rc(tid * 16 + i * 8192, R, C); const int Rb = Epi::PERM ? ((R & ~31) + perm32(R & 31)) : R;
        voffA[i] = (unsigned)(R * K + C) * 2u; voffB[i] = (unsigned)(Rb * K + C) * 2u; }
    const size_t kstep = (size_t)(BK * 2);
    const size_t hstep = (size_t)HALF * K * 2;
    const size_t tstep = 2 * hstep;
    const unsigned ldsw = (unsigned)wid * 1024u;
    const int aoff = lds_byte(wr * 64 + fr, fq * 8), boff = lds_byte(wc * 32 + fr, fq * 8);
#define PG8_SA(b, h) (((b) * 2 + (h)) * HTB)
#define PG8_SB(b, h) ((4 + (b) * 2 + (h)) * HTB)
#define PG8_STAGE(bufoff, gbase, voff) do { _Pragma("unroll") for (int _i = 0; _i < 2; ++_i) \
        __builtin_amdgcn_global_load_lds((const unsigned*)((const char*)(gbase) + (voff)[_i]), (PG8_LAS unsigned*)(lds + (bufoff) + ldsw + _i * 8192), 16, 0, 0); } while (0)
#define PG8_LDA(dst, b, h) do { _Pragma("unroll") for (int m = 0; m < 4; ++m) _Pragma("unroll") for (int k = 0; k < 2; ++k) dst[m][k] = *(const PG8_LAS bf16x8*)(lds + PG8_SA(b, h) + aoff + m * 2048 + k * 1024); } while (0)
#define PG8_LDB(dst, b, h) do { _Pragma("unroll") for (int n = 0; n < 2; ++n) _Pragma("unroll") for (int k = 0; k < 2; ++k) dst[n][k] = *(const PG8_LAS bf16x8*)(lds + PG8_SB(b, h) + boff + n * 2048 + k * 1024); } while (0)
#define PG8_MMA(ai, bj, At, Bt) do { __builtin_amdgcn_s_setprio(1); _Pragma("unroll") for (int m = 0; m < 4; ++m) _Pragma("unroll") for (int n = 0; n < 2; ++n) _Pragma("unroll") for (int k = 0; k < 2; ++k) \
        acc[ai][bj][m][n] = __builtin_amdgcn_mfma_f32_16x16x32_bf16(Bt[n][k], At[m][k], acc[ai][bj][m][n], 0, 0, 0); __builtin_amdgcn_s_setprio(0); } while (0)
#define PG8_WAIT_V(n) asm volatile("s_waitcnt vmcnt(" #n ")" ::: "memory")
#define PG8_WAIT_L(n) asm volatile("s_waitcnt lgkmcnt(" #n ")" ::: "memory")
#define PG8_BAR __builtin_amdgcn_s_barrier()
#define PG8_SCHED __builtin_amdgcn_sched_barrier(0)
    Unit cur, nxt; int ui = 0;
    if (!S.next(0, cur)) return;
    f32x4 acc[2][2][4][2];
#pragma unroll
    for (int a = 0; a < 2; ++a)
#pragma unroll
        for (int b = 0; b < 2; ++b)
#pragma unroll
            for (int m = 0; m < 4; ++m)
#pragma unroll
                for (int n = 0; n < 2; ++n) acc[a][b][m][n] = (f32x4){0.f, 0.f, 0.f, 0.f};
    bf16x8 At[4][2], B0[2][2], B1[2][2];
    const char* cA = (const char*)g.A + (size_t)cur.pm * tstep; const char* cB = (const char*)g.Bt + (size_t)cur.pn * tstep;
    S.a_ready(cur);
    if constexpr (SP2) {
        PG8_STAGE(PG8_SB(0, 0), cB, voffB); PG8_STAGE(PG8_SB(0, 1), cB + hstep, voffB); PG8_STAGE(PG8_SA(0, 0), cA, voffA); PG8_STAGE(PG8_SA(0, 1), cA + hstep, voffA);
        if (wr == 1) PG8_BAR;
        PG8_WAIT_V(2); PG8_BAR;
        PG8_STAGE(PG8_SB(1, 0), cB + kstep, voffB); PG8_STAGE(PG8_SA(1, 0), cA + kstep, voffA); PG8_STAGE(PG8_SB(1, 1), cB + hstep + kstep, voffB);
        PG8_WAIT_V(6); PG8_BAR;
    } else {
        PG8_STAGE(PG8_SB(0, 0), cB, voffB); PG8_STAGE(PG8_SA(0, 0), cA, voffA); PG8_STAGE(PG8_SB(0, 1), cB + hstep, voffB); PG8_STAGE(PG8_SA(0, 1), cA + hstep, voffA);
        if (wr == 1) PG8_BAR;
        PG8_WAIT_V(4); PG8_BAR;
        PG8_STAGE(PG8_SB(1, 0), cB + kstep, voffB); PG8_STAGE(PG8_SA(1, 0), cA + kstep, voffA); PG8_STAGE(PG8_SB(1, 1), cB + hstep + kstep, voffB);
        PG8_WAIT_V(6); PG8_BAR;
    }
    for (;;) {
        const bool has_next = S.next(ui + 1, nxt);
        const char* nA = has_next ? (const char*)g.A + (size_t)nxt.pm * tstep : cA; const char* nB = has_next ? (const char*)g.Bt + (size_t)nxt.pn * tstep : cB;
        for (int t = 0; t < nt; t += 2) {
            const bool last = (t == nt - 2);
            const char* a1 = cA + (size_t)(t + 1) * kstep;
            const char* a2 = last ? nA : cA + (size_t)(t + 2) * kstep; const char* b2 = last ? nB : cB + (size_t)(t + 2) * kstep;
            const char* a3 = a2 + kstep; const char* b3 = b2 + kstep;
            if (last && has_next) S.a_ready(nxt);
            if constexpr (SP2) {
            PG8_LDB(B0, 0, 0); PG8_LDB(B1, 0, 1); PG8_SCHED; PG8_LDA(At, 0, 0); PG8_STAGE(PG8_SA(1, 1), a1 + hstep, voffA);
            PG8_WAIT_V(8); PG8_WAIT_L(0); PG8_BAR; PG8_MMA(0, 0, At, B0); PG8_MMA(0, 1, At, B1); PG8_BAR; PG8_SCHED;
            PG8_LDA(At, 0, 1); PG8_STAGE(PG8_SB(0, 0), b2, voffB); PG8_STAGE(PG8_SB(0, 1), b2 + hstep, voffB); PG8_STAGE(PG8_SA(0, 0), a2, voffA);
            PG8_WAIT_V(8); PG8_WAIT_L(0); PG8_BAR; PG8_MMA(1, 0, At, B0); PG8_MMA(1, 1, At, B1); PG8_BAR; PG8_SCHED;
            PG8_LDB(B0, 1, 0); PG8_LDB(B1, 1, 1); PG8_SCHED; PG8_LDA(At, 1, 0); PG8_STAGE(PG8_SA(0, 1), a2 + hstep, voffA);
            PG8_WAIT_V(8); PG8_WAIT_L(0); PG8_BAR; PG8_MMA(0, 0, At, B0); PG8_MMA(0, 1, At, B1); PG8_BAR; PG8_SCHED;
            PG8_LDA(At, 1, 1); PG8_STAGE(PG8_SB(1, 0), b3, voffB); PG8_STAGE(PG8_SB(1, 1), b3 + hstep, voffB); PG8_STAGE(PG8_SA(1, 0), a3, voffA);
            PG8_WAIT_V(8); PG8_WAIT_L(0); PG8_BAR; PG8_MMA(1, 0, At, B0); PG8_MMA(1, 1, At, B1); PG8_BAR; PG8_SCHED;
            } else {
            PG8_LDB(B0, 0, 0); PG8_SCHED; PG8_LDA(At, 0, 0); PG8_STAGE(PG8_SA(1, 1), a1 + hstep, voffA);
            PG8_WAIT_L(8); PG8_BAR; PG8_WAIT_L(0); PG8_MMA(0, 0, At, B0); PG8_BAR; PG8_SCHED;
            PG8_LDB(B1, 0, 1); PG8_STAGE(PG8_SB(0, 0), b2, voffB);
            PG8_BAR; PG8_WAIT_L(0); PG8_MMA(0, 1, At, B1); PG8_BAR;
            PG8_LDA(At, 0, 1); PG8_STAGE(PG8_SA(0, 0), a2, voffA);
            PG8_BAR; PG8_WAIT_L(0); PG8_MMA(1, 0, At, B0); PG8_BAR; PG8_SCHED;
            PG8_STAGE(PG8_SB(0, 1), b2 + hstep, voffB);
            PG8_WAIT_V(6); PG8_BAR; PG8_MMA(1, 1, At, B1); PG8_BAR;
            PG8_LDB(B0, 1, 0); PG8_SCHED; PG8_LDA(At, 1, 0); PG8_STAGE(PG8_SA(0, 1), a2 + hstep, voffA);
            PG8_WAIT_L(8); PG8_BAR; PG8_WAIT_L(0); PG8_MMA(0, 0, At, B0); PG8_BAR; PG8_SCHED;
            PG8_LDB(B1, 1, 1); PG8_STAGE(PG8_SB(1, 0), b3, voffB);
            PG8_BAR; PG8_WAIT_L(0); PG8_MMA(0, 1, At, B1); PG8_BAR;
            PG8_LDA(At, 1, 1); PG8_STAGE(PG8_SA(1, 0), a3, voffA);
            PG8_BAR; PG8_WAIT_L(0); PG8_MMA(1, 0, At, B0); PG8_BAR; PG8_SCHED;
            PG8_STAGE(PG8_SB(1, 1), b3 + hstep, voffB);
            PG8_WAIT_V(6); PG8_BAR; PG8_MMA(1, 1, At, B1); PG8_BAR;
            }
        }
        if constexpr (ALIGN_EPI) { if (wr == 0) PG8_BAR; }
        if constexpr (!Epi::AFTER_DRAIN) { E(acc, cur, wr, wc, fr, fq); S.done(cur); }
        if (!has_next) break;
#pragma unroll
        for (int a = 0; a < 2; ++a)
#pragma unroll
            for (int b = 0; b < 2; ++b)
#pragma unroll
                for (int m = 0; m < 4; ++m)
#pragma unroll
                    for (int n = 0; n < 2; ++n) acc[a][b][m][n] = (f32x4){0.f, 0.f, 0.f, 0.f};
        cur = nxt; cA = nA; cB = nB; ++ui;
        if constexpr (ALIGN_EPI) { if (wr == 1) PG8_BAR; }
    }
    PG8_WAIT_V(0);
    if constexpr (!ALIGN_EPI) { if (wr == 0) PG8_BAR; }
    PG8_BAR;
    if constexpr (Epi::AFTER_DRAIN) { E.fused(acc, cur, wr, wc, fr, fq, lds, wid, lane); S.done(cur); }
#undef PG8_SA
#undef PG8_SB
#undef PG8_STAGE
#undef PG8_LDA
#undef PG8_LDB
#undef PG8_MMA
#undef PG8_WAIT_V
#undef PG8_WAIT_L
#undef PG8_BAR
#undef PG8_SCHED
}
}

#define LAS __attribute__((address_space(3)))
typedef unsigned short bf16;
typedef unsigned v4u __attribute__((ext_vector_type(4)));
typedef unsigned v2u __attribute__((ext_vector_type(2)));
typedef float f32x4 __attribute__((ext_vector_type(4)));
__device__ __forceinline__ unsigned pk2(float lo, float hi) { return pg8::cvt_pk_bf16(lo, hi); }
__device__ __forceinline__ float bf2f(unsigned short b) { return __uint_as_float(((unsigned)b) << 16); }
__device__ __forceinline__ float bflo(unsigned w) { return __uint_as_float(w << 16); }
__device__ __forceinline__ float bfhi(unsigned w) { return __uint_as_float(w & 0xffff0000u); }
__device__ __forceinline__ float wave_sum(float v) {
#pragma unroll
    for (int o = 1; o < 64; o <<= 1) v += __shfl_xor(v, o);
    return v;
}
__device__ __forceinline__ float wave_max(float v) {
#pragma unroll
    for (int o = 1; o < 64; o <<= 1) v = fmaxf(v, __shfl_xor(v, o));
    return v;
}

__device__ __forceinline__ void transpose_tile(const float* W, size_t ldw, int K, int k0, int n0, bf16* WT, int nbase, LAS unsigned* scr, int lane) {
    const int g = lane & 15, ks = lane >> 4;
#pragma unroll
    for (int i = 0; i < 8; ++i) {
        const int k = k0 + 8 * i + 2 * ks;
        const f32x4 a = *(const f32x4*)(W + (size_t)k * ldw + n0 + 4 * g), b = *(const f32x4*)(W + (size_t)(k + 1) * ldw + n0 + 4 * g);
#pragma unroll
        for (int j = 0; j < 4; ++j) scr[(4 * g + j) * 33 + 4 * i + ks] = pk2(a[j], b[j]);
    }
    asm volatile("s_waitcnt lgkmcnt(0)" ::: "memory");
    const int c = lane & 7;
#pragma unroll
    for (int r = 0; r < 8; ++r) { const int n = 8 * r + (lane >> 3);
        v4u o; o.x = scr[n * 33 + 4 * c]; o.y = scr[n * 33 + 4 * c + 1]; o.z = scr[n * 33 + 4 * c + 2]; o.w = scr[n * 33 + 4 * c + 3];
        *(v4u*)(WT + (size_t)(n0 - nbase + n) * K + k0 + 8 * c) = o; }
    asm volatile("s_waitcnt lgkmcnt(0)" ::: "memory");
}
__device__ __forceinline__ void rms_row_bf16(const float* xrow, const float* w, bf16* orow, int lane) {
    const f32x4* xr = (const f32x4*)xrow + lane; const f32x4* wr = (const f32x4*)w + lane;
    f32x4 v[16]; float s = 0.f;
#pragma unroll
    for (int j = 0; j < 16; ++j) { v[j] = xr[64 * j]; s += (v[j].x * v[j].x + v[j].y * v[j].y) + (v[j].z * v[j].z + v[j].w * v[j].w); }
    const float rs = 1.0f / sqrtf(wave_sum(s) * (1.0f / D) + EPS);
    v2u* o8 = (v2u*)orow + lane;
#pragma unroll
    for (int j = 0; j < 16; ++j) { const f32x4 g = wr[64 * j]; v2u o; o.x = pk2(v[j].x * rs * g.x, v[j].y * rs * g.y); o.y = pk2(v[j].z * rs * g.z, v[j].w * rs * g.w); o8[64 * j] = o; }
}
__device__ __forceinline__ void rms_row_f32(const float* xrow, const float* w, float* orow, int lane) {
    const f32x4* xr = (const f32x4*)xrow + lane; const f32x4* wr = (const f32x4*)w + lane;
    f32x4 v[16]; float s = 0.f;
#pragma unroll
    for (int j = 0; j < 16; ++j) { v[j] = xr[64 * j]; s += (v[j].x * v[j].x + v[j].y * v[j].y) + (v[j].z * v[j].z + v[j].w * v[j].w); }
    const float rs = 1.0f / sqrtf(wave_sum(s) * (1.0f / D) + EPS);
    f32x4* o = (f32x4*)orow + lane;
#pragma unroll
    for (int j = 0; j < 16; ++j) { const f32x4 g = wr[64 * j]; o[64 * j] = (f32x4){v[j].x * rs * g.x, v[j].y * rs * g.y, v[j].z * rs * g.z, v[j].w * rs * g.w}; }
}

constexpr size_t MiB = 1u << 20;
constexpr size_t WS_CTL = 0;
constexpr size_t WS_WA  = 1 * MiB;
constexpr size_t WS_WB  = WS_WA + 256 * MiB;
constexpr size_t WS_WF  = WS_WB + 256 * MiB;
constexpr size_t WS_WOA = WS_WF + 1 * MiB;
constexpr size_t WS_WOB = WS_WOA + 64 * MiB;
constexpr size_t WS_HB  = WS_WOB + 64 * MiB;
constexpr size_t WS_X1  = WS_HB + 64 * MiB;
constexpr size_t WS_P   = WS_X1 + 128 * MiB;
constexpr size_t WS_Y   = WS_P + 512 * MiB;
constexpr size_t WS_LS  = WS_Y + 128 * MiB;
constexpr size_t WS_END = WS_LS + 2 * MiB;

#ifndef CONV_P0_PCT
#define CONV_P0_PCT 0
#endif
__device__ __forceinline__ void prologue_phase(LAS unsigned char* lds, int part, const float* x, const float* norm_w, const float* w_in_a, const float* w_out_a, const float* w_in_b, const float* w_out_b,
                                               unsigned char* ws, int vcu, int G, int wave, int lane) {
    LAS unsigned* scr = (LAS unsigned*)(lds + wave * 8448);
    const int gw = vcu * 8 + wave, NGW = G * 8;
    bf16* WA = (bf16*)(ws + WS_WA); bf16* WB = (bf16*)(ws + WS_WB); bf16* WF = (bf16*)(ws + WS_WF); bf16* WOA = (bf16*)(ws + WS_WOA); bf16* WOB = (bf16*)(ws + WS_WOB);
    constexpr int T_IN = (D / 64) * (LDP / 64);
    constexpr int T_F = (D / 64) * 1;
    constexpr int T_OUT = (DI / 64) * (D / 64);
    constexpr int T_DEF = T_OUT + T_IN + T_F + T_OUT, SPLIT = (int)((long)T_DEF * CONV_P0_PCT / 100);
    if (part == 0) {
        for (int it = gw; it < T_IN; it += NGW) { const int kb = it / (LDP / 64), nb = it % (LDP / 64); transpose_tile(w_in_a, LDP, D, kb * 64, nb * 64, WA, 0, scr, lane); }
        bf16* HB = (bf16*)(ws + WS_HB);
        for (int m = gw; m < M; m += NGW) rms_row_bf16(x + (size_t)m * D, norm_w, HB + (size_t)m * D, lane);
    }
    {
        const int i0 = (part == 0) ? 0 : SPLIT, i1 = (part == 0) ? SPLIT : T_DEF;
        for (int it = i0 + gw; it < i1; it += NGW) {
            int r = it;
            if (r < T_OUT) { const int kb = r / (D / 64), nb = r % (D / 64); transpose_tile(w_out_a, D, DI, kb * 64, nb * 64, WOA, 0, scr, lane); continue; } r -= T_OUT;
            if (r < T_OUT) { const int kb = r / (D / 64), nb = r % (D / 64); transpose_tile(w_out_b, D, DI, kb * 64, nb * 64, WOB, 0, scr, lane); continue; } r -= T_OUT;
            if (r < T_F) { transpose_tile(w_in_b, NWB, D, r * 64, LDP, WF, LDP, scr, lane); continue; } r -= T_F;
            { const int kb = r / (LDP / 64), nb = r % (LDP / 64); transpose_tile(w_in_b, NWB, D, kb * 64, nb * 64, WB, 0, scr, lane); }
        }
    }
}

namespace scan {
typedef short s16x4 __attribute__((ext_vector_type(4)));
typedef short bf16x8 __attribute__((ext_vector_type(8)));
typedef float f32x4 __attribute__((ext_vector_type(4)));
typedef unsigned u32x2 __attribute__((ext_vector_type(2)));
#ifndef SCAN_STAGGER
#define SCAN_STAGGER 1
#endif
constexpr int R = 8, NSTEP = SEQ / 16;
constexpr int RAW = 0, PRD = R * 16384, PRD_SZ = 3 * 4096 + 512, QDT = 0, KIT = 4096, KE = 8192, DEC = 12288, SSQ = PRD + 2 * PRD_SZ, LDS_BYTES = SSQ + 1024;
__device__ __forceinline__ s16x4 trd(LAS const unsigned char* p) { return __builtin_bit_cast(s16x4, __builtin_amdgcn_ds_read_tr16_b64_v4i16((LAS s16x4*)p)); }
__device__ __forceinline__ s16x4 pk4(float a, float b, float c, float d) { u32x2 w; w.x = pk2(a, b); w.y = pk2(c, d); return __builtin_bit_cast(s16x4, w); }
__device__ __forceinline__ bf16x8 cat8(s16x4 a, s16x4 b) { return __builtin_shufflevector(a, b, 0, 1, 2, 3, 4, 5, 6, 7); }
#define SC_BAR() do { asm volatile("" ::: "memory"); __builtin_amdgcn_s_barrier(); asm volatile("" ::: "memory"); } while (0)

__device__ __forceinline__ void scan_unit(LAS unsigned char* lds, const bf16* __restrict__ P, const float* __restrict__ onw, bf16* __restrict__ Y, int bh) {
    const int tid = threadIdx.x, wid = __builtin_amdgcn_readfirstlane(tid >> 6), lane = tid & 63, n = lane & 15, g = lane >> 4, tq = n >> 2, tp = n & 3;
    const int b = bh / NH, h = bh % NH;
    const bf16* base = P + (size_t)(b * NH + h) * SEQ * HD;
    size_t goff[2]; int ldst[2];
#pragma unroll
    for (int ii = 0; ii < 2; ++ii) { const int i = 2 * wid + ii, ti = i >> 2, rg = i & 3, row = 4 * rg + (lane >> 4), pc = lane & 15, c = pc ^ ((row & 7) << 1);
        const int sec = (ti == 0) ? 1 : ((ti == 1) ? 0 : ti);
        goff[ii] = (size_t)row * HD + (size_t)sec * ((size_t)NB * NH * SEQ * HD) + c * 8; ldst[ii] = ti * 4096 + rg * 1024; }
#define SC_DMA(step) do { const int st_ = (step) < NSTEP ? (step) : NSTEP - 1; const int sl_ = ((step) & (R - 1)) * 16384; _Pragma("unroll") for (int ii = 0; ii < 2; ++ii) \
        __builtin_amdgcn_global_load_lds((const unsigned*)(base + (size_t)st_ * 16 * HD + goff[ii]), (LAS unsigned*)(lds + RAW + sl_ + ldst[ii]), 16, 0, 0); } while (0)
    const int rrow = 4 * g + tq;
    const int rtr = rrow * 256 + ((2 * wid + (tp >> 1)) ^ ((rrow & 7) << 1)) * 16 + 8 * (tp & 1);
    const int rsg = n * 256 + ((2 * wid + (g >> 1)) ^ ((n & 7) << 1)) * 16 + 8 * (g & 1);
    const int wq = (16 * wid + n) * 32 + g * 8;
    const int wk = (g >> 1) * 2048 + (16 * wid + n) * 16 + (g & 1) * 8;
    const int rqt = (4 * g + tq) * 32 + 8 * tp;
    const int rke = (g >> 1) * 2048 + n * 16 + (g & 1) * 8;
    const int rdec = (4 * g) * 4;
    s16x4 ltri; { short one = (short)0x3F80; ltri[0] = (4 * g + 0 <= n) ? one : (short)0; ltri[1] = (4 * g + 1 <= n) ? one : (short)0; ltri[2] = (4 * g + 2 <= n) ? one : (short)0; ltri[3] = (4 * g + 3 <= n) ? one : (short)0; }
    f32x4 gain = *(const f32x4*)(onw + h * HD + 16 * wid + 4 * g);
    asm volatile("" : "+v"(gain[0]), "+v"(gain[1]), "+v"(gain[2]), "+v"(gain[3]));
    f32x4 S[8];
#pragma unroll
    for (int t = 0; t < 8; ++t) S[t] = (f32x4){0.f, 0.f, 0.f, 0.f};
    f32x4 oprev = (f32x4){0.f, 0.f, 0.f, 0.f};
#define SC_PREP(s_) do { const LAS unsigned char* raw_ = lds + RAW + ((s_) & (R - 1)) * 16384; LAS unsigned char* img_ = lds + PRD + ((s_) & 1) * PRD_SZ; \
        const s16x4 lfB = trd(raw_ + rtr), qsB = trd(raw_ + 4096 + rtr); \
        const f32x4 G = __builtin_amdgcn_mfma_f32_16x16x16bf16_1k(ltri, lfB, (f32x4){0.f, 0.f, 0.f, 0.f}, 0, 0, 0); \
        const float dec_ = __builtin_amdgcn_exp2f(__shfl(G[3], 48 + n)); \
        float qd[4], ki[4], ke[4]; \
        _Pragma("unroll") for (int j = 0; j < 4; ++j) { const float lf = bf2f((unsigned short)lfB[j]), qs = bf2f((unsigned short)qsB[j]); \
            const float E = __builtin_amdgcn_exp2f(G[j]), Ei = __builtin_amdgcn_exp2f(-G[j]); \
            const float kk = 1.0f - __builtin_amdgcn_exp2f(lf); \
            qd[j] = qs * E; ki[j] = kk * Ei; ke[j] = ki[j] * dec_; } \
        *(LAS s16x4*)(img_ + QDT + wq) = pk4(qd[0], qd[1], qd[2], qd[3]); \
        *(LAS s16x4*)(img_ + KIT + wq) = pk4(ki[0], ki[1], ki[2], ki[3]); \
        *(LAS s16x4*)(img_ + KE + wk) = pk4(ke[0], ke[1], ke[2], ke[3]); \
        if (g == 0) *(LAS float*)(img_ + DEC + (16 * wid + n) * 4) = dec_; } while (0)
#define SC_OUT(s_) do { const LAS unsigned char* rawp = lds + RAW + ((s_) & (R - 1)) * 16384; const LAS unsigned char* sq = lds + SSQ + ((s_) & 1) * 512 + n * 32; \
        const f32x4 a = *(const LAS f32x4*)sq, c = *(const LAS f32x4*)(sq + 16); \
        const float tot = ((a[0] + a[1]) + (a[2] + a[3])) + ((c[0] + c[1]) + (c[2] + c[3])); \
        const float rs = __builtin_amdgcn_rsqf(tot * (1.0f / HD) + EPS); \
        const s16x4 sgv = *(const LAS s16x4*)(rawp + 3 * 4096 + rsg); \
        const float y0 = oprev[0] * rs * gain[0] * bf2f((unsigned short)sgv[0]), y1 = oprev[1] * rs * gain[1] * bf2f((unsigned short)sgv[1]); \
        const float y2 = oprev[2] * rs * gain[2] * bf2f((unsigned short)sgv[2]), y3 = oprev[3] * rs * gain[3] * bf2f((unsigned short)sgv[3]); \
        u32x2 w; w.x = pk2(y0, y1); w.y = pk2(y2, y3); \
        *(u32x2*)(Y + (size_t)(b * SEQ + 16 * (s_) + n) * DI + h * HD + 16 * wid + 4 * g) = w; } while (0)
    SC_DMA(0); SC_DMA(1); SC_DMA(2); SC_DMA(3); SC_DMA(4); SC_DMA(5);
    asm volatile("s_waitcnt vmcnt(10)" ::: "memory");
    SC_BAR();
    SC_PREP(0);
    for (int st = 0; st < NSTEP; ++st) {
        if (st < 6) asm volatile("s_waitcnt vmcnt(8) lgkmcnt(0)" ::: "memory"); else asm volatile("s_waitcnt vmcnt(12) lgkmcnt(0)" ::: "memory");
        SC_BAR();
        SC_DMA(st + 6);
        if (SCAN_STAGGER && wid >= 4 && st + 1 < NSTEP) SC_PREP(st + 1);
        if (st > 0) SC_OUT(st - 1);
        {
            const LAS unsigned char* raw = lds + RAW + (st & (R - 1)) * 16384; const LAS unsigned char* img = lds + PRD + (st & 1) * PRD_SZ;
            s16x4 qf[8], kf[8];
#pragma unroll
            for (int t = 0; t < 8; ++t) { qf[t] = trd(img + QDT + rqt + 512 * t); kf[t] = trd(img + KIT + rqt + 512 * t); }
            const s16x4 vf = trd(raw + 2 * 4096 + rtr);
            f32x4 sc = (f32x4){0.f, 0.f, 0.f, 0.f};
#pragma unroll
            for (int u = 0; u < 4; ++u) sc = __builtin_amdgcn_mfma_f32_16x16x32_bf16(cat8(kf[2 * u], kf[2 * u + 1]), cat8(qf[2 * u], qf[2 * u + 1]), sc, 0, 0, 0);
#pragma unroll
            for (int j = 0; j < 4; ++j) sc[j] = (4 * g + j <= n) ? sc[j] : 0.f;
            f32x4 o = (f32x4){0.f, 0.f, 0.f, 0.f};
#pragma unroll
            for (int u = 0; u < 4; ++u) { const s16x4 s0 = pk4(S[2 * u][0], S[2 * u][1], S[2 * u][2], S[2 * u][3]), s1 = pk4(S[2 * u + 1][0], S[2 * u + 1][1], S[2 * u + 1][2], S[2 * u + 1][3]);
                o = __builtin_amdgcn_mfma_f32_16x16x32_bf16(cat8(s0, s1), cat8(qf[2 * u], qf[2 * u + 1]), o, 0, 0, 0); }
            o = __builtin_amdgcn_mfma_f32_16x16x16bf16_1k(vf, pk4(sc[0], sc[1], sc[2], sc[3]), o, 0, 0, 0);
#pragma unroll
            for (int t = 0; t < 8; ++t) { const s16x4 kef = *(const LAS s16x4*)(img + KE + rke + 256 * t); const f32x4 dv = *(const LAS f32x4*)(img + DEC + rdec + 64 * t);
                S[t] = __builtin_amdgcn_mfma_f32_16x16x16bf16_1k(kef, vf, S[t] * dv, 0, 0, 0); }
            float ss = (o[0] * o[0] + o[1] * o[1]) + (o[2] * o[2] + o[3] * o[3]);
            ss += __shfl_xor(ss, 16); ss += __shfl_xor(ss, 32);
            if (g == 0) *(LAS float*)(lds + SSQ + (st & 1) * 512 + (n * 8 + wid) * 4) = ss;
            oprev = o;
        }
        if ((!SCAN_STAGGER || wid < 4) && st + 1 < NSTEP) SC_PREP(st + 1);
    }
    asm volatile("s_waitcnt lgkmcnt(0)" ::: "memory");
    SC_BAR();
    SC_OUT(NSTEP - 1);
    asm volatile("s_waitcnt vmcnt(0) lgkmcnt(0)" ::: "memory");
    SC_BAR();
#undef SC_DMA
#undef SC_PREP
#undef SC_OUT
}
#undef SC_BAR
}

namespace fox {
enum { ORDER_NATURAL = 0, ORDER_REVERSED = 1, ORDER_PAIRED = 2, ORDER_XCD = 4 };
constexpr int B = NB, H = NH, HKV = NH, SQ = SEQ, SKV = SEQ, D = HD, QOFF = 0, WINDOW = SEQ;
constexpr int LDQ = HD, LDO = DI;
constexpr size_t SECSZ = (size_t)NB * NH * SEQ * HD;
constexpr float THR = 8.f;
constexpr int ORDER = ORDER_PAIRED | ORDER_XCD;
constexpr bool WSKIP = false;
constexpr float ISCALE = 11.313708498984761f;
constexpr int STG_ROW = 272;
constexpr float SCALE = 0.08838834764831845f;
constexpr int NW = 8, QBLK = 32, KVBLK = 64, QB = NW * QBLK;
constexpr int SHM_V = KVBLK * D * 2, SHM_K = KVBLK * D * 2;
constexpr int LDS_BYTES = 2 * SHM_V + 2 * SHM_K + NW * 64 * 4;
constexpr int C_OFF = LDS_BYTES, STG_OFF = C_OFF + SEQ * 4;
static_assert(D == 128 && SQ % QB == 0 && SKV % KVBLK == 0 && H % HKV == 0 && QOFF >= 0 && QOFF + SQ <= SKV && WINDOW >= 1, "geometry");

using bf16 = unsigned short;
typedef short bf16x8 __attribute__((ext_vector_type(8)));
typedef short s16x4 __attribute__((ext_vector_type(4)));
typedef float f32x16 __attribute__((ext_vector_type(16)));
typedef float f32x4 __attribute__((ext_vector_type(4)));
typedef unsigned u32x4 __attribute__((ext_vector_type(4)));
template <class A, class Bt> struct same_t { static constexpr bool v = false; };
template <class A> struct same_t<A, A> { static constexpr bool v = true; };

#define KSWZ(row, colB) ((row) * 256 + ((colB) ^ (((row) & 7) << 4)))
#define SBAR() __builtin_amdgcn_sched_barrier(0)
__device__ __forceinline__ int v_st(int k, int c) { const int kk = (k & ~0xC) | ((k & 4) << 1) | ((k & 8) >> 1); return ((kk >> 3) * 4 + (c >> 5)) * 512 + ((kk & 7) * 32 + (c & 31)) * 2; }
__device__ __forceinline__ int v_rd_base(int lane) { return ((lane & 3) << 3) | (((lane >> 2) & 3) << 6) | (((lane >> 4) & 1) << 5) | (((lane >> 5) & 1) << 8); }
constexpr int v_rd_off(int d0, int ks, int half) { return d0 * 512 + ks * 4096 + half * 2048; }
__device__ __forceinline__ int crow(int r, int hi) { return (r & 3) + 8 * (r >> 2) + 4 * hi; }
__device__ __forceinline__ unsigned cvtpk(float lo, float hi) {
    unsigned r; asm volatile("v_cvt_pk_bf16_f32 %0, %1, %2" : "=v"(r) : "v"(lo), "v"(hi)); return r;
}
__device__ __forceinline__ bf16x8 pack8(f32x4 a, f32x4 b) {
    u32x4 w = {cvtpk(a[0], a[1]), cvtpk(a[2], a[3]), cvtpk(b[0], b[1]), cvtpk(b[2], b[3])};
    return *reinterpret_cast<bf16x8*>(&w);
}
template <class T> __device__ __forceinline__ bf16x8 load8(const T* p) {
    if constexpr (same_t<T, float>::v) { return pack8(*(const f32x4*)p, *(const f32x4*)(p + 4)); }
    else { return *reinterpret_cast<const bf16x8*>(p); }
}
__device__ __forceinline__ void mask_tile(f32x16& p0, f32x16& p1, int dq, unsigned W) {
    const float NEG = -__builtin_inff();
#pragma unroll
    for (int r = 0; r < 16; ++r) {
        const int c = (r & 3) + 8 * (r >> 2);
        if ((unsigned)(dq - c) >= W) p0[r] = NEG;
        if ((unsigned)(dq - c - 32) >= W) p1[r] = NEG;
    }
}
__device__ __forceinline__ void partialSM(f32x16& p0, f32x16& p1, float& m_reg, float& mn, float& alpha) {
    float pmax = p0[0]; for (int r = 1; r < 16; ++r) pmax = fmaxf(pmax, p0[r]); for (int r = 0; r < 16; ++r) pmax = fmaxf(pmax, p1[r]);
    { auto rr = __builtin_amdgcn_permlane32_swap(__float_as_uint(pmax), __float_as_uint(pmax), false, false);
      pmax = fmaxf(__uint_as_float(rr[0]), __uint_as_float(rr[1])); }
    constexpr float C2 = 1.4426950408889634f * SCALE;
    if (__builtin_expect(__all((pmax - m_reg) * SCALE <= THR), 1)) { mn = m_reg; alpha = 1.f; }
    else { mn = fmaxf(m_reg, pmax); alpha = __builtin_amdgcn_exp2f((m_reg - mn) * C2); m_reg = mn; }
    const float mnL = -mn * C2;
    for (int r = 0; r < 16; ++r) p0[r] = fmaf(p0[r], C2, mnL); for (int r = 0; r < 16; ++r) p1[r] = fmaf(p1[r], C2, mnL);
    for (int r = 0; r < 16; ++r) p0[r] = __builtin_amdgcn_exp2f(p0[r]);
}
__device__ __forceinline__ void finishSM(f32x16& p0, f32x16& p1, float alpha, float& l_reg, bf16x8& pa0, bf16x8& pa1, bf16x8& pa2, bf16x8& pa3) {
    for (int r = 0; r < 16; ++r) p1[r] = __builtin_amdgcn_exp2f(p1[r]);
    float ps = 0; for (int r = 0; r < 16; ++r) ps += p0[r]; for (int r = 0; r < 16; ++r) ps += p1[r];
    { auto rr = __builtin_amdgcn_permlane32_swap(__float_as_uint(ps), __float_as_uint(ps), false, false);
      ps = __uint_as_float(rr[0]) + __uint_as_float(rr[1]); }
    l_reg = l_reg * alpha + ps;
#define PK4(P, B_, OUT) do { unsigned a0 = cvtpk(P[B_+0], P[B_+1]), a1 = cvtpk(P[B_+2], P[B_+3]);                          \
        unsigned b0 = cvtpk(P[B_+4], P[B_+5]), b1 = cvtpk(P[B_+6], P[B_+7]);                                             \
        auto r0 = __builtin_amdgcn_permlane32_swap(a0, b0, false, false); auto r1 = __builtin_amdgcn_permlane32_swap(a1, b1, false, false); \
        u32x4 w = {r0[0], r1[0], r0[1], r1[1]}; OUT = *reinterpret_cast<bf16x8*>(&w); } while (0)
    PK4(p0, 0, pa0); PK4(p0, 8, pa1); PK4(p1, 0, pa2); PK4(p1, 8, pa3);
#undef PK4
}
__device__ __forceinline__ void bias_tile(f32x16& p0, f32x16& p1, const float* cl, int kb, int hi) {
    const f32x4* cp = (const f32x4*)(cl + kb + 4 * hi);
#pragma unroll
    for (int j = 0; j < 4; ++j) { const f32x4 c0 = cp[2 * j], c1 = cp[8 + 2 * j];
#pragma unroll
        for (int e = 0; e < 4; ++e) { p0[4 * j + e] = fmaf(c0[e], -ISCALE, p0[4 * j + e]); p1[4 * j + e] = fmaf(c1[e], -ISCALE, p1[4 * j + e]); } }
}
template <int KB, bool SK>
__device__ __forceinline__ void qkt(f32x16& p0, f32x16& p1, const char* K_lds, int r32, int hi, const bf16x8* qr, bool act) {
    if (SK && !act) { const float NEG = -__builtin_inff();
#pragma unroll
        for (int r = 0; r < 16; ++r) { p0[r] = NEG; p1[r] = NEG; } return; }
    p0 = f32x16{}; p1 = f32x16{};
    const char* kb[4];
#pragma unroll
    for (int dd = 0; dd < 4; ++dd) kb[dd] = K_lds + KB * SHM_K + KSWZ(r32, (dd * 16 + hi * 8) * 2);
#pragma unroll
    for (int d0 = 0; d0 < 8; ++d0) { const char* a = kb[d0 & 3] + (d0 >> 2) * 128;
        bf16x8 b0 = *reinterpret_cast<const bf16x8*>(a);
        bf16x8 b1 = *reinterpret_cast<const bf16x8*>(a + 32 * 256);
        p0 = __builtin_amdgcn_mfma_f32_32x32x16_bf16(b0, qr[d0], p0, 0, 0, 0);
        p1 = __builtin_amdgcn_mfma_f32_32x32x16_bf16(b1, qr[d0], p1, 0, 0, 0); }
}
template <int VB, bool SK>
__device__ __forceinline__ void pv_tile(f32x16* o, int vb0, bf16x8 pa0, bf16x8 pa1, bf16x8 pa2, bf16x8 pa3, bool act) {
    if (SK && !act) return;
#define TRRD(dst, off) asm volatile("ds_read_b64_tr_b16 %0, %1 offset:%2" : "=&v"(dst) : "v"(vb0), "i"(off) : "memory")
#define PV_D0(d0) do { s16x4 l0, l1, l2, l3, h0, h1, h2, h3; constexpr int b_ = VB * SHM_V + v_rd_off(d0, 0, 0);     \
        TRRD(l0, b_); TRRD(h0, b_ + 2048); TRRD(l1, b_ + 4096); TRRD(h1, b_ + 6144); TRRD(l2, b_ + 8192); TRRD(h2, b_ + 10240); TRRD(l3, b_ + 12288); TRRD(h3, b_ + 14336); \
        asm volatile("s_waitcnt lgkmcnt(0)" ::: "memory"); SBAR();                 \
        o[d0] = __builtin_amdgcn_mfma_f32_32x32x16_bf16(pa0, (bf16x8){l0[0], l0[1], l0[2], l0[3], h0[0], h0[1], h0[2], h0[3]}, o[d0], 0, 0, 0);   \
        o[d0] = __builtin_amdgcn_mfma_f32_32x32x16_bf16(pa1, (bf16x8){l1[0], l1[1], l1[2], l1[3], h1[0], h1[1], h1[2], h1[3]}, o[d0], 0, 0, 0);   \
        o[d0] = __builtin_amdgcn_mfma_f32_32x32x16_bf16(pa2, (bf16x8){l2[0], l2[1], l2[2], l2[3], h2[0], h2[1], h2[2], h2[3]}, o[d0], 0, 0, 0);   \
        o[d0] = __builtin_amdgcn_mfma_f32_32x32x16_bf16(pa3, (bf16x8){l3[0], l3[1], l3[2], l3[3], h3[0], h3[1], h3[2], h3[3]}, o[d0], 0, 0, 0); } while (0)
    PV_D0(0); PV_D0(1); PV_D0(2); PV_D0(3);
#undef PV_D0
#undef TRRD
}

template <class TIn, class TOut> struct BlockRef { const TIn* Q; const TIn* K; const TIn* V; const TIn* G; TOut* O; int P0; };
template <class TIn> struct Seam {
    bf16x8 qr[8];
    bf16x8 st_v0, st_v1, st_k0, st_k1; f32x4 sf0, sf1, sf2, sf3;
    f32x4 tq[16];
};
__device__ __forceinline__ int swa_jlo(int P0, int W) { const int lowk = P0 - W + 1; return lowk > 0 ? lowk / KVBLK : 0; }
__device__ __forceinline__ int swa_jhi(int P0, int skv) { int j = (P0 + QB - 1) / KVBLK + 1; return j > skv / KVBLK ? skv / KVBLK : j; }
#define ROW(p, k0, rr) ((p) + (size_t)((k0) + (rr)) * LDQ + sc)
#define VMW() asm volatile("s_waitcnt vmcnt(0)" ::: "memory")
#define VMWN(n) asm volatile("s_waitcnt vmcnt(%0)" :: "i"(n) : "memory")
#define SLOAD_H(Kp, Vp, k0) do { const char* kb__ = (const char*)((Kp) + (size_t)(k0) * LDQ); const char* vb__ = (const char*)((Vp) + (size_t)(k0) * LDQ);     \
                         S.st_v0 = *(const bf16x8*)(vb__ + svoff); S.st_v1 = *(const bf16x8*)(vb__ + (size_t)32 * LDQ * 2 + svoff);              \
                         S.st_k0 = *(const bf16x8*)(kb__ + svoff); S.st_k1 = *(const bf16x8*)(kb__ + (size_t)32 * LDQ * 2 + svoff); } while (0)
#define SWRITE_HK(bf) do { *(bf16x8*)(K_lds + (bf) * SHM_K + kws) = S.st_k0; *(bf16x8*)(K_lds + (bf) * SHM_K + kws + 32 * 256) = S.st_k1; } while (0)
#define SWRITE_HV(bf) do { *(bf16x8*)(V_lds + (bf) * SHM_V + vst0) = S.st_v0; *(bf16x8*)(V_lds + (bf) * SHM_V + vst1) = S.st_v1; } while (0)
#define SWRITE_H(bf) do { SWRITE_HV(bf); SWRITE_HK(bf); } while (0)
#define SLOAD_F(p, k0) do { S.sf0 = *(const f32x4*)ROW(p, k0, sr); S.sf1 = *(const f32x4*)(ROW(p, k0, sr) + 4);                \
                            S.sf2 = *(const f32x4*)ROW(p, k0, 32 + sr); S.sf3 = *(const f32x4*)(ROW(p, k0, 32 + sr) + 4); } while (0)
#define SWRITE_KF(bf) do { *(bf16x8*)(K_lds + (bf) * SHM_K + kws) = pack8(S.sf0, S.sf1); *(bf16x8*)(K_lds + (bf) * SHM_K + kws + 32 * 256) = pack8(S.sf2, S.sf3); } while (0)
#define SWRITE_VF(bf) do { *(bf16x8*)(V_lds + (bf) * SHM_V + vst0) = pack8(S.sf0, S.sf1); *(bf16x8*)(V_lds + (bf) * SHM_V + vst1) = pack8(S.sf2, S.sf3); } while (0)
template <class TIn, class TOut>
__device__ __forceinline__ void causal_swa_prime(const BlockRef<TIn, TOut>& cur, int skv, int W, char* lds, Seam<TIn>& S) {
    constexpr bool F32 = same_t<TIn, float>::v;
    const int tid = threadIdx.x, wid = __builtin_amdgcn_readfirstlane(tid >> 6), lane = tid & 63, r32 = lane & 31, hi = lane >> 5;
    const int sr = tid >> 4, sc = (tid & 15) * 8, kws = KSWZ(sr, sc * 2); char* K_lds = lds + 2 * SHM_V;
    const unsigned svoff = (unsigned)(sr * LDQ + sc) * 2u, qvoff = (unsigned)(r32 * LDQ + hi * 8) * 2u;
    const int kb0 = (swa_jhi(cur.P0, skv) - 1) * KVBLK; (void)W;
    for (int d0 = 0; d0 < 8; ++d0) S.qr[d0] = *(const bf16x8*)((const char*)(cur.Q + (size_t)(wid * QBLK) * LDQ) + d0 * 32 + qvoff);
    if constexpr (F32) { SLOAD_F((const float*)cur.K, kb0); VMW(); SWRITE_KF(0); SBAR(); SLOAD_F((const float*)cur.V, kb0); }
    else { SLOAD_H(cur.K, cur.V, kb0); VMW(); SWRITE_HK(0); }
    __syncthreads();
}
template <class TIn, class TOut>
__device__ __forceinline__ void causal_swa_block(const BlockRef<TIn, TOut>& cur, const BlockRef<TIn, TOut>& nxt, int skv, int W, char* lds, Seam<TIn>& S, float thr) {
    constexpr bool F32 = same_t<TIn, float>::v;
    const int tid = threadIdx.x, wid = __builtin_amdgcn_readfirstlane(tid >> 6), lane = tid & 63, r32 = lane & 31, hi = lane >> 5;
    int j_hi = (cur.P0 + QB - 1) / KVBLK + 1; if (j_hi > skv / KVBLK) j_hi = skv / KVBLK;
    const int kbn = (swa_jhi(nxt.P0, skv) - 1) * KVBLK;
    const int qlo = cur.P0 + wid * QBLK, qm = qlo + r32 - 4 * hi;
    char* V_lds = lds; char* K_lds = lds + 2 * SHM_V;
    const float* cl = (const float*)(lds + C_OFF);
    int j_lo; { const int lastk = 64 * lane + 63; const bool skip = (lastk < cur.P0) && (cl[cur.P0] - cl[lastk] < -thr);
        const unsigned long long keep = __ballot(!skip); j_lo = keep ? (int)__builtin_ctzll(keep) : 0; (void)W; }
    const int NT = j_hi - j_lo;
    float* ws = (float*)(lds + 2 * SHM_V + 2 * SHM_K) + wid * 64; float* li_l = ws, * al_l = ws + 32;
    float m_reg = -1e30f, l_reg = 0; f32x16 o[4] = {};
    const int sr = tid >> 4, sc = (tid & 15) * 8, vst0 = v_st(sr, sc), vst1 = v_st(32 + sr, sc), kws = KSWZ(sr, sc * 2);
    const unsigned svoff = (unsigned)(sr * LDQ + sc) * 2u, qvoff = (unsigned)(r32 * LDQ + hi * 8) * 2u;
    const int vb0 = (int)(uintptr_t)V_lds + v_rd_base(lane);
    const TIn* Kh = cur.K; const TIn* Vh = cur.V;
#define RESC(a) do { if (__any((a) < 1.f)) { if (hi == 0) al_l[r32] = (a); asm volatile("s_waitcnt lgkmcnt(0)" ::: "memory");              \
                     for (int d_ = 0; d_ < 4; ++d_) for (int r = 0; r < 16; ++r) o[d_][r] *= al_l[crow(r, hi)]; } } while (0)
#define KBASE(t) ((j_hi - 1 - (t)) * KVBLK)
#define ACT(t) (KBASE(t) <= qlo + QBLK - 1 && KBASE(t) + KVBLK - 1 >= qlo - W + 1)
#define MASKT(P0_, P1_, t) do { const int kb_ = KBASE(t); bias_tile(P0_, P1_, cl, kb_, hi); if ((!SK || ACT(t)) && (kb_ + KVBLK - 1 > qlo || kb_ <= qlo + QBLK - 1 - W)) mask_tile(P0_, P1_, qm - kb_, (unsigned)W); } while (0)
    constexpr int NQL = F32 ? 16 : 8;
    constexpr bool SK = WSKIP && !F32;
#define SEAM_K0() do { VMWN(NQL); if constexpr (F32) { SWRITE_KF(0); SBAR(); SLOAD_F((const float*)nxt.V, kbn); } else { SWRITE_HK(0); } SBAR(); } while (0)
    f32x16 pA0, pA1, pB0, pB1; float mnA, mnB, alA, alB; bf16x8 pa0, pa1, pa2, pa3;
    if constexpr (F32) { VMW(); SWRITE_VF(0); SBAR(); } else { SWRITE_HV(0); SBAR(); }
    if (NT > 1) { if constexpr (F32) SLOAD_F((const float*)Kh, KBASE(1)); else SLOAD_H(Kh, Vh, KBASE(1)); }
    SBAR(); qkt<0, SK>(pA0, pA1, K_lds, r32, hi, S.qr, ACT(0));
    if constexpr (F32) { if (NT > 1) { VMW(); SWRITE_KF(1); SBAR(); SLOAD_F((const float*)Vh, KBASE(1)); } }
    MASKT(pA0, pA1, 0); partialSM(pA0, pA1, m_reg, mnA, alA);
    if (NT > 1) { VMW(); if constexpr (F32) { SWRITE_VF(1); SBAR(); if (NT > 2) SLOAD_F((const float*)Kh, KBASE(2)); } else SWRITE_H(1); }
    __syncthreads();
#define HALF_STEP(PX0, PX1, mnX, alX, PY0, PY1, alY, t, KB, VB, SB) do {                                                      \
        SBAR(); qkt<KB, SK>(PX0, PX1, K_lds, r32, hi, S.qr, ACT(t));                                             \
        finishSM(PY0, PY1, alY, l_reg, pa0, pa1, pa2, pa3); SBAR();                                                           \
        if ((t) + 1 < NT) { if constexpr (F32) { VMW(); SWRITE_KF(SB); SBAR(); SLOAD_F((const float*)Vh, KBASE((t) + 1)); }  \
                            else { SLOAD_H(Kh, Vh, KBASE((t) + 1)); } SBAR(); }                                               \
        pv_tile<VB, SK>(o, vb0, pa0, pa1, pa2, pa3, ACT((t) - 1)); MASKT(PX0, PX1, (t)); partialSM(PX0, PX1, m_reg, mnX, alX);                                        \
        __syncthreads();                                                                                                      \
        if ((t) + 1 < NT) { VMW(); if constexpr (F32) { SWRITE_VF(SB); SBAR(); if ((t) + 2 < NT) SLOAD_F((const float*)Kh, KBASE((t) + 2)); } \
                            else { SWRITE_H(SB); } }                                                                          \
        RESC(alX); __syncthreads(); } while (0)
    for (int t = 1; t + 1 < NT; t += 2) {
        HALF_STEP(pB0, pB1, mnB, alB, pA0, pA1, alA, t, 1, 0, 0);
        HALF_STEP(pA0, pA1, mnA, alA, pB0, pB1, alB, t + 1, 0, 1, 1);
    }
    const bool even = (NT & 1) == 0;
    if (even) { SBAR(); qkt<1, SK>(pB0, pB1, K_lds, r32, hi, S.qr, ACT(NT - 1)); SBAR(); }
#define QROW(e) (nxt.Q + (size_t)(wid * QBLK + r32) * LDQ + ((e) >> 1) * 16 + hi * 8 + ((e) & 1) * 4)
    if constexpr (F32) { SLOAD_F((const float*)nxt.K, kbn); SBAR();
#pragma unroll
        for (int e = 0; e < 8; ++e) S.tq[e] = *(const f32x4*)QROW(e); }
    else { SLOAD_H(nxt.K, nxt.V, kbn); SBAR();
#pragma unroll
        for (int d0 = 0; d0 < 8; ++d0) S.qr[d0] = *(const bf16x8*)((const char*)(nxt.Q + (size_t)(wid * QBLK) * LDQ) + d0 * 32 + qvoff); }
    SBAR();
    finishSM(pA0, pA1, alA, l_reg, pa0, pa1, pa2, pa3); SBAR();
    if constexpr (F32) {
#pragma unroll
        for (int e = 8; e < 16; ++e) S.tq[e] = *(const f32x4*)QROW(e); SBAR(); }
#undef QROW
    pv_tile<0, SK>(o, vb0, pa0, pa1, pa2, pa3, ACT(even ? NT - 2 : NT - 1));
    if (even) { MASKT(pB0, pB1, NT - 1); partialSM(pB0, pB1, m_reg, mnB, alB); __syncthreads(); RESC(alB);
        finishSM(pB0, pB1, alB, l_reg, pa0, pa1, pa2, pa3); SBAR(); pv_tile<1, SK>(o, vb0, pa0, pa1, pa2, pa3, ACT(NT - 1)); }
    SBAR(); SEAM_K0();
    if (hi == 0) li_l[r32] = l_reg; asm volatile("s_waitcnt lgkmcnt(0)" ::: "memory");
    float rli[16];
#pragma unroll
    for (int r = 0; r < 16; ++r) rli[r] = __builtin_amdgcn_rcpf(li_l[crow(r, hi)]);
    { char* stg = lds + STG_OFF + wid * (QBLK * STG_ROW);
      int loff = (lane >> 4) * LDQ + (lane & 15) * 8, yoff = (lane >> 4) * LDO + (lane & 15) * 8;
      asm volatile("" : "+v"(loff), "+v"(yoff));
      const TIn* Gw = cur.G + (size_t)(wid * QBLK) * LDQ + loff; TOut* Ow = cur.O + (size_t)(wid * QBLK) * LDO + yoff;
#pragma unroll
      for (int r = 0; r < 16; ++r) { const int orow = crow(r, hi);
#pragma unroll
          for (int d0 = 0; d0 < 4; ++d0) { const float v = o[d0][r] * rli[r]; const float vn = __shfl_xor(v, 1);
              if ((r32 & 1) == 0) *(unsigned*)(stg + orow * STG_ROW + (d0 * 32 + r32) * 2) = cvtpk(v, vn); } }
      asm volatile("s_waitcnt lgkmcnt(0)" ::: "memory");
#pragma unroll
      for (int hf = 0; hf < 2; ++hf) { u32x4 gv[4];
#pragma unroll
          for (int i = 0; i < 4; ++i) gv[i] = *(const u32x4*)(Gw + (size_t)(16 * hf + 4 * i) * LDQ);
#pragma unroll
          for (int i = 0; i < 4; ++i) { const u32x4 ov = *(const u32x4*)(stg + (16 * hf + 4 * i + (lane >> 4)) * STG_ROW + (lane & 15) * 16); const u32x4 g4 = gv[i]; u32x4 w;
#pragma unroll
              for (int e = 0; e < 4; ++e) w[e] = cvtpk(__uint_as_float(ov[e] << 16) * __uint_as_float(g4[e] << 16), __uint_as_float(ov[e] & 0xffff0000u) * __uint_as_float(g4[e] & 0xffff0000u));
              *(u32x4*)(Ow + (size_t)(16 * hf + 4 * i) * LDO) = w; }
          asm volatile("" ::: "memory"); } }
    if constexpr (F32) {
#pragma unroll
        for (int d0 = 0; d0 < 8; ++d0) S.qr[d0] = pack8(S.tq[2 * d0], S.tq[2 * d0 + 1]); }
    __syncthreads();
#undef RESC
#undef KBASE
#undef ACT
#undef MASKT
#undef SEAM_K0
#undef HALF_STEP
}
#undef ROW
#undef VMW
#undef VMWN
#undef SLOAD_H
#undef SWRITE_HK
#undef SWRITE_HV
#undef SWRITE_H
#undef SLOAD_F
#undef SWRITE_KF
#undef SWRITE_VF

__host__ __device__ inline int swa_nramp(int nqb, int W, int qoff) { const int t = W - 1 - qoff; const int n = t < 0 ? 0 : t / QB + 1; return n > nqb ? nqb : n; }
__host__ __device__ inline int swa_nx(int nqb, int nramp, int order) { return (order & ORDER_PAIRED) ? (nramp + 1) / 2 + (nqb - nramp) : nqb; }
struct SwaItem { int bh, qb0, qb1; };
__device__ __forceinline__ SwaItem swa_decode(int L, int nb, int nh, int nhkv, int nqb, int nx, int nramp, int order) {
    const int G = nh / nhkv; SwaItem it; int x;
    if ((order & ORDER_XCD) && (nb * nhkv) % 8 == 0) { const int xcd = L & 7, k = L >> 3, per = G * nx, gi = k / per, r = k - gi * per;
        it.bh = (gi * 8 + xcd) * G + r / nx; x = r % nx; }
    else { it.bh = L / nx; x = L - it.bh * nx; }
    if (order & ORDER_PAIRED) { const int ns = nqb - nramp;
        if (x < ns) { it.qb0 = it.qb1 = nqb - 1 - x; } else { it.qb0 = x - ns; it.qb1 = nramp - 1 - it.qb0; } }
    else { it.qb0 = it.qb1 = ((order & 3) == ORDER_REVERSED) ? nqb - 1 - x : x; }
    return it;
}
template <class TIn, class TOut>
__device__ __forceinline__ BlockRef<TIn, TOut> swa_ref(const SwaItem& it, int pass, const TIn* Q, const TIn* K, const TIn* V, TOut* O,
                                                    int nh, int nhkv, int sq, int skv, int qoff) {
    const int qb = pass ? it.qb1 : it.qb0, kvh = it.bh / (nh / nhkv);
    BlockRef<TIn, TOut> r;
    const int b_ = it.bh / nh, h_ = it.bh % nh; (void)kvh; (void)K; (void)V;
    const TIn* rowb = Q + (size_t)(b_ * nh + h_) * sq * LDQ;
    r.Q = rowb + (size_t)qb * QB * LDQ; r.K = rowb + SECSZ; r.V = rowb + 2 * SECSZ; r.G = r.Q + 3 * SECSZ;
    r.O = O + ((size_t)b_ * sq + (size_t)qb * QB) * LDO + h_ * D; r.P0 = qoff + qb * QB;
    return r;
}

constexpr int WT_OFF = STG_OFF + NW * QBLK * STG_ROW, ATT_LDS = WT_OFF + 64;
__device__ __forceinline__ void load_c(char* lds, const float* LS, int bh) {
    int tid = threadIdx.x; asm volatile("" : "+v"(tid));
    const int lane = tid & 63, wv = tid >> 6;
    const f32x4* src = (const f32x4*)(LS + (size_t)bh * SEQ) + 2 * tid;
    const f32x4 a = src[0], b = src[1];
    float v[8]; v[0] = a[0]; v[1] = v[0] + a[1]; v[2] = v[1] + a[2]; v[3] = v[2] + a[3]; v[4] = v[3] + b[0]; v[5] = v[4] + b[1]; v[6] = v[5] + b[2]; v[7] = v[6] + b[3];
    float inc = v[7];
#pragma unroll
    for (int o = 1; o < 64; o <<= 1) { const float t = __uint_as_float(__builtin_amdgcn_ds_bpermute(((lane - o) & 63) << 2, __float_as_uint(inc))); if (lane >= o) inc += t; }
    float* wt = (float*)(lds + WT_OFF);
    if (lane == 63) wt[wv] = inc;
    __syncthreads();
    float base = inc - v[7];
#pragma unroll
    for (int w = 0; w < 7; ++w) if (w < wv) base += wt[w];
    f32x4* dst = (f32x4*)(lds + C_OFF) + 2 * tid;
    dst[0] = (f32x4){base + v[0], base + v[1], base + v[2], base + v[3]}; dst[1] = (f32x4){base + v[4], base + v[5], base + v[6], base + v[7]};
}
__device__ __forceinline__ BlockRef<bf16, bf16> blk_ref(int id, const bf16* P, bf16* Y, int& bh) {
    constexpr int nqb = SQ / QB; bh = id % (B * H); const int qb = nqb - 1 - id / (B * H);
    SwaItem it; it.bh = bh; it.qb0 = it.qb1 = qb;
    return swa_ref<bf16, bf16>(it, 0, P, P, P, Y, H, HKV, SQ, SKV, QOFF);
}
__device__ __forceinline__ float skip_thr(const float* NRM, int bh) {
    const float* nq = NRM + (size_t)bh * 4; const float* nk = NRM + (size_t)(B * H + bh) * 4;
    const float q2 = (nq[0] + nq[1]) + (nq[2] + nq[3]), k2 = (nk[0] + nk[1]) + (nk[2] + nk[3]);
    return 118.0f + 2.04f * SCALE * sqrtf(q2 * k2);
}
__device__ __forceinline__ void attn_phase(char* lds, const bf16* P, const float* LS, const float* NRM, bf16* Y, unsigned* qctr, int blk, int nblk) {
    constexpr int total = B * H * (SQ / QB);
    volatile int* qslot = (volatile int*)(lds + WT_OFF + 32);
    (void)blk; (void)nblk;
    if (threadIdx.x == 0) { qslot[0] = (int)atomicAdd(qctr, 1u); qslot[1] = (int)atomicAdd(qctr, 1u); }
    __syncthreads();
    int id0 = __builtin_amdgcn_readfirstlane(qslot[0]), id1 = __builtin_amdgcn_readfirstlane(qslot[1]);
    if (id0 >= total) return;
    int bh0, bh1 = 0;
    BlockRef<bf16, bf16> cur = blk_ref(id0, P, Y, bh0);
    Seam<bf16> S;
    load_c(lds, LS, bh0);
    causal_swa_prime<bf16, bf16>(cur, SKV, WINDOW, lds, S);
    for (;;) {
        const bool last = id1 >= total;
        const BlockRef<bf16, bf16> nxt = last ? cur : blk_ref(id1, P, Y, bh1);
        int id2 = total;
        if (threadIdx.x == 0 && !last) id2 = (int)atomicAdd(qctr, 1u);
        const float thr = skip_thr(NRM, bh0);
        causal_swa_block<bf16, bf16>(cur, nxt, SKV, WINDOW, lds, S, thr);
        if (last) break;
        if (threadIdx.x == 0) qslot[0] = id2;
        load_c(lds, LS, bh1); __syncthreads();
        id1 = __builtin_amdgcn_readfirstlane(qslot[0]);
        cur = nxt; bh0 = bh1;
    }
}
}

__device__ __forceinline__ void flogit_phase(const bf16* __restrict__ HB, const bf16* __restrict__ WF, const float* __restrict__ b_f, float* __restrict__ LS, int blk, int nblk) {
    typedef short bf16x8_t __attribute__((ext_vector_type(8)));
    const int tid = threadIdx.x, wid = __builtin_amdgcn_readfirstlane(tid >> 6), lane = tid & 63, n = lane & 15, g = lane >> 4;
    for (int rb = blk; rb < M / 32; rb += nblk) {
        const int r0 = rb * 32 + (wid >> 2) * 16, h0 = (wid & 3) * 16;
        const bf16x8_t* ap = (const bf16x8_t*)(HB + (size_t)(r0 + n) * D + 8 * g);
        const bf16x8_t* bp = (const bf16x8_t*)(WF + (size_t)(h0 + n) * D + 8 * g);
        f32x4 acc = (f32x4){0.f, 0.f, 0.f, 0.f};
#pragma unroll 8
        for (int k = 0; k < D / 32; ++k) acc = __builtin_amdgcn_mfma_f32_16x16x32_bf16(ap[4 * k], bp[4 * k], acc, 0, 0, 0);
        const float bias = b_f[h0 + n];
        f32x4 o;
#pragma unroll
        for (int j = 0; j < 4; ++j) { const float z = acc[j] + bias; const float e = __builtin_amdgcn_exp2f(-1.4426950408889634f * fabsf(z));
            o[j] = fminf(z, 0.f) - 0.6931471805599453f * __builtin_amdgcn_logf(1.0f + e); }
        const int row = r0 + 4 * g, b = row / SEQ, s = row % SEQ;
        *(f32x4*)(LS + ((size_t)b * NH + h0 + n) * SEQ + s) = o;
    }
}

#define XB_TMO      128
#define XB_XCNT(j)  (256  + 64 * (j))
#define XB_XSUB(j)  (1280 + 64 * (j))
#define XB_XGEN(j)  (2304 + 64 * (j))
#define XB_TOP      3328
#define XB_TOPGEN   3392
#define XCD_BAR_WORDS 3456
#define XB_SPIN_CAP (1u << 18)

__device__ __forceinline__ unsigned xb_ld(unsigned* p)              { return __hip_atomic_load(p, __ATOMIC_RELAXED, __HIP_MEMORY_SCOPE_AGENT); }
__device__ __forceinline__ unsigned xb_add(unsigned* p, unsigned v) { return __hip_atomic_fetch_add(p, v, __ATOMIC_RELAXED, __HIP_MEMORY_SCOPE_AGENT); }
__device__ __forceinline__ unsigned xb_xcc_id() { return (unsigned)__builtin_amdgcn_s_getreg((3 << 11) | 20) & 0xFu; }
#define XB_SPIN(cond, bar) do { unsigned _sp = 0; while (cond) { __builtin_amdgcn_s_sleep(1); \
    if ((++_sp & 255u) == 0u) { if (xb_ld(&(bar)[XB_TMO])) break; if (_sp > XB_SPIN_CAP) { atomicAdd(&(bar)[XB_TMO], 1u); break; } } } } while (0)

struct XcdBarrier {
    unsigned* bar; unsigned x;
    volatile LAS unsigned* st;
};

__device__ __forceinline__ XcdBarrier xcd_barrier_post(unsigned* bar, volatile LAS unsigned* st) {
    XcdBarrier b; b.bar = bar; b.x = xb_xcc_id(); b.st = st;
    if (threadIdx.x == 0) (void)xb_add(&bar[XB_XCNT(b.x)], 1u);
    return b;
}
__device__ __forceinline__ void xcd_barrier_complete(unsigned* bar, unsigned x, unsigned& nloc, unsigned& nx) {
    const unsigned G = gridDim.x * gridDim.y * gridDim.z;
    unsigned sum, cnt, mine, sp = 0u;
    for (;;) {
        sum = 0u; cnt = 0u; mine = 0u;
#pragma unroll
        for (unsigned j = 0; j < 16; ++j) { const unsigned c = xb_ld(&bar[XB_XCNT(j)]); sum += c; cnt += (c > 0u) ? 1u : 0u; mine = (j == x) ? c : mine; }
        if (sum == G) break;
        __builtin_amdgcn_s_sleep(1);
        if ((++sp & 255u) == 0u) { if (xb_ld(&bar[XB_TMO])) break; if (sp > XB_SPIN_CAP) { atomicAdd(&bar[XB_TMO], 1u); break; } }
    }
    nloc = mine > 0u ? mine : 1u; nx = cnt > 0u ? cnt : 1u;
}

__device__ __forceinline__ void xcd_barrier(const XcdBarrier& b) {
    asm volatile("s_waitcnt vmcnt(0)" ::: "memory");
    __syncthreads();
    if (threadIdx.x == 0) {
        unsigned* bar = b.bar;
        __builtin_amdgcn_s_waitcnt(0);
        unsigned nloc = b.st[0], nx = b.st[1];
        if (nloc == 0u) { xcd_barrier_complete(bar, b.x, nloc, nx); b.st[0] = nloc; b.st[1] = nx; }
        const unsigned old = xb_add(&bar[XB_XSUB(b.x)], 1u);
        const unsigned gen = old / nloc;
        if (old + 1u == (gen + 1u) * nloc) {
            __builtin_amdgcn_fence(__ATOMIC_RELEASE, "agent");
            asm volatile("s_waitcnt vmcnt(0)" ::: "memory");
            const unsigned og = xb_add(&bar[XB_TOP], 1u);
            const unsigned tg = og / nx;
            if (og + 1u == (tg + 1u) * nx) xb_add(&bar[XB_TOPGEN], 1u);
            else XB_SPIN(xb_ld(&bar[XB_TOPGEN]) == tg, bar);
            __builtin_amdgcn_fence(__ATOMIC_ACQUIRE, "agent");
            xb_add(&bar[XB_XGEN(b.x)], 1u);
            asm volatile("s_waitcnt vmcnt(0)" ::: "memory");
        } else {
            XB_SPIN(xb_ld(&bar[XB_XGEN(b.x)]) == gen, bar);
            __builtin_amdgcn_fence(__ATOMIC_ACQUIRE, "agent");
            asm volatile("s_waitcnt vmcnt(0)" ::: "memory");
        }
    }
    __syncthreads();
}

constexpr int CW_BAR = 1024;
constexpr size_t CTL_ZERO_BYTES = 32768;
constexpr size_t QCTR_OFF = 28672;
constexpr size_t NRM_OFF = 24576;
constexpr int LDS_TOTAL = 163840;
constexpr int MISC_OFF = LDS_TOTAL - 64;
static_assert(fox::ATT_LDS <= MISC_OFF && scan::LDS_BYTES <= MISC_OFF && pg8::STAGE_BYTES <= MISC_OFF && 8 * 8448 <= MISC_OFF, "LDS map");
#ifndef MK_N_LAUNCHES
#define MK_N_LAUNCHES 1
#endif
constexpr int N_PHASES = 9;
struct Args { const float* in[10]; float* out; unsigned char* ws; int ph_lo, ph_hi; };
__global__ void __launch_bounds__(512, 2) mega_fwd(Args args) {
    extern __shared__ __attribute__((aligned(16))) unsigned char lds[];
    LAS unsigned char* L = (LAS unsigned char*)lds;
    volatile LAS unsigned* MISC = (volatile LAS unsigned*)(L + MISC_OFF);
    const int tid = threadIdx.x, lane = tid & 63, wave = __builtin_amdgcn_readfirstlane(tid >> 6);
    const int G = gridDim.x, bx = blockIdx.x;
    if (tid < 16) MISC[tid] = 0u;
    __syncthreads();
    unsigned char* ws = args.ws;
    XcdBarrier bar; bar.bar = (unsigned*)(ws + WS_CTL) + CW_BAR; bar.x = 0; bar.st = nullptr;
    if (MK_N_LAUNCHES != N_PHASES) bar = xcd_barrier_post((unsigned*)(ws + WS_CTL) + CW_BAR, MISC + 8);
    const float* x = args.in[0]; const float* norm_w = args.in[1]; const float* w_in_a = args.in[2]; const float* lb_logits = args.in[3]; const float* o_norm_a = args.in[4];
    const float* w_out_a = args.in[5]; const float* w_in_b = args.in[6]; const float* b_f = args.in[7]; const float* w_out_b = args.in[8]; const float* final_norm = args.in[9];
    float* out = args.out;
    bf16* WA = (bf16*)(ws + WS_WA); bf16* WB = (bf16*)(ws + WS_WB); bf16* WF = (bf16*)(ws + WS_WF); bf16* WOA = (bf16*)(ws + WS_WOA); bf16* WOB = (bf16*)(ws + WS_WOB);
    bf16* HB = (bf16*)(ws + WS_HB); float* X1 = (float*)(ws + WS_X1); bf16* P = (bf16*)(ws + WS_P); bf16* Y = (bf16*)(ws + WS_Y); float* LS = (float*)(ws + WS_LS);
    const int lo = args.ph_lo, hi = args.ph_hi;
#define IN(k) (lo <= (k) && (k) < hi)
#define SEAM(k) do { if (IN(k) && IN((k) + 1)) xcd_barrier(bar); } while (0)
#define RUN(k, ...) do { if (IN(k)) { __VA_ARGS__ } } while (0)

    RUN(0, { prologue_phase(L, 0, x, norm_w, w_in_a, w_out_a, w_in_b, w_out_b, ws, bx, G, wave, lane); } );
    SEAM(0);
    RUN(1, { pg8::Gemm g{HB, WA, M, LDP, D, 0}; pg8::StaticOrder S; S.init(M, LDP, G, bx); pg8::EpiAct<0> E{P, lb_logits, nullptr, LDP, 0};
        pg8::gemm_phase<pg8::EpiAct<0>, pg8::StaticOrder, true, true>(L, g, S, E); } );
    SEAM(1);
    RUN(2, { if (G >= 2 * NB * NH) { if (bx < NB * NH) scan::scan_unit(L, P, o_norm_a, Y, bx); else prologue_phase(L, 1, x, norm_w, w_in_a, w_out_a, w_in_b, w_out_b, ws, bx - NB * NH, G - NB * NH, wave, lane); }
              else { for (int bh = bx; bh < NB * NH; bh += G) scan::scan_unit(L, P, o_norm_a, Y, bh); prologue_phase(L, 1, x, norm_w, w_in_a, w_out_a, w_in_b, w_out_b, ws, bx, G, wave, lane); } } );
    SEAM(2);
    RUN(3, { pg8::Gemm g{Y, WOA, M, D, DI, 0}; pg8::StaticOrder S; S.init(M, D, G, bx); pg8::EpiRes E{x, X1, D, 0};
        pg8::gemm_phase<pg8::EpiRes, pg8::StaticOrder, true, true>(L, g, S, E); } );
    SEAM(3);
    RUN(4, { const int gw = bx * 8 + wave, NGW = G * 8; for (int m = gw; m < M; m += NGW) rms_row_bf16(X1 + (size_t)m * D, norm_w + D, HB + (size_t)m * D, lane); } );
    SEAM(4);
    RUN(5, { flogit_phase(HB, WF, b_f, LS, bx, G);
        pg8::Gemm g{HB, WB, M, LDP, D, 0}; pg8::StaticOrder S; S.init(M, LDP, G, bx); pg8::EpiAct<1> E{P, nullptr, (unsigned*)(ws + WS_CTL + NRM_OFF), LDP, 0};
        pg8::gemm_phase<pg8::EpiAct<1>, pg8::StaticOrder, true, true>(L, g, S, E); } );
    SEAM(5);
    RUN(6, { fox::attn_phase((char*)lds, P, LS, (const float*)(ws + WS_CTL + NRM_OFF), Y, (unsigned*)(ws + WS_CTL + QCTR_OFF), bx, G); } );
    SEAM(6);
    RUN(7, { pg8::Gemm g{Y, WOB, M, D, DI, 0}; pg8::StaticOrder S; S.init(M, D, G, bx); pg8::EpiRes E{X1, out, D, 0};
        pg8::gemm_phase<pg8::EpiRes, pg8::StaticOrder, true, true>(L, g, S, E); } );
    SEAM(7);
    RUN(8, { const int gw = bx * 8 + wave, NGW = G * 8; for (int m = gw; m < M; m += NGW) rms_row_f32(out + (size_t)m * D, final_norm, out + (size_t)m * D, lane); } );
#undef IN
#undef SEAM
}

extern "C" void kernel_launch(void* const* d_in, const int* in_sizes, int n_in, void* d_out, int out_size, void* d_ws, size_t ws_size, hipStream_t stream) {
    static int grid = 0;
    if (grid == 0) {
        if (n_in != 10 || in_sizes[0] != M * D || out_size != M * D || ws_size < WS_END) { fprintf(stderr, "kernel_launch: unexpected shapes (n_in %d, in0 %d, out %d, ws %zu < %zu); nothing launched\n", n_in, n_in > 0 ? in_sizes[0] : -1, out_size, ws_size, (size_t)WS_END); grid = -1; return; }
        int dev = 0, cus = 0, per_cu = 0;
        if (hipGetDevice(&dev) != hipSuccess || hipDeviceGetAttribute(&cus, hipDeviceAttributeMultiprocessorCount, dev) != hipSuccess) { fprintf(stderr, "kernel_launch: device query failed\n"); grid = -1; return; }
        if (hipFuncSetAttribute((const void*)mega_fwd, hipFuncAttributeMaxDynamicSharedMemorySize, LDS_TOTAL) != hipSuccess) { fprintf(stderr, "kernel_launch: hipFuncSetAttribute(%d B LDS) failed\n", LDS_TOTAL); grid = -1; return; }
        if (hipOccupancyMaxActiveBlocksPerMultiprocessor(&per_cu, (const void*)mega_fwd, 512, LDS_TOTAL) != hipSuccess || per_cu < 1)
            fprintf(stderr, "kernel_launch: note: occupancy query reports %d workgroups per CU\n", per_cu);
        (void)hipGetLastError();
        grid = cus;
    }
    if (grid < 0) return;
    if (hipMemsetAsync((char*)d_ws + WS_CTL, 0, CTL_ZERO_BYTES, stream) != hipSuccess) { fprintf(stderr, "kernel_launch: hipMemsetAsync failed\n"); return; }
    Args a{};
    for (int i = 0; i < 10; ++i) a.in[i] = (const float*)d_in[i];
    a.out = (float*)d_out; a.ws = (unsigned char*)d_ws;
#if MK_N_LAUNCHES == 1
    a.ph_lo = 0; a.ph_hi = N_PHASES;
    hipLaunchKernelGGL(mega_fwd, dim3(grid), dim3(512), LDS_TOTAL, stream, a);
#else
    for (int p = 0; p < N_PHASES; ++p) { a.ph_lo = p; a.ph_hi = p + 1; hipLaunchKernelGGL(mega_fwd, dim3(grid), dim3(512), LDS_TOTAL, stream, a); }
#endif
    const hipError_t le = hipPeekAtLastError();
    if (le != hipSuccess) fprintf(stderr, "kernel_launch: launch failed: %s\n", hipGetErrorName(le));
}
```

```cpp
#include <hip/hip_runtime.h>
#include <cstdio>
#include <cstdint>

constexpr int NB = 2, SEQ = 4096, D = 4096, DI = 8192, NH = 64, HD = 128;
constexpr int M = NB * SEQ;
constexpr int LDP = 4 * DI;
constexpr int NWB = 4 * DI + NH;
constexpr float EPS = 1e-6f;
namespace pg8 {
#define PG8_LAS __attribute__((address_space(3)))
typedef unsigned short bf16_t;
typedef short bf16x8 __attribute__((ext_vector_type(8)));
typedef float f32x4 __attribute__((ext_vector_type(4)));
typedef unsigned u32x4 __attribute__((ext_vector_type(4)));
constexpr int BM = 256, BK = 64, HALF = 128, HTB = HALF * BK * 2  , STAGE_BYTES = 8 * HTB, NXCD = 8, WGM = 8;

__host__ __device__ __forceinline__ int lds_byte(int r, int c) { const int st = (r >> 4) * 2 + (c >> 5), rr = r & 15, cc = c & 31, ob = rr * 64 + cc * 2; return st * 1024 + (ob ^ (((ob >> 9) & 1) << 5)); }
__host__ __device__ __forceinline__ void stage_rc(int b, int& R, int& C) { const int st = b / 1024, sb = b % 1024, swz = sb ^ (((sb >> 9) & 1) << 5); R = (st >> 1) * 16 + swz / 64; C = (st & 1) * 32 + (swz % 64) / 2; }
__host__ __device__ __forceinline__ int perm32(int rho) { const int n = rho >> 4, i = rho & 15; return 8 * (i >> 2) + 4 * n + (i & 3); }

struct Unit { int pm, pn; };
struct Gemm { const bf16_t* A; const bf16_t* Bt; int M, N, K, pad; };

struct StaticOrder {
    int nM, nN, nwg, G, c;
    __host__ __device__ void init(int M, int N, int G_, int c_) { nM = M / BM; nN = N / BM; nwg = nM * nN; G = G_; c = c_; }
    __host__ __device__ bool next(int i, Unit& u) const {
        const long L = (long)i * G + c; if (L >= nwg) return false;
        int wgid = (int)L; { const int q = nwg / NXCD, r = nwg % NXCD, xcd = wgid % NXCD, off = wgid / NXCD; wgid = (xcd < r ? xcd * (q + 1) : r * (q + 1) + (xcd - r) * q) + off; }
        const int nig = WGM * nN, gid = wgid / nig, fm = gid * WGM, gsz = (nM - fm) < WGM ? (nM - fm) : WGM;
        u.pm = fm + ((wgid % nig) % gsz); u.pn = (wgid % nig) / gsz; return true;
    }
    __device__ __forceinline__ void a_ready(const Unit&) const {}
    __device__ __forceinline__ void done(const Unit&) const {}
};

typedef float f32x2_t __attribute__((ext_vector_type(2)));
typedef __bf16 bf16x2_t __attribute__((ext_vector_type(2)));
__device__ __forceinline__ unsigned cvt_pk_bf16(float lo, float hi) { f32x2_t v = {lo, hi}; bf16x2_t b = __builtin_convertvector(v, bf16x2_t); return __builtin_bit_cast(unsigned, b); }
__device__ __forceinline__ float silu_f(float x) { return x * __builtin_amdgcn_rcpf(1.0f + __builtin_amdgcn_exp2f(-1.4426950408889634f * x)); }

#define PG8_PSTORE(p, v) (*(p) = (v))
template <int LAYER> struct EpiAct {
    static constexpr bool PERM = true, AFTER_DRAIN = false;
    bf16_t* O; const float* lbl; unsigned* nrm; int ldc, pad;
    __device__ __forceinline__ void operator()(const f32x4 (&acc)[2][2][4][2], const Unit& u, int wr, int wc, int fr, int fq) const {
        const int sec = u.pn >> 5;
        const int row0 = u.pm * BM + wr * 64 + fr, col0 = u.pn * BM + wc * 32 + 8 * fq;
        const int mode = (LAYER == 0) ? ((sec == 0 || sec == 3) ? 1 : (sec == 1 ? 2 : 0)) : (sec == 3 ? 1 : 0);
        const int rb = row0 >> 12, rs = row0 & 4095, hh = (2 * u.pn) & 63;
        bf16_t* hm = O + ((size_t)((sec * 2 + rb) * 64 + hh) * 4096 + rs) * 128 + wc * 32 + 8 * fq;
        if (mode == 2) {
            float lb[2][8], om[2][8];
#pragma unroll
            for (int bj = 0; bj < 2; ++bj) { const int c = col0 + bj * HALF - 8192;
                const f32x4 a0 = *(const f32x4*)(lbl + c), a1 = *(const f32x4*)(lbl + c + 4), b0 = *(const f32x4*)(lbl + 8192 + c), b1 = *(const f32x4*)(lbl + 8192 + c + 4);
#pragma unroll
                for (int e = 0; e < 4; ++e) { const float x0 = __builtin_amdgcn_rcpf(1.0f + __builtin_amdgcn_exp2f(1.4426950408889634f * (b0[e] - a0[e]))), x1 = __builtin_amdgcn_rcpf(1.0f + __builtin_amdgcn_exp2f(1.4426950408889634f * (b1[e] - a1[e])));
                    lb[bj][e] = x0; om[bj][e] = 1.0f - x0; lb[bj][4 + e] = x1; om[bj][4 + e] = 1.0f - x1; } }
#pragma unroll
            for (int ai = 0; ai < 2; ++ai)
#pragma unroll
                for (int m = 0; m < 4; ++m) { bf16_t* rowp = hm + (size_t)(ai * HALF + m * 16) * 128;
#pragma unroll
                    for (int bj = 0; bj < 2; ++bj) { float v[8];
#pragma unroll
                        for (int e = 0; e < 8; ++e) { const float f = acc[ai][bj][m][e >> 2][e & 3];
                            const float sg = __builtin_amdgcn_rcpf(1.0f + __builtin_amdgcn_exp2f(-1.4426950408889634f * f));
                            v[e] = __builtin_amdgcn_logf(lb[bj][e] + om[bj][e] * sg); }
                        u32x4 w; w.x = cvt_pk_bf16(v[0], v[1]); w.y = cvt_pk_bf16(v[2], v[3]); w.z = cvt_pk_bf16(v[4], v[5]); w.w = cvt_pk_bf16(v[6], v[7]);
                        PG8_PSTORE((u32x4*)(rowp + (size_t)bj * (4096 * 128)), w); } }
        } else if (mode == 1) {
#pragma unroll
            for (int ai = 0; ai < 2; ++ai)
#pragma unroll
                for (int m = 0; m < 4; ++m) { bf16_t* rowp = hm + (size_t)(ai * HALF + m * 16) * 128;
#pragma unroll
                    for (int bj = 0; bj < 2; ++bj) { float v[8];
#pragma unroll
                        for (int e = 0; e < 8; ++e) v[e] = silu_f(acc[ai][bj][m][e >> 2][e & 3]);
                        u32x4 w; w.x = cvt_pk_bf16(v[0], v[1]); w.y = cvt_pk_bf16(v[2], v[3]); w.z = cvt_pk_bf16(v[4], v[5]); w.w = cvt_pk_bf16(v[6], v[7]);
                        PG8_PSTORE((u32x4*)(rowp + (size_t)bj * (4096 * 128)), w); } }
        } else {
            float nmax[2] = {0.f, 0.f};
#pragma unroll
            for (int ai = 0; ai < 2; ++ai)
#pragma unroll
                for (int m = 0; m < 4; ++m) { bf16_t* rowp = hm + (size_t)(ai * HALF + m * 16) * 128;
#pragma unroll
                    for (int bj = 0; bj < 2; ++bj) { const f32x4 v0 = acc[ai][bj][m][0], v1 = acc[ai][bj][m][1];
                        u32x4 w; w.x = cvt_pk_bf16(v0[0], v0[1]); w.y = cvt_pk_bf16(v0[2], v0[3]); w.z = cvt_pk_bf16(v1[0], v1[1]); w.w = cvt_pk_bf16(v1[2], v1[3]);
                        PG8_PSTORE((u32x4*)(rowp + (size_t)bj * (4096 * 128)), w);
                        if (LAYER == 1 && sec < 2) { float ss = (v0[0] * v0[0] + v0[1] * v0[1]) + (v0[2] * v0[2] + v0[3] * v0[3]) + (v1[0] * v1[0] + v1[1] * v1[1]) + (v1[2] * v1[2] + v1[3] * v1[3]);
                            ss += __shfl_xor(ss, 16); ss += __shfl_xor(ss, 32); nmax[bj] = fmaxf(nmax[bj], ss); } } }
            if (LAYER == 1 && sec < 2) {
#pragma unroll
                for (int bj = 0; bj < 2; ++bj) { float v = nmax[bj];
#pragma unroll
                    for (int o = 1; o < 16; o <<= 1) v = fmaxf(v, __shfl_xor(v, o));
                    if (fr == 0 && fq == 0) atomicMax(nrm + ((size_t)(sec * 128 + rb * 64 + hh + bj)) * 4 + wc, __float_as_uint(v)); }
            }
        }
    }
};
struct EpiRes {
    static constexpr bool PERM = false, AFTER_DRAIN = false;
    const float* base; float* out; int ldc, pad;
    __device__ __forceinline__ void operator()(const f32x4 (&acc)[2][2][4][2], const Unit& u, int wr, int wc, int fr, int fq) const {
        const int row0 = u.pm * BM + wr * 64 + fr, col0 = u.pn * BM + wc * 32 + 4 * fq;
#pragma unroll
        for (int ai = 0; ai < 2; ++ai)
#pragma unroll
            for (int m = 0; m < 4; ++m) { const size_t off = (size_t)(row0 + ai * HALF + m * 16) * ldc + col0;
#pragma unroll
                for (int bj = 0; bj < 2; ++bj)
#pragma unroll
                    for (int n = 0; n < 2; ++n) { const f32x4 bs = *(const f32x4*)(base + off + bj * HALF + n * 16); *(f32x4*)(out + off + bj * HALF + n * 16) = bs + acc[ai][bj][m][n]; }
                }
    }
};

template <class Epi, class Sched, bool ALIGN_EPI = false, bool SP2 = false>
__device__ __forceinline__ void gemm_phase(PG8_LAS unsigned char* lds, const Gemm g, const Sched& S, const Epi& E) {
    const int tid = threadIdx.x, wid = __builtin_amdgcn_readfirstlane(tid >> 6), lane = tid & 63, wr = wid >> 2, wc = wid & 3, fr = lane & 15, fq = lane >> 4;
    const int K = g.K, nt = K / BK;
    unsigned voffA[2], voffB[2];
#pragma unroll
    for (int i = 0; i < 2; ++i) { int R, C; stage_rc(tid * 16 + i * 8192, R, C); const int Rb = Epi::PERM ? ((R & ~31) + perm32(R & 31)) : R;
        voffA[i] = (unsigned)(R * K + C) * 2u; voffB[i] = (unsigned)(Rb * K + C) * 2u; }
    const size_t kstep = (size_t)(BK * 2);
    const size_t hstep = (size_t)HALF * K * 2;
    const size_t tstep = 2 * hstep;
    const unsigned ldsw = (unsigned)wid * 1024u;
    const int aoff = lds_byte(wr * 64 + fr, fq * 8), boff = lds_byte(wc * 32 + fr, fq * 8);
#define PG8_SA(b, h) (((b) * 2 + (h)) * HTB)
#define PG8_SB(b, h) ((4 + (b) * 2 + (h)) * HTB)
#define PG8_STAGE(bufoff, gbase, voff) do { _Pragma("unroll") for (int _i = 0; _i < 2; ++_i) \
        __builtin_amdgcn_global_load_lds((const unsigned*)((const char*)(gbase) + (voff)[_i]), (PG8_LAS unsigned*)(lds + (bufoff) + ldsw + _i * 8192), 16, 0, 0); } while (0)
#define PG8_LDA(dst, b, h) do { _Pragma("unroll") for (int m = 0; m < 4; ++m) _Pragma("unroll") for (int k = 0; k < 2; ++k) dst[m][k] = *(const PG8_LAS bf16x8*)(lds + PG8_SA(b, h) + aoff + m * 2048 + k * 1024); } while (0)
#define PG8_LDB(dst, b, h) do { _Pragma("unroll") for (int n = 0; n < 2; ++n) _Pragma("unroll") for (int k = 0; k < 2; ++k) dst[n][k] = *(const PG8_LAS bf16x8*)(lds + PG8_SB(b, h) + boff + n * 2048 + k * 1024); } while (0)
#define PG8_MMA(ai, bj, At, Bt) do { __builtin_amdgcn_s_setprio(1); _Pragma("unroll") for (int m = 0; m < 4; ++m) _Pragma("unroll") for (int n = 0; n < 2; ++n) _Pragma("unroll") for (int k = 0; k < 2; ++k) \
        acc[ai][bj][m][n] = __builtin_amdgcn_mfma_f32_16x16x32_bf16(Bt[n][k], At[m][k], acc[ai][bj][m][n], 0, 0, 0); __builtin_amdgcn_s_setprio(0); } while (0)
#define PG8_WAIT_V(n) asm volatile("s_waitcnt vmcnt(" #n ")" ::: "memory")
#define PG8_WAIT_L(n) asm volatile("s_waitcnt lgkmcnt(" #n ")" ::: "memory")
#define PG8_BAR __builtin_amdgcn_s_barrier()
#define PG8_SCHED __builtin_amdgcn_sched_barrier(0)
    Unit cur, nxt; int ui = 0;
    if (!S.next(0, cur)) return;
    f32x4 acc[2][2][4][2];
#pragma unroll
    for (int a = 0; a < 2; ++a)
#pragma unroll
        for (int b = 0; b < 2; ++b)
#pragma unroll
            for (int m = 0; m < 4; ++m)
#pragma unroll
                for (int n = 0; n < 2; ++n) acc[a][b][m][n] = (f32x4){0.f, 0.f, 0.f, 0.f};
    bf16x8 At[4][2], B0[2][2], B1[2][2];
    const char* cA = (const char*)g.A + (size_t)cur.pm * tstep; const char* cB = (const char*)g.Bt + (size_t)cur.pn * tstep;
    S.a_ready(cur);
    if constexpr (SP2) {
        PG8_STAGE(PG8_SB(0, 0), cB, voffB); PG8_STAGE(PG8_SB(0, 1), cB + hstep, voffB); PG8_STAGE(PG8_SA(0, 0), cA, voffA); PG8_STAGE(PG8_SA(0, 1), cA + hstep, voffA);
        if (wr == 1) PG8_BAR;
        PG8_WAIT_V(2); PG8_BAR;
        PG8_STAGE(PG8_SB(1, 0), cB + kstep, voffB); PG8_STAGE(PG8_SA(1, 0), cA + kstep, voffA); PG8_STAGE(PG8_SB(1, 1), cB + hstep + kstep, voffB);
        PG8_WAIT_V(6); PG8_BAR;
    } else {
        PG8_STAGE(PG8_SB(0, 0), cB, voffB); PG8_STAGE(PG8_SA(0, 0), cA, voffA); PG8_STAGE(PG8_SB(0, 1), cB + hstep, voffB); PG8_STAGE(PG8_SA(0, 1), cA + hstep, voffA);
        if (wr == 1) PG8_BAR;
        PG8_WAIT_V(4); PG8_BAR;
        PG8_STAGE(PG8_SB(1, 0), cB + kstep, voffB); PG8_STAGE(PG8_SA(1, 0), cA + kstep, voffA); PG8_STAGE(PG8_SB(1, 1), cB + hstep + kstep, voffB);
        PG8_WAIT_V(6); PG8_BAR;
    }
    for (;;) {
        const bool has_next = S.next(ui + 1, nxt);
        const char* nA = has_next ? (const char*)g.A + (size_t)nxt.pm * tstep : cA; const char* nB = has_next ? (const char*)g.Bt + (size_t)nxt.pn * tstep : cB;
        for (int t = 0; t < nt; t += 2) {
            const bool last = (t == nt - 2);
            const char* a1 = cA + (size_t)(t + 1) * kstep;
            const char* a2 = last ? nA : cA + (size_t)(t + 2) * kstep; const char* b2 = last ? nB : cB + (size_t)(t + 2) * kstep;
            const char* a3 = a2 + kstep; const char* b3 = b2 + kstep;
            if (last && has_next) S.a_ready(nxt);
            if constexpr (SP2) {
            PG8_LDB(B0, 0, 0); PG8_LDB(B1, 0, 1); PG8_SCHED; PG8_LDA(At, 0, 0); PG8_STAGE(PG8_SA(1, 1), a1 + hstep, voffA);
            PG8_WAIT_V(8); PG8_WAIT_L(0); PG8_BAR; PG8_MMA(0, 0, At, B0); PG8_MMA(0, 1, At, B1); PG8_BAR; PG8_SCHED;
            PG8_LDA(At, 0, 1); PG8_STAGE(PG8_SB(0, 0), b2, voffB); PG8_STAGE(PG8_SB(0, 1), b2 + hstep, voffB); PG8_STAGE(PG8_SA(0, 0), a2, voffA);
            PG8_WAIT_V(8); PG8_WAIT_L(0); PG8_BAR; PG8_MMA(1, 0, At, B0); PG8_MMA(1, 1, At, B1); PG8_BAR; PG8_SCHED;
            PG8_LDB(B0, 1, 0); PG8_LDB(B1, 1, 1); PG8_SCHED; PG8_LDA(At, 1, 0); PG8_STAGE(PG8_SA(0, 1), a2 + hstep, voffA);
            PG8_WAIT_V(8); PG8_WAIT_L(0); PG8_BAR; PG8_MMA(0, 0, At, B0); PG8_MMA(0, 1, At, B1); PG8_BAR; PG8_SCHED;
            PG8_LDA(At, 1, 1); PG8_STAGE(PG8_SB(1, 0), b3, voffB); PG8_STAGE(PG8_SB(1, 1), b3 + hstep, voffB); PG8_STAGE(PG8_SA(1, 0), a3, voffA);
            PG8_WAIT_V(8); PG8_WAIT_L(0); PG8_BAR; PG8_MMA(1, 0, At, B0); PG8_MMA(1, 1, At, B1); PG8_BAR; PG8_SCHED;
            } else {
            PG8_LDB(B0, 0, 0); PG8_SCHED; PG8_LDA(At, 0, 0); PG8_STAGE(PG8_SA(1, 1), a1 + hstep, voffA);
            PG8_WAIT_L(8); PG8_BAR; PG8_WAIT_L(0); PG8_MMA(0, 0, At, B0); PG8_BAR; PG8_SCHED;
            PG8_LDB(B1, 0, 1); PG8_STAGE(PG8_SB(0, 0), b2, voffB);
            PG8_BAR; PG8_WAIT_L(0); PG8_MMA(0, 1, At, B1); PG8_BAR;
            PG8_LDA(At, 0, 1); PG8_STAGE(PG8_SA(0, 0), a2, voffA);
            PG8_BAR; PG8_WAIT_L(0); PG8_MMA(1, 0, At, B0); PG8_BAR; PG8_SCHED;
            PG8_STAGE(PG8_SB(0, 1), b2 + hstep, voffB);
            PG8_WAIT_V(6); PG8_BAR; PG8_MMA(1, 1, At, B1); PG8_BAR;
            PG8_LDB(B0, 1, 0); PG8_SCHED; PG8_LDA(At, 1, 0); PG8_STAGE(PG8_SA(0, 1), a2 + hstep, voffA);
            PG8_WAIT_L(8); PG8_BAR; PG8_WAIT_L(0); PG8_MMA(0, 0, At, B0); PG8_BAR; PG8_SCHED;
            PG8_LDB(B1, 1, 1); PG8_STAGE(PG8_SB(1, 0), b3, voffB);
            PG8_BAR; PG8_WAIT_L(0); PG8_MMA(0, 1, At, B1); PG8_BAR;
            PG8_LDA(At, 1, 1); PG8_STAGE(PG8_SA(1, 0), a3, voffA);
            PG8_BAR; PG8_WAIT_L(0); PG8_MMA(1, 0, At, B0); PG8_BAR; PG8_SCHED;
            PG8_STAGE(PG8_SB(1, 1), b3 + hstep, voffB);
            PG8_WAIT_V(6); PG8_BAR; PG8_MMA(1, 1, At, B1); PG8_BAR;
            }
        }
        if constexpr (ALIGN_EPI) { if (wr == 0) PG8_BAR; }
        if constexpr (!Epi::AFTER_DRAIN) { E(acc, cur, wr, wc, fr, fq); S.done(cur); }
        if (!has_next) break;
#pragma unroll
        for (int a = 0; a < 2; ++a)
#pragma unroll
            for (int b = 0; b < 2; ++b)
#pragma unroll
                for (int m = 0; m < 4; ++m)
#pragma unroll
                    for (int n = 0; n < 2; ++n) acc[a][b][m][n] = (f32x4){0.f, 0.f, 0.f, 0.f};
        cur = nxt; cA = nA; cB = nB; ++ui;
        if constexpr (ALIGN_EPI) { if (wr == 1) PG8_BAR; }
    }
    PG8_WAIT_V(0);
    if constexpr (!ALIGN_EPI) { if (wr == 0) PG8_BAR; }
    PG8_BAR;
    if constexpr (Epi::AFTER_DRAIN) { E.fused(acc, cur, wr, wc, fr, fq, lds, wid, lane); S.done(cur); }
#undef PG8_SA
#undef PG8_SB
#undef PG8_STAGE
#undef PG8_LDA
#undef PG8_LDB
#undef PG8_MMA
#undef PG8_WAIT_V
#undef PG8_WAIT_L
#undef PG8_BAR
#undef PG8_SCHED
}
}

#define LAS __attribute__((address_space(3)))
typedef unsigned short bf16;
typedef unsigned v4u __attribute__((ext_vector_type(4)));
typedef unsigned v2u __attribute__((ext_vector_type(2)));
typedef float f32x4 __attribute__((ext_vector_type(4)));
__device__ __forceinline__ unsigned pk2(float lo, float hi) { return pg8::cvt_pk_bf16(lo, hi); }
__device__ __forceinline__ float bf2f(unsigned short b) { return __uint_as_float(((unsigned)b) << 16); }
__device__ __forceinline__ float bflo(unsigned w) { return __uint_as_float(w << 16); }
__device__ __forceinline__ float bfhi(unsigned w) { return __uint_as_float(w & 0xffff0000u); }
__device__ __forceinline__ float wave_sum(float v) {
#pragma unroll
    for (int o = 1; o < 64; o <<= 1) v += __shfl_xor(v, o);
    return v;
}
__device__ __forceinline__ float wave_max(float v) {
#pragma unroll
    for (int o = 1; o < 64; o <<= 1) v = fmaxf(v, __shfl_xor(v, o));
    return v;
}

__device__ __forceinline__ void transpose_tile(const float* W, size_t ldw, int K, int k0, int n0, bf16* WT, int nbase, LAS unsigned* scr, int lane) {
    const int g = lane & 15, ks = lane >> 4;
#pragma unroll
    for (int i = 0; i < 8; ++i) {
        const int k = k0 + 8 * i + 2 * ks;
        const f32x4 a = *(const f32x4*)(W + (size_t)k * ldw + n0 + 4 * g), b = *(const f32x4*)(W + (size_t)(k + 1) * ldw + n0 + 4 * g);
#pragma unroll
        for (int j = 0; j < 4; ++j) scr[(4 * g + j) * 33 + 4 * i + ks] = pk2(a[j], b[j]);
    }
    asm volatile("s_waitcnt lgkmcnt(0)" ::: "memory");
    const int c = lane & 7;
#pragma unroll
    for (int r = 0; r < 8; ++r) { const int n = 8 * r + (lane >> 3);
        v4u o; o.x = scr[n * 33 + 4 * c]; o.y = scr[n * 33 + 4 * c + 1]; o.z = scr[n * 33 + 4 * c + 2]; o.w = scr[n * 33 + 4 * c + 3];
        *(v4u*)(WT + (size_t)(n0 - nbase + n) * K + k0 + 8 * c) = o; }
    asm volatile("s_waitcnt lgkmcnt(0)" ::: "memory");
}
__device__ __forceinline__ void rms_row_bf16(const float* xrow, const float* w, bf16* orow, int lane) {
    const f32x4* xr = (const f32x4*)xrow + lane; const f32x4* wr = (const f32x4*)w + lane;
    f32x4 v[16]; float s = 0.f;
#pragma unroll
    for (int j = 0; j < 16; ++j) { v[j] = xr[64 * j]; s += (v[j].x * v[j].x + v[j].y * v[j].y) + (v[j].z * v[j].z + v[j].w * v[j].w); }
    const float rs = 1.0f / sqrtf(wave_sum(s) * (1.0f / D) + EPS);
    v2u* o8 = (v2u*)orow + lane;
#pragma unroll
    for (int j = 0; j < 16; ++j) { const f32x4 g = wr[64 * j]; v2u o; o.x = pk2(v[j].x * rs * g.x, v[j].y * rs * g.y); o.y = pk2(v[j].z * rs * g.z, v[j].w * rs * g.w); o8[64 * j] = o; }
}
__device__ __forceinline__ void rms_row_f32(const float* xrow, const float* w, float* orow, int lane) {
    const f32x4* xr = (const f32x4*)xrow + lane; const f32x4* wr = (const f32x4*)w + lane;
    f32x4 v[16]; float s = 0.f;
#pragma unroll
    for (int j = 0; j < 16; ++j) { v[j] = xr[64 * j]; s += (v[j].x * v[j].x + v[j].y * v[j].y) + (v[j].z * v[j].z + v[j].w * v[j].w); }
    const float rs = 1.0f / sqrtf(wave_sum(s) * (1.0f / D) + EPS);
    f32x4* o = (f32x4*)orow + lane;
#pragma unroll
    for (int j = 0; j < 16; ++j) { const f32x4 g = wr[64 * j]; o[64 * j] = (f32x4){v[j].x * rs * g.x, v[j].y * rs * g.y, v[j].z * rs * g.z, v[j].w * rs * g.w}; }
}

constexpr size_t MiB = 1u << 20;
constexpr size_t WS_CTL = 0;
constexpr size_t WS_WA  = 1 * MiB;
constexpr size_t WS_WB  = WS_WA + 256 * MiB;
constexpr size_t WS_WF  = WS_WB + 256 * MiB;
constexpr size_t WS_WOA = WS_WF + 1 * MiB;
constexpr size_t WS_WOB = WS_WOA + 64 * MiB;
constexpr size_t WS_HB  = WS_WOB + 64 * MiB;
constexpr size_t WS_X1  = WS_HB + 64 * MiB;
constexpr size_t WS_P   = WS_X1 + 128 * MiB;
constexpr size_t WS_Y   = WS_P + 512 * MiB;
constexpr size_t WS_LS  = WS_Y + 128 * MiB;
constexpr size_t WS_END = WS_LS + 2 * MiB;

#ifndef CONV_P0_PCT
#define CONV_P0_PCT 0
#endif
__device__ __forceinline__ void prologue_phase(LAS unsigned char* lds, int part, const float* x, const float* norm_w, const float* w_in_a, const float* w_out_a, const float* w_in_b, const float* w_out_b,
                                               unsigned char* ws, int vcu, int G, int wave, int lane) {
    LAS unsigned* scr = (LAS unsigned*)(lds + wave * 8448);
    const int gw = vcu * 8 + wave, NGW = G * 8;
    bf16* WA = (bf16*)(ws + WS_WA); bf16* WB = (bf16*)(ws + WS_WB); bf16* WF = (bf16*)(ws + WS_WF); bf16* WOA = (bf16*)(ws + WS_WOA); bf16* WOB = (bf16*)(ws + WS_WOB);
    constexpr int T_IN = (D / 64) * (LDP / 64);
    constexpr int T_F = (D / 64) * 1;
    constexpr int T_OUT = (DI / 64) * (D / 64);
    constexpr int T_DEF = T_OUT + T_IN + T_F + T_OUT, SPLIT = (int)((long)T_DEF * CONV_P0_PCT / 100);
    if (part == 0) {
        for (int it = gw; it < T_IN; it += NGW) { const int kb = it / (LDP / 64), nb = it % (LDP / 64); transpose_tile(w_in_a, LDP, D, kb * 64, nb * 64, WA, 0, scr, lane); }
        bf16* HB = (bf16*)(ws + WS_HB);
        for (int m = gw; m < M; m += NGW) rms_row_bf16(x + (size_t)m * D, norm_w, HB + (size_t)m * D, lane);
    }
    {
        const int i0 = (part == 0) ? 0 : SPLIT, i1 = (part == 0) ? SPLIT : T_DEF;
        for (int it = i0 + gw; it < i1; it += NGW) {
            int r = it;
            if (r < T_OUT) { const int kb = r / (D / 64), nb = r % (D / 64); transpose_tile(w_out_a, D, DI, kb * 64, nb * 64, WOA, 0, scr, lane); continue; } r -= T_OUT;
            if (r < T_OUT) { const int kb = r / (D / 64), nb = r % (D / 64); transpose_tile(w_out_b, D, DI, kb * 64, nb * 64, WOB, 0, scr, lane); continue; } r -= T_OUT;
            if (r < T_F) { transpose_tile(w_in_b, NWB, D, r * 64, LDP, WF, LDP, scr, lane); continue; } r -= T_F;
            { const int kb = r / (LDP / 64), nb = r % (LDP / 64); transpose_tile(w_in_b, NWB, D, kb * 64, nb * 64, WB, 0, scr, lane); }
        }
    }
}

namespace scan {
typedef short s16x4 __attribute__((ext_vector_type(4)));
typedef short bf16x8 __attribute__((ext_vector_type(8)));
typedef float f32x4 __attribute__((ext_vector_type(4)));
typedef unsigned u32x2 __attribute__((ext_vector_type(2)));
#ifndef SCAN_STAGGER
#define SCAN_STAGGER 1
#endif
constexpr int R = 8, NSTEP = SEQ / 16;
constexpr int RAW = 0, PRD = R * 16384, PRD_SZ = 3 * 4096 + 512, QDT = 0, KIT = 4096, KE = 8192, DEC = 12288, SSQ = PRD + 2 * PRD_SZ, LDS_BYTES = SSQ + 1024;
__device__ __forceinline__ s16x4 trd(LAS const unsigned char* p) { return __builtin_bit_cast(s16x4, __builtin_amdgcn_ds_read_tr16_b64_v4i16((LAS s16x4*)p)); }
__device__ __forceinline__ s16x4 pk4(float a, float b, float c, float d) { u32x2 w; w.x = pk2(a, b); w.y = pk2(c, d); return __builtin_bit_cast(s16x4, w); }
__device__ __forceinline__ bf16x8 cat8(s16x4 a, s16x4 b) { return __builtin_shufflevector(a, b, 0, 1, 2, 3, 4, 5, 6, 7); }
#define SC_BAR() do { asm volatile("" ::: "memory"); __builtin_amdgcn_s_barrier(); asm volatile("" ::: "memory"); } while (0)

__device__ __forceinline__ void scan_unit(LAS unsigned char* lds, const bf16* __restrict__ P, const float* __restrict__ onw, bf16* __restrict__ Y, int bh) {
    const int tid = threadIdx.x, wid = __builtin_amdgcn_readfirstlane(tid >> 6), lane = tid & 63, n = lane & 15, g = lane >> 4, tq = n >> 2, tp = n & 3;
    const int b = bh / NH, h = bh % NH;
    const bf16* base = P + (size_t)(b * NH + h) * SEQ * HD;
    size_t goff[2]; int ldst[2];
#pragma unroll
    for (int ii = 0; ii < 2; ++ii) { const int i = 2 * wid + ii, ti = i >> 2, rg = i & 3, row = 4 * rg + (lane >> 4), pc = lane & 15, c = pc ^ ((row & 7) << 1);
        const int sec = (ti == 0) ? 1 : ((ti == 1) ? 0 : ti);
        goff[ii] = (size_t)row * HD + (size_t)sec * ((size_t)NB * NH * SEQ * HD) + c * 8; ldst[ii] = ti * 4096 + rg * 1024; }
#define SC_DMA(step) do { const int st_ = (step) < NSTEP ? (step) : NSTEP - 1; const int sl_ = ((step) & (R - 1)) * 16384; _Pragma("unroll") for (int ii = 0; ii < 2; ++ii) \
        __builtin_amdgcn_global_load_lds((const unsigned*)(base + (size_t)st_ * 16 * HD + goff[ii]), (LAS unsigned*)(lds + RAW + sl_ + ldst[ii]), 16, 0, 0); } while (0)
    const int rrow = 4 * g + tq;
    const int rtr = rrow * 256 + ((2 * wid + (tp >> 1)) ^ ((rrow & 7) << 1)) * 16 + 8 * (tp & 1);
    const int rsg = n * 256 + ((2 * wid + (g >> 1)) ^ ((n & 7) << 1)) * 16 + 8 * (g & 1);
    const int wq = (16 * wid + n) * 32 + g * 8;
    const int wk = (g >> 1) * 2048 + (16 * wid + n) * 16 + (g & 1) * 8;
    const int rqt = (4 * g + tq) * 32 + 8 * tp;
    const int rke = (g >> 1) * 2048 + n * 16 + (g & 1) * 8;
    const int rdec = (4 * g) * 4;
    s16x4 ltri; { short one = (short)0x3F80; ltri[0] = (4 * g + 0 <= n) ? one : (short)0; ltri[1] = (4 * g + 1 <= n) ? one : (short)0; ltri[2] = (4 * g + 2 <= n) ? one : (short)0; ltri[3] = (4 * g + 3 <= n) ? one : (short)0; }
    f32x4 gain = *(const f32x4*)(onw + h * HD + 16 * wid + 4 * g);
    asm volatile("" : "+v"(gain[0]), "+v"(gain[1]), "+v"(gain[2]), "+v"(gain[3]));
    f32x4 S[8];
#pragma unroll
    for (int t = 0; t < 8; ++t) S[t] = (f32x4){0.f, 0.f, 0.f, 0.f};
    f32x4 oprev = (f32x4){0.f, 0.f, 0.f, 0.f};
#define SC_PREP(s_) do { const LAS unsigned char* raw_ = lds + RAW + ((s_) & (R - 1)) * 16384; LAS unsigned char* img_ = lds + PRD + ((s_) & 1) * PRD_SZ; \
        const s16x4 lfB = trd(raw_ + rtr), qsB = trd(raw_ + 4096 + rtr); \
        const f32x4 G = __builtin_amdgcn_mfma_f32_16x16x16bf16_1k(ltri, lfB, (f32x4){0.f, 0.f, 0.f, 0.f}, 0, 0, 0); \
        const float dec_ = __builtin_amdgcn_exp2f(__shfl(G[3], 48 + n)); \
        float qd[4], ki[4], ke[4]; \
        _Pragma("unroll") for (int j = 0; j < 4; ++j) { const float lf = bf2f((unsigned short)lfB[j]), qs = bf2f((unsigned short)qsB[j]); \
            const float E = __builtin_amdgcn_exp2f(G[j]), Ei = __builtin_amdgcn_exp2f(-G[j]); \
            const float kk = 1.0f - __builtin_amdgcn_exp2f(lf); \
            qd[j] = qs * E; ki[j] = kk * Ei; ke[j] = ki[j] * dec_; } \
        *(LAS s16x4*)(img_ + QDT + wq) = pk4(qd[0], qd[1], qd[2], qd[3]); \
        *(LAS s16x4*)(img_ + KIT + wq) = pk4(ki[0], ki[1], ki[2], ki[3]); \
        *(LAS s16x4*)(img_ + KE + wk) = pk4(ke[0], ke[1], ke[2], ke[3]); \
        if (g == 0) *(LAS float*)(img_ + DEC + (16 * wid + n) * 4) = dec_; } while (0)
#define SC_OUT(s_) do { const LAS unsigned char* rawp = lds + RAW + ((s_) & (R - 1)) * 16384; const LAS unsigned char* sq = lds + SSQ + ((s_) & 1) * 512 + n * 32; \
        const f32x4 a = *(const LAS f32x4*)sq, c = *(const LAS f32x4*)(sq + 16); \
        const float tot = ((a[0] + a[1]) + (a[2] + a[3])) + ((c[0] + c[1]) + (c[2] + c[3])); \
        const float rs = __builtin_amdgcn_rsqf(tot * (1.0f / HD) + EPS); \
        const s16x4 sgv = *(const LAS s16x4*)(rawp + 3 * 4096 + rsg); \
        const float y0 = oprev[0] * rs * gain[0] * bf2f((unsigned short)sgv[0]), y1 = oprev[1] * rs * gain[1] * bf2f((unsigned short)sgv[1]); \
        const float y2 = oprev[2] * rs * gain[2] * bf2f((unsigned short)sgv[2]), y3 = oprev[3] * rs * gain[3] * bf2f((unsigned short)sgv[3]); \
        u32x2 w; w.x = pk2(y0, y1); w.y = pk2(y2, y3); \
        *(u32x2*)(Y + (size_t)(b * SEQ + 16 * (s_) + n) * DI + h * HD + 16 * wid + 4 * g) = w; } while (0)
    SC_DMA(0); SC_DMA(1); SC_DMA(2); SC_DMA(3); SC_DMA(4); SC_DMA(5);
    asm volatile("s_waitcnt vmcnt(10)" ::: "memory");
    SC_BAR();
    SC_PREP(0);
    for (int st = 0; st < NSTEP; ++st) {
        asm volatile("s_waitcnt vmcnt(8) lgkmcnt(0)" ::: "memory");
        SC_BAR();
        SC_DMA(st + 6);
        if (SCAN_STAGGER && wid >= 4 && st + 1 < NSTEP) SC_PREP(st + 1);
        if (st > 0) SC_OUT(st - 1);
        {
            const LAS unsigned char* raw = lds + RAW + (st & (R - 1)) * 16384; const LAS unsigned char* img = lds + PRD + (st & 1) * PRD_SZ;
            s16x4 qf[8], kf[8];
#pragma unroll
            for (int t = 0; t < 8; ++t) { qf[t] = trd(img + QDT + rqt + 512 * t); kf[t] = trd(img + KIT + rqt + 512 * t); }
            const s16x4 vf = trd(raw + 2 * 4096 + rtr);
            f32x4 sc = (f32x4){0.f, 0.f, 0.f, 0.f};
#pragma unroll
            for (int u = 0; u < 4; ++u) sc = __builtin_amdgcn_mfma_f32_16x16x32_bf16(cat8(kf[2 * u], kf[2 * u + 1]), cat8(qf[2 * u], qf[2 * u + 1]), sc, 0, 0, 0);
#pragma unroll
            for (int j = 0; j < 4; ++j) sc[j] = (4 * g + j <= n) ? sc[j] : 0.f;
            f32x4 o = (f32x4){0.f, 0.f, 0.f, 0.f};
#pragma unroll
            for (int u = 0; u < 4; ++u) { const s16x4 s0 = pk4(S[2 * u][0], S[2 * u][1], S[2 * u][2], S[2 * u][3]), s1 = pk4(S[2 * u + 1][0], S[2 * u + 1][1], S[2 * u + 1][2], S[2 * u + 1][3]);
                o = __builtin_amdgcn_mfma_f32_16x16x32_bf16(cat8(s0, s1), cat8(qf[2 * u], qf[2 * u + 1]), o, 0, 0, 0); }
            o = __builtin_amdgcn_mfma_f32_16x16x16bf16_1k(vf, pk4(sc[0], sc[1], sc[2], sc[3]), o, 0, 0, 0);
#pragma unroll
            for (int t = 0; t < 8; ++t) { const s16x4 kef = *(const LAS s16x4*)(img + KE + rke + 256 * t); const f32x4 dv = *(const LAS f32x4*)(img + DEC + rdec + 64 * t);
                S[t] = __builtin_amdgcn_mfma_f32_16x16x16bf16_1k(kef, vf, S[t] * dv, 0, 0, 0); }
            float ss = (o[0] * o[0] + o[1] * o[1]) + (o[2] * o[2] + o[3] * o[3]);
            ss += __shfl_xor(ss, 16); ss += __shfl_xor(ss, 32);
            if (g == 0) *(LAS float*)(lds + SSQ + (st & 1) * 512 + (n * 8 + wid) * 4) = ss;
            oprev = o;
        }
        if ((!SCAN_STAGGER || wid < 4) && st + 1 < NSTEP) SC_PREP(st + 1);
    }
    asm volatile("s_waitcnt lgkmcnt(0)" ::: "memory");
    SC_BAR();
    SC_OUT(NSTEP - 1);
    asm volatile("s_waitcnt vmcnt(0) lgkmcnt(0)" ::: "memory");
    SC_BAR();
#undef SC_DMA
#undef SC_PREP
#undef SC_OUT
}
#undef SC_BAR
}

namespace fox {
enum { ORDER_NATURAL = 0, ORDER_REVERSED = 1, ORDER_PAIRED = 2, ORDER_XCD = 4 };
constexpr int B = NB, H = NH, HKV = NH, SQ = SEQ, SKV = SEQ, D = HD, QOFF = 0, WINDOW = SEQ;
constexpr int LDQ = HD, LDO = DI;
constexpr size_t SECSZ = (size_t)NB * NH * SEQ * HD;
constexpr float THR = 8.f;
constexpr int ORDER = ORDER_PAIRED | ORDER_XCD;
constexpr bool WSKIP = false;
constexpr float ISCALE = 11.313708498984761f;
constexpr int STG_ROW = 272;
constexpr float SCALE = 0.08838834764831845f;
constexpr int NW = 8, QBLK = 32, KVBLK = 64, QB = NW * QBLK;
constexpr int SHM_V = KVBLK * D * 2, SHM_K = KVBLK * D * 2;
constexpr int LDS_BYTES = 2 * SHM_V + 2 * SHM_K + NW * 64 * 4;
constexpr int C_OFF = LDS_BYTES, STG_OFF = C_OFF + SEQ * 4;
static_assert(D == 128 && SQ % QB == 0 && SKV % KVBLK == 0 && H % HKV == 0 && QOFF >= 0 && QOFF + SQ <= SKV && WINDOW >= 1, "geometry");

using bf16 = unsigned short;
typedef short bf16x8 __attribute__((ext_vector_type(8)));
typedef short s16x4 __attribute__((ext_vector_type(4)));
typedef float f32x16 __attribute__((ext_vector_type(16)));
typedef float f32x4 __attribute__((ext_vector_type(4)));
typedef unsigned u32x4 __attribute__((ext_vector_type(4)));
template <class A, class Bt> struct same_t { static constexpr bool v = false; };
template <class A> struct same_t<A, A> { static constexpr bool v = true; };

#define KSWZ(row, colB) ((row) * 256 + ((colB) ^ (((row) & 7) << 4)))
#define SBAR() __builtin_amdgcn_sched_barrier(0)
__device__ __forceinline__ int v_st(int k, int c) { const int kk = (k & ~0xC) | ((k & 4) << 1) | ((k & 8) >> 1); return ((kk >> 3) * 4 + (c >> 5)) * 512 + ((kk & 7) * 32 + (c & 31)) * 2; }
__device__ __forceinline__ int v_rd_base(int lane) { return ((lane & 3) << 3) | (((lane >> 2) & 3) << 6) | (((lane >> 4) & 1) << 5) | (((lane >> 5) & 1) << 8); }
constexpr int v_rd_off(int d0, int ks, int half) { return d0 * 512 + ks * 4096 + half * 2048; }
__device__ __forceinline__ int crow(int r, int hi) { return (r & 3) + 8 * (r >> 2) + 4 * hi; }
__device__ __forceinline__ unsigned cvtpk(float lo, float hi) {
    return pg8::cvt_pk_bf16(lo, hi);
}
__device__ __forceinline__ bf16x8 pack8(f32x4 a, f32x4 b) {
    u32x4 w = {cvtpk(a[0], a[1]), cvtpk(a[2], a[3]), cvtpk(b[0], b[1]), cvtpk(b[2], b[3])};
    return *reinterpret_cast<bf16x8*>(&w);
}
template <class T> __device__ __forceinline__ bf16x8 load8(const T* p) {
    if constexpr (same_t<T, float>::v) { return pack8(*(const f32x4*)p, *(const f32x4*)(p + 4)); }
    else { return *reinterpret_cast<const bf16x8*>(p); }
}
__device__ __forceinline__ void mask_tile(f32x16& p0, f32x16& p1, int dq, unsigned W) {
    const float NEG = -__builtin_inff();
#pragma unroll
    for (int r = 0; r < 16; ++r) {
        const int c = (r & 3) + 8 * (r >> 2);
        if ((unsigned)(dq - c) >= W) p0[r] = NEG;
        if ((unsigned)(dq - c - 32) >= W) p1[r] = NEG;
    }
}
__device__ __forceinline__ void partialSM(f32x16& p0, f32x16& p1, float mnL) {
    constexpr float C2 = 1.4426950408889634f * SCALE;
    for (int r = 0; r < 16; ++r) p0[r] = fmaf(p0[r], C2, mnL); for (int r = 0; r < 16; ++r) p1[r] = fmaf(p1[r], C2, mnL);
    for (int r = 0; r < 16; ++r) p0[r] = __builtin_amdgcn_exp2f(p0[r]);
}
__device__ __forceinline__ void finishSM(f32x16& p0, f32x16& p1, float& l_reg, bf16x8& pa0, bf16x8& pa1, bf16x8& pa2, bf16x8& pa3) {
    for (int r = 0; r < 16; ++r) p1[r] = __builtin_amdgcn_exp2f(p1[r]);
    float ps = 0; for (int r = 0; r < 16; ++r) ps += p0[r]; for (int r = 0; r < 16; ++r) ps += p1[r];
    { auto rr = __builtin_amdgcn_permlane32_swap(__float_as_uint(ps), __float_as_uint(ps), false, false);
      ps = __uint_as_float(rr[0]) + __uint_as_float(rr[1]); }
    l_reg += ps;
#define PK4(P, B_, OUT) do { unsigned a0 = cvtpk(P[B_+0], P[B_+1]), a1 = cvtpk(P[B_+2], P[B_+3]);                          \
        unsigned b0 = cvtpk(P[B_+4], P[B_+5]), b1 = cvtpk(P[B_+6], P[B_+7]);                                             \
        auto r0 = __builtin_amdgcn_permlane32_swap(a0, b0, false, false); auto r1 = __builtin_amdgcn_permlane32_swap(a1, b1, false, false); \
        u32x4 w = {r0[0], r1[0], r0[1], r1[1]}; OUT = *reinterpret_cast<bf16x8*>(&w); } while (0)
    PK4(p0, 0, pa0); PK4(p0, 8, pa1); PK4(p1, 0, pa2); PK4(p1, 8, pa3);
#undef PK4
}
__device__ __forceinline__ void bias_tile(f32x16& p0, f32x16& p1, const float* cl, int kb, int hi) {
    const f32x4* cp = (const f32x4*)(cl + kb + 4 * hi);
#pragma unroll
    for (int j = 0; j < 4; ++j) { const f32x4 c0 = cp[2 * j], c1 = cp[8 + 2 * j];
#pragma unroll
        for (int e = 0; e < 4; ++e) { p0[4 * j + e] = fmaf(c0[e], -ISCALE, p0[4 * j + e]); p1[4 * j + e] = fmaf(c1[e], -ISCALE, p1[4 * j + e]); } }
}
template <int KB, bool SK>
__device__ __forceinline__ void qkt(f32x16& p0, f32x16& p1, const char* K_lds, int r32, int hi, const bf16x8* qr, bool act) {
    if (SK && !act) { const float NEG = -__builtin_inff();
#pragma unroll
        for (int r = 0; r < 16; ++r) { p0[r] = NEG; p1[r] = NEG; } return; }
    p0 = f32x16{}; p1 = f32x16{};
    const char* kb[4];
#pragma unroll
    for (int dd = 0; dd < 4; ++dd) kb[dd] = K_lds + KB * SHM_K + KSWZ(r32, (dd * 16 + hi * 8) * 2);
#pragma unroll
    for (int d0 = 0; d0 < 8; ++d0) { const char* a = kb[d0 & 3] + (d0 >> 2) * 128;
        bf16x8 b0 = *reinterpret_cast<const bf16x8*>(a);
        bf16x8 b1 = *reinterpret_cast<const bf16x8*>(a + 32 * 256);
        p0 = __builtin_amdgcn_mfma_f32_32x32x16_bf16(b0, qr[d0], p0, 0, 0, 0);
        p1 = __builtin_amdgcn_mfma_f32_32x32x16_bf16(b1, qr[d0], p1, 0, 0, 0); }
}
template <int VB, bool SK>
__device__ __forceinline__ void pv_tile(f32x16* o, int vb0, bf16x8 pa0, bf16x8 pa1, bf16x8 pa2, bf16x8 pa3, bool act) {
    if (SK && !act) return;
#define TRRD(dst, off) asm volatile("ds_read_b64_tr_b16 %0, %1 offset:%2" : "=&v"(dst) : "v"(vb0), "i"(off) : "memory")
#define PV_D0(d0) do { s16x4 l0, l1, l2, l3, h0, h1, h2, h3; constexpr int b_ = VB * SHM_V + v_rd_off(d0, 0, 0);     \
        TRRD(l0, b_); TRRD(h0, b_ + 2048); TRRD(l1, b_ + 4096); TRRD(h1, b_ + 6144); TRRD(l2, b_ + 8192); TRRD(h2, b_ + 10240); TRRD(l3, b_ + 12288); TRRD(h3, b_ + 14336); \
        asm volatile("s_waitcnt lgkmcnt(0)" ::: "memory"); SBAR();                 \
        o[d0] = __builtin_amdgcn_mfma_f32_32x32x16_bf16(pa0, (bf16x8){l0[0], l0[1], l0[2], l0[3], h0[0], h0[1], h0[2], h0[3]}, o[d0], 0, 0, 0);   \
        o[d0] = __builtin_amdgcn_mfma_f32_32x32x16_bf16(pa1, (bf16x8){l1[0], l1[1], l1[2], l1[3], h1[0], h1[1], h1[2], h1[3]}, o[d0], 0, 0, 0);   \
        o[d0] = __builtin_amdgcn_mfma_f32_32x32x16_bf16(pa2, (bf16x8){l2[0], l2[1], l2[2], l2[3], h2[0], h2[1], h2[2], h2[3]}, o[d0], 0, 0, 0);   \
        o[d0] = __builtin_amdgcn_mfma_f32_32x32x16_bf16(pa3, (bf16x8){l3[0], l3[1], l3[2], l3[3], h3[0], h3[1], h3[2], h3[3]}, o[d0], 0, 0, 0); } while (0)
    PV_D0(0); PV_D0(1); PV_D0(2); PV_D0(3);
#undef PV_D0
#undef TRRD
}

template <class TIn, class TOut> struct BlockRef { const TIn* Q; const TIn* K; const TIn* V; const TIn* G; TOut* O; int P0; };
template <class TIn> struct Seam {
    bf16x8 qr[8];
    bf16x8 st_v0, st_v1, st_k0, st_k1; f32x4 sf0, sf1, sf2, sf3;
    f32x4 tq[16];
};
__device__ __forceinline__ int swa_jlo(int P0, int W) { const int lowk = P0 - W + 1; return lowk > 0 ? lowk / KVBLK : 0; }
__device__ __forceinline__ int swa_jhi(int P0, int skv) { int j = (P0 + QB - 1) / KVBLK + 1; return j > skv / KVBLK ? skv / KVBLK : j; }
#define ROW(p, k0, rr) ((p) + (size_t)((k0) + (rr)) * LDQ + sc)
#define VMW() asm volatile("s_waitcnt vmcnt(0)" ::: "memory")
#define VMWN(n) asm volatile("s_waitcnt vmcnt(%0)" :: "i"(n) : "memory")
#define SLOAD_H(Kp, Vp, k0) do { const char* kb__ = (const char*)((Kp) + (size_t)(k0) * LDQ); const char* vb__ = (const char*)((Vp) + (size_t)(k0) * LDQ);     \
                         S.st_v0 = *(const bf16x8*)(vb__ + svoff); S.st_v1 = *(const bf16x8*)(vb__ + (size_t)32 * LDQ * 2 + svoff);              \
                         S.st_k0 = *(const bf16x8*)(kb__ + svoff); S.st_k1 = *(const bf16x8*)(kb__ + (size_t)32 * LDQ * 2 + svoff); } while (0)
#define SWRITE_HK(bf) do { *(bf16x8*)(K_lds + (bf) * SHM_K + kws) = S.st_k0; *(bf16x8*)(K_lds + (bf) * SHM_K + kws + 32 * 256) = S.st_k1; } while (0)
#define SWRITE_HV(bf) do { *(bf16x8*)(V_lds + (bf) * SHM_V + vst0) = S.st_v0; *(bf16x8*)(V_lds + (bf) * SHM_V + vst1) = S.st_v1; } while (0)
#define SWRITE_H(bf) do { SWRITE_HV(bf); SWRITE_HK(bf); } while (0)
#define SLOAD_F(p, k0) do { S.sf0 = *(const f32x4*)ROW(p, k0, sr); S.sf1 = *(const f32x4*)(ROW(p, k0, sr) + 4);                \
                            S.sf2 = *(const f32x4*)ROW(p, k0, 32 + sr); S.sf3 = *(const f32x4*)(ROW(p, k0, 32 + sr) + 4); } while (0)
#define SWRITE_KF(bf) do { *(bf16x8*)(K_lds + (bf) * SHM_K + kws) = pack8(S.sf0, S.sf1); *(bf16x8*)(K_lds + (bf) * SHM_K + kws + 32 * 256) = pack8(S.sf2, S.sf3); } while (0)
#define SWRITE_VF(bf) do { *(bf16x8*)(V_lds + (bf) * SHM_V + vst0) = pack8(S.sf0, S.sf1); *(bf16x8*)(V_lds + (bf) * SHM_V + vst1) = pack8(S.sf2, S.sf3); } while (0)
template <class TIn, class TOut>
__device__ __forceinline__ void causal_swa_prime(const BlockRef<TIn, TOut>& cur, int skv, int W, char* lds, Seam<TIn>& S) {
    constexpr bool F32 = same_t<TIn, float>::v;
    const int tid = threadIdx.x, wid = __builtin_amdgcn_readfirstlane(tid >> 6), lane = tid & 63, r32 = lane & 31, hi = lane >> 5;
    const int sr = tid >> 4, sc = (tid & 15) * 8, kws = KSWZ(sr, sc * 2); char* K_lds = lds + 2 * SHM_V;
    const unsigned svoff = (unsigned)(sr * LDQ + sc) * 2u, qvoff = (unsigned)(r32 * LDQ + hi * 8) * 2u;
    const int kb0 = (swa_jhi(cur.P0, skv) - 1) * KVBLK; (void)W;
    for (int d0 = 0; d0 < 8; ++d0) S.qr[d0] = *(const bf16x8*)((const char*)(cur.Q + (size_t)(wid * QBLK) * LDQ) + d0 * 32 + qvoff);
    if constexpr (F32) { SLOAD_F((const float*)cur.K, kb0); VMW(); SWRITE_KF(0); SBAR(); SLOAD_F((const float*)cur.V, kb0); }
    else { SLOAD_H(cur.K, cur.V, kb0); VMW(); SWRITE_HK(0); }
    __syncthreads();
}
template <class TIn, class TOut>
__device__ __forceinline__ void causal_swa_block(const BlockRef<TIn, TOut>& cur, const BlockRef<TIn, TOut>& nxt, int skv, int W, char* lds, Seam<TIn>& S, float thr, float kn) {
    constexpr bool F32 = same_t<TIn, float>::v;
    const int tid = threadIdx.x, wid = __builtin_amdgcn_readfirstlane(tid >> 6), lane = tid & 63, r32 = lane & 31, hi = lane >> 5;
    int j_hi = (cur.P0 + QB - 1) / KVBLK + 1; if (j_hi > skv / KVBLK) j_hi = skv / KVBLK;
    const int kbn = (swa_jhi(nxt.P0, skv) - 1) * KVBLK;
    const int qlo = cur.P0 + wid * QBLK, qm = qlo + r32 - 4 * hi;
    char* V_lds = lds; char* K_lds = lds + 2 * SHM_V;
    const float* cl = (const float*)(lds + C_OFF);
    int j_lo; { const int lastk = 64 * lane + 63; const bool skip = (lastk < cur.P0) && (cl[cur.P0] - cl[lastk] < -thr);
        const unsigned long long keep = __ballot(!skip); j_lo = keep ? (int)__builtin_ctzll(keep) : 0; (void)W; }
    const int NT = j_hi - j_lo;
    float* ws = (float*)(lds + 2 * SHM_V + 2 * SHM_K) + wid * 64; float* li_l = ws, * al_l = ws + 32;
    float l_reg = 0; f32x16 o[4] = {};
    float mnL; { float q2 = 0.f;
#pragma unroll
        for (int d0 = 0; d0 < 8; ++d0)
#pragma unroll
            for (int j = 0; j < 8; ++j) { const float v = __uint_as_float(((unsigned)(unsigned short)S.qr[d0][j]) << 16); q2 = fmaf(v, v, q2); }
        { auto rr = __builtin_amdgcn_permlane32_swap(__float_as_uint(q2), __float_as_uint(q2), false, false); q2 = __uint_as_float(rr[0]) + __uint_as_float(rr[1]); }
        const float Mt = fminf(SCALE * sqrtf(q2) * kn, 42.0f);
        int ci = wid * QBLK + r32; asm volatile("" : "+v"(ci));
        mnL = -(Mt - cl[cur.P0 + ci]) * 1.4426950408889634f; }
    const int sr = tid >> 4, sc = (tid & 15) * 8, vst0 = v_st(sr, sc), vst1 = v_st(32 + sr, sc), kws = KSWZ(sr, sc * 2);
    const unsigned svoff = (unsigned)(sr * LDQ + sc) * 2u, qvoff = (unsigned)(r32 * LDQ + hi * 8) * 2u;
    const int vb0 = (int)(uintptr_t)V_lds + v_rd_base(lane);
    const TIn* Kh = cur.K; const TIn* Vh = cur.V;
#define KBASE(t) ((j_hi - 1 - (t)) * KVBLK)
#define ACT(t) (KBASE(t) <= qlo + QBLK - 1 && KBASE(t) + KVBLK - 1 >= qlo - W + 1)
#define MASKT(P0_, P1_, t) do { const int kb_ = KBASE(t); bias_tile(P0_, P1_, cl, kb_, hi); if ((!SK || ACT(t)) && (kb_ + KVBLK - 1 > qlo || kb_ <= qlo + QBLK - 1 - W)) mask_tile(P0_, P1_, qm - kb_, (unsigned)W); } while (0)
    constexpr int NQL = F32 ? 16 : 8;
    constexpr bool SK = WSKIP && !F32;
#define SEAM_K0() do { VMWN(NQL); if constexpr (F32) { SWRITE_KF(0); SBAR(); SLOAD_F((const float*)nxt.V, kbn); } else { SWRITE_HK(0); } SBAR(); } while (0)
    f32x16 pA0, pA1, pB0, pB1; bf16x8 pa0, pa1, pa2, pa3;
    if constexpr (F32) { VMW(); SWRITE_VF(0); SBAR(); } else { SWRITE_HV(0); SBAR(); }
    if (NT > 1) { if constexpr (F32) SLOAD_F((const float*)Kh, KBASE(1)); else SLOAD_H(Kh, Vh, KBASE(1)); }
    SBAR(); qkt<0, SK>(pA0, pA1, K_lds, r32, hi, S.qr, ACT(0));
    if constexpr (F32) { if (NT > 1) { VMW(); SWRITE_KF(1); SBAR(); SLOAD_F((const float*)Vh, KBASE(1)); } }
    MASKT(pA0, pA1, 0); partialSM(pA0, pA1, mnL);
    if (NT > 1) { VMW(); if constexpr (F32) { SWRITE_VF(1); SBAR(); if (NT > 2) SLOAD_F((const float*)Kh, KBASE(2)); } else SWRITE_H(1); }
    __syncthreads();
#define HALF_STEP(PX0, PX1, PY0, PY1, t, KB, VB, SB) do {                                                      \
        SBAR(); qkt<KB, SK>(PX0, PX1, K_lds, r32, hi, S.qr, ACT(t));                                             \
        finishSM(PY0, PY1, l_reg, pa0, pa1, pa2, pa3); SBAR();                                                                \
        if ((t) + 1 < NT) { if constexpr (F32) { VMW(); SWRITE_KF(SB); SBAR(); SLOAD_F((const float*)Vh, KBASE((t) + 1)); }  \
                            else { SLOAD_H(Kh, Vh, KBASE((t) + 1)); } SBAR(); }                                               \
        pv_tile<VB, SK>(o, vb0, pa0, pa1, pa2, pa3, ACT((t) - 1)); MASKT(PX0, PX1, (t)); partialSM(PX0, PX1, mnL);                                        \
        __syncthreads();                                                                                                      \
        if ((t) + 1 < NT) { VMW(); if constexpr (F32) { SWRITE_VF(SB); SBAR(); if ((t) + 2 < NT) SLOAD_F((const float*)Kh, KBASE((t) + 2)); } \
                            else { SWRITE_H(SB); } }                                                                          \
        __syncthreads(); } while (0)
    for (int t = 1; t + 1 < NT; t += 2) {
        HALF_STEP(pB0, pB1, pA0, pA1, t, 1, 0, 0);
        HALF_STEP(pA0, pA1, pB0, pB1, t + 1, 0, 1, 1);
    }
    const bool even = (NT & 1) == 0;
    if (even) { SBAR(); qkt<1, SK>(pB0, pB1, K_lds, r32, hi, S.qr, ACT(NT - 1)); SBAR(); }
#define QROW(e) (nxt.Q + (size_t)(wid * QBLK + r32) * LDQ + ((e) >> 1) * 16 + hi * 8 + ((e) & 1) * 4)
    if constexpr (F32) { SLOAD_F((const float*)nxt.K, kbn); SBAR();
#pragma unroll
        for (int e = 0; e < 8; ++e) S.tq[e] = *(const f32x4*)QROW(e); }
    else { SLOAD_H(nxt.K, nxt.V, kbn); SBAR();
#pragma unroll
        for (int d0 = 0; d0 < 8; ++d0) S.qr[d0] = *(const bf16x8*)((const char*)(nxt.Q + (size_t)(wid * QBLK) * LDQ) + d0 * 32 + qvoff); }
    SBAR();
    finishSM(pA0, pA1, l_reg, pa0, pa1, pa2, pa3); SBAR();
    if constexpr (F32) {
#pragma unroll
        for (int e = 8; e < 16; ++e) S.tq[e] = *(const f32x4*)QROW(e); SBAR(); }
#undef QROW
    pv_tile<0, SK>(o, vb0, pa0, pa1, pa2, pa3, ACT(even ? NT - 2 : NT - 1));
    if (even) { MASKT(pB0, pB1, NT - 1); partialSM(pB0, pB1, mnL); __syncthreads();
        finishSM(pB0, pB1, l_reg, pa0, pa1, pa2, pa3); SBAR(); pv_tile<1, SK>(o, vb0, pa0, pa1, pa2, pa3, ACT(NT - 1)); }
    SBAR(); SEAM_K0();
    if (hi == 0) li_l[r32] = l_reg; asm volatile("s_waitcnt lgkmcnt(0)" ::: "memory");
    float rli[16];
#pragma unroll
    for (int r = 0; r < 16; ++r) rli[r] = __builtin_amdgcn_rcpf(li_l[crow(r, hi)]);
    { char* stg = lds + STG_OFF + wid * (QBLK * STG_ROW);
      int loff = (lane >> 4) * LDQ + (lane & 15) * 8, yoff = (lane >> 4) * LDO + (lane & 15) * 8;
      asm volatile("" : "+v"(loff), "+v"(yoff));
      const TIn* Gw = cur.G + (size_t)(wid * QBLK) * LDQ + loff; TOut* Ow = cur.O + (size_t)(wid * QBLK) * LDO + yoff;
#pragma unroll
      for (int r = 0; r < 16; ++r) { const int orow = crow(r, hi);
#pragma unroll
          for (int d0 = 0; d0 < 4; ++d0) { const float v = o[d0][r] * rli[r]; const float vn = __shfl_xor(v, 1);
              if ((r32 & 1) == 0) *(unsigned*)(stg + orow * STG_ROW + (d0 * 32 + r32) * 2) = cvtpk(v, vn); } }
      asm volatile("s_waitcnt lgkmcnt(0)" ::: "memory");
#pragma unroll
      for (int hf = 0; hf < 2; ++hf) { u32x4 gv[4];
#pragma unroll
          for (int i = 0; i < 4; ++i) gv[i] = *(const u32x4*)(Gw + (size_t)(16 * hf + 4 * i) * LDQ);
#pragma unroll
          for (int i = 0; i < 4; ++i) { const u32x4 ov = *(const u32x4*)(stg + (16 * hf + 4 * i + (lane >> 4)) * STG_ROW + (lane & 15) * 16); const u32x4 g4 = gv[i]; u32x4 w;
#pragma unroll
              for (int e = 0; e < 4; ++e) w[e] = cvtpk(__uint_as_float(ov[e] << 16) * __uint_as_float(g4[e] << 16), __uint_as_float(ov[e] & 0xffff0000u) * __uint_as_float(g4[e] & 0xffff0000u));
              *(u32x4*)(Ow + (size_t)(16 * hf + 4 * i) * LDO) = w; }
          asm volatile("" ::: "memory"); } }
    if constexpr (F32) {
#pragma unroll
        for (int d0 = 0; d0 < 8; ++d0) S.qr[d0] = pack8(S.tq[2 * d0], S.tq[2 * d0 + 1]); }
    __syncthreads();
#undef KBASE
#undef ACT
#undef MASKT
#undef SEAM_K0
#undef HALF_STEP
}
#undef ROW
#undef VMW
#undef VMWN
#undef SLOAD_H
#undef SWRITE_HK
#undef SWRITE_HV
#undef SWRITE_H
#undef SLOAD_F
#undef SWRITE_KF
#undef SWRITE_VF

__host__ __device__ inline int swa_nramp(int nqb, int W, int qoff) { const int t = W - 1 - qoff; const int n = t < 0 ? 0 : t / QB + 1; return n > nqb ? nqb : n; }
__host__ __device__ inline int swa_nx(int nqb, int nramp, int order) { return (order & ORDER_PAIRED) ? (nramp + 1) / 2 + (nqb - nramp) : nqb; }
struct SwaItem { int bh, qb0, qb1; };
__device__ __forceinline__ SwaItem swa_decode(int L, int nb, int nh, int nhkv, int nqb, int nx, int nramp, int order) {
    const int G = nh / nhkv; SwaItem it; int x;
    if ((order & ORDER_XCD) && (nb * nhkv) % 8 == 0) { const int xcd = L & 7, k = L >> 3, per = G * nx, gi = k / per, r = k - gi * per;
        it.bh = (gi * 8 + xcd) * G + r / nx; x = r % nx; }
    else { it.bh = L / nx; x = L - it.bh * nx; }
    if (order & ORDER_PAIRED) { const int ns = nqb - nramp;
        if (x < ns) { it.qb0 = it.qb1 = nqb - 1 - x; } else { it.qb0 = x - ns; it.qb1 = nramp - 1 - it.qb0; } }
    else { it.qb0 = it.qb1 = ((order & 3) == ORDER_REVERSED) ? nqb - 1 - x : x; }
    return it;
}
template <class TIn, class TOut>
__device__ __forceinline__ BlockRef<TIn, TOut> swa_ref(const SwaItem& it, int pass, const TIn* Q, const TIn* K, const TIn* V, TOut* O,
                                                    int nh, int nhkv, int sq, int skv, int qoff) {
    const int qb = pass ? it.qb1 : it.qb0, kvh = it.bh / (nh / nhkv);
    BlockRef<TIn, TOut> r;
    const int b_ = it.bh / nh, h_ = it.bh % nh; (void)kvh; (void)K; (void)V;
    const TIn* rowb = Q + (size_t)(b_ * nh + h_) * sq * LDQ;
    r.Q = rowb + (size_t)qb * QB * LDQ; r.K = rowb + SECSZ; r.V = rowb + 2 * SECSZ; r.G = r.Q + 3 * SECSZ;
    r.O = O + ((size_t)b_ * sq + (size_t)qb * QB) * LDO + h_ * D; r.P0 = qoff + qb * QB;
    return r;
}

constexpr int WT_OFF = STG_OFF + NW * QBLK * STG_ROW, ATT_LDS = WT_OFF + 64;
__device__ __forceinline__ void load_c(char* lds, const float* LS, int bh) {
    int tid = threadIdx.x; asm volatile("" : "+v"(tid));
    const int lane = tid & 63, wv = tid >> 6;
    const f32x4* src = (const f32x4*)(LS + (size_t)bh * SEQ) + 2 * tid;
    const f32x4 a = src[0], b = src[1];
    float v[8]; v[0] = a[0]; v[1] = v[0] + a[1]; v[2] = v[1] + a[2]; v[3] = v[2] + a[3]; v[4] = v[3] + b[0]; v[5] = v[4] + b[1]; v[6] = v[5] + b[2]; v[7] = v[6] + b[3];
    float inc = v[7];
#pragma unroll
    for (int o = 1; o < 64; o <<= 1) { const float t = __uint_as_float(__builtin_amdgcn_ds_bpermute(((lane - o) & 63) << 2, __float_as_uint(inc))); if (lane >= o) inc += t; }
    float* wt = (float*)(lds + WT_OFF);
    if (lane == 63) wt[wv] = inc;
    __syncthreads();
    float base = inc - v[7];
#pragma unroll
    for (int w = 0; w < 7; ++w) if (w < wv) base += wt[w];
    f32x4* dst = (f32x4*)(lds + C_OFF) + 2 * tid;
    dst[0] = (f32x4){base + v[0], base + v[1], base + v[2], base + v[3]}; dst[1] = (f32x4){base + v[4], base + v[5], base + v[6], base + v[7]};
}
__device__ __forceinline__ BlockRef<bf16, bf16> blk_ref(int id, const bf16* P, bf16* Y, int& bh) {
    constexpr int nqb = SQ / QB; bh = id % (B * H); const int qb = nqb - 1 - id / (B * H);
    SwaItem it; it.bh = bh; it.qb0 = it.qb1 = qb;
    return swa_ref<bf16, bf16>(it, 0, P, P, P, Y, H, HKV, SQ, SKV, QOFF);
}
__device__ __forceinline__ void head_bounds(const float* NRM, int bh, float& thr, float& kn) {
    const float* nq = NRM + (size_t)bh * 4; const float* nk = NRM + (size_t)(B * H + bh) * 4;
    const float q2 = (nq[0] + nq[1]) + (nq[2] + nq[3]), k2 = (nk[0] + nk[1]) + (nk[2] + nk[3]);
    kn = 1.01f * sqrtf(k2);
    thr = 110.0f + fmaxf(0.f, 1.01f * SCALE * sqrtf(q2) * kn - 42.0f);
}
__device__ __forceinline__ void attn_phase(char* lds, const bf16* P, const float* LS, const float* NRM, bf16* Y, unsigned* qctr, int blk, int nblk) {
    constexpr int total = B * H * (SQ / QB);
    volatile int* qslot = (volatile int*)(lds + WT_OFF + 32);
    (void)blk; (void)nblk;
    if (threadIdx.x == 0) { qslot[0] = (int)atomicAdd(qctr, 1u); qslot[1] = (int)atomicAdd(qctr, 1u); }
    __syncthreads();
    int id0 = __builtin_amdgcn_readfirstlane(qslot[0]), id1 = __builtin_amdgcn_readfirstlane(qslot[1]);
    if (id0 >= total) return;
    int bh0, bh1 = 0;
    BlockRef<bf16, bf16> cur = blk_ref(id0, P, Y, bh0);
    Seam<bf16> S;
    load_c(lds, LS, bh0);
    causal_swa_prime<bf16, bf16>(cur, SKV, WINDOW, lds, S);
    for (;;) {
        const bool last = id1 >= total;
        const BlockRef<bf16, bf16> nxt = last ? cur : blk_ref(id1, P, Y, bh1);
        int id2 = total;
        if (threadIdx.x == 0 && !last) id2 = (int)atomicAdd(qctr, 1u);
        float thr, kn; head_bounds(NRM, bh0, thr, kn);
        causal_swa_block<bf16, bf16>(cur, nxt, SKV, WINDOW, lds, S, thr, kn);
        if (last) break;
        if (threadIdx.x == 0) qslot[0] = id2;
        load_c(lds, LS, bh1); __syncthreads();
        id1 = __builtin_amdgcn_readfirstlane(qslot[0]);
        cur = nxt; bh0 = bh1;
    }
}
}

__device__ __forceinline__ void flogit_phase(const bf16* __restrict__ HB, const bf16* __restrict__ WF, const float* __restrict__ b_f, float* __restrict__ LS, int blk, int nblk) {
    typedef short bf16x8_t __attribute__((ext_vector_type(8)));
    const int tid = threadIdx.x, wid = __builtin_amdgcn_readfirstlane(tid >> 6), lane = tid & 63, n = lane & 15, g = lane >> 4;
    for (int rb = blk; rb < M / 32; rb += nblk) {
        const int r0 = rb * 32 + (wid >> 2) * 16, h0 = (wid & 3) * 16;
        const bf16x8_t* ap = (const bf16x8_t*)(HB + (size_t)(r0 + n) * D + 8 * g);
        const bf16x8_t* bp = (const bf16x8_t*)(WF + (size_t)(h0 + n) * D + 8 * g);
        f32x4 acc = (f32x4){0.f, 0.f, 0.f, 0.f};
#pragma unroll 8
        for (int k = 0; k < D / 32; ++k) acc = __builtin_amdgcn_mfma_f32_16x16x32_bf16(ap[4 * k], bp[4 * k], acc, 0, 0, 0);
        const float bias = b_f[h0 + n];
        f32x4 o;
#pragma unroll
        for (int j = 0; j < 4; ++j) { const float z = acc[j] + bias; const float e = __builtin_amdgcn_exp2f(-1.4426950408889634f * fabsf(z));
            o[j] = fminf(z, 0.f) - 0.6931471805599453f * __builtin_amdgcn_logf(1.0f + e); }
        const int row = r0 + 4 * g, b = row / SEQ, s = row % SEQ;
        *(f32x4*)(LS + ((size_t)b * NH + h0 + n) * SEQ + s) = o;
    }
}

#define XB_TMO      128
#define XB_XCNT(j)  (256  + 64 * (j))
#define XB_XSUB(j)  (1280 + 64 * (j))
#define XB_XGEN(j)  (2304 + 64 * (j))
#define XB_TOP      3328
#define XB_TOPGEN   3392
#define XCD_BAR_WORDS 3456
#define XB_SPIN_CAP (1u << 18)

__device__ __forceinline__ unsigned xb_ld(unsigned* p)              { return __hip_atomic_load(p, __ATOMIC_RELAXED, __HIP_MEMORY_SCOPE_AGENT); }
__device__ __forceinline__ unsigned xb_add(unsigned* p, unsigned v) { return __hip_atomic_fetch_add(p, v, __ATOMIC_RELAXED, __HIP_MEMORY_SCOPE_AGENT); }
__device__ __forceinline__ unsigned xb_xcc_id() { return (unsigned)__builtin_amdgcn_s_getreg((3 << 11) | 20) & 0xFu; }
#define XB_SPIN(cond, bar) do { unsigned _sp = 0; while (cond) { __builtin_amdgcn_s_sleep(1); \
    if ((++_sp & 255u) == 0u) { if (xb_ld(&(bar)[XB_TMO])) break; if (_sp > XB_SPIN_CAP) { atomicAdd(&(bar)[XB_TMO], 1u); break; } } } } while (0)

struct XcdBarrier {
    unsigned* bar; unsigned x;
    volatile LAS unsigned* st;
};

__device__ __forceinline__ XcdBarrier xcd_barrier_post(unsigned* bar, volatile LAS unsigned* st) {
    XcdBarrier b; b.bar = bar; b.x = xb_xcc_id(); b.st = st;
    if (threadIdx.x == 0) (void)xb_add(&bar[XB_XCNT(b.x)], 1u);
    return b;
}
__device__ __forceinline__ void xcd_barrier_complete(unsigned* bar, unsigned x, unsigned& nloc, unsigned& nx) {
    const unsigned G = gridDim.x * gridDim.y * gridDim.z;
    unsigned sum, cnt, mine, sp = 0u;
    for (;;) {
        sum = 0u; cnt = 0u; mine = 0u;
#pragma unroll
        for (unsigned j = 0; j < 16; ++j) { const unsigned c = xb_ld(&bar[XB_XCNT(j)]); sum += c; cnt += (c > 0u) ? 1u : 0u; mine = (j == x) ? c : mine; }
        if (sum == G) break;
        __builtin_amdgcn_s_sleep(1);
        if ((++sp & 255u) == 0u) { if (xb_ld(&bar[XB_TMO])) break; if (sp > XB_SPIN_CAP) { atomicAdd(&bar[XB_TMO], 1u); break; } }
    }
    nloc = mine > 0u ? mine : 1u; nx = cnt > 0u ? cnt : 1u;
}

__device__ __forceinline__ void xcd_barrier(const XcdBarrier& b) {
    asm volatile("s_waitcnt vmcnt(0)" ::: "memory");
    __syncthreads();
    if (threadIdx.x == 0) {
        unsigned* bar = b.bar;
        __builtin_amdgcn_s_waitcnt(0);
        unsigned nloc = b.st[0], nx = b.st[1];
        if (nloc == 0u) { xcd_barrier_complete(bar, b.x, nloc, nx); b.st[0] = nloc; b.st[1] = nx; }
        const unsigned old = xb_add(&bar[XB_XSUB(b.x)], 1u);
        const unsigned gen = old / nloc;
        if (old + 1u == (gen + 1u) * nloc) {
            __builtin_amdgcn_fence(__ATOMIC_RELEASE, "agent");
            asm volatile("s_waitcnt vmcnt(0)" ::: "memory");
            const unsigned og = xb_add(&bar[XB_TOP], 1u);
            const unsigned tg = og / nx;
            if (og + 1u == (tg + 1u) * nx) xb_add(&bar[XB_TOPGEN], 1u);
            else XB_SPIN(xb_ld(&bar[XB_TOPGEN]) == tg, bar);
            __builtin_amdgcn_fence(__ATOMIC_ACQUIRE, "agent");
            xb_add(&bar[XB_XGEN(b.x)], 1u);
            asm volatile("s_waitcnt vmcnt(0)" ::: "memory");
        } else {
            XB_SPIN(xb_ld(&bar[XB_XGEN(b.x)]) == gen, bar);
            __builtin_amdgcn_fence(__ATOMIC_ACQUIRE, "agent");
            asm volatile("s_waitcnt vmcnt(0)" ::: "memory");
        }
    }
    __syncthreads();
}

constexpr int CW_BAR = 1024;
constexpr size_t CTL_ZERO_BYTES = 32768;
constexpr size_t QCTR_OFF = 28672;
constexpr size_t NRM_OFF = 24576;
constexpr int LDS_TOTAL = 163840;
constexpr int MISC_OFF = LDS_TOTAL - 64;
static_assert(fox::ATT_LDS <= MISC_OFF && scan::LDS_BYTES <= MISC_OFF && pg8::STAGE_BYTES <= MISC_OFF && 8 * 8448 <= MISC_OFF, "LDS map");
#ifndef MK_N_LAUNCHES
#define MK_N_LAUNCHES 1
#endif
constexpr int N_PHASES = 9;
struct Args { const float* in[10]; float* out; unsigned char* ws; int ph_lo, ph_hi; };
__global__ void __launch_bounds__(512, 2) mega_fwd(Args args) {
    extern __shared__ __attribute__((aligned(16))) unsigned char lds[];
    LAS unsigned char* L = (LAS unsigned char*)lds;
    volatile LAS unsigned* MISC = (volatile LAS unsigned*)(L + MISC_OFF);
    const int tid = threadIdx.x, lane = tid & 63, wave = __builtin_amdgcn_readfirstlane(tid >> 6);
    const int G = gridDim.x, bx = blockIdx.x;
    if (tid < 16) MISC[tid] = 0u;
    __syncthreads();
    unsigned char* ws = args.ws;
    XcdBarrier bar; bar.bar = (unsigned*)(ws + WS_CTL) + CW_BAR; bar.x = 0; bar.st = nullptr;
    if (MK_N_LAUNCHES != N_PHASES) bar = xcd_barrier_post((unsigned*)(ws + WS_CTL) + CW_BAR, MISC + 8);
    const float* x = args.in[0]; const float* norm_w = args.in[1]; const float* w_in_a = args.in[2]; const float* lb_logits = args.in[3]; const float* o_norm_a = args.in[4];
    const float* w_out_a = args.in[5]; const float* w_in_b = args.in[6]; const float* b_f = args.in[7]; const float* w_out_b = args.in[8]; const float* final_norm = args.in[9];
    float* out = args.out;
    bf16* WA = (bf16*)(ws + WS_WA); bf16* WB = (bf16*)(ws + WS_WB); bf16* WF = (bf16*)(ws + WS_WF); bf16* WOA = (bf16*)(ws + WS_WOA); bf16* WOB = (bf16*)(ws + WS_WOB);
    bf16* HB = (bf16*)(ws + WS_HB); float* X1 = (float*)(ws + WS_X1); bf16* P = (bf16*)(ws + WS_P); bf16* Y = (bf16*)(ws + WS_Y); float* LS = (float*)(ws + WS_LS);
    const int lo = args.ph_lo, hi = args.ph_hi;
#define IN(k) (lo <= (k) && (k) < hi)
#define SEAM(k) do { if (IN(k) && IN((k) + 1)) xcd_barrier(bar); } while (0)
#define RUN(k, ...) do { if (IN(k)) { __VA_ARGS__ } } while (0)

    RUN(0, { prologue_phase(L, 0, x, norm_w, w_in_a, w_out_a, w_in_b, w_out_b, ws, bx, G, wave, lane); } );
    SEAM(0);
#ifdef GEMM_DESYNC_TICKS
    if (IN(1)) { const unsigned long long t0 = __builtin_amdgcn_s_memrealtime(); const unsigned long long dl = (unsigned long long)(((unsigned)bx >> 3) & 3u) * GEMM_DESYNC_TICKS;
        while (__builtin_amdgcn_s_memrealtime() - t0 < dl) __builtin_amdgcn_s_sleep(8); }
#endif
    RUN(1, { pg8::Gemm g{HB, WA, M, LDP, D, 0}; pg8::StaticOrder S; S.init(M, LDP, G, bx); pg8::EpiAct<0> E{P, lb_logits, nullptr, LDP, 0};
        pg8::gemm_phase<pg8::EpiAct<0>, pg8::StaticOrder, true, true>(L, g, S, E); } );
    SEAM(1);
    RUN(2, { if (G >= 2 * NB * NH) { if (bx < NB * NH) scan::scan_unit(L, P, o_norm_a, Y, bx); else prologue_phase(L, 1, x, norm_w, w_in_a, w_out_a, w_in_b, w_out_b, ws, bx - NB * NH, G - NB * NH, wave, lane); }
              else { for (int bh = bx; bh < NB * NH; bh += G) scan::scan_unit(L, P, o_norm_a, Y, bh); prologue_phase(L, 1, x, norm_w, w_in_a, w_out_a, w_in_b, w_out_b, ws, bx, G, wave, lane); } } );
    SEAM(2);
    RUN(3, { pg8::Gemm g{Y, WOA, M, D, DI, 0}; pg8::StaticOrder S; S.init(M, D, G, bx); pg8::EpiRes E{x, X1, D, 0};
        pg8::gemm_phase<pg8::EpiRes, pg8::StaticOrder, true, true>(L, g, S, E); } );
    SEAM(3);
    RUN(4, { const int gw = bx * 8 + wave, NGW = G * 8; for (int m = gw; m < M; m += NGW) rms_row_bf16(X1 + (size_t)m * D, norm_w + D, HB + (size_t)m * D, lane); } );
    SEAM(4);
    RUN(5, { flogit_phase(HB, WF, b_f, LS, bx, G);
        pg8::Gemm g{HB, WB, M, LDP, D, 0}; pg8::StaticOrder S; S.init(M, LDP, G, bx); pg8::EpiAct<1> E{P, nullptr, (unsigned*)(ws + WS_CTL + NRM_OFF), LDP, 0};
        pg8::gemm_phase<pg8::EpiAct<1>, pg8::StaticOrder, true, true>(L, g, S, E); } );
    SEAM(5);
    RUN(6, { fox::attn_phase((char*)lds, P, LS, (const float*)(ws + WS_CTL + NRM_OFF), Y, (unsigned*)(ws + WS_CTL + QCTR_OFF), bx, G); } );
    SEAM(6);
    RUN(7, { pg8::Gemm g{Y, WOB, M, D, DI, 0}; pg8::StaticOrder S; S.init(M, D, G, bx); pg8::EpiRes E{X1, out, D, 0};
        pg8::gemm_phase<pg8::EpiRes, pg8::StaticOrder, true, true>(L, g, S, E); } );
    SEAM(7);
    RUN(8, { const int gw = bx * 8 + wave, NGW = G * 8; for (int m = gw; m < M; m += NGW) rms_row_f32(out + (size_t)m * D, final_norm, out + (size_t)m * D, lane); } );
#undef IN
#undef SEAM
}

extern "C" void kernel_launch(void* const* d_in, const int* in_sizes, int n_in, void* d_out, int out_size, void* d_ws, size_t ws_size, hipStream_t stream) {
    static int grid = 0;
    if (grid == 0) {
        if (n_in != 10 || in_sizes[0] != M * D || out_size != M * D || ws_size < WS_END) { fprintf(stderr, "kernel_launch: unexpected shapes (n_in %d, in0 %d, out %d, ws %zu < %zu); nothing launched\n", n_in, n_in > 0 ? in_sizes[0] : -1, out_size, ws_size, (size_t)WS_END); grid = -1; return; }
        int dev = 0, cus = 0, per_cu = 0;
        if (hipGetDevice(&dev) != hipSuccess || hipDeviceGetAttribute(&cus, hipDeviceAttributeMultiprocessorCount, dev) != hipSuccess) { fprintf(stderr, "kernel_launch: device query failed\n"); grid = -1; return; }
        if (hipFuncSetAttribute((const void*)mega_fwd, hipFuncAttributeMaxDynamicSharedMemorySize, LDS_TOTAL) != hipSuccess) { fprintf(stderr, "kernel_launch: hipFuncSetAttribute(%d B LDS) failed\n", LDS_TOTAL); grid = -1; return; }
        if (hipOccupancyMaxActiveBlocksPerMultiprocessor(&per_cu, (const void*)mega_fwd, 512, LDS_TOTAL) != hipSuccess || per_cu < 1)
            fprintf(stderr, "kernel_launch: note: occupancy query reports %d workgroups per CU\n", per_cu);
        (void)hipGetLastError();
        grid = cus;
    }
    if (grid < 0) return;
    if (hipMemsetAsync((char*)d_ws + WS_CTL, 0, CTL_ZERO_BYTES, stream) != hipSuccess) { fprintf(stderr, "kernel_launch: hipMemsetAsync failed\n"); return; }
    Args a{};
    for (int i = 0; i < 10; ++i) a.in[i] = (const float*)d_in[i];
    a.out = (float*)d_out; a.ws = (unsigned char*)d_ws;
#if MK_N_LAUNCHES == 1
    a.ph_lo = 0; a.ph_hi = N_PHASES;
    hipLaunchKernelGGL(mega_fwd, dim3(grid), dim3(512), LDS_TOTAL, stream, a);
#else
    for (int p = 0; p < N_PHASES; ++p) { a.ph_lo = p; a.ph_hi = p + 1; hipLaunchKernelGGL(mega_fwd, dim3(grid), dim3(512), LDS_TOTAL, stream, a); }
#endif
    const hipError_t le = hipPeekAtLastError();
    if (le != hipSuccess) fprintf(stderr, "kernel_launch: launch failed: %s\n", hipGetErrorName(le));
}
```

```cpp
#include <hip/hip_runtime.h>
#include <cstdio>
#include <cstdint>

constexpr int NB = 2, SEQ = 4096, D = 4096, DI = 8192, NH = 64, HD = 128;
constexpr int M = NB * SEQ;
constexpr int LDP = 4 * DI;
constexpr int NWB = 4 * DI + NH;
constexpr float EPS = 1e-6f;
namespace pg8 {
#define PG8_LAS __attribute__((address_space(3)))
typedef unsigned short bf16_t;
typedef short bf16x8 __attribute__((ext_vector_type(8)));
typedef float f32x4 __attribute__((ext_vector_type(4)));
typedef unsigned u32x4 __attribute__((ext_vector_type(4)));
constexpr int BM = 256, BK = 64, HALF = 128, HTB = HALF * BK * 2  , STAGE_BYTES = 8 * HTB, NXCD = 8, WGM = 8;

__host__ __device__ __forceinline__ int lds_byte(int r, int c) { const int st = (r >> 4) * 2 + (c >> 5), rr = r & 15, cc = c & 31, ob = rr * 64 + cc * 2; return st * 1024 + (ob ^ (((ob >> 9) & 1) << 5)); }
__host__ __device__ __forceinline__ void stage_rc(int b, int& R, int& C) { const int st = b / 1024, sb = b % 1024, swz = sb ^ (((sb >> 9) & 1) << 5); R = (st >> 1) * 16 + swz / 64; C = (st & 1) * 32 + (swz % 64) / 2; }
__host__ __device__ __forceinline__ int perm32(int rho) { const int n = rho >> 4, i = rho & 15; return 8 * (i >> 2) + 4 * n + (i & 3); }

struct Unit { int pm, pn; };
struct Gemm { const bf16_t* A; const bf16_t* Bt; int M, N, K, pad; };

struct StaticOrder {
    int nM, nN, nwg, G, c;
    __host__ __device__ void init(int M, int N, int G_, int c_) { nM = M / BM; nN = N / BM; nwg = nM * nN; G = G_; c = c_; }
    __host__ __device__ bool next(int i, Unit& u) const {
        const long L = (long)i * G + c; if (L >= nwg) return false;
        int wgid = (int)L; { const int q = nwg / NXCD, r = nwg % NXCD, xcd = wgid % NXCD, off = wgid / NXCD; wgid = (xcd < r ? xcd * (q + 1) : r * (q + 1) + (xcd - r) * q) + off; }
        const int nig = WGM * nN, gid = wgid / nig, fm = gid * WGM, gsz = (nM - fm) < WGM ? (nM - fm) : WGM;
        u.pm = fm + ((wgid % nig) % gsz); u.pn = (wgid % nig) / gsz; return true;
    }
    __device__ __forceinline__ void a_ready(const Unit&) const {}
    __device__ __forceinline__ void done(const Unit&) const {}
};

typedef float f32x2_t __attribute__((ext_vector_type(2)));
typedef __bf16 bf16x2_t __attribute__((ext_vector_type(2)));
__device__ __forceinline__ unsigned cvt_pk_bf16(float lo, float hi) { f32x2_t v = {lo, hi}; bf16x2_t b = __builtin_convertvector(v, bf16x2_t); return __builtin_bit_cast(unsigned, b); }
__device__ __forceinline__ float silu_f(float x) { return x * __builtin_amdgcn_rcpf(1.0f + __builtin_amdgcn_exp2f(-1.4426950408889634f * x)); }

#define PG8_PSTORE(p, v) (*(p) = (v))
template <int LAYER> struct EpiAct {
    static constexpr bool PERM = true, AFTER_DRAIN = false;
    bf16_t* O; const float* lbl; unsigned* nrm; int ldc, pad;
    __device__ __forceinline__ void operator()(const f32x4 (&acc)[2][2][4][2], const Unit& u, int wr, int wc, int fr, int fq) const {
        const int sec = u.pn >> 5;
        const int row0 = u.pm * BM + wr * 64 + fr, col0 = u.pn * BM + wc * 32 + 8 * fq;
        const int mode = (LAYER == 0) ? ((sec == 0 || sec == 3) ? 1 : (sec == 1 ? 2 : 0)) : (sec == 3 ? 1 : 0);
        const int rb = row0 >> 12, rs = row0 & 4095, hh = (2 * u.pn) & 63;
        bf16_t* hm = O + ((size_t)((sec * 2 + rb) * 64 + hh) * 4096 + rs) * 128 + wc * 32 + 8 * fq;
        if (mode == 2) {
            float lb[2][8], om[2][8];
#pragma unroll
            for (int bj = 0; bj < 2; ++bj) { const int c = col0 + bj * HALF - 8192;
                const f32x4 a0 = *(const f32x4*)(lbl + c), a1 = *(const f32x4*)(lbl + c + 4), b0 = *(const f32x4*)(lbl + 8192 + c), b1 = *(const f32x4*)(lbl + 8192 + c + 4);
#pragma unroll
                for (int e = 0; e < 4; ++e) { const float x0 = __builtin_amdgcn_rcpf(1.0f + __builtin_amdgcn_exp2f(1.4426950408889634f * (b0[e] - a0[e]))), x1 = __builtin_amdgcn_rcpf(1.0f + __builtin_amdgcn_exp2f(1.4426950408889634f * (b1[e] - a1[e])));
                    lb[bj][e] = x0; om[bj][e] = 1.0f - x0; lb[bj][4 + e] = x1; om[bj][4 + e] = 1.0f - x1; } }
#pragma unroll
            for (int ai = 0; ai < 2; ++ai)
#pragma unroll
                for (int m = 0; m < 4; ++m) { bf16_t* rowp = hm + (size_t)(ai * HALF + m * 16) * 128;
#pragma unroll
                    for (int bj = 0; bj < 2; ++bj) { float v[8];
#pragma unroll
                        for (int e = 0; e < 8; ++e) { const float f = acc[ai][bj][m][e >> 2][e & 3];
                            const float sg = __builtin_amdgcn_rcpf(1.0f + __builtin_amdgcn_exp2f(-1.4426950408889634f * f));
                            v[e] = __builtin_amdgcn_logf(lb[bj][e] + om[bj][e] * sg); }
                        u32x4 w; w.x = cvt_pk_bf16(v[0], v[1]); w.y = cvt_pk_bf16(v[2], v[3]); w.z = cvt_pk_bf16(v[4], v[5]); w.w = cvt_pk_bf16(v[6], v[7]);
                        PG8_PSTORE((u32x4*)(rowp + (size_t)bj * (4096 * 128)), w); } }
        } else if (mode == 1) {
#pragma unroll
            for (int ai = 0; ai < 2; ++ai)
#pragma unroll
                for (int m = 0; m < 4; ++m) { bf16_t* rowp = hm + (size_t)(ai * HALF + m * 16) * 128;
#pragma unroll
                    for (int bj = 0; bj < 2; ++bj) { float v[8];
#pragma unroll
                        for (int e = 0; e < 8; ++e) v[e] = silu_f(acc[ai][bj][m][e >> 2][e & 3]);
                        u32x4 w; w.x = cvt_pk_bf16(v[0], v[1]); w.y = cvt_pk_bf16(v[2], v[3]); w.z = cvt_pk_bf16(v[4], v[5]); w.w = cvt_pk_bf16(v[6], v[7]);
                        PG8_PSTORE((u32x4*)(rowp + (size_t)bj * (4096 * 128)), w); } }
        } else {
            float nmax[2] = {0.f, 0.f};
#pragma unroll
            for (int ai = 0; ai < 2; ++ai)
#pragma unroll
                for (int m = 0; m < 4; ++m) { bf16_t* rowp = hm + (size_t)(ai * HALF + m * 16) * 128;
#pragma unroll
                    for (int bj = 0; bj < 2; ++bj) { const f32x4 v0 = acc[ai][bj][m][0], v1 = acc[ai][bj][m][1];
                        u32x4 w; w.x = cvt_pk_bf16(v0[0], v0[1]); w.y = cvt_pk_bf16(v0[2], v0[3]); w.z = cvt_pk_bf16(v1[0], v1[1]); w.w = cvt_pk_bf16(v1[2], v1[3]);
                        PG8_PSTORE((u32x4*)(rowp + (size_t)bj * (4096 * 128)), w);
                        if (LAYER == 1 && sec < 2) { float ss = (v0[0] * v0[0] + v0[1] * v0[1]) + (v0[2] * v0[2] + v0[3] * v0[3]) + (v1[0] * v1[0] + v1[1] * v1[1]) + (v1[2] * v1[2] + v1[3] * v1[3]);
                            ss += __shfl_xor(ss, 16); ss += __shfl_xor(ss, 32); nmax[bj] = fmaxf(nmax[bj], ss); } } }
            if (LAYER == 1 && sec < 2) {
#pragma unroll
                for (int bj = 0; bj < 2; ++bj) { float v = nmax[bj];
#pragma unroll
                    for (int o = 1; o < 16; o <<= 1) v = fmaxf(v, __shfl_xor(v, o));
                    if (fr == 0 && fq == 0) atomicMax(nrm + ((size_t)(sec * 128 + rb * 64 + hh + bj)) * 4 + wc, __float_as_uint(v)); }
            }
        }
    }
};
struct EpiRes {
    static constexpr bool PERM = false, AFTER_DRAIN = false;
    const float* base; float* out; int ldc, pad;
    __device__ __forceinline__ void operator()(const f32x4 (&acc)[2][2][4][2], const Unit& u, int wr, int wc, int fr, int fq) const {
        const int row0 = u.pm * BM + wr * 64 + fr, col0 = u.pn * BM + wc * 32 + 4 * fq;
#pragma unroll
        for (int ai = 0; ai < 2; ++ai)
#pragma unroll
            for (int m = 0; m < 4; ++m) { const size_t off = (size_t)(row0 + ai * HALF + m * 16) * ldc + col0;
#pragma unroll
                for (int bj = 0; bj < 2; ++bj)
#pragma unroll
                    for (int n = 0; n < 2; ++n) { const f32x4 bs = *(const f32x4*)(base + off + bj * HALF + n * 16); *(f32x4*)(out + off + bj * HALF + n * 16) = bs + acc[ai][bj][m][n]; }
                }
    }
};

template <class Epi, class Sched, bool ALIGN_EPI = false, bool SP2 = false>
__device__ __forceinline__ void gemm_phase(PG8_LAS unsigned char* lds, const Gemm g, const Sched& S, const Epi& E) {
    const int tid = threadIdx.x, wid = __builtin_amdgcn_readfirstlane(tid >> 6), lane = tid & 63, wr = wid >> 2, wc = wid & 3, fr = lane & 15, fq = lane >> 4;
    const int K = g.K, nt = K / BK;
    unsigned voffA[2], voffB[2];
#pragma unroll
    for (int i = 0; i < 2; ++i) { int R, C; stage_rc(tid * 16 + i * 8192, R, C); const int Rb = Epi::PERM ? ((R & ~31) + perm32(R & 31)) : R;
        voffA[i] = (unsigned)(R * K + C) * 2u; voffB[i] = (unsigned)(Rb * K + C) * 2u; }
    const size_t kstep = (size_t)(BK * 2);
    const size_t hstep = (size_t)HALF * K * 2;
    const size_t tstep = 2 * hstep;
    const unsigned ldsw = (unsigned)wid * 1024u;
    const int aoff = lds_byte(wr * 64 + fr, fq * 8), boff = lds_byte(wc * 32 + fr, fq * 8);
#define PG8_SA(b, h) (((b) * 2 + (h)) * HTB)
#define PG8_SB(b, h) ((4 + (b) * 2 + (h)) * HTB)
#define PG8_STAGE(bufoff, gbase, voff) do { _Pragma("unroll") for (int _i = 0; _i < 2; ++_i) \
        __builtin_amdgcn_global_load_lds((const unsigned*)((const char*)(gbase) + (voff)[_i]), (PG8_LAS unsigned*)(lds + (bufoff) + ldsw + _i * 8192), 16, 0, 0); } while (0)
#define PG8_LDA(dst, b, h) do { _Pragma("unroll") for (int m = 0; m < 4; ++m) _Pragma("unroll") for (int k = 0; k < 2; ++k) dst[m][k] = *(const PG8_LAS bf16x8*)(lds + PG8_SA(b, h) + aoff + m * 2048 + k * 1024); } while (0)
#define PG8_LDB(dst, b, h) do { _Pragma("unroll") for (int n = 0; n < 2; ++n) _Pragma("unroll") for (int k = 0; k < 2; ++k) dst[n][k] = *(const PG8_LAS bf16x8*)(lds + PG8_SB(b, h) + boff + n * 2048 + k * 1024); } while (0)
#define PG8_MMA(ai, bj, At, Bt) do { __builtin_amdgcn_s_setprio(1); _Pragma("unroll") for (int m = 0; m < 4; ++m) _Pragma("unroll") for (int n = 0; n < 2; ++n) _Pragma("unroll") for (int k = 0; k < 2; ++k) \
        acc[ai][bj][m][n] = __builtin_amdgcn_mfma_f32_16x16x32_bf16(Bt[n][k], At[m][k], acc[ai][bj][m][n], 0, 0, 0); __builtin_amdgcn_s_setprio(0); } while (0)
#define PG8_WAIT_V(n) asm volatile("s_waitcnt vmcnt(" #n ")" ::: "memory")
#define PG8_WAIT_L(n) asm volatile("s_waitcnt lgkmcnt(" #n ")" ::: "memory")
#define PG8_BAR __builtin_amdgcn_s_barrier()
#define PG8_SCHED __builtin_amdgcn_sched_barrier(0)
    Unit cur, nxt; int ui = 0;
    if (!S.next(0, cur)) return;
    f32x4 acc[2][2][4][2];
#pragma unroll
    for (int a = 0; a < 2; ++a)
#pragma unroll
        for (int b = 0; b < 2; ++b)
#pragma unroll
            for (int m = 0; m < 4; ++m)
#pragma unroll
                for (int n = 0; n < 2; ++n) acc[a][b][m][n] = (f32x4){0.f, 0.f, 0.f, 0.f};
    bf16x8 At[4][2], B0[2][2], B1[2][2];
    const char* cA = (const char*)g.A + (size_t)cur.pm * tstep; const char* cB = (const char*)g.Bt + (size_t)cur.pn * tstep;
    S.a_ready(cur);
    if constexpr (SP2) {
        PG8_STAGE(PG8_SB(0, 0), cB, voffB); PG8_STAGE(PG8_SB(0, 1), cB + hstep, voffB); PG8_STAGE(PG8_SA(0, 0), cA, voffA); PG8_STAGE(PG8_SA(0, 1), cA + hstep, voffA);
        if (wr == 1) PG8_BAR;
        PG8_WAIT_V(2); PG8_BAR;
        PG8_STAGE(PG8_SB(1, 0), cB + kstep, voffB); PG8_STAGE(PG8_SA(1, 0), cA + kstep, voffA); PG8_STAGE(PG8_SB(1, 1), cB + hstep + kstep, voffB);
        PG8_WAIT_V(6); PG8_BAR;
    } else {
        PG8_STAGE(PG8_SB(0, 0), cB, voffB); PG8_STAGE(PG8_SA(0, 0), cA, voffA); PG8_STAGE(PG8_SB(0, 1), cB + hstep, voffB); PG8_STAGE(PG8_SA(0, 1), cA + hstep, voffA);
        if (wr == 1) PG8_BAR;
        PG8_WAIT_V(4); PG8_BAR;
        PG8_STAGE(PG8_SB(1, 0), cB + kstep, voffB); PG8_STAGE(PG8_SA(1, 0), cA + kstep, voffA); PG8_STAGE(PG8_SB(1, 1), cB + hstep + kstep, voffB);
        PG8_WAIT_V(6); PG8_BAR;
    }
    for (;;) {
        const bool has_next = S.next(ui + 1, nxt);
        const char* nA = has_next ? (const char*)g.A + (size_t)nxt.pm * tstep : cA; const char* nB = has_next ? (const char*)g.Bt + (size_t)nxt.pn * tstep : cB;
        for (int t = 0; t < nt; t += 2) {
            const bool last = (t == nt - 2);
            const char* a1 = cA + (size_t)(t + 1) * kstep;
            const char* a2 = last ? nA : cA + (size_t)(t + 2) * kstep; const char* b2 = last ? nB : cB + (size_t)(t + 2) * kstep;
            const char* a3 = a2 + kstep; const char* b3 = b2 + kstep;
            if (last && has_next) S.a_ready(nxt);
            if constexpr (SP2) {
            PG8_LDB(B0, 0, 0); PG8_LDB(B1, 0, 1); PG8_SCHED; PG8_LDA(At, 0, 0); PG8_STAGE(PG8_SA(1, 1), a1 + hstep, voffA);
            PG8_WAIT_V(8); PG8_WAIT_L(0); PG8_BAR; PG8_MMA(0, 0, At, B0); PG8_MMA(0, 1, At, B1); PG8_BAR; PG8_SCHED;
            PG8_LDA(At, 0, 1); PG8_STAGE(PG8_SB(0, 0), b2, voffB); PG8_STAGE(PG8_SB(0, 1), b2 + hstep, voffB); PG8_STAGE(PG8_SA(0, 0), a2, voffA);
            PG8_WAIT_V(8); PG8_WAIT_L(0); PG8_BAR; PG8_MMA(1, 0, At, B0); PG8_MMA(1, 1, At, B1); PG8_BAR; PG8_SCHED;
            PG8_LDB(B0, 1, 0); PG8_LDB(B1, 1, 1); PG8_SCHED; PG8_LDA(At, 1, 0); PG8_STAGE(PG8_SA(0, 1), a2 + hstep, voffA);
            PG8_WAIT_V(8); PG8_WAIT_L(0); PG8_BAR; PG8_MMA(0, 0, At, B0); PG8_MMA(0, 1, At, B1); PG8_BAR; PG8_SCHED;
            PG8_LDA(At, 1, 1); PG8_STAGE(PG8_SB(1, 0), b3, voffB); PG8_STAGE(PG8_SB(1, 1), b3 + hstep, voffB); PG8_STAGE(PG8_SA(1, 0), a3, voffA);
            PG8_WAIT_V(8); PG8_WAIT_L(0); PG8_BAR; PG8_MMA(1, 0, At, B0); PG8_MMA(1, 1, At, B1); PG8_BAR; PG8_SCHED;
            } else {
            PG8_LDB(B0, 0, 0); PG8_SCHED; PG8_LDA(At, 0, 0); PG8_STAGE(PG8_SA(1, 1), a1 + hstep, voffA);
            PG8_WAIT_L(8); PG8_BAR; PG8_WAIT_L(0); PG8_MMA(0, 0, At, B0); PG8_BAR; PG8_SCHED;
            PG8_LDB(B1, 0, 1); PG8_STAGE(PG8_SB(0, 0), b2, voffB);
            PG8_BAR; PG8_WAIT_L(0); PG8_MMA(0, 1, At, B1); PG8_BAR;
            PG8_LDA(At, 0, 1); PG8_STAGE(PG8_SA(0, 0), a2, voffA);
            PG8_BAR; PG8_WAIT_L(0); PG8_MMA(1, 0, At, B0); PG8_BAR; PG8_SCHED;
            PG8_STAGE(PG8_SB(0, 1), b2 + hstep, voffB);
            PG8_WAIT_V(6); PG8_BAR; PG8_MMA(1, 1, At, B1); PG8_BAR;
            PG8_LDB(B0, 1, 0); PG8_SCHED; PG8_LDA(At, 1, 0); PG8_STAGE(PG8_SA(0, 1), a2 + hstep, voffA);
            PG8_WAIT_L(8); PG8_BAR; PG8_WAIT_L(0); PG8_MMA(0, 0, At, B0); PG8_BAR; PG8_SCHED;
            PG8_LDB(B1, 1, 1); PG8_STAGE(PG8_SB(1, 0), b3, voffB);
            PG8_BAR; PG8_WAIT_L(0); PG8_MMA(0, 1, At, B1); PG8_BAR;
            PG8_LDA(At, 1, 1); PG8_STAGE(PG8_SA(1, 0), a3, voffA);
            PG8_BAR; PG8_WAIT_L(0); PG8_MMA(1, 0, At, B0); PG8_BAR; PG8_SCHED;
            PG8_STAGE(PG8_SB(1, 1), b3 + hstep, voffB);
            PG8_WAIT_V(6); PG8_BAR; PG8_MMA(1, 1, At, B1); PG8_BAR;
            }
        }
        if constexpr (ALIGN_EPI) { if (wr == 0) PG8_BAR; }
        if constexpr (!Epi::AFTER_DRAIN) { E(acc, cur, wr, wc, fr, fq); S.done(cur); }
        if (!has_next) break;
#pragma unroll
        for (int a = 0; a < 2; ++a)
#pragma unroll
            for (int b = 0; b < 2; ++b)
#pragma unroll
                for (int m = 0; m < 4; ++m)
#pragma unroll
                    for (int n = 0; n < 2; ++n) acc[a][b][m][n] = (f32x4){0.f, 0.f, 0.f, 0.f};
        cur = nxt; cA = nA; cB = nB; ++ui;
        if constexpr (ALIGN_EPI) { if (wr == 1) PG8_BAR; }
    }
    PG8_WAIT_V(0);
    if constexpr (!ALIGN_EPI) { if (wr == 0) PG8_BAR; }
    PG8_BAR;
    if constexpr (Epi::AFTER_DRAIN) { E.fused(acc, cur, wr, wc, fr, fq, lds, wid, lane); S.done(cur); }
#undef PG8_SA
#undef PG8_SB
#undef PG8_STAGE
#undef PG8_LDA
#undef PG8_LDB
#undef PG8_MMA
#undef PG8_WAIT_V
#undef PG8_WAIT_L
#undef PG8_BAR
#undef PG8_SCHED
}
}

#define LAS __attribute__((address_space(3)))
typedef unsigned short bf16;
typedef unsigned v4u __attribute__((ext_vector_type(4)));
typedef unsigned v2u __attribute__((ext_vector_type(2)));
typedef float f32x4 __attribute__((ext_vector_type(4)));
__device__ __forceinline__ unsigned pk2(float lo, float hi) { return pg8::cvt_pk_bf16(lo, hi); }
__device__ __forceinline__ float bf2f(unsigned short b) { return __uint_as_float(((unsigned)b) << 16); }
__device__ __forceinline__ float bflo(unsigned w) { return __uint_as_float(w << 16); }
__device__ __forceinline__ float bfhi(unsigned w) { return __uint_as_float(w & 0xffff0000u); }
__device__ __forceinline__ float wave_sum(float v) {
#pragma unroll
    for (int o = 1; o < 64; o <<= 1) v += __shfl_xor(v, o);
    return v;
}
__device__ __forceinline__ float wave_max(float v) {
#pragma unroll
    for (int o = 1; o < 64; o <<= 1) v = fmaxf(v, __shfl_xor(v, o));
    return v;
}

#define WLOAD(p) __builtin_nontemporal_load(p)
struct TileDesc { const float* W; size_t ldw; int K, k0, n0; bf16* WT; int nbase; };
__device__ __forceinline__ void tile_load(const TileDesc& d, f32x4 (&ra)[8], f32x4 (&rb)[8], int lane) {
    const int g = lane & 15, ks = lane >> 4;
#pragma unroll
    for (int i = 0; i < 8; ++i) { const int k = d.k0 + 8 * i + 2 * ks;
        ra[i] = WLOAD((const f32x4*)(d.W + (size_t)k * d.ldw + d.n0 + 4 * g)); rb[i] = WLOAD((const f32x4*)(d.W + (size_t)(k + 1) * d.ldw + d.n0 + 4 * g)); }
}
__device__ __forceinline__ void tile_store(const TileDesc& d, const f32x4 (&ra)[8], const f32x4 (&rb)[8], LAS unsigned* scr, int lane) {
    const int g = lane & 15, ks = lane >> 4;
#pragma unroll
    for (int i = 0; i < 8; ++i)
#pragma unroll
        for (int j = 0; j < 4; ++j) scr[(4 * g + j) * 33 + 4 * i + ks] = pk2(ra[i][j], rb[i][j]);
    asm volatile("s_waitcnt lgkmcnt(0)" ::: "memory");
    const int c = lane & 7;
#pragma unroll
    for (int r = 0; r < 8; ++r) { const int n = 8 * r + (lane >> 3);
        v4u o; o.x = scr[n * 33 + 4 * c]; o.y = scr[n * 33 + 4 * c + 1]; o.z = scr[n * 33 + 4 * c + 2]; o.w = scr[n * 33 + 4 * c + 3];
        *(v4u*)(d.WT + (size_t)(d.n0 - d.nbase + n) * d.K + d.k0 + 8 * c) = o; }
    asm volatile("s_waitcnt lgkmcnt(0)" ::: "memory");
}
__device__ __forceinline__ void rms_row_bf16(const float* xrow, const float* w, bf16* orow, int lane) {
    const f32x4* xr = (const f32x4*)xrow + lane; const f32x4* wr = (const f32x4*)w + lane;
    f32x4 v[16]; float s = 0.f;
#pragma unroll
    for (int j = 0; j < 16; ++j) { v[j] = xr[64 * j]; s += (v[j].x * v[j].x + v[j].y * v[j].y) + (v[j].z * v[j].z + v[j].w * v[j].w); }
    const float rs = 1.0f / sqrtf(wave_sum(s) * (1.0f / D) + EPS);
    v2u* o8 = (v2u*)orow + lane;
#pragma unroll
    for (int j = 0; j < 16; ++j) { const f32x4 g = wr[64 * j]; v2u o; o.x = pk2(v[j].x * rs * g.x, v[j].y * rs * g.y); o.y = pk2(v[j].z * rs * g.z, v[j].w * rs * g.w); o8[64 * j] = o; }
}
__device__ __forceinline__ void rms_row_f32(const float* xrow, const float* w, float* orow, int lane) {
    const f32x4* xr = (const f32x4*)xrow + lane; const f32x4* wr = (const f32x4*)w + lane;
    f32x4 v[16]; float s = 0.f;
#pragma unroll
    for (int j = 0; j < 16; ++j) { v[j] = xr[64 * j]; s += (v[j].x * v[j].x + v[j].y * v[j].y) + (v[j].z * v[j].z + v[j].w * v[j].w); }
    const float rs = 1.0f / sqrtf(wave_sum(s) * (1.0f / D) + EPS);
    f32x4* o = (f32x4*)orow + lane;
#pragma unroll
    for (int j = 0; j < 16; ++j) { const f32x4 g = wr[64 * j]; o[64 * j] = (f32x4){v[j].x * rs * g.x, v[j].y * rs * g.y, v[j].z * rs * g.z, v[j].w * rs * g.w}; }
}

constexpr size_t MiB = 1u << 20;
constexpr size_t WS_CTL = 0;
constexpr size_t WS_WA  = 1 * MiB;
constexpr size_t WS_WB  = WS_WA + 256 * MiB;
constexpr size_t WS_WF  = WS_WB + 256 * MiB;
constexpr size_t WS_WOA = WS_WF + 1 * MiB;
constexpr size_t WS_WOB = WS_WOA + 64 * MiB;
constexpr size_t WS_HB  = WS_WOB + 64 * MiB;
constexpr size_t WS_X1  = WS_HB + 64 * MiB;
constexpr size_t WS_P   = WS_X1 + 128 * MiB;
constexpr size_t WS_Y   = WS_P + 512 * MiB;
constexpr size_t WS_LS  = WS_Y + 128 * MiB;
constexpr size_t WS_END = WS_LS + 2 * MiB;

#ifndef CONV_P0_PCT
#define CONV_P0_PCT 0
#endif
__device__ __forceinline__ void prologue_phase(LAS unsigned char* lds, int part, const float* x, const float* norm_w, const float* w_in_a, const float* w_out_a, const float* w_in_b, const float* w_out_b,
                                               unsigned char* ws, int vcu, int G, int wave, int lane) {
    LAS unsigned* scr = (LAS unsigned*)(lds + wave * 8448);
    const int gw = vcu * 8 + wave, NGW = G * 8;
    bf16* WA = (bf16*)(ws + WS_WA); bf16* WB = (bf16*)(ws + WS_WB); bf16* WF = (bf16*)(ws + WS_WF); bf16* WOA = (bf16*)(ws + WS_WOA); bf16* WOB = (bf16*)(ws + WS_WOB);
    constexpr int T_IN = (D / 64) * (LDP / 64);
    constexpr int T_F = (D / 64) * 1;
    constexpr int T_OUT = (DI / 64) * (D / 64);
    constexpr int T_DEF = T_OUT + T_IN + T_F + T_OUT, SPLIT = (int)((long)T_DEF * CONV_P0_PCT / 100);
    f32x4 a0[8], b0[8], a1[8], b1[8];
    if (part == 0) {
        auto dsc = [=](int it) { TileDesc d; d.W = w_in_a; d.ldw = LDP; d.K = D; d.k0 = (it / (LDP / 64)) * 64; d.n0 = (it % (LDP / 64)) * 64; d.WT = WA; d.nbase = 0; return d; };
        int it = gw;
        if (it < T_IN) { TileDesc d0 = dsc(it); tile_load(d0, a0, b0, lane);
            for (;;) {
                const int i1 = it + NGW; const bool m1 = i1 < T_IN; TileDesc d1 = dsc(m1 ? i1 : it); if (m1) tile_load(d1, a1, b1, lane);
                tile_store(d0, a0, b0, scr, lane); if (!m1) break;
                const int i2 = i1 + NGW; const bool m2 = i2 < T_IN; d0 = dsc(m2 ? i2 : i1); if (m2) tile_load(d0, a0, b0, lane);
                tile_store(d1, a1, b1, scr, lane); if (!m2) break;
                it = i2;
            } }
        bf16* HB = (bf16*)(ws + WS_HB);
        for (int m = gw; m < M; m += NGW) rms_row_bf16(x + (size_t)m * D, norm_w, HB + (size_t)m * D, lane);
    }
    {
        const int i0 = (part == 0) ? 0 : SPLIT, i1e = (part == 0) ? SPLIT : T_DEF;
        auto dsc = [=](int r) { TileDesc d; d.nbase = 0;
            if (r < T_OUT) { d.W = w_out_a; d.ldw = D; d.K = DI; d.k0 = (r / (D / 64)) * 64; d.n0 = (r % (D / 64)) * 64; d.WT = WOA; return d; } r -= T_OUT;
            if (r < T_OUT) { d.W = w_out_b; d.ldw = D; d.K = DI; d.k0 = (r / (D / 64)) * 64; d.n0 = (r % (D / 64)) * 64; d.WT = WOB; return d; } r -= T_OUT;
            if (r < T_F) { d.W = w_in_b; d.ldw = NWB; d.K = D; d.k0 = r * 64; d.n0 = LDP; d.WT = WF; d.nbase = LDP; return d; } r -= T_F;
            d.W = w_in_b; d.ldw = NWB; d.K = D; d.k0 = (r / (LDP / 64)) * 64; d.n0 = (r % (LDP / 64)) * 64; d.WT = WB; return d; };
        int it = i0 + gw;
        if (it < i1e) { TileDesc d0 = dsc(it); tile_load(d0, a0, b0, lane);
            for (;;) {
                const int i1 = it + NGW; const bool m1 = i1 < i1e; TileDesc d1 = dsc(m1 ? i1 : it); if (m1) tile_load(d1, a1, b1, lane);
                tile_store(d0, a0, b0, scr, lane); if (!m1) break;
                const int i2 = i1 + NGW; const bool m2 = i2 < i1e; d0 = dsc(m2 ? i2 : i1); if (m2) tile_load(d0, a0, b0, lane);
                tile_store(d1, a1, b1, scr, lane); if (!m2) break;
                it = i2;
            } }
    }
}

namespace scan {
typedef short s16x4 __attribute__((ext_vector_type(4)));
typedef short bf16x8 __attribute__((ext_vector_type(8)));
typedef float f32x4 __attribute__((ext_vector_type(4)));
typedef unsigned u32x2 __attribute__((ext_vector_type(2)));
#ifndef SCAN_DMA_AUX
#define SCAN_DMA_AUX 2
#endif
#ifndef SCAN_STAGGER
#define SCAN_STAGGER 1
#endif
constexpr int R = 8, NSTEP = SEQ / 16;
constexpr int RAW = 0, PRD = R * 16384, PRD_SZ = 3 * 4096 + 512, QDT = 0, KIT = 4096, KE = 8192, DEC = 12288, SSQ = PRD + 2 * PRD_SZ, LDS_BYTES = SSQ + 1024;
__device__ __forceinline__ s16x4 trd(LAS const unsigned char* p) { return __builtin_bit_cast(s16x4, __builtin_amdgcn_ds_read_tr16_b64_v4i16((LAS s16x4*)p)); }
__device__ __forceinline__ s16x4 pk4(float a, float b, float c, float d) { u32x2 w; w.x = pk2(a, b); w.y = pk2(c, d); return __builtin_bit_cast(s16x4, w); }
__device__ __forceinline__ bf16x8 cat8(s16x4 a, s16x4 b) { return __builtin_shufflevector(a, b, 0, 1, 2, 3, 4, 5, 6, 7); }
#define SC_BAR() do { asm volatile("" ::: "memory"); __builtin_amdgcn_s_barrier(); asm volatile("" ::: "memory"); } while (0)

__device__ __forceinline__ void scan_unit(LAS unsigned char* lds, const bf16* __restrict__ P, const float* __restrict__ onw, bf16* __restrict__ Y, int bh) {
    const int tid = threadIdx.x, wid = __builtin_amdgcn_readfirstlane(tid >> 6), lane = tid & 63, n = lane & 15, g = lane >> 4, tq = n >> 2, tp = n & 3;
    const int b = bh / NH, h = bh % NH;
    const bf16* base = P + (size_t)(b * NH + h) * SEQ * HD;
    size_t goff[2]; int ldst[2];
#pragma unroll
    for (int ii = 0; ii < 2; ++ii) { const int i = 2 * wid + ii, ti = i >> 2, rg = i & 3, row = 4 * rg + (lane >> 4), pc = lane & 15, c = pc ^ ((row & 7) << 1);
        const int sec = (ti == 0) ? 1 : ((ti == 1) ? 0 : ti);
        goff[ii] = (size_t)row * HD + (size_t)sec * ((size_t)NB * NH * SEQ * HD) + c * 8; ldst[ii] = ti * 4096 + rg * 1024; }
#define SC_DMA(step) do { const int st_ = (step) < NSTEP ? (step) : NSTEP - 1; const int sl_ = ((step) & (R - 1)) * 16384; _Pragma("unroll") for (int ii = 0; ii < 2; ++ii) \
        __builtin_amdgcn_global_load_lds((const unsigned*)(base + (size_t)st_ * 16 * HD + goff[ii]), (LAS unsigned*)(lds + RAW + sl_ + ldst[ii]), 16, 0, SCAN_DMA_AUX); } while (0)
    const int rrow = 4 * g + tq;
    const int rtr = rrow * 256 + ((2 * wid + (tp >> 1)) ^ ((rrow & 7) << 1)) * 16 + 8 * (tp & 1);
    const int rsg = n * 256 + ((2 * wid + (g >> 1)) ^ ((n & 7) << 1)) * 16 + 8 * (g & 1);
    const int wq = (16 * wid + n) * 32 + g * 8;
    const int wk = (g >> 1) * 2048 + (16 * wid + n) * 16 + (g & 1) * 8;
    const int rqt = (4 * g + tq) * 32 + 8 * tp;
    const int rke = (g >> 1) * 2048 + n * 16 + (g & 1) * 8;
    const int rdec = (4 * g) * 4;
    s16x4 ltri; { short one = (short)0x3F80; ltri[0] = (4 * g + 0 <= n) ? one : (short)0; ltri[1] = (4 * g + 1 <= n) ? one : (short)0; ltri[2] = (4 * g + 2 <= n) ? one : (short)0; ltri[3] = (4 * g + 3 <= n) ? one : (short)0; }
    f32x4 gain = *(const f32x4*)(onw + h * HD + 16 * wid + 4 * g);
    asm volatile("" : "+v"(gain[0]), "+v"(gain[1]), "+v"(gain[2]), "+v"(gain[3]));
    f32x4 S[8];
#pragma unroll
    for (int t = 0; t < 8; ++t) S[t] = (f32x4){0.f, 0.f, 0.f, 0.f};
    f32x4 oprev = (f32x4){0.f, 0.f, 0.f, 0.f};
#define SC_PREP(s_) do { const LAS unsigned char* raw_ = lds + RAW + ((s_) & (R - 1)) * 16384; LAS unsigned char* img_ = lds + PRD + ((s_) & 1) * PRD_SZ; \
        const s16x4 lfB = trd(raw_ + rtr), qsB = trd(raw_ + 4096 + rtr); \
        const f32x4 G = __builtin_amdgcn_mfma_f32_16x16x16bf16_1k(ltri, lfB, (f32x4){0.f, 0.f, 0.f, 0.f}, 0, 0, 0); \
        const float dec_ = __builtin_amdgcn_exp2f(__shfl(G[3], 48 + n)); \
        float qd[4], ki[4], ke[4]; \
        _Pragma("unroll") for (int j = 0; j < 4; ++j) { const float lf = bf2f((unsigned short)lfB[j]), qs = bf2f((unsigned short)qsB[j]); \
            const float E = __builtin_amdgcn_exp2f(G[j]), Ei = __builtin_amdgcn_exp2f(-G[j]); \
            const float kk = 1.0f - __builtin_amdgcn_exp2f(lf); \
            qd[j] = qs * E; ki[j] = kk * Ei; ke[j] = ki[j] * dec_; } \
        *(LAS s16x4*)(img_ + QDT + wq) = pk4(qd[0], qd[1], qd[2], qd[3]); \
        *(LAS s16x4*)(img_ + KIT + wq) = pk4(ki[0], ki[1], ki[2], ki[3]); \
        *(LAS s16x4*)(img_ + KE + wk) = pk4(ke[0], ke[1], ke[2], ke[3]); \
        if (g == 0) *(LAS float*)(img_ + DEC + (16 * wid + n) * 4) = dec_; } while (0)
#define SC_OUT(s_) do { const LAS unsigned char* rawp = lds + RAW + ((s_) & (R - 1)) * 16384; const LAS unsigned char* sq = lds + SSQ + ((s_) & 1) * 512 + n * 32; \
        const f32x4 a = *(const LAS f32x4*)sq, c = *(const LAS f32x4*)(sq + 16); \
        const float tot = ((a[0] + a[1]) + (a[2] + a[3])) + ((c[0] + c[1]) + (c[2] + c[3])); \
        const float rs = __builtin_amdgcn_rsqf(tot * (1.0f / HD) + EPS); \
        const s16x4 sgv = *(const LAS s16x4*)(rawp + 3 * 4096 + rsg); \
        const float y0 = oprev[0] * rs * gain[0] * bf2f((unsigned short)sgv[0]), y1 = oprev[1] * rs * gain[1] * bf2f((unsigned short)sgv[1]); \
        const float y2 = oprev[2] * rs * gain[2] * bf2f((unsigned short)sgv[2]), y3 = oprev[3] * rs * gain[3] * bf2f((unsigned short)sgv[3]); \
        u32x2 w; w.x = pk2(y0, y1); w.y = pk2(y2, y3); \
        *(u32x2*)(Y + (size_t)(b * SEQ + 16 * (s_) + n) * DI + h * HD + 16 * wid + 4 * g) = w; } while (0)
    SC_DMA(0); SC_DMA(1); SC_DMA(2); SC_DMA(3); SC_DMA(4); SC_DMA(5);
    asm volatile("s_waitcnt vmcnt(10)" ::: "memory");
    SC_BAR();
    SC_PREP(0);
    for (int st = 0; st < NSTEP; ++st) {
        asm volatile("s_waitcnt vmcnt(8) lgkmcnt(0)" ::: "memory");
        SC_BAR();
        SC_DMA(st + 6);
        if (SCAN_STAGGER && wid >= 4 && st + 1 < NSTEP) SC_PREP(st + 1);
        if (st > 0) SC_OUT(st - 1);
        {
            const LAS unsigned char* raw = lds + RAW + (st & (R - 1)) * 16384; const LAS unsigned char* img = lds + PRD + (st & 1) * PRD_SZ;
            s16x4 qf[8], kf[8];
#pragma unroll
            for (int t = 0; t < 8; ++t) { qf[t] = trd(img + QDT + rqt + 512 * t); kf[t] = trd(img + KIT + rqt + 512 * t); }
            const s16x4 vf = trd(raw + 2 * 4096 + rtr);
            f32x4 sc = (f32x4){0.f, 0.f, 0.f, 0.f};
#pragma unroll
            for (int u = 0; u < 4; ++u) sc = __builtin_amdgcn_mfma_f32_16x16x32_bf16(cat8(kf[2 * u], kf[2 * u + 1]), cat8(qf[2 * u], qf[2 * u + 1]), sc, 0, 0, 0);
#pragma unroll
            for (int j = 0; j < 4; ++j) sc[j] = (4 * g + j <= n) ? sc[j] : 0.f;
            f32x4 o = (f32x4){0.f, 0.f, 0.f, 0.f};
#pragma unroll
            for (int u = 0; u < 4; ++u) { const s16x4 s0 = pk4(S[2 * u][0], S[2 * u][1], S[2 * u][2], S[2 * u][3]), s1 = pk4(S[2 * u + 1][0], S[2 * u + 1][1], S[2 * u + 1][2], S[2 * u + 1][3]);
                o = __builtin_amdgcn_mfma_f32_16x16x32_bf16(cat8(s0, s1), cat8(qf[2 * u], qf[2 * u + 1]), o, 0, 0, 0); }
            o = __builtin_amdgcn_mfma_f32_16x16x16bf16_1k(vf, pk4(sc[0], sc[1], sc[2], sc[3]), o, 0, 0, 0);
#pragma unroll
            for (int t = 0; t < 8; ++t) { const s16x4 kef = *(const LAS s16x4*)(img + KE + rke + 256 * t); const f32x4 dv = *(const LAS f32x4*)(img + DEC + rdec + 64 * t);
                S[t] = __builtin_amdgcn_mfma_f32_16x16x16bf16_1k(kef, vf, S[t] * dv, 0, 0, 0); }
            float ss = (o[0] * o[0] + o[1] * o[1]) + (o[2] * o[2] + o[3] * o[3]);
            ss += __shfl_xor(ss, 16); ss += __shfl_xor(ss, 32);
            if (g == 0) *(LAS float*)(lds + SSQ + (st & 1) * 512 + (n * 8 + wid) * 4) = ss;
            oprev = o;
        }
        if ((!SCAN_STAGGER || wid < 4) && st + 1 < NSTEP) SC_PREP(st + 1);
    }
    asm volatile("s_waitcnt lgkmcnt(0)" ::: "memory");
    SC_BAR();
    SC_OUT(NSTEP - 1);
    asm volatile("s_waitcnt vmcnt(0) lgkmcnt(0)" ::: "memory");
    SC_BAR();
#undef SC_DMA
#undef SC_PREP
#undef SC_OUT
}
#undef SC_BAR
}

namespace fox {
enum { ORDER_NATURAL = 0, ORDER_REVERSED = 1, ORDER_PAIRED = 2, ORDER_XCD = 4 };
constexpr int B = NB, H = NH, HKV = NH, SQ = SEQ, SKV = SEQ, D = HD, QOFF = 0, WINDOW = SEQ;
constexpr int LDQ = HD, LDO = DI;
constexpr size_t SECSZ = (size_t)NB * NH * SEQ * HD;
constexpr float THR = 8.f;
constexpr int ORDER = ORDER_PAIRED | ORDER_XCD;
constexpr bool WSKIP = false;
constexpr float ISCALE = 11.313708498984761f;
constexpr int STG_ROW = 272;
constexpr float SCALE = 0.08838834764831845f;
constexpr int NW = 8, QBLK = 32, KVBLK = 64, QB = NW * QBLK;
constexpr int SHM_V = KVBLK * D * 2, SHM_K = KVBLK * D * 2;
constexpr int LDS_BYTES = 2 * SHM_V + 2 * SHM_K + NW * 64 * 4;
constexpr int C_OFF = LDS_BYTES, STG_OFF = C_OFF + SEQ * 4;
static_assert(D == 128 && SQ % QB == 0 && SKV % KVBLK == 0 && H % HKV == 0 && QOFF >= 0 && QOFF + SQ <= SKV && WINDOW >= 1, "geometry");

using bf16 = unsigned short;
typedef short bf16x8 __attribute__((ext_vector_type(8)));
typedef short s16x4 __attribute__((ext_vector_type(4)));
typedef float f32x16 __attribute__((ext_vector_type(16)));
typedef float f32x4 __attribute__((ext_vector_type(4)));
typedef unsigned u32x4 __attribute__((ext_vector_type(4)));
template <class A, class Bt> struct same_t { static constexpr bool v = false; };
template <class A> struct same_t<A, A> { static constexpr bool v = true; };

#define KSWZ(row, colB) ((row) * 256 + ((colB) ^ (((row) & 7) << 4)))
#define SBAR() __builtin_amdgcn_sched_barrier(0)
__device__ __forceinline__ int v_st(int k, int c) { const int kk = (k & ~0xC) | ((k & 4) << 1) | ((k & 8) >> 1); return ((kk >> 3) * 4 + (c >> 5)) * 512 + ((kk & 7) * 32 + (c & 31)) * 2; }
__device__ __forceinline__ int v_rd_base(int lane) { return ((lane & 3) << 3) | (((lane >> 2) & 3) << 6) | (((lane >> 4) & 1) << 5) | (((lane >> 5) & 1) << 8); }
constexpr int v_rd_off(int d0, int ks, int half) { return d0 * 512 + ks * 4096 + half * 2048; }
__device__ __forceinline__ int crow(int r, int hi) { return (r & 3) + 8 * (r >> 2) + 4 * hi; }
__device__ __forceinline__ unsigned cvtpk(float lo, float hi) {
    return pg8::cvt_pk_bf16(lo, hi);
}
__device__ __forceinline__ bf16x8 pack8(f32x4 a, f32x4 b) {
    u32x4 w = {cvtpk(a[0], a[1]), cvtpk(a[2], a[3]), cvtpk(b[0], b[1]), cvtpk(b[2], b[3])};
    return *reinterpret_cast<bf16x8*>(&w);
}
template <class T> __device__ __forceinline__ bf16x8 load8(const T* p) {
    if constexpr (same_t<T, float>::v) { return pack8(*(const f32x4*)p, *(const f32x4*)(p + 4)); }
    else { return *reinterpret_cast<const bf16x8*>(p); }
}
__device__ __forceinline__ void mask_tile(f32x16& p0, f32x16& p1, int dq, unsigned W) {
    const float NEG = -__builtin_inff();
#pragma unroll
    for (int r = 0; r < 16; ++r) {
        const int c = (r & 3) + 8 * (r >> 2);
        if ((unsigned)(dq - c) >= W) p0[r] = NEG;
        if ((unsigned)(dq - c - 32) >= W) p1[r] = NEG;
    }
}
__device__ __forceinline__ void partialSM(f32x16& p0, f32x16& p1, float mnL) {
    constexpr float C2 = 1.4426950408889634f * SCALE;
    for (int r = 0; r < 16; ++r) p0[r] = fmaf(p0[r], C2, mnL); for (int r = 0; r < 16; ++r) p1[r] = fmaf(p1[r], C2, mnL);
    for (int r = 0; r < 16; ++r) p0[r] = __builtin_amdgcn_exp2f(p0[r]);
}
__device__ __forceinline__ void finishSM(f32x16& p0, f32x16& p1, float& l_reg, bf16x8& pa0, bf16x8& pa1, bf16x8& pa2, bf16x8& pa3) {
    for (int r = 0; r < 16; ++r) p1[r] = __builtin_amdgcn_exp2f(p1[r]);
    float ps = 0; for (int r = 0; r < 16; ++r) ps += p0[r]; for (int r = 0; r < 16; ++r) ps += p1[r];
    { auto rr = __builtin_amdgcn_permlane32_swap(__float_as_uint(ps), __float_as_uint(ps), false, false);
      ps = __uint_as_float(rr[0]) + __uint_as_float(rr[1]); }
    l_reg += ps;
#define PK4(P, B_, OUT) do { unsigned a0 = cvtpk(P[B_+0], P[B_+1]), a1 = cvtpk(P[B_+2], P[B_+3]);                          \
        unsigned b0 = cvtpk(P[B_+4], P[B_+5]), b1 = cvtpk(P[B_+6], P[B_+7]);                                             \
        auto r0 = __builtin_amdgcn_permlane32_swap(a0, b0, false, false); auto r1 = __builtin_amdgcn_permlane32_swap(a1, b1, false, false); \
        u32x4 w = {r0[0], r1[0], r0[1], r1[1]}; OUT = *reinterpret_cast<bf16x8*>(&w); } while (0)
    PK4(p0, 0, pa0); PK4(p0, 8, pa1); PK4(p1, 0, pa2); PK4(p1, 8, pa3);
#undef PK4
}
__device__ __forceinline__ void bias_tile(f32x16& p0, f32x16& p1, const float* cl, int kb, int hi) {
    const f32x4* cp = (const f32x4*)(cl + kb + 4 * hi);
#pragma unroll
    for (int j = 0; j < 4; ++j) { const f32x4 c0 = cp[2 * j], c1 = cp[8 + 2 * j];
#pragma unroll
        for (int e = 0; e < 4; ++e) { p0[4 * j + e] = fmaf(c0[e], -ISCALE, p0[4 * j + e]); p1[4 * j + e] = fmaf(c1[e], -ISCALE, p1[4 * j + e]); } }
}
template <int KB, bool SK>
__device__ __forceinline__ void qkt(f32x16& p0, f32x16& p1, const char* K_lds, int r32, int hi, const bf16x8* qr, bool act) {
    if (SK && !act) { const float NEG = -__builtin_inff();
#pragma unroll
        for (int r = 0; r < 16; ++r) { p0[r] = NEG; p1[r] = NEG; } return; }
    p0 = f32x16{}; p1 = f32x16{};
    const char* kb[4];
#pragma unroll
    for (int dd = 0; dd < 4; ++dd) kb[dd] = K_lds + KB * SHM_K + KSWZ(r32, (dd * 16 + hi * 8) * 2);
#pragma unroll
    for (int d0 = 0; d0 < 8; ++d0) { const char* a = kb[d0 & 3] + (d0 >> 2) * 128;
        bf16x8 b0 = *reinterpret_cast<const bf16x8*>(a);
        bf16x8 b1 = *reinterpret_cast<const bf16x8*>(a + 32 * 256);
        p0 = __builtin_amdgcn_mfma_f32_32x32x16_bf16(b0, qr[d0], p0, 0, 0, 0);
        p1 = __builtin_amdgcn_mfma_f32_32x32x16_bf16(b1, qr[d0], p1, 0, 0, 0); }
}
template <int VB, bool SK>
__device__ __forceinline__ void pv_tile(f32x16* o, int vb0, bf16x8 pa0, bf16x8 pa1, bf16x8 pa2, bf16x8 pa3, bool act) {
    if (SK && !act) return;
#define TRRD(dst, off) asm volatile("ds_read_b64_tr_b16 %0, %1 offset:%2" : "=&v"(dst) : "v"(vb0), "i"(off) : "memory")
#define PV_D0(d0) do { s16x4 l0, l1, l2, l3, h0, h1, h2, h3; constexpr int b_ = VB * SHM_V + v_rd_off(d0, 0, 0);     \
        TRRD(l0, b_); TRRD(h0, b_ + 2048); TRRD(l1, b_ + 4096); TRRD(h1, b_ + 6144); TRRD(l2, b_ + 8192); TRRD(h2, b_ + 10240); TRRD(l3, b_ + 12288); TRRD(h3, b_ + 14336); \
        asm volatile("s_waitcnt lgkmcnt(0)" ::: "memory"); SBAR();                 \
        o[d0] = __builtin_amdgcn_mfma_f32_32x32x16_bf16(pa0, (bf16x8){l0[0], l0[1], l0[2], l0[3], h0[0], h0[1], h0[2], h0[3]}, o[d0], 0, 0, 0);   \
        o[d0] = __builtin_amdgcn_mfma_f32_32x32x16_bf16(pa1, (bf16x8){l1[0], l1[1], l1[2], l1[3], h1[0], h1[1], h1[2], h1[3]}, o[d0], 0, 0, 0);   \
        o[d0] = __builtin_amdgcn_mfma_f32_32x32x16_bf16(pa2, (bf16x8){l2[0], l2[1], l2[2], l2[3], h2[0], h2[1], h2[2], h2[3]}, o[d0], 0, 0, 0);   \
        o[d0] = __builtin_amdgcn_mfma_f32_32x32x16_bf16(pa3, (bf16x8){l3[0], l3[1], l3[2], l3[3], h3[0], h3[1], h3[2], h3[3]}, o[d0], 0, 0, 0); } while (0)
    PV_D0(0); PV_D0(1); PV_D0(2); PV_D0(3);
#undef PV_D0
#undef TRRD
}

template <class TIn, class TOut> struct BlockRef { const TIn* Q; const TIn* K; const TIn* V; const TIn* G; TOut* O; int P0; };
template <class TIn> struct Seam {
    bf16x8 qr[8];
    bf16x8 st_v0, st_v1, st_k0, st_k1; f32x4 sf0, sf1, sf2, sf3;
    f32x4 tq[16];
};
__device__ __forceinline__ int swa_jlo(int P0, int W) { const int lowk = P0 - W + 1; return lowk > 0 ? lowk / KVBLK : 0; }
__device__ __forceinline__ int swa_jhi(int P0, int skv) { int j = (P0 + QB - 1) / KVBLK + 1; return j > skv / KVBLK ? skv / KVBLK : j; }
#define ROW(p, k0, rr) ((p) + (size_t)((k0) + (rr)) * LDQ + sc)
#define VMW() asm volatile("s_waitcnt vmcnt(0)" ::: "memory")
#define VMWN(n) asm volatile("s_waitcnt vmcnt(%0)" :: "i"(n) : "memory")
#define SLOAD_H(Kp, Vp, k0) do { const char* kb__ = (const char*)((Kp) + (size_t)(k0) * LDQ); const char* vb__ = (const char*)((Vp) + (size_t)(k0) * LDQ);     \
                         S.st_v0 = *(const bf16x8*)(vb__ + svoff); S.st_v1 = *(const bf16x8*)(vb__ + (size_t)32 * LDQ * 2 + svoff);              \
                         S.st_k0 = *(const bf16x8*)(kb__ + svoff); S.st_k1 = *(const bf16x8*)(kb__ + (size_t)32 * LDQ * 2 + svoff); } while (0)
#define SWRITE_HK(bf) do { *(bf16x8*)(K_lds + (bf) * SHM_K + kws) = S.st_k0; *(bf16x8*)(K_lds + (bf) * SHM_K + kws + 32 * 256) = S.st_k1; } while (0)
#define SWRITE_HV(bf) do { *(bf16x8*)(V_lds + (bf) * SHM_V + vst0) = S.st_v0; *(bf16x8*)(V_lds + (bf) * SHM_V + vst1) = S.st_v1; } while (0)
#define SWRITE_H(bf) do { SWRITE_HV(bf); SWRITE_HK(bf); } while (0)
#define SLOAD_F(p, k0) do { S.sf0 = *(const f32x4*)ROW(p, k0, sr); S.sf1 = *(const f32x4*)(ROW(p, k0, sr) + 4);                \
                            S.sf2 = *(const f32x4*)ROW(p, k0, 32 + sr); S.sf3 = *(const f32x4*)(ROW(p, k0, 32 + sr) + 4); } while (0)
#define SWRITE_KF(bf) do { *(bf16x8*)(K_lds + (bf) * SHM_K + kws) = pack8(S.sf0, S.sf1); *(bf16x8*)(K_lds + (bf) * SHM_K + kws + 32 * 256) = pack8(S.sf2, S.sf3); } while (0)
#define SWRITE_VF(bf) do { *(bf16x8*)(V_lds + (bf) * SHM_V + vst0) = pack8(S.sf0, S.sf1); *(bf16x8*)(V_lds + (bf) * SHM_V + vst1) = pack8(S.sf2, S.sf3); } while (0)
template <class TIn, class TOut>
__device__ __forceinline__ void causal_swa_prime(const BlockRef<TIn, TOut>& cur, int skv, int W, char* lds, Seam<TIn>& S) {
    constexpr bool F32 = same_t<TIn, float>::v;
    const int tid = threadIdx.x, wid = __builtin_amdgcn_readfirstlane(tid >> 6), lane = tid & 63, r32 = lane & 31, hi = lane >> 5;
    const int sr = tid >> 4, sc = (tid & 15) * 8, kws = KSWZ(sr, sc * 2); char* K_lds = lds + 2 * SHM_V;
    const unsigned svoff = (unsigned)(sr * LDQ + sc) * 2u, qvoff = (unsigned)(r32 * LDQ + hi * 8) * 2u;
    const int kb0 = (swa_jhi(cur.P0, skv) - 1) * KVBLK; (void)W;
    for (int d0 = 0; d0 < 8; ++d0) S.qr[d0] = *(const bf16x8*)((const char*)(cur.Q + (size_t)(wid * QBLK) * LDQ) + d0 * 32 + qvoff);
    if constexpr (F32) { SLOAD_F((const float*)cur.K, kb0); VMW(); SWRITE_KF(0); SBAR(); SLOAD_F((const float*)cur.V, kb0); }
    else { SLOAD_H(cur.K, cur.V, kb0); VMW(); SWRITE_HK(0); }
    __syncthreads();
}
template <class TIn, class TOut>
__device__ __forceinline__ void causal_swa_block(const BlockRef<TIn, TOut>& cur, const BlockRef<TIn, TOut>& nxt, int skv, int W, char* lds, Seam<TIn>& S, float thr, float kn) {
    constexpr bool F32 = same_t<TIn, float>::v;
    const int tid = threadIdx.x, wid = __builtin_amdgcn_readfirstlane(tid >> 6), lane = tid & 63, r32 = lane & 31, hi = lane >> 5;
    int j_hi = (cur.P0 + QB - 1) / KVBLK + 1; if (j_hi > skv / KVBLK) j_hi = skv / KVBLK;
    const int kbn = (swa_jhi(nxt.P0, skv) - 1) * KVBLK;
    const int qlo = cur.P0 + wid * QBLK, qm = qlo + r32 - 4 * hi;
    char* V_lds = lds; char* K_lds = lds + 2 * SHM_V;
    const float* cl = (const float*)(lds + C_OFF);
    int j_lo; { const int lastk = 64 * lane + 63; const bool skip = (lastk < cur.P0) && (cl[cur.P0] - cl[lastk] < -thr);
        const unsigned long long keep = __ballot(!skip); j_lo = keep ? (int)__builtin_ctzll(keep) : 0; (void)W; }
    const int NT = j_hi - j_lo;
    float* ws = (float*)(lds + 2 * SHM_V + 2 * SHM_K) + wid * 64; float* li_l = ws, * al_l = ws + 32;
    float l_reg = 0; f32x16 o[4] = {};
    float mnL; { float q2 = 0.f;
#pragma unroll
        for (int d0 = 0; d0 < 8; ++d0)
#pragma unroll
            for (int j = 0; j < 8; ++j) { const float v = __uint_as_float(((unsigned)(unsigned short)S.qr[d0][j]) << 16); q2 = fmaf(v, v, q2); }
        { auto rr = __builtin_amdgcn_permlane32_swap(__float_as_uint(q2), __float_as_uint(q2), false, false); q2 = __uint_as_float(rr[0]) + __uint_as_float(rr[1]); }
        const float Mt = fminf(SCALE * sqrtf(q2) * kn, 42.0f);
        int ci = wid * QBLK + r32; asm volatile("" : "+v"(ci));
        mnL = -(Mt - cl[cur.P0 + ci]) * 1.4426950408889634f; }
    const int sr = tid >> 4, sc = (tid & 15) * 8, vst0 = v_st(sr, sc), vst1 = v_st(32 + sr, sc), kws = KSWZ(sr, sc * 2);
    const unsigned svoff = (unsigned)(sr * LDQ + sc) * 2u, qvoff = (unsigned)(r32 * LDQ + hi * 8) * 2u;
    const int vb0 = (int)(uintptr_t)V_lds + v_rd_base(lane);
    const TIn* Kh = cur.K; const TIn* Vh = cur.V;
#define KBASE(t) ((j_hi - 1 - (t)) * KVBLK)
#define ACT(t) (KBASE(t) <= qlo + QBLK - 1 && KBASE(t) + KVBLK - 1 >= qlo - W + 1)
#define MASKT(P0_, P1_, t) do { const int kb_ = KBASE(t); bias_tile(P0_, P1_, cl, kb_, hi); if ((!SK || ACT(t)) && (kb_ + KVBLK - 1 > qlo || kb_ <= qlo + QBLK - 1 - W)) mask_tile(P0_, P1_, qm - kb_, (unsigned)W); } while (0)
    constexpr int NQL = F32 ? 16 : 8;
    constexpr bool SK = WSKIP && !F32;
#define SEAM_K0() do { VMWN(NQL); if constexpr (F32) { SWRITE_KF(0); SBAR(); SLOAD_F((const float*)nxt.V, kbn); } else { SWRITE_HK(0); } SBAR(); } while (0)
    f32x16 pA0, pA1, pB0, pB1; bf16x8 pa0, pa1, pa2, pa3;
    if constexpr (F32) { VMW(); SWRITE_VF(0); SBAR(); } else { SWRITE_HV(0); SBAR(); }
    if (NT > 1) { if constexpr (F32) SLOAD_F((const float*)Kh, KBASE(1)); else SLOAD_H(Kh, Vh, KBASE(1)); }
    SBAR(); qkt<0, SK>(pA0, pA1, K_lds, r32, hi, S.qr, ACT(0));
    if constexpr (F32) { if (NT > 1) { VMW(); SWRITE_KF(1); SBAR(); SLOAD_F((const float*)Vh, KBASE(1)); } }
    MASKT(pA0, pA1, 0); partialSM(pA0, pA1, mnL);
    if (NT > 1) { VMW(); if constexpr (F32) { SWRITE_VF(1); SBAR(); if (NT > 2) SLOAD_F((const float*)Kh, KBASE(2)); } else SWRITE_H(1); }
    __syncthreads();
#define HALF_STEP(PX0, PX1, PY0, PY1, t, KB, VB, SB) do {                                                      \
        SBAR(); qkt<KB, SK>(PX0, PX1, K_lds, r32, hi, S.qr, ACT(t));                                             \
        finishSM(PY0, PY1, l_reg, pa0, pa1, pa2, pa3); SBAR();                                                                \
        if ((t) + 1 < NT) { if constexpr (F32) { VMW(); SWRITE_KF(SB); SBAR(); SLOAD_F((const float*)Vh, KBASE((t) + 1)); }  \
                            else { SLOAD_H(Kh, Vh, KBASE((t) + 1)); } SBAR(); }                                               \
        pv_tile<VB, SK>(o, vb0, pa0, pa1, pa2, pa3, ACT((t) - 1)); MASKT(PX0, PX1, (t)); partialSM(PX0, PX1, mnL);                                        \
        __syncthreads();                                                                                                      \
        if ((t) + 1 < NT) { VMW(); if constexpr (F32) { SWRITE_VF(SB); SBAR(); if ((t) + 2 < NT) SLOAD_F((const float*)Kh, KBASE((t) + 2)); } \
                            else { SWRITE_H(SB); } }                                                                          \
        __syncthreads(); } while (0)
    for (int t = 1; t + 1 < NT; t += 2) {
        HALF_STEP(pB0, pB1, pA0, pA1, t, 1, 0, 0);
        HALF_STEP(pA0, pA1, pB0, pB1, t + 1, 0, 1, 1);
    }
    const bool even = (NT & 1) == 0;
    if (even) { SBAR(); qkt<1, SK>(pB0, pB1, K_lds, r32, hi, S.qr, ACT(NT - 1)); SBAR(); }
#define QROW(e) (nxt.Q + (size_t)(wid * QBLK + r32) * LDQ + ((e) >> 1) * 16 + hi * 8 + ((e) & 1) * 4)
    if constexpr (F32) { SLOAD_F((const float*)nxt.K, kbn); SBAR();
#pragma unroll
        for (int e = 0; e < 8; ++e) S.tq[e] = *(const f32x4*)QROW(e); }
    else { SLOAD_H(nxt.K, nxt.V, kbn); SBAR();
#pragma unroll
        for (int d0 = 0; d0 < 8; ++d0) S.qr[d0] = *(const bf16x8*)((const char*)(nxt.Q + (size_t)(wid * QBLK) * LDQ) + d0 * 32 + qvoff); }
    SBAR();
    finishSM(pA0, pA1, l_reg, pa0, pa1, pa2, pa3); SBAR();
    if constexpr (F32) {
#pragma unroll
        for (int e = 8; e < 16; ++e) S.tq[e] = *(const f32x4*)QROW(e); SBAR(); }
#undef QROW
    pv_tile<0, SK>(o, vb0, pa0, pa1, pa2, pa3, ACT(even ? NT - 2 : NT - 1));
    if (even) { MASKT(pB0, pB1, NT - 1); partialSM(pB0, pB1, mnL); __syncthreads();
        finishSM(pB0, pB1, l_reg, pa0, pa1, pa2, pa3); SBAR(); pv_tile<1, SK>(o, vb0, pa0, pa1, pa2, pa3, ACT(NT - 1)); }
    SBAR(); SEAM_K0();
    if (hi == 0) li_l[r32] = l_reg; asm volatile("s_waitcnt lgkmcnt(0)" ::: "memory");
    float rli[16];
#pragma unroll
    for (int r = 0; r < 16; ++r) rli[r] = __builtin_amdgcn_rcpf(li_l[crow(r, hi)]);
    { char* stg = lds + STG_OFF + wid * (QBLK * STG_ROW);
      int loff = (lane >> 4) * LDQ + (lane & 15) * 8, yoff = (lane >> 4) * LDO + (lane & 15) * 8;
      asm volatile("" : "+v"(loff), "+v"(yoff));
      const TIn* Gw = cur.G + (size_t)(wid * QBLK) * LDQ + loff; TOut* Ow = cur.O + (size_t)(wid * QBLK) * LDO + yoff;
#pragma unroll
      for (int r = 0; r < 16; ++r) { const int orow = crow(r, hi);
#pragma unroll
          for (int d0 = 0; d0 < 4; ++d0) { const float v = o[d0][r] * rli[r]; const float vn = __shfl_xor(v, 1);
              if ((r32 & 1) == 0) *(unsigned*)(stg + orow * STG_ROW + (d0 * 32 + r32) * 2) = cvtpk(v, vn); } }
      asm volatile("s_waitcnt lgkmcnt(0)" ::: "memory");
#pragma unroll
      for (int hf = 0; hf < 2; ++hf) { u32x4 gv[4];
#pragma unroll
          for (int i = 0; i < 4; ++i) gv[i] = *(const u32x4*)(Gw + (size_t)(16 * hf + 4 * i) * LDQ);
#pragma unroll
          for (int i = 0; i < 4; ++i) { const u32x4 ov = *(const u32x4*)(stg + (16 * hf + 4 * i + (lane >> 4)) * STG_ROW + (lane & 15) * 16); const u32x4 g4 = gv[i]; u32x4 w;
#pragma unroll
              for (int e = 0; e < 4; ++e) w[e] = cvtpk(__uint_as_float(ov[e] << 16) * __uint_as_float(g4[e] << 16), __uint_as_float(ov[e] & 0xffff0000u) * __uint_as_float(g4[e] & 0xffff0000u));
              *(u32x4*)(Ow + (size_t)(16 * hf + 4 * i) * LDO) = w; }
          asm volatile("" ::: "memory"); } }
    if constexpr (F32) {
#pragma unroll
        for (int d0 = 0; d0 < 8; ++d0) S.qr[d0] = pack8(S.tq[2 * d0], S.tq[2 * d0 + 1]); }
    __syncthreads();
#undef KBASE
#undef ACT
#undef MASKT
#undef SEAM_K0
#undef HALF_STEP
}
#undef ROW
#undef VMW
#undef VMWN
#undef SLOAD_H
#undef SWRITE_HK
#undef SWRITE_HV
#undef SWRITE_H
#undef SLOAD_F
#undef SWRITE_KF
#undef SWRITE_VF

__host__ __device__ inline int swa_nramp(int nqb, int W, int qoff) { const int t = W - 1 - qoff; const int n = t < 0 ? 0 : t / QB + 1; return n > nqb ? nqb : n; }
__host__ __device__ inline int swa_nx(int nqb, int nramp, int order) { return (order & ORDER_PAIRED) ? (nramp + 1) / 2 + (nqb - nramp) : nqb; }
struct SwaItem { int bh, qb0, qb1; };
__device__ __forceinline__ SwaItem swa_decode(int L, int nb, int nh, int nhkv, int nqb, int nx, int nramp, int order) {
    const int G = nh / nhkv; SwaItem it; int x;
    if ((order & ORDER_XCD) && (nb * nhkv) % 8 == 0) { const int xcd = L & 7, k = L >> 3, per = G * nx, gi = k / per, r = k - gi * per;
        it.bh = (gi * 8 + xcd) * G + r / nx; x = r % nx; }
    else { it.bh = L / nx; x = L - it.bh * nx; }
    if (order & ORDER_PAIRED) { const int ns = nqb - nramp;
        if (x < ns) { it.qb0 = it.qb1 = nqb - 1 - x; } else { it.qb0 = x - ns; it.qb1 = nramp - 1 - it.qb0; } }
    else { it.qb0 = it.qb1 = ((order & 3) == ORDER_REVERSED) ? nqb - 1 - x : x; }
    return it;
}
template <class TIn, class TOut>
__device__ __forceinline__ BlockRef<TIn, TOut> swa_ref(const SwaItem& it, int pass, const TIn* Q, const TIn* K, const TIn* V, TOut* O,
                                                    int nh, int nhkv, int sq, int skv, int qoff) {
    const int qb = pass ? it.qb1 : it.qb0, kvh = it.bh / (nh / nhkv);
    BlockRef<TIn, TOut> r;
    const int b_ = it.bh / nh, h_ = it.bh % nh; (void)kvh; (void)K; (void)V;
    const TIn* rowb = Q + (size_t)(b_ * nh + h_) * sq * LDQ;
    r.Q = rowb + (size_t)qb * QB * LDQ; r.K = rowb + SECSZ; r.V = rowb + 2 * SECSZ; r.G = r.Q + 3 * SECSZ;
    r.O = O + ((size_t)b_ * sq + (size_t)qb * QB) * LDO + h_ * D; r.P0 = qoff + qb * QB;
    return r;
}

constexpr int WT_OFF = STG_OFF + NW * QBLK * STG_ROW, ATT_LDS = WT_OFF + 64;
__device__ __forceinline__ void load_c(char* lds, const float* LS, int bh) {
    int tid = threadIdx.x; asm volatile("" : "+v"(tid));
    const int lane = tid & 63, wv = tid >> 6;
    const f32x4* src = (const f32x4*)(LS + (size_t)bh * SEQ) + 2 * tid;
    const f32x4 a = src[0], b = src[1];
    float v[8]; v[0] = a[0]; v[1] = v[0] + a[1]; v[2] = v[1] + a[2]; v[3] = v[2] + a[3]; v[4] = v[3] + b[0]; v[5] = v[4] + b[1]; v[6] = v[5] + b[2]; v[7] = v[6] + b[3];
    float inc = v[7];
#pragma unroll
    for (int o = 1; o < 64; o <<= 1) { const float t = __uint_as_float(__builtin_amdgcn_ds_bpermute(((lane - o) & 63) << 2, __float_as_uint(inc))); if (lane >= o) inc += t; }
    float* wt = (float*)(lds + WT_OFF);
    if (lane == 63) wt[wv] = inc;
    __syncthreads();
    float base = inc - v[7];
#pragma unroll
    for (int w = 0; w < 7; ++w) if (w < wv) base += wt[w];
    f32x4* dst = (f32x4*)(lds + C_OFF) + 2 * tid;
    dst[0] = (f32x4){base + v[0], base + v[1], base + v[2], base + v[3]}; dst[1] = (f32x4){base + v[4], base + v[5], base + v[6], base + v[7]};
}
__device__ __forceinline__ BlockRef<bf16, bf16> blk_ref(int id, const bf16* P, bf16* Y, int& bh) {
    constexpr int nqb = SQ / QB; bh = id % (B * H); const int qb = nqb - 1 - id / (B * H);
    SwaItem it; it.bh = bh; it.qb0 = it.qb1 = qb;
    return swa_ref<bf16, bf16>(it, 0, P, P, P, Y, H, HKV, SQ, SKV, QOFF);
}
__device__ __forceinline__ void head_bounds(const float* NRM, int bh, float& thr, float& kn) {
    const float* nq = NRM + (size_t)bh * 4; const float* nk = NRM + (size_t)(B * H + bh) * 4;
    const float q2 = (nq[0] + nq[1]) + (nq[2] + nq[3]), k2 = (nk[0] + nk[1]) + (nk[2] + nk[3]);
    kn = 1.01f * sqrtf(k2);
    thr = 110.0f + fmaxf(0.f, 1.01f * SCALE * sqrtf(q2) * kn - 42.0f);
}
__device__ __forceinline__ void attn_phase(char* lds, const bf16* P, const float* LS, const float* NRM, bf16* Y, unsigned* qctr, int blk, int nblk) {
    constexpr int total = B * H * (SQ / QB);
    volatile int* qslot = (volatile int*)(lds + WT_OFF + 32);
    (void)blk; (void)nblk;
    if (threadIdx.x == 0) { qslot[0] = (int)atomicAdd(qctr, 1u); qslot[1] = (int)atomicAdd(qctr, 1u); }
    __syncthreads();
    int id0 = __builtin_amdgcn_readfirstlane(qslot[0]), id1 = __builtin_amdgcn_readfirstlane(qslot[1]);
    if (id0 >= total) return;
#ifdef ATT_SETPRIO
    if (threadIdx.x >= 256) __builtin_amdgcn_s_setprio(1);
#endif
    int bh0, bh1 = 0;
    BlockRef<bf16, bf16> cur = blk_ref(id0, P, Y, bh0);
    Seam<bf16> S;
    load_c(lds, LS, bh0);
    causal_swa_prime<bf16, bf16>(cur, SKV, WINDOW, lds, S);
    for (;;) {
        const bool last = id1 >= total;
        const BlockRef<bf16, bf16> nxt = last ? cur : blk_ref(id1, P, Y, bh1);
        int id2 = total;
        if (threadIdx.x == 0 && !last) id2 = (int)atomicAdd(qctr, 1u);
        float thr, kn; head_bounds(NRM, bh0, thr, kn);
        causal_swa_block<bf16, bf16>(cur, nxt, SKV, WINDOW, lds, S, thr, kn);
        if (last) { __builtin_amdgcn_s_setprio(0); break; }
        if (threadIdx.x == 0) qslot[0] = id2;
        load_c(lds, LS, bh1); __syncthreads();
        id1 = __builtin_amdgcn_readfirstlane(qslot[0]);
        cur = nxt; bh0 = bh1;
    }
}
}

__device__ __forceinline__ void flogit_phase(const bf16* __restrict__ HB, const bf16* __restrict__ WF, const float* __restrict__ b_f, float* __restrict__ LS, int blk, int nblk) {
    typedef short bf16x8_t __attribute__((ext_vector_type(8)));
    const int tid = threadIdx.x, wid = __builtin_amdgcn_readfirstlane(tid >> 6), lane = tid & 63, n = lane & 15, g = lane >> 4;
    for (int rb = blk; rb < M / 32; rb += nblk) {
        const int r0 = rb * 32 + (wid >> 2) * 16, h0 = (wid & 3) * 16;
        const bf16x8_t* ap = (const bf16x8_t*)(HB + (size_t)(r0 + n) * D + 8 * g);
        const bf16x8_t* bp = (const bf16x8_t*)(WF + (size_t)(h0 + n) * D + 8 * g);
        f32x4 acc = (f32x4){0.f, 0.f, 0.f, 0.f};
#pragma unroll 8
        for (int k = 0; k < D / 32; ++k) acc = __builtin_amdgcn_mfma_f32_16x16x32_bf16(ap[4 * k], bp[4 * k], acc, 0, 0, 0);
        const float bias = b_f[h0 + n];
        f32x4 o;
#pragma unroll
        for (int j = 0; j < 4; ++j) { const float z = acc[j] + bias; const float e = __builtin_amdgcn_exp2f(-1.4426950408889634f * fabsf(z));
            o[j] = fminf(z, 0.f) - 0.6931471805599453f * __builtin_amdgcn_logf(1.0f + e); }
        const int row = r0 + 4 * g, b = row / SEQ, s = row % SEQ;
        *(f32x4*)(LS + ((size_t)b * NH + h0 + n) * SEQ + s) = o;
    }
}

#define XB_TMO      128
#define XB_XCNT(j)  (256  + 64 * (j))
#define XB_XSUB(j)  (1280 + 64 * (j))
#define XB_XGEN(j)  (2304 + 64 * (j))
#define XB_TOP      3328
#define XB_TOPGEN   3392
#define XCD_BAR_WORDS 3456
#define XB_SPIN_CAP (1u << 18)

__device__ __forceinline__ unsigned xb_ld(unsigned* p)              { return __hip_atomic_load(p, __ATOMIC_RELAXED, __HIP_MEMORY_SCOPE_AGENT); }
__device__ __forceinline__ unsigned xb_add(unsigned* p, unsigned v) { return __hip_atomic_fetch_add(p, v, __ATOMIC_RELAXED, __HIP_MEMORY_SCOPE_AGENT); }
__device__ __forceinline__ unsigned xb_xcc_id() { return (unsigned)__builtin_amdgcn_s_getreg((3 << 11) | 20) & 0xFu; }
#define XB_SPIN(cond, bar) do { unsigned _sp = 0; while (cond) { __builtin_amdgcn_s_sleep(1); \
    if ((++_sp & 255u) == 0u) { if (xb_ld(&(bar)[XB_TMO])) break; if (_sp > XB_SPIN_CAP) { atomicAdd(&(bar)[XB_TMO], 1u); break; } } } } while (0)

struct XcdBarrier {
    unsigned* bar; unsigned x;
    volatile LAS unsigned* st;
};

__device__ __forceinline__ XcdBarrier xcd_barrier_post(unsigned* bar, volatile LAS unsigned* st) {
    XcdBarrier b; b.bar = bar; b.x = xb_xcc_id(); b.st = st;
    if (threadIdx.x == 0) (void)xb_add(&bar[XB_XCNT(b.x)], 1u);
    return b;
}
__device__ __forceinline__ void xcd_barrier_complete(unsigned* bar, unsigned x, unsigned& nloc, unsigned& nx) {
    const unsigned G = gridDim.x * gridDim.y * gridDim.z;
    unsigned sum, cnt, mine, sp = 0u;
    for (;;) {
        sum = 0u; cnt = 0u; mine = 0u;
#pragma unroll
        for (unsigned j = 0; j < 16; ++j) { const unsigned c = xb_ld(&bar[XB_XCNT(j)]); sum += c; cnt += (c > 0u) ? 1u : 0u; mine = (j == x) ? c : mine; }
        if (sum == G) break;
        __builtin_amdgcn_s_sleep(1);
        if ((++sp & 255u) == 0u) { if (xb_ld(&bar[XB_TMO])) break; if (sp > XB_SPIN_CAP) { atomicAdd(&bar[XB_TMO], 1u); break; } }
    }
    nloc = mine > 0u ? mine : 1u; nx = cnt > 0u ? cnt : 1u;
}

__device__ __forceinline__ void xcd_barrier(const XcdBarrier& b) {
    asm volatile("s_waitcnt vmcnt(0)" ::: "memory");
    __syncthreads();
    if (threadIdx.x == 0) {
        unsigned* bar = b.bar;
        __builtin_amdgcn_s_waitcnt(0);
        unsigned nloc = b.st[0], nx = b.st[1];
        if (nloc == 0u) { xcd_barrier_complete(bar, b.x, nloc, nx); b.st[0] = nloc; b.st[1] = nx; }
        const unsigned old = xb_add(&bar[XB_XSUB(b.x)], 1u);
        const unsigned gen = old / nloc;
        if (old + 1u == (gen + 1u) * nloc) {
            __builtin_amdgcn_fence(__ATOMIC_RELEASE, "agent");
            asm volatile("s_waitcnt vmcnt(0)" ::: "memory");
            const unsigned og = xb_add(&bar[XB_TOP], 1u);
            const unsigned tg = og / nx;
            if (og + 1u == (tg + 1u) * nx) xb_add(&bar[XB_TOPGEN], 1u);
            else XB_SPIN(xb_ld(&bar[XB_TOPGEN]) == tg, bar);
            __builtin_amdgcn_fence(__ATOMIC_ACQUIRE, "agent");
            xb_add(&bar[XB_XGEN(b.x)], 1u);
            asm volatile("s_waitcnt vmcnt(0)" ::: "memory");
        } else {
            XB_SPIN(xb_ld(&bar[XB_XGEN(b.x)]) == gen, bar);
            __builtin_amdgcn_fence(__ATOMIC_ACQUIRE, "agent");
            asm volatile("s_waitcnt vmcnt(0)" ::: "memory");
        }
    }
    __syncthreads();
}

constexpr int CW_BAR = 1024;
constexpr size_t CTL_ZERO_BYTES = 32768;
constexpr size_t QCTR_OFF = 28672;
constexpr size_t NRM_OFF = 24576;
constexpr int LDS_TOTAL = 163840;
constexpr int MISC_OFF = LDS_TOTAL - 64;
static_assert(fox::ATT_LDS <= MISC_OFF && scan::LDS_BYTES <= MISC_OFF && pg8::STAGE_BYTES <= MISC_OFF && 8 * 8448 <= MISC_OFF, "LDS map");
#ifndef MK_N_LAUNCHES
#define MK_N_LAUNCHES 1
#endif
constexpr int N_PHASES = 9;
struct Args { const float* in[10]; float* out; unsigned char* ws; int ph_lo, ph_hi; };
__global__ void __launch_bounds__(512, 2) mega_fwd(Args args) {
    extern __shared__ __attribute__((aligned(16))) unsigned char lds[];
    LAS unsigned char* L = (LAS unsigned char*)lds;
    volatile LAS unsigned* MISC = (volatile LAS unsigned*)(L + MISC_OFF);
    const int tid = threadIdx.x, lane = tid & 63, wave = __builtin_amdgcn_readfirstlane(tid >> 6);
    const int G = gridDim.x, bx = blockIdx.x;
    if (tid < 16) MISC[tid] = 0u;
    __syncthreads();
    unsigned char* ws = args.ws;
    XcdBarrier bar; bar.bar = (unsigned*)(ws + WS_CTL) + CW_BAR; bar.x = 0; bar.st = nullptr;
    if (MK_N_LAUNCHES != N_PHASES) bar = xcd_barrier_post((unsigned*)(ws + WS_CTL) + CW_BAR, MISC + 8);
    const float* x = args.in[0]; const float* norm_w = args.in[1]; const float* w_in_a = args.in[2]; const float* lb_logits = args.in[3]; const float* o_norm_a = args.in[4];
    const float* w_out_a = args.in[5]; const float* w_in_b = args.in[6]; const float* b_f = args.in[7]; const float* w_out_b = args.in[8]; const float* final_norm = args.in[9];
    float* out = args.out;
    bf16* WA = (bf16*)(ws + WS_WA); bf16* WB = (bf16*)(ws + WS_WB); bf16* WF = (bf16*)(ws + WS_WF); bf16* WOA = (bf16*)(ws + WS_WOA); bf16* WOB = (bf16*)(ws + WS_WOB);
    bf16* HB = (bf16*)(ws + WS_HB); float* X1 = (float*)(ws + WS_X1); bf16* P = (bf16*)(ws + WS_P); bf16* Y = (bf16*)(ws + WS_Y); float* LS = (float*)(ws + WS_LS);
    const int lo = args.ph_lo, hi = args.ph_hi;
#define IN(k) (lo <= (k) && (k) < hi)
#define SEAM(k) do { if (IN(k) && IN((k) + 1)) xcd_barrier(bar); } while (0)
#define RUN(k, ...) do { if (IN(k)) { __VA_ARGS__ } } while (0)

    RUN(0, { prologue_phase(L, 0, x, norm_w, w_in_a, w_out_a, w_in_b, w_out_b, ws, bx, G, wave, lane); } );
    SEAM(0);
#ifdef GEMM_DESYNC_TICKS
    if (IN(1)) { const unsigned long long t0 = __builtin_amdgcn_s_memrealtime(); const unsigned long long dl = (unsigned long long)(((unsigned)bx >> 3) & 3u) * GEMM_DESYNC_TICKS;
        while (__builtin_amdgcn_s_memrealtime() - t0 < dl) __builtin_amdgcn_s_sleep(8); }
#endif
    RUN(1, { pg8::Gemm g{HB, WA, M, LDP, D, 0}; pg8::StaticOrder S; S.init(M, LDP, G, bx); pg8::EpiAct<0> E{P, lb_logits, nullptr, LDP, 0};
        pg8::gemm_phase<pg8::EpiAct<0>, pg8::StaticOrder, true, true>(L, g, S, E); } );
    SEAM(1);
    RUN(2, { if (G >= 2 * NB * NH) { if (bx < NB * NH) scan::scan_unit(L, P, o_norm_a, Y, bx); else prologue_phase(L, 1, x, norm_w, w_in_a, w_out_a, w_in_b, w_out_b, ws, bx - NB * NH, G - NB * NH, wave, lane); }
              else { for (int bh = bx; bh < NB * NH; bh += G) scan::scan_unit(L, P, o_norm_a, Y, bh); prologue_phase(L, 1, x, norm_w, w_in_a, w_out_a, w_in_b, w_out_b, ws, bx, G, wave, lane); } } );
#ifdef PROBE_CONV128
    if (IN(2)) { xcd_barrier(bar); if (bx >= NB * NH) prologue_phase(L, 1, x, norm_w, w_in_a, w_out_a, w_in_b, w_out_b, ws, bx - NB * NH, G - NB * NH, wave, lane); }
#endif
#ifdef PROBE_SCAN128
    if (IN(2)) { xcd_barrier(bar); if (bx < NB * NH) scan::scan_unit(L, P, o_norm_a, Y, bx); }
#endif
    SEAM(2);
    RUN(3, { pg8::Gemm g{Y, WOA, M, D, DI, 0}; pg8::StaticOrder S; S.init(M, D, G, bx); pg8::EpiRes E{x, X1, D, 0};
        pg8::gemm_phase<pg8::EpiRes, pg8::StaticOrder, true, true>(L, g, S, E); } );
    SEAM(3);
    RUN(4, { const int gw = bx * 8 + wave, NGW = G * 8; for (int m = gw; m < M; m += NGW) rms_row_bf16(X1 + (size_t)m * D, norm_w + D, HB + (size_t)m * D, lane); } );
    SEAM(4);
    RUN(5, { flogit_phase(HB, WF, b_f, LS, bx, G);
        pg8::Gemm g{HB, WB, M, LDP, D, 0}; pg8::StaticOrder S; S.init(M, LDP, G, bx); pg8::EpiAct<1> E{P, nullptr, (unsigned*)(ws + WS_CTL + NRM_OFF), LDP, 0};
        pg8::gemm_phase<pg8::EpiAct<1>, pg8::StaticOrder, true, true>(L, g, S, E); } );
    SEAM(5);
    RUN(6, { fox::attn_phase((char*)lds, P, LS, (const float*)(ws + WS_CTL + NRM_OFF), Y, (unsigned*)(ws + WS_CTL + QCTR_OFF), bx, G); } );
    SEAM(6);
    RUN(7, { pg8::Gemm g{Y, WOB, M, D, DI, 0}; pg8::StaticOrder S; S.init(M, D, G, bx); pg8::EpiRes E{X1, out, D, 0};
        pg8::gemm_phase<pg8::EpiRes, pg8::StaticOrder, true, true>(L, g, S, E); } );
    SEAM(7);
    RUN(8, { const int gw = bx * 8 + wave, NGW = G * 8; for (int m = gw; m < M; m += NGW) rms_row_f32(out + (size_t)m * D, final_norm, out + (size_t)m * D, lane); } );
#undef IN
#undef SEAM
}

extern "C" void kernel_launch(void* const* d_in, const int* in_sizes, int n_in, void* d_out, int out_size, void* d_ws, size_t ws_size, hipStream_t stream) {
    static int grid = 0;
    if (grid == 0) {
        if (n_in != 10 || in_sizes[0] != M * D || out_size != M * D || ws_size < WS_END) { fprintf(stderr, "kernel_launch: unexpected shapes (n_in %d, in0 %d, out %d, ws %zu < %zu); nothing launched\n", n_in, n_in > 0 ? in_sizes[0] : -1, out_size, ws_size, (size_t)WS_END); grid = -1; return; }
        int dev = 0, cus = 0, per_cu = 0;
        if (hipGetDevice(&dev) != hipSuccess || hipDeviceGetAttribute(&cus, hipDeviceAttributeMultiprocessorCount, dev) != hipSuccess) { fprintf(stderr, "kernel_launch: device query failed\n"); grid = -1; return; }
        if (hipFuncSetAttribute((const void*)mega_fwd, hipFuncAttributeMaxDynamicSharedMemorySize, LDS_TOTAL) != hipSuccess) { fprintf(stderr, "kernel_launch: hipFuncSetAttribute(%d B LDS) failed\n", LDS_TOTAL); grid = -1; return; }
        if (hipOccupancyMaxActiveBlocksPerMultiprocessor(&per_cu, (const void*)mega_fwd, 512, LDS_TOTAL) != hipSuccess || per_cu < 1)
            fprintf(stderr, "kernel_launch: note: occupancy query reports %d workgroups per CU\n", per_cu);
        (void)hipGetLastError();
        grid = cus;
    }
    if (grid < 0) return;
    if (hipMemsetAsync((char*)d_ws + WS_CTL, 0, CTL_ZERO_BYTES, stream) != hipSuccess) { fprintf(stderr, "kernel_launch: hipMemsetAsync failed\n"); return; }
    Args a{};
    for (int i = 0; i < 10; ++i) a.in[i] = (const float*)d_in[i];
    a.out = (float*)d_out; a.ws = (unsigned char*)d_ws;
#if MK_N_LAUNCHES == 1
    a.ph_lo = 0; a.ph_hi = N_PHASES;
    hipLaunchKernelGGL(mega_fwd, dim3(grid), dim3(512), LDS_TOTAL, stream, a);
#else
    for (int p = 0; p < N_PHASES; ++p) { a.ph_lo = p; a.ph_hi = p + 1; hipLaunchKernelGGL(mega_fwd, dim3(grid), dim3(512), LDS_TOTAL, stream, a); }
#endif
    const hipError_t le = hipPeekAtLastError();
    if (le != hipSuccess) fprintf(stderr, "kernel_launch: launch failed: %s\n", hipGetErrorName(le));
}
```

```cpp
#include <hip/hip_runtime.h>
#include <cstdio>
#include <cstdint>

constexpr int NB = 2, SEQ = 4096, D = 4096, DI = 8192, NH = 64, HD = 128;
constexpr int M = NB * SEQ;
constexpr int LDP = 4 * DI;
constexpr int NWB = 4 * DI + NH;
constexpr float EPS = 1e-6f;
namespace pg8 {
#define PG8_LAS __attribute__((address_space(3)))
typedef unsigned short bf16_t;
typedef short bf16x8 __attribute__((ext_vector_type(8)));
typedef float f32x4 __attribute__((ext_vector_type(4)));
typedef unsigned u32x4 __attribute__((ext_vector_type(4)));
constexpr int BM = 256, BK = 64, HALF = 128, HTB = HALF * BK * 2  , STAGE_BYTES = 8 * HTB, NXCD = 8, WGM = 8;

__host__ __device__ __forceinline__ int lds_byte(int r, int c) { const int st = (r >> 4) * 2 + (c >> 5), rr = r & 15, cc = c & 31, ob = rr * 64 + cc * 2; return st * 1024 + (ob ^ (((ob >> 9) & 1) << 5)); }
__host__ __device__ __forceinline__ void stage_rc(int b, int& R, int& C) { const int st = b / 1024, sb = b % 1024, swz = sb ^ (((sb >> 9) & 1) << 5); R = (st >> 1) * 16 + swz / 64; C = (st & 1) * 32 + (swz % 64) / 2; }
__host__ __device__ __forceinline__ int perm32(int rho) { const int n = rho >> 4, i = rho & 15; return 8 * (i >> 2) + 4 * n + (i & 3); }

struct Unit { int pm, pn; };
struct Gemm { const bf16_t* A; const bf16_t* Bt; int M, N, K, pad; };

struct StaticOrder {
    int nM, nN, nwg, G, c;
    __host__ __device__ void init(int M, int N, int G_, int c_) { nM = M / BM; nN = N / BM; nwg = nM * nN; G = G_; c = c_; }
    __host__ __device__ bool next(int i, Unit& u) const {
        const long L = (long)i * G + c; if (L >= nwg) return false;
        int wgid = (int)L; { const int q = nwg / NXCD, r = nwg % NXCD, xcd = wgid % NXCD, off = wgid / NXCD; wgid = (xcd < r ? xcd * (q + 1) : r * (q + 1) + (xcd - r) * q) + off; }
        const int nig = WGM * nN, gid = wgid / nig, fm = gid * WGM, gsz = (nM - fm) < WGM ? (nM - fm) : WGM;
        u.pm = fm + ((wgid % nig) % gsz); u.pn = (wgid % nig) / gsz; return true;
    }
    __device__ __forceinline__ void a_ready(const Unit&) const {}
    __device__ __forceinline__ void done(const Unit&) const {}
};

typedef float f32x2_t __attribute__((ext_vector_type(2)));
typedef __bf16 bf16x2_t __attribute__((ext_vector_type(2)));
__device__ __forceinline__ unsigned cvt_pk_bf16(float lo, float hi) { f32x2_t v = {lo, hi}; bf16x2_t b = __builtin_convertvector(v, bf16x2_t); return __builtin_bit_cast(unsigned, b); }
__device__ __forceinline__ float silu_f(float x) { return x * __builtin_amdgcn_rcpf(1.0f + __builtin_amdgcn_exp2f(-1.4426950408889634f * x)); }

#define PG8_PSTORE(p, v) (*(p) = (v))
template <int LAYER> struct EpiAct {
    static constexpr bool PERM = true, AFTER_DRAIN = false;
    bf16_t* O; const float* lbl; unsigned* nrm; int ldc, pad;
    __device__ __forceinline__ void operator()(const f32x4 (&acc)[2][2][4][2], const Unit& u, int wr, int wc, int fr, int fq) const {
        const int sec = u.pn >> 5;
        const int row0 = u.pm * BM + wr * 64 + fr, col0 = u.pn * BM + wc * 32 + 8 * fq;
        const int mode = (LAYER == 0) ? ((sec == 0 || sec == 3) ? 1 : (sec == 1 ? 2 : 0)) : (sec == 3 ? 1 : 0);
        const int rb = row0 >> 12, rs = row0 & 4095, hh = (2 * u.pn) & 63;
        bf16_t* hm = O + ((size_t)((sec * 2 + rb) * 64 + hh) * 4096 + rs) * 128 + wc * 32 + 8 * fq;
        if (mode == 2) {
            float lb[2][8], om[2][8];
#pragma unroll
            for (int bj = 0; bj < 2; ++bj) { const int c = col0 + bj * HALF - 8192;
                const f32x4 a0 = *(const f32x4*)(lbl + c), a1 = *(const f32x4*)(lbl + c + 4), b0 = *(const f32x4*)(lbl + 8192 + c), b1 = *(const f32x4*)(lbl + 8192 + c + 4);
#pragma unroll
                for (int e = 0; e < 4; ++e) { const float x0 = __builtin_amdgcn_rcpf(1.0f + __builtin_amdgcn_exp2f(1.4426950408889634f * (b0[e] - a0[e]))), x1 = __builtin_amdgcn_rcpf(1.0f + __builtin_amdgcn_exp2f(1.4426950408889634f * (b1[e] - a1[e])));
                    lb[bj][e] = x0; om[bj][e] = 1.0f - x0; lb[bj][4 + e] = x1; om[bj][4 + e] = 1.0f - x1; } }
#pragma unroll
            for (int ai = 0; ai < 2; ++ai)
#pragma unroll
                for (int m = 0; m < 4; ++m) { bf16_t* rowp = hm + (size_t)(ai * HALF + m * 16) * 128;
#pragma unroll
                    for (int bj = 0; bj < 2; ++bj) { float v[8];
#pragma unroll
                        for (int e = 0; e < 8; ++e) { const float f = acc[ai][bj][m][e >> 2][e & 3];
                            const float sg = __builtin_amdgcn_rcpf(1.0f + __builtin_amdgcn_exp2f(-1.4426950408889634f * f));
                            v[e] = __builtin_amdgcn_logf(lb[bj][e] + om[bj][e] * sg); }
                        u32x4 w; w.x = cvt_pk_bf16(v[0], v[1]); w.y = cvt_pk_bf16(v[2], v[3]); w.z = cvt_pk_bf16(v[4], v[5]); w.w = cvt_pk_bf16(v[6], v[7]);
                        PG8_PSTORE((u32x4*)(rowp + (size_t)bj * (4096 * 128)), w); } }
        } else if (mode == 1) {
#pragma unroll
            for (int ai = 0; ai < 2; ++ai)
#pragma unroll
                for (int m = 0; m < 4; ++m) { bf16_t* rowp = hm + (size_t)(ai * HALF + m * 16) * 128;
#pragma unroll
                    for (int bj = 0; bj < 2; ++bj) { float v[8];
#pragma unroll
                        for (int e = 0; e < 8; ++e) v[e] = silu_f(acc[ai][bj][m][e >> 2][e & 3]);
                        u32x4 w; w.x = cvt_pk_bf16(v[0], v[1]); w.y = cvt_pk_bf16(v[2], v[3]); w.z = cvt_pk_bf16(v[4], v[5]); w.w = cvt_pk_bf16(v[6], v[7]);
                        PG8_PSTORE((u32x4*)(rowp + (size_t)bj * (4096 * 128)), w); } }
        } else {
            float nmax[2] = {0.f, 0.f};
#pragma unroll
            for (int ai = 0; ai < 2; ++ai)
#pragma unroll
                for (int m = 0; m < 4; ++m) { bf16_t* rowp = hm + (size_t)(ai * HALF + m * 16) * 128;
#pragma unroll
                    for (int bj = 0; bj < 2; ++bj) { const f32x4 v0 = acc[ai][bj][m][0], v1 = acc[ai][bj][m][1];
                        u32x4 w; w.x = cvt_pk_bf16(v0[0], v0[1]); w.y = cvt_pk_bf16(v0[2], v0[3]); w.z = cvt_pk_bf16(v1[0], v1[1]); w.w = cvt_pk_bf16(v1[2], v1[3]);
                        PG8_PSTORE((u32x4*)(rowp + (size_t)bj * (4096 * 128)), w);
                        if (LAYER == 1 && sec < 2) { float ss = (v0[0] * v0[0] + v0[1] * v0[1]) + (v0[2] * v0[2] + v0[3] * v0[3]) + (v1[0] * v1[0] + v1[1] * v1[1]) + (v1[2] * v1[2] + v1[3] * v1[3]);
                            ss += __shfl_xor(ss, 16); ss += __shfl_xor(ss, 32); nmax[bj] = fmaxf(nmax[bj], ss); } } }
            if (LAYER == 1 && sec < 2) {
#pragma unroll
                for (int bj = 0; bj < 2; ++bj) { float v = nmax[bj];
#pragma unroll
                    for (int o = 1; o < 16; o <<= 1) v = fmaxf(v, __shfl_xor(v, o));
                    if (fr == 0 && fq == 0) atomicMax(nrm + ((size_t)(sec * 128 + rb * 64 + hh + bj)) * 4 + wc, __float_as_uint(v)); }
            }
        }
    }
};
struct EpiRes {
    static constexpr bool PERM = false, AFTER_DRAIN = false;
    const float* base; float* out; int ldc, pad;
    __device__ __forceinline__ void operator()(const f32x4 (&acc)[2][2][4][2], const Unit& u, int wr, int wc, int fr, int fq) const {
        const int row0 = u.pm * BM + wr * 64 + fr, col0 = u.pn * BM + wc * 32 + 4 * fq;
#pragma unroll
        for (int ai = 0; ai < 2; ++ai)
#pragma unroll
            for (int m = 0; m < 4; ++m) { const size_t off = (size_t)(row0 + ai * HALF + m * 16) * ldc + col0;
#pragma unroll
                for (int bj = 0; bj < 2; ++bj)
#pragma unroll
                    for (int n = 0; n < 2; ++n) { const f32x4 bs = *(const f32x4*)(base + off + bj * HALF + n * 16); *(f32x4*)(out + off + bj * HALF + n * 16) = bs + acc[ai][bj][m][n]; }
                }
    }
};

template <class Epi, class Sched, bool ALIGN_EPI = false, bool SP2 = false>
__device__ __forceinline__ void gemm_phase(PG8_LAS unsigned char* lds, const Gemm g, const Sched& S, const Epi& E) {
    const int tid = threadIdx.x, wid = __builtin_amdgcn_readfirstlane(tid >> 6), lane = tid & 63, wr = wid >> 2, wc = wid & 3, fr = lane & 15, fq = lane >> 4;
    const int K = g.K, nt = K / BK;
    unsigned voffA[2], voffB[2];
#pragma unroll
    for (int i = 0; i < 2; ++i) { int R, C; stage_rc(tid * 16 + i * 8192, R, C); const int Rb = Epi::PERM ? ((R & ~31) + perm32(R & 31)) : R;
        voffA[i] = (unsigned)(R * K + C) * 2u; voffB[i] = (unsigned)(Rb * K + C) * 2u; }
    const size_t kstep = (size_t)(BK * 2);
    const size_t hstep = (size_t)HALF * K * 2;
    const size_t tstep = 2 * hstep;
    const unsigned ldsw = (unsigned)wid * 1024u;
    const int aoff = lds_byte(wr * 64 + fr, fq * 8), boff = lds_byte(wc * 32 + fr, fq * 8);
#define PG8_SA(b, h) (((b) * 2 + (h)) * HTB)
#define PG8_SB(b, h) ((4 + (b) * 2 + (h)) * HTB)
#define PG8_STAGE(bufoff, gbase, voff) do { _Pragma("unroll") for (int _i = 0; _i < 2; ++_i) \
        __builtin_amdgcn_global_load_lds((const unsigned*)((const char*)(gbase) + (voff)[_i]), (PG8_LAS unsigned*)(lds + (bufoff) + ldsw + _i * 8192), 16, 0, 0); } while (0)
#define PG8_LDA(dst, b, h) do { _Pragma("unroll") for (int m = 0; m < 4; ++m) _Pragma("unroll") for (int k = 0; k < 2; ++k) dst[m][k] = *(const PG8_LAS bf16x8*)(lds + PG8_SA(b, h) + aoff + m * 2048 + k * 1024); } while (0)
#define PG8_LDB(dst, b, h) do { _Pragma("unroll") for (int n = 0; n < 2; ++n) _Pragma("unroll") for (int k = 0; k < 2; ++k) dst[n][k] = *(const PG8_LAS bf16x8*)(lds + PG8_SB(b, h) + boff + n * 2048 + k * 1024); } while (0)
#define PG8_MMA(ai, bj, At, Bt) do { __builtin_amdgcn_s_setprio(1); _Pragma("unroll") for (int m = 0; m < 4; ++m) _Pragma("unroll") for (int n = 0; n < 2; ++n) _Pragma("unroll") for (int k = 0; k < 2; ++k) \
        acc[ai][bj][m][n] = __builtin_amdgcn_mfma_f32_16x16x32_bf16(Bt[n][k], At[m][k], acc[ai][bj][m][n], 0, 0, 0); __builtin_amdgcn_s_setprio(0); } while (0)
#define PG8_WAIT_V(n) asm volatile("s_waitcnt vmcnt(" #n ")" ::: "memory")
#define PG8_WAIT_L(n) asm volatile("s_waitcnt lgkmcnt(" #n ")" ::: "memory")
#define PG8_BAR __builtin_amdgcn_s_barrier()
#define PG8_SCHED __builtin_amdgcn_sched_barrier(0)
    Unit cur, nxt; int ui = 0;
    if (!S.next(0, cur)) return;
    f32x4 acc[2][2][4][2];
#pragma unroll
    for (int a = 0; a < 2; ++a)
#pragma unroll
        for (int b = 0; b < 2; ++b)
#pragma unroll
            for (int m = 0; m < 4; ++m)
#pragma unroll
                for (int n = 0; n < 2; ++n) acc[a][b][m][n] = (f32x4){0.f, 0.f, 0.f, 0.f};
    bf16x8 At[4][2], B0[2][2], B1[2][2];
    const char* cA = (const char*)g.A + (size_t)cur.pm * tstep; const char* cB = (const char*)g.Bt + (size_t)cur.pn * tstep;
    S.a_ready(cur);
    if constexpr (SP2) {
        PG8_STAGE(PG8_SB(0, 0), cB, voffB); PG8_STAGE(PG8_SB(0, 1), cB + hstep, voffB); PG8_STAGE(PG8_SA(0, 0), cA, voffA); PG8_STAGE(PG8_SA(0, 1), cA + hstep, voffA);
        if (wr == 1) PG8_BAR;
        PG8_WAIT_V(2); PG8_BAR;
        PG8_STAGE(PG8_SB(1, 0), cB + kstep, voffB); PG8_STAGE(PG8_SA(1, 0), cA + kstep, voffA); PG8_STAGE(PG8_SB(1, 1), cB + hstep + kstep, voffB);
        PG8_WAIT_V(6); PG8_BAR;
    } else {
        PG8_STAGE(PG8_SB(0, 0), cB, voffB); PG8_STAGE(PG8_SA(0, 0), cA, voffA); PG8_STAGE(PG8_SB(0, 1), cB + hstep, voffB); PG8_STAGE(PG8_SA(0, 1), cA + hstep, voffA);
        if (wr == 1) PG8_BAR;
        PG8_WAIT_V(4); PG8_BAR;
        PG8_STAGE(PG8_SB(1, 0), cB + kstep, voffB); PG8_STAGE(PG8_SA(1, 0), cA + kstep, voffA); PG8_STAGE(PG8_SB(1, 1), cB + hstep + kstep, voffB);
        PG8_WAIT_V(6); PG8_BAR;
    }
    for (;;) {
        const bool has_next = S.next(ui + 1, nxt);
        const char* nA = has_next ? (const char*)g.A + (size_t)nxt.pm * tstep : cA; const char* nB = has_next ? (const char*)g.Bt + (size_t)nxt.pn * tstep : cB;
        for (int t = 0; t < nt; t += 2) {
            const bool last = (t == nt - 2);
            const char* a1 = cA + (size_t)(t + 1) * kstep;
            const char* a2 = last ? nA : cA + (size_t)(t + 2) * kstep; const char* b2 = last ? nB : cB + (size_t)(t + 2) * kstep;
            const char* a3 = a2 + kstep; const char* b3 = b2 + kstep;
            if (last && has_next) S.a_ready(nxt);
            if constexpr (SP2) {
            PG8_LDB(B0, 0, 0); PG8_LDB(B1, 0, 1); PG8_SCHED; PG8_LDA(At, 0, 0); PG8_STAGE(PG8_SA(1, 1), a1 + hstep, voffA);
            PG8_WAIT_V(8); PG8_WAIT_L(0); PG8_BAR; PG8_MMA(0, 0, At, B0); PG8_MMA(0, 1, At, B1); PG8_BAR; PG8_SCHED;
            PG8_LDA(At, 0, 1); PG8_STAGE(PG8_SB(0, 0), b2, voffB); PG8_STAGE(PG8_SB(0, 1), b2 + hstep, voffB); PG8_STAGE(PG8_SA(0, 0), a2, voffA);
            PG8_WAIT_V(8); PG8_WAIT_L(0); PG8_BAR; PG8_MMA(1, 0, At, B0); PG8_MMA(1, 1, At, B1); PG8_BAR; PG8_SCHED;
            PG8_LDB(B0, 1, 0); PG8_LDB(B1, 1, 1); PG8_SCHED; PG8_LDA(At, 1, 0); PG8_STAGE(PG8_SA(0, 1), a2 + hstep, voffA);
            PG8_WAIT_V(8); PG8_WAIT_L(0); PG8_BAR; PG8_MMA(0, 0, At, B0); PG8_MMA(0, 1, At, B1); PG8_BAR; PG8_SCHED;
            PG8_LDA(At, 1, 1); PG8_STAGE(PG8_SB(1, 0), b3, voffB); PG8_STAGE(PG8_SB(1, 1), b3 + hstep, voffB); PG8_STAGE(PG8_SA(1, 0), a3, voffA);
            PG8_WAIT_V(8); PG8_WAIT_L(0); PG8_BAR; PG8_MMA(1, 0, At, B0); PG8_MMA(1, 1, At, B1); PG8_BAR; PG8_SCHED;
            } else {
            PG8_LDB(B0, 0, 0); PG8_SCHED; PG8_LDA(At, 0, 0); PG8_STAGE(PG8_SA(1, 1), a1 + hstep, voffA);
            PG8_WAIT_L(8); PG8_BAR; PG8_WAIT_L(0); PG8_MMA(0, 0, At, B0); PG8_BAR; PG8_SCHED;
            PG8_LDB(B1, 0, 1); PG8_STAGE(PG8_SB(0, 0), b2, voffB);
            PG8_BAR; PG8_WAIT_L(0); PG8_MMA(0, 1, At, B1); PG8_BAR;
            PG8_LDA(At, 0, 1); PG8_STAGE(PG8_SA(0, 0), a2, voffA);
            PG8_BAR; PG8_WAIT_L(0); PG8_MMA(1, 0, At, B0); PG8_BAR; PG8_SCHED;
            PG8_STAGE(PG8_SB(0, 1), b2 + hstep, voffB);
            PG8_WAIT_V(6); PG8_BAR; PG8_MMA(1, 1, At, B1); PG8_BAR;
            PG8_LDB(B0, 1, 0); PG8_SCHED; PG8_LDA(At, 1, 0); PG8_STAGE(PG8_SA(0, 1), a2 + hstep, voffA);
            PG8_WAIT_L(8); PG8_BAR; PG8_WAIT_L(0); PG8_MMA(0, 0, At, B0); PG8_BAR; PG8_SCHED;
            PG8_LDB(B1, 1, 1); PG8_STAGE(PG8_SB(1, 0), b3, voffB);
            PG8_BAR; PG8_WAIT_L(0); PG8_MMA(0, 1, At, B1); PG8_BAR;
            PG8_LDA(At, 1, 1); PG8_STAGE(PG8_SA(1, 0), a3, voffA);
            PG8_BAR; PG8_WAIT_L(0); PG8_MMA(1, 0, At, B0); PG8_BAR; PG8_SCHED;
            PG8_STAGE(PG8_SB(1, 1), b3 + hstep, voffB);
            PG8_WAIT_V(6); PG8_BAR; PG8_MMA(1, 1, At, B1); PG8_BAR;
            }
        }
        if constexpr (ALIGN_EPI) { if (wr == 0) PG8_BAR; }
        if constexpr (!Epi::AFTER_DRAIN) { E(acc, cur, wr, wc, fr, fq); S.done(cur); }
        if (!has_next) break;
#pragma unroll
        for (int a = 0; a < 2; ++a)
#pragma unroll
            for (int b = 0; b < 2; ++b)
#pragma unroll
                for (int m = 0; m < 4; ++m)
#pragma unroll
                    for (int n = 0; n < 2; ++n) acc[a][b][m][n] = (f32x4){0.f, 0.f, 0.f, 0.f};
        cur = nxt; cA = nA; cB = nB; ++ui;
        if constexpr (ALIGN_EPI) { if (wr == 1) PG8_BAR; }
    }
    PG8_WAIT_V(0);
    if constexpr (!ALIGN_EPI) { if (wr == 0) PG8_BAR; }
    PG8_BAR;
    if constexpr (Epi::AFTER_DRAIN) { E.fused(acc, cur, wr, wc, fr, fq, lds, wid, lane); S.done(cur); }
#undef PG8_SA
#undef PG8_SB
#undef PG8_STAGE
#undef PG8_LDA
#undef PG8_LDB
#undef PG8_MMA
#undef PG8_WAIT_V
#undef PG8_WAIT_L
#undef PG8_BAR
#undef PG8_SCHED
}
}

#define LAS __attribute__((address_space(3)))
typedef unsigned short bf16;
typedef unsigned v4u __attribute__((ext_vector_type(4)));
typedef unsigned v2u __attribute__((ext_vector_type(2)));
typedef float f32x4 __attribute__((ext_vector_type(4)));
__device__ __forceinline__ unsigned pk2(float lo, float hi) { return pg8::cvt_pk_bf16(lo, hi); }
__device__ __forceinline__ float bf2f(unsigned short b) { return __uint_as_float(((unsigned)b) << 16); }
__device__ __forceinline__ float bflo(unsigned w) { return __uint_as_float(w << 16); }
__device__ __forceinline__ float bfhi(unsigned w) { return __uint_as_float(w & 0xffff0000u); }
__device__ __forceinline__ float wave_sum(float v) {
#pragma unroll
    for (int o = 1; o < 64; o <<= 1) v += __shfl_xor(v, o);
    return v;
}
__device__ __forceinline__ float wave_max(float v) {
#pragma unroll
    for (int o = 1; o < 64; o <<= 1) v = fmaxf(v, __shfl_xor(v, o));
    return v;
}

#define WLOAD(p) __builtin_nontemporal_load(p)
struct TileDesc { const float* W; size_t ldw; int K, k0, n0; bf16* WT; int nbase; };
__device__ __forceinline__ void tile_load(const TileDesc& d, f32x4 (&ra)[8], f32x4 (&rb)[8], int lane) {
    const int g = lane & 15, ks = lane >> 4;
#pragma unroll
    for (int i = 0; i < 8; ++i) { const int k = d.k0 + 8 * i + 2 * ks;
        ra[i] = WLOAD((const f32x4*)(d.W + (size_t)k * d.ldw + d.n0 + 4 * g)); rb[i] = WLOAD((const f32x4*)(d.W + (size_t)(k + 1) * d.ldw + d.n0 + 4 * g)); }
}
__device__ __forceinline__ void tile_store(const TileDesc& d, const f32x4 (&ra)[8], const f32x4 (&rb)[8], LAS unsigned* scr, int lane) {
    const int g = lane & 15, ks = lane >> 4;
#pragma unroll
    for (int i = 0; i < 8; ++i)
#pragma unroll
        for (int j = 0; j < 4; ++j) scr[(4 * g + j) * 33 + 4 * i + ks] = pk2(ra[i][j], rb[i][j]);
    asm volatile("s_waitcnt lgkmcnt(0)" ::: "memory");
    const int c = lane & 7;
#pragma unroll
    for (int r = 0; r < 8; ++r) { const int n = 8 * r + (lane >> 3);
        v4u o; o.x = scr[n * 33 + 4 * c]; o.y = scr[n * 33 + 4 * c + 1]; o.z = scr[n * 33 + 4 * c + 2]; o.w = scr[n * 33 + 4 * c + 3];
        *(v4u*)(d.WT + (size_t)(d.n0 - d.nbase + n) * d.K + d.k0 + 8 * c) = o; }
    asm volatile("s_waitcnt lgkmcnt(0)" ::: "memory");
}
__device__ __forceinline__ void rms_row_bf16(const float* xrow, const float* w, bf16* orow, int lane) {
    const f32x4* xr = (const f32x4*)xrow + lane; const f32x4* wr = (const f32x4*)w + lane;
    f32x4 v[16]; float s = 0.f;
#pragma unroll
    for (int j = 0; j < 16; ++j) { v[j] = xr[64 * j]; s += (v[j].x * v[j].x + v[j].y * v[j].y) + (v[j].z * v[j].z + v[j].w * v[j].w); }
    const float rs = 1.0f / sqrtf(wave_sum(s) * (1.0f / D) + EPS);
    v2u* o8 = (v2u*)orow + lane;
#pragma unroll
    for (int j = 0; j < 16; ++j) { const f32x4 g = wr[64 * j]; v2u o; o.x = pk2(v[j].x * rs * g.x, v[j].y * rs * g.y); o.y = pk2(v[j].z * rs * g.z, v[j].w * rs * g.w); o8[64 * j] = o; }
}
__device__ __forceinline__ void rms_row_f32(const float* xrow, const float* w, float* orow, int lane) {
    const f32x4* xr = (const f32x4*)xrow + lane; const f32x4* wr = (const f32x4*)w + lane;
    f32x4 v[16]; float s = 0.f;
#pragma unroll
    for (int j = 0; j < 16; ++j) { v[j] = xr[64 * j]; s += (v[j].x * v[j].x + v[j].y * v[j].y) + (v[j].z * v[j].z + v[j].w * v[j].w); }
    const float rs = 1.0f / sqrtf(wave_sum(s) * (1.0f / D) + EPS);
    f32x4* o = (f32x4*)orow + lane;
#pragma unroll
    for (int j = 0; j < 16; ++j) { const f32x4 g = wr[64 * j]; o[64 * j] = (f32x4){v[j].x * rs * g.x, v[j].y * rs * g.y, v[j].z * rs * g.z, v[j].w * rs * g.w}; }
}

constexpr size_t MiB = 1u << 20;
constexpr size_t WS_CTL = 0;
constexpr size_t WS_WA  = 1 * MiB;
constexpr size_t WS_WB  = WS_WA + 256 * MiB;
constexpr size_t WS_WF  = WS_WB + 256 * MiB;
constexpr size_t WS_WOA = WS_WF + 1 * MiB;
constexpr size_t WS_WOB = WS_WOA + 64 * MiB;
constexpr size_t WS_HB  = WS_WOB + 64 * MiB;
constexpr size_t WS_X1  = WS_HB + 64 * MiB;
constexpr size_t WS_P   = WS_X1 + 128 * MiB;
constexpr size_t WS_Y   = WS_P + 512 * MiB;
constexpr size_t WS_LS  = WS_Y + 128 * MiB;
constexpr size_t WS_END = WS_LS + 2 * MiB;

#ifndef CONV_P0_PCT
#define CONV_P0_PCT 0
#endif
__device__ __forceinline__ void prologue_phase(LAS unsigned char* lds, int part, const float* x, const float* norm_w, const float* w_in_a, const float* w_out_a, const float* w_in_b, const float* w_out_b,
                                               unsigned char* ws, int vcu, int G, int wave, int lane) {
    LAS unsigned* scr = (LAS unsigned*)(lds + wave * 8448);
    const int gw = vcu * 8 + wave, NGW = G * 8;
    bf16* WA = (bf16*)(ws + WS_WA); bf16* WB = (bf16*)(ws + WS_WB); bf16* WF = (bf16*)(ws + WS_WF); bf16* WOA = (bf16*)(ws + WS_WOA); bf16* WOB = (bf16*)(ws + WS_WOB);
    constexpr int T_IN = (D / 64) * (LDP / 64);
    constexpr int T_F = (D / 64) * 1;
    constexpr int T_OUT = (DI / 64) * (D / 64);
    constexpr int T_DEF = T_OUT + T_IN + T_F + T_OUT, SPLIT = (int)((long)T_DEF * CONV_P0_PCT / 100);
    f32x4 a0[8], b0[8], a1[8], b1[8];
    if (part == 0) {
        auto dsc = [=](int it) { TileDesc d; d.W = w_in_a; d.ldw = LDP; d.K = D; d.k0 = (it / (LDP / 64)) * 64; d.n0 = (it % (LDP / 64)) * 64; d.WT = WA; d.nbase = 0; return d; };
        int it = gw;
        if (it < T_IN) { TileDesc d0 = dsc(it); tile_load(d0, a0, b0, lane);
            for (;;) {
                const int i1 = it + NGW; const bool m1 = i1 < T_IN; TileDesc d1 = dsc(m1 ? i1 : it); if (m1) tile_load(d1, a1, b1, lane);
                tile_store(d0, a0, b0, scr, lane); if (!m1) break;
                const int i2 = i1 + NGW; const bool m2 = i2 < T_IN; d0 = dsc(m2 ? i2 : i1); if (m2) tile_load(d0, a0, b0, lane);
                tile_store(d1, a1, b1, scr, lane); if (!m2) break;
                it = i2;
            } }
        bf16* HB = (bf16*)(ws + WS_HB);
        for (int m = gw; m < M; m += NGW) rms_row_bf16(x + (size_t)m * D, norm_w, HB + (size_t)m * D, lane);
    }
    {
        const int i0 = (part == 0) ? 0 : SPLIT, i1e = (part == 0) ? SPLIT : T_DEF;
        auto dsc = [=](int r) { TileDesc d; d.nbase = 0;
            if (r < T_OUT) { d.W = w_out_a; d.ldw = D; d.K = DI; d.k0 = (r / (D / 64)) * 64; d.n0 = (r % (D / 64)) * 64; d.WT = WOA; return d; } r -= T_OUT;
            if (r < T_OUT) { d.W = w_out_b; d.ldw = D; d.K = DI; d.k0 = (r / (D / 64)) * 64; d.n0 = (r % (D / 64)) * 64; d.WT = WOB; return d; } r -= T_OUT;
            if (r < T_F) { d.W = w_in_b; d.ldw = NWB; d.K = D; d.k0 = r * 64; d.n0 = LDP; d.WT = WF; d.nbase = LDP; return d; } r -= T_F;
            d.W = w_in_b; d.ldw = NWB; d.K = D; d.k0 = (r / (LDP / 64)) * 64; d.n0 = (r % (LDP / 64)) * 64; d.WT = WB; return d; };
        int it = i0 + gw;
        if (it < i1e) { TileDesc d0 = dsc(it); tile_load(d0, a0, b0, lane);
            for (;;) {
                const int i1 = it + NGW; const bool m1 = i1 < i1e; TileDesc d1 = dsc(m1 ? i1 : it); if (m1) tile_load(d1, a1, b1, lane);
                tile_store(d0, a0, b0, scr, lane); if (!m1) break;
                const int i2 = i1 + NGW; const bool m2 = i2 < i1e; d0 = dsc(m2 ? i2 : i1); if (m2) tile_load(d0, a0, b0, lane);
                tile_store(d1, a1, b1, scr, lane); if (!m2) break;
                it = i2;
            } }
    }
}

namespace scan {
typedef short s16x4 __attribute__((ext_vector_type(4)));
typedef short bf16x8 __attribute__((ext_vector_type(8)));
typedef float f32x4 __attribute__((ext_vector_type(4)));
typedef unsigned u32x2 __attribute__((ext_vector_type(2)));
#ifndef SCAN_DMA_AUX
#define SCAN_DMA_AUX 2
#endif
#ifndef SCAN_STAGGER
#define SCAN_STAGGER 1
#endif
constexpr int R = 8, NSTEP = SEQ / 16;
constexpr int RAW = 0, PRD = R * 16384, PRD_SZ = 3 * 4096 + 512, QDT = 0, KIT = 4096, KE = 8192, DEC = 12288, SSQ = PRD + 2 * PRD_SZ, LDS_BYTES = SSQ + 1024;
__device__ __forceinline__ s16x4 trd(LAS const unsigned char* p) { return __builtin_bit_cast(s16x4, __builtin_amdgcn_ds_read_tr16_b64_v4i16((LAS s16x4*)p)); }
__device__ __forceinline__ s16x4 pk4(float a, float b, float c, float d) { u32x2 w; w.x = pk2(a, b); w.y = pk2(c, d); return __builtin_bit_cast(s16x4, w); }
__device__ __forceinline__ bf16x8 cat8(s16x4 a, s16x4 b) { return __builtin_shufflevector(a, b, 0, 1, 2, 3, 4, 5, 6, 7); }
#define SC_BAR() do { asm volatile("" ::: "memory"); __builtin_amdgcn_s_barrier(); asm volatile("" ::: "memory"); } while (0)

__device__ __forceinline__ void scan_unit(LAS unsigned char* lds, const bf16* __restrict__ P, const float* __restrict__ onw, bf16* __restrict__ Y, int bh) {
    const int tid = threadIdx.x, wid = __builtin_amdgcn_readfirstlane(tid >> 6), lane = tid & 63, n = lane & 15, g = lane >> 4, tq = n >> 2, tp = n & 3;
    const int b = bh / NH, h = bh % NH;
    const bf16* base = P + (size_t)(b * NH + h) * SEQ * HD;
    size_t goff[2]; int ldst[2];
#pragma unroll
    for (int ii = 0; ii < 2; ++ii) { const int i = 2 * wid + ii, ti = i >> 2, rg = i & 3, row = 4 * rg + (lane >> 4), pc = lane & 15, c = pc ^ ((row & 7) << 1);
        const int sec = (ti == 0) ? 1 : ((ti == 1) ? 0 : ti);
        goff[ii] = (size_t)row * HD + (size_t)sec * ((size_t)NB * NH * SEQ * HD) + c * 8; ldst[ii] = ti * 4096 + rg * 1024; }
#define SC_DMA(step) do { const int st_ = (step) < NSTEP ? (step) : NSTEP - 1; const int sl_ = ((step) & (R - 1)) * 16384; _Pragma("unroll") for (int ii = 0; ii < 2; ++ii) \
        __builtin_amdgcn_global_load_lds((const unsigned*)(base + (size_t)st_ * 16 * HD + goff[ii]), (LAS unsigned*)(lds + RAW + sl_ + ldst[ii]), 16, 0, SCAN_DMA_AUX); } while (0)
    const int rrow = 4 * g + tq;
    const int rtr = rrow * 256 + ((2 * wid + (tp >> 1)) ^ ((rrow & 7) << 1)) * 16 + 8 * (tp & 1);
    const int rsg = n * 256 + ((2 * wid + (g >> 1)) ^ ((n & 7) << 1)) * 16 + 8 * (g & 1);
    const int wq = (16 * wid + n) * 32 + g * 8;
    const int wk = (g >> 1) * 2048 + (16 * wid + n) * 16 + (g & 1) * 8;
    const int rqt = (4 * g + tq) * 32 + 8 * tp;
    const int rke = (g >> 1) * 2048 + n * 16 + (g & 1) * 8;
    const int rdec = (4 * g) * 4;
    s16x4 ltri; { short one = (short)0x3F80; ltri[0] = (4 * g + 0 <= n) ? one : (short)0; ltri[1] = (4 * g + 1 <= n) ? one : (short)0; ltri[2] = (4 * g + 2 <= n) ? one : (short)0; ltri[3] = (4 * g + 3 <= n) ? one : (short)0; }
    f32x4 gain = *(const f32x4*)(onw + h * HD + 16 * wid + 4 * g);
    asm volatile("" : "+v"(gain[0]), "+v"(gain[1]), "+v"(gain[2]), "+v"(gain[3]));
    f32x4 S[8];
#pragma unroll
    for (int t = 0; t < 8; ++t) S[t] = (f32x4){0.f, 0.f, 0.f, 0.f};
    f32x4 oprev = (f32x4){0.f, 0.f, 0.f, 0.f};
#define SC_PREP(s_) do { const LAS unsigned char* raw_ = lds + RAW + ((s_) & (R - 1)) * 16384; LAS unsigned char* img_ = lds + PRD + ((s_) & 1) * PRD_SZ; \
        const s16x4 lfB = trd(raw_ + rtr), qsB = trd(raw_ + 4096 + rtr); \
        const f32x4 G = __builtin_amdgcn_mfma_f32_16x16x16bf16_1k(ltri, lfB, (f32x4){0.f, 0.f, 0.f, 0.f}, 0, 0, 0); \
        const float dec_ = __builtin_amdgcn_exp2f(__shfl(G[3], 48 + n)); \
        float qd[4], ki[4], ke[4]; \
        _Pragma("unroll") for (int j = 0; j < 4; ++j) { const float lf = bf2f((unsigned short)lfB[j]), qs = bf2f((unsigned short)qsB[j]); \
            const float E = __builtin_amdgcn_exp2f(G[j]), Ei = __builtin_amdgcn_exp2f(-G[j]); \
            const float kk = 1.0f - __builtin_amdgcn_exp2f(lf); \
            qd[j] = qs * E; ki[j] = kk * Ei; ke[j] = ki[j] * dec_; } \
        *(LAS s16x4*)(img_ + QDT + wq) = pk4(qd[0], qd[1], qd[2], qd[3]); \
        *(LAS s16x4*)(img_ + KIT + wq) = pk4(ki[0], ki[1], ki[2], ki[3]); \
        *(LAS s16x4*)(img_ + KE + wk) = pk4(ke[0], ke[1], ke[2], ke[3]); \
        if (g == 0) *(LAS float*)(img_ + DEC + (16 * wid + n) * 4) = dec_; } while (0)
#define SC_OUT(s_) do { const LAS unsigned char* rawp = lds + RAW + ((s_) & (R - 1)) * 16384; const LAS unsigned char* sq = lds + SSQ + ((s_) & 1) * 512 + n * 32; \
        const f32x4 a = *(const LAS f32x4*)sq, c = *(const LAS f32x4*)(sq + 16); \
        const float tot = ((a[0] + a[1]) + (a[2] + a[3])) + ((c[0] + c[1]) + (c[2] + c[3])); \
        const float rs = __builtin_amdgcn_rsqf(tot * (1.0f / HD) + EPS); \
        const s16x4 sgv = *(const LAS s16x4*)(rawp + 3 * 4096 + rsg); \
        const float y0 = oprev[0] * rs * gain[0] * bf2f((unsigned short)sgv[0]), y1 = oprev[1] * rs * gain[1] * bf2f((unsigned short)sgv[1]); \
        const float y2 = oprev[2] * rs * gain[2] * bf2f((unsigned short)sgv[2]), y3 = oprev[3] * rs * gain[3] * bf2f((unsigned short)sgv[3]); \
        u32x2 w; w.x = pk2(y0, y1); w.y = pk2(y2, y3); \
        *(u32x2*)(Y + (size_t)(b * SEQ + 16 * (s_) + n) * DI + h * HD + 16 * wid + 4 * g) = w; } while (0)
    SC_DMA(0); SC_DMA(1); SC_DMA(2); SC_DMA(3); SC_DMA(4); SC_DMA(5);
    asm volatile("s_waitcnt vmcnt(10)" ::: "memory");
    SC_BAR();
    SC_PREP(0);
    for (int st = 0; st < NSTEP; ++st) {
        asm volatile("s_waitcnt vmcnt(8) lgkmcnt(0)" ::: "memory");
        SC_BAR();
        SC_DMA(st + 6);
        if (SCAN_STAGGER && wid >= 4 && st + 1 < NSTEP) SC_PREP(st + 1);
        if (st > 0) SC_OUT(st - 1);
        {
            const LAS unsigned char* raw = lds + RAW + (st & (R - 1)) * 16384; const LAS unsigned char* img = lds + PRD + (st & 1) * PRD_SZ;
            s16x4 qf[8], kf[8];
#pragma unroll
            for (int t = 0; t < 8; ++t) { qf[t] = trd(img + QDT + rqt + 512 * t); kf[t] = trd(img + KIT + rqt + 512 * t); }
            const s16x4 vf = trd(raw + 2 * 4096 + rtr);
            f32x4 sc = (f32x4){0.f, 0.f, 0.f, 0.f};
#pragma unroll
            for (int u = 0; u < 4; ++u) sc = __builtin_amdgcn_mfma_f32_16x16x32_bf16(cat8(kf[2 * u], kf[2 * u + 1]), cat8(qf[2 * u], qf[2 * u + 1]), sc, 0, 0, 0);
#pragma unroll
            for (int j = 0; j < 4; ++j) sc[j] = (4 * g + j <= n) ? sc[j] : 0.f;
            f32x4 o = (f32x4){0.f, 0.f, 0.f, 0.f};
#pragma unroll
            for (int u = 0; u < 4; ++u) { const s16x4 s0 = pk4(S[2 * u][0], S[2 * u][1], S[2 * u][2], S[2 * u][3]), s1 = pk4(S[2 * u + 1][0], S[2 * u + 1][1], S[2 * u + 1][2], S[2 * u + 1][3]);
                o = __builtin_amdgcn_mfma_f32_16x16x32_bf16(cat8(s0, s1), cat8(qf[2 * u], qf[2 * u + 1]), o, 0, 0, 0); }
            o = __builtin_amdgcn_mfma_f32_16x16x16bf16_1k(vf, pk4(sc[0], sc[1], sc[2], sc[3]), o, 0, 0, 0);
#pragma unroll
            for (int t = 0; t < 8; ++t) { const s16x4 kef = *(const LAS s16x4*)(img + KE + rke + 256 * t); const f32x4 dv = *(const LAS f32x4*)(img + DEC + rdec + 64 * t);
                S[t] = __builtin_amdgcn_mfma_f32_16x16x16bf16_1k(kef, vf, S[t] * dv, 0, 0, 0); }
            float ss = (o[0] * o[0] + o[1] * o[1]) + (o[2] * o[2] + o[3] * o[3]);
            ss += __shfl_xor(ss, 16); ss += __shfl_xor(ss, 32);
            if (g == 0) *(LAS float*)(lds + SSQ + (st & 1) * 512 + (n * 8 + wid) * 4) = ss;
            oprev = o;
        }
        if ((!SCAN_STAGGER || wid < 4) && st + 1 < NSTEP) SC_PREP(st + 1);
    }
    asm volatile("s_waitcnt lgkmcnt(0)" ::: "memory");
    SC_BAR();
    SC_OUT(NSTEP - 1);
    asm volatile("s_waitcnt vmcnt(0) lgkmcnt(0)" ::: "memory");
    SC_BAR();
#undef SC_DMA
#undef SC_PREP
#undef SC_OUT
}
#undef SC_BAR
}

#ifndef ATT_BODY
#define ATT_BODY 3
#endif
#ifdef ATT_USE_SETPRIO
#define ATT_PRIO(x) __builtin_amdgcn_s_setprio(x)
#else
#define ATT_PRIO(x) do { } while (0)
#endif
namespace fox {
enum { ORDER_NATURAL = 0, ORDER_REVERSED = 1, ORDER_PAIRED = 2, ORDER_XCD = 4 };
constexpr int B = NB, H = NH, HKV = NH, SQ = SEQ, SKV = SEQ, D = HD, QOFF = 0, WINDOW = SEQ;
constexpr int LDQ = HD, LDO = DI;
constexpr size_t SECSZ = (size_t)NB * NH * SEQ * HD;
constexpr float THR = 8.f;
constexpr int ORDER = ORDER_PAIRED | ORDER_XCD;
constexpr bool WSKIP = false;
constexpr float ISCALE = 11.313708498984761f;
constexpr int STG_ROW = 272;
constexpr float SCALE = 0.08838834764831845f;
constexpr int NW = 8, QBLK = 32, KVBLK = 64, QB = NW * QBLK;
constexpr int SHM_V = KVBLK * D * 2, SHM_K = KVBLK * D * 2;
constexpr int LDS_BYTES = 2 * SHM_V + 2 * SHM_K + NW * 64 * 4;
constexpr int RING = 4;
constexpr int C_OFF = (ATT_BODY == 3) ? 2 * RING * SHM_V + NW * 64 * 4 : LDS_BYTES, STG_OFF = (ATT_BODY == 3) ? 0 : C_OFF + SEQ * 4;
static_assert(D == 128 && SQ % QB == 0 && SKV % KVBLK == 0 && H % HKV == 0 && QOFF >= 0 && QOFF + SQ <= SKV && WINDOW >= 1, "geometry");

using bf16 = unsigned short;
typedef short bf16x8 __attribute__((ext_vector_type(8)));
typedef short s16x4 __attribute__((ext_vector_type(4)));
typedef float f32x16 __attribute__((ext_vector_type(16)));
typedef float f32x4 __attribute__((ext_vector_type(4)));
typedef unsigned u32x4 __attribute__((ext_vector_type(4)));
template <class A, class Bt> struct same_t { static constexpr bool v = false; };
template <class A> struct same_t<A, A> { static constexpr bool v = true; };

#define KSWZ(row, colB) ((row) * 256 + ((colB) ^ (((row) & 7) << 4)))
#define SBAR() __builtin_amdgcn_sched_barrier(0)
__device__ __forceinline__ int v_st(int k, int c) { const int kk = (k & ~0xC) | ((k & 4) << 1) | ((k & 8) >> 1); return ((kk >> 3) * 4 + (c >> 5)) * 512 + ((kk & 7) * 32 + (c & 31)) * 2; }
__device__ __forceinline__ int v_rd_base(int lane) { return ((lane & 3) << 3) | (((lane >> 2) & 3) << 6) | (((lane >> 4) & 1) << 5) | (((lane >> 5) & 1) << 8); }
constexpr int v_rd_off(int d0, int ks, int half) { return d0 * 512 + ks * 4096 + half * 2048; }
__device__ __forceinline__ int crow(int r, int hi) { return (r & 3) + 8 * (r >> 2) + 4 * hi; }
__device__ __forceinline__ unsigned cvtpk(float lo, float hi) {
    return pg8::cvt_pk_bf16(lo, hi);
}
__device__ __forceinline__ bf16x8 pack8(f32x4 a, f32x4 b) {
    u32x4 w = {cvtpk(a[0], a[1]), cvtpk(a[2], a[3]), cvtpk(b[0], b[1]), cvtpk(b[2], b[3])};
    return *reinterpret_cast<bf16x8*>(&w);
}
template <class T> __device__ __forceinline__ bf16x8 load8(const T* p) {
    if constexpr (same_t<T, float>::v) { return pack8(*(const f32x4*)p, *(const f32x4*)(p + 4)); }
    else { return *reinterpret_cast<const bf16x8*>(p); }
}
__device__ __forceinline__ void mask_tile(f32x16& p0, f32x16& p1, int dq, unsigned W) {
    const float NEG = -__builtin_inff();
#pragma unroll
    for (int r = 0; r < 16; ++r) {
        const int c = (r & 3) + 8 * (r >> 2);
        if ((unsigned)(dq - c) >= W) p0[r] = NEG;
        if ((unsigned)(dq - c - 32) >= W) p1[r] = NEG;
    }
}
__device__ __forceinline__ void partialSM(f32x16& p0, f32x16& p1, float mnL) {
    constexpr float C2 = 1.4426950408889634f * SCALE;
    for (int r = 0; r < 16; ++r) p0[r] = fmaf(p0[r], C2, mnL); for (int r = 0; r < 16; ++r) p1[r] = fmaf(p1[r], C2, mnL);
    for (int r = 0; r < 16; ++r) p0[r] = __builtin_amdgcn_exp2f(p0[r]);
}
__device__ __forceinline__ void finishSM(f32x16& p0, f32x16& p1, float& l_reg, bf16x8& pa0, bf16x8& pa1, bf16x8& pa2, bf16x8& pa3) {
    for (int r = 0; r < 16; ++r) p1[r] = __builtin_amdgcn_exp2f(p1[r]);
    float ps = 0; for (int r = 0; r < 16; ++r) ps += p0[r]; for (int r = 0; r < 16; ++r) ps += p1[r];
    { auto rr = __builtin_amdgcn_permlane32_swap(__float_as_uint(ps), __float_as_uint(ps), false, false);
      ps = __uint_as_float(rr[0]) + __uint_as_float(rr[1]); }
    l_reg += ps;
#define PK4(P, B_, OUT) do { unsigned a0 = cvtpk(P[B_+0], P[B_+1]), a1 = cvtpk(P[B_+2], P[B_+3]);                          \
        unsigned b0 = cvtpk(P[B_+4], P[B_+5]), b1 = cvtpk(P[B_+6], P[B_+7]);                                             \
        auto r0 = __builtin_amdgcn_permlane32_swap(a0, b0, false, false); auto r1 = __builtin_amdgcn_permlane32_swap(a1, b1, false, false); \
        u32x4 w = {r0[0], r1[0], r0[1], r1[1]}; OUT = *reinterpret_cast<bf16x8*>(&w); } while (0)
    PK4(p0, 0, pa0); PK4(p0, 8, pa1); PK4(p1, 0, pa2); PK4(p1, 8, pa3);
#undef PK4
}
__device__ __forceinline__ void bias_tile(f32x16& p0, f32x16& p1, const float* cl, int kb, int hi) {
    const f32x4* cp = (const f32x4*)(cl + kb + 4 * hi);
#pragma unroll
    for (int j = 0; j < 4; ++j) { const f32x4 c0 = cp[2 * j], c1 = cp[8 + 2 * j];
#pragma unroll
        for (int e = 0; e < 4; ++e) { p0[4 * j + e] = fmaf(c0[e], -ISCALE, p0[4 * j + e]); p1[4 * j + e] = fmaf(c1[e], -ISCALE, p1[4 * j + e]); } }
}
template <int KB, bool SK>
__device__ __forceinline__ void qkt(f32x16& p0, f32x16& p1, const char* K_lds, int r32, int hi, const bf16x8* qr, bool act) {
    if (SK && !act) { const float NEG = -__builtin_inff();
#pragma unroll
        for (int r = 0; r < 16; ++r) { p0[r] = NEG; p1[r] = NEG; } return; }
    p0 = f32x16{}; p1 = f32x16{};
    const char* kb[4];
#pragma unroll
    for (int dd = 0; dd < 4; ++dd) kb[dd] = K_lds + KB * SHM_K + KSWZ(r32, (dd * 16 + hi * 8) * 2);
#pragma unroll
    for (int d0 = 0; d0 < 8; ++d0) { const char* a = kb[d0 & 3] + (d0 >> 2) * 128;
        bf16x8 b0 = *reinterpret_cast<const bf16x8*>(a);
        bf16x8 b1 = *reinterpret_cast<const bf16x8*>(a + 32 * 256);
        p0 = __builtin_amdgcn_mfma_f32_32x32x16_bf16(b0, qr[d0], p0, 0, 0, 0);
        p1 = __builtin_amdgcn_mfma_f32_32x32x16_bf16(b1, qr[d0], p1, 0, 0, 0); }
}
template <int KB>
__device__ __forceinline__ void qkt3(f32x16& p0, f32x16& p1, int ka0, int ka1, int ka2, int ka3, const bf16x8* qr) {
#define KRD(dst, a_, off) asm volatile("ds_read_b128 %0, %1 offset:%2" : "=&v"(dst) : "v"(a_), "i"(off) : "memory")
#define KWAIT(n) do { asm volatile("s_waitcnt lgkmcnt(" #n ")" ::: "memory"); SBAR(); } while (0)
#define KMM(fa, fb, d0) do { p0 = __builtin_amdgcn_mfma_f32_32x32x16_bf16(fa, qr[d0], p0, 0, 0, 0); p1 = __builtin_amdgcn_mfma_f32_32x32x16_bf16(fb, qr[d0], p1, 0, 0, 0); SBAR(); } while (0)
    constexpr int o_ = KB * SHM_K, H_ = 32 * 256;
    bf16x8 f0, f1, f2, f3, f4, f5, f6, f7;
    KRD(f0, ka0, o_); KRD(f1, ka0, o_ + H_); KRD(f2, ka1, o_); KRD(f3, ka1, o_ + H_); KRD(f4, ka2, o_); KRD(f5, ka2, o_ + H_); KRD(f6, ka3, o_); KRD(f7, ka3, o_ + H_);
    p0 = f32x16{}; p1 = f32x16{};
    KWAIT(6); KMM(f0, f1, 0); KRD(f0, ka0, o_ + 128); KRD(f1, ka0, o_ + 128 + H_);
    KWAIT(6); KMM(f2, f3, 1); KRD(f2, ka1, o_ + 128); KRD(f3, ka1, o_ + 128 + H_);
    KWAIT(6); KMM(f4, f5, 2); KRD(f4, ka2, o_ + 128); KRD(f5, ka2, o_ + 128 + H_);
    KWAIT(6); KMM(f6, f7, 3); KRD(f6, ka3, o_ + 128); KRD(f7, ka3, o_ + 128 + H_);
    KWAIT(6); KMM(f0, f1, 4);
    KWAIT(4); KMM(f2, f3, 5);
    KWAIT(2); KMM(f4, f5, 6);
    KWAIT(0); KMM(f6, f7, 7);
#undef KRD
#undef KWAIT
#undef KMM
}
template <int VB, bool SK>
__device__ __forceinline__ void pv_tile(f32x16* o, int vb0, bf16x8 pa0, bf16x8 pa1, bf16x8 pa2, bf16x8 pa3, bool act) {
    if (SK && !act) return;
#define TRRD(dst, off) asm volatile("ds_read_b64_tr_b16 %0, %1 offset:%2" : "=&v"(dst) : "v"(vb0), "i"(off) : "memory")
#define PV_D0(d0) do { s16x4 l0, l1, l2, l3, h0, h1, h2, h3; constexpr int b_ = VB * SHM_V + v_rd_off(d0, 0, 0);     \
        TRRD(l0, b_); TRRD(h0, b_ + 2048); TRRD(l1, b_ + 4096); TRRD(h1, b_ + 6144); TRRD(l2, b_ + 8192); TRRD(h2, b_ + 10240); TRRD(l3, b_ + 12288); TRRD(h3, b_ + 14336); \
        asm volatile("s_waitcnt lgkmcnt(0)" ::: "memory"); SBAR();                 \
        o[d0] = __builtin_amdgcn_mfma_f32_32x32x16_bf16(pa0, (bf16x8){l0[0], l0[1], l0[2], l0[3], h0[0], h0[1], h0[2], h0[3]}, o[d0], 0, 0, 0);   \
        o[d0] = __builtin_amdgcn_mfma_f32_32x32x16_bf16(pa1, (bf16x8){l1[0], l1[1], l1[2], l1[3], h1[0], h1[1], h1[2], h1[3]}, o[d0], 0, 0, 0);   \
        o[d0] = __builtin_amdgcn_mfma_f32_32x32x16_bf16(pa2, (bf16x8){l2[0], l2[1], l2[2], l2[3], h2[0], h2[1], h2[2], h2[3]}, o[d0], 0, 0, 0);   \
        o[d0] = __builtin_amdgcn_mfma_f32_32x32x16_bf16(pa3, (bf16x8){l3[0], l3[1], l3[2], l3[3], h3[0], h3[1], h3[2], h3[3]}, o[d0], 0, 0, 0); } while (0)
    PV_D0(0); PV_D0(1); PV_D0(2); PV_D0(3);
#undef PV_D0
#undef TRRD
}

template <class TIn, class TOut> struct BlockRef { const TIn* Q; const TIn* K; const TIn* V; const TIn* G; TOut* O; int P0; };
template <class TIn> struct Seam {
    bf16x8 qr[8];
    bf16x8 st_v0, st_v1, st_k0, st_k1; f32x4 sf0, sf1, sf2, sf3;
    f32x4 tq[16];
};
__device__ __forceinline__ int swa_jlo(int P0, int W) { const int lowk = P0 - W + 1; return lowk > 0 ? lowk / KVBLK : 0; }
__device__ __forceinline__ int swa_jhi(int P0, int skv) { int j = (P0 + QB - 1) / KVBLK + 1; return j > skv / KVBLK ? skv / KVBLK : j; }
#define ROW(p, k0, rr) ((p) + (size_t)((k0) + (rr)) * LDQ + sc)
#define VMW() asm volatile("s_waitcnt vmcnt(0)" ::: "memory")
#define VMWN(n) asm volatile("s_waitcnt vmcnt(%0)" :: "i"(n) : "memory")
#define SLOAD_H(Kp, Vp, k0) do { const char* kb__ = (const char*)((Kp) + (size_t)(k0) * LDQ); const char* vb__ = (const char*)((Vp) + (size_t)(k0) * LDQ);     \
                         S.st_v0 = *(const bf16x8*)(vb__ + svoff); S.st_v1 = *(const bf16x8*)(vb__ + (size_t)32 * LDQ * 2 + svoff);              \
                         S.st_k0 = *(const bf16x8*)(kb__ + svoff); S.st_k1 = *(const bf16x8*)(kb__ + (size_t)32 * LDQ * 2 + svoff); } while (0)
#define SWRITE_HK(bf) do { *(bf16x8*)(K_lds + (bf) * SHM_K + kws) = S.st_k0; *(bf16x8*)(K_lds + (bf) * SHM_K + kws + 32 * 256) = S.st_k1; } while (0)
#define SWRITE_HV(bf) do { *(bf16x8*)(V_lds + (bf) * SHM_V + vst0) = S.st_v0; *(bf16x8*)(V_lds + (bf) * SHM_V + vst1) = S.st_v1; } while (0)
#define SWRITE_H(bf) do { SWRITE_HV(bf); SWRITE_HK(bf); } while (0)
#define SLOAD_F(p, k0) do { S.sf0 = *(const f32x4*)ROW(p, k0, sr); S.sf1 = *(const f32x4*)(ROW(p, k0, sr) + 4);                \
                            S.sf2 = *(const f32x4*)ROW(p, k0, 32 + sr); S.sf3 = *(const f32x4*)(ROW(p, k0, 32 + sr) + 4); } while (0)
#define SWRITE_KF(bf) do { *(bf16x8*)(K_lds + (bf) * SHM_K + kws) = pack8(S.sf0, S.sf1); *(bf16x8*)(K_lds + (bf) * SHM_K + kws + 32 * 256) = pack8(S.sf2, S.sf3); } while (0)
#define SWRITE_VF(bf) do { *(bf16x8*)(V_lds + (bf) * SHM_V + vst0) = pack8(S.sf0, S.sf1); *(bf16x8*)(V_lds + (bf) * SHM_V + vst1) = pack8(S.sf2, S.sf3); } while (0)
template <class TIn, class TOut>
__device__ __forceinline__ void causal_swa_prime(const BlockRef<TIn, TOut>& cur, int skv, int W, char* lds, Seam<TIn>& S) {
    constexpr bool F32 = same_t<TIn, float>::v;
    const int tid = threadIdx.x, wid = __builtin_amdgcn_readfirstlane(tid >> 6), lane = tid & 63, r32 = lane & 31, hi = lane >> 5;
    const int sr = tid >> 4, sc = (tid & 15) * 8, kws = KSWZ(sr, sc * 2); char* K_lds = lds + 2 * SHM_V;
    const unsigned svoff = (unsigned)(sr * LDQ + sc) * 2u, qvoff = (unsigned)(r32 * LDQ + hi * 8) * 2u;
    const int kb0 = (swa_jhi(cur.P0, skv) - 1) * KVBLK; (void)W;
    for (int d0 = 0; d0 < 8; ++d0) S.qr[d0] = *(const bf16x8*)((const char*)(cur.Q + (size_t)(wid * QBLK) * LDQ) + d0 * 32 + qvoff);
    if constexpr (F32) { SLOAD_F((const float*)cur.K, kb0); VMW(); SWRITE_KF(0); SBAR(); SLOAD_F((const float*)cur.V, kb0); }
    else { SLOAD_H(cur.K, cur.V, kb0); VMW(); SWRITE_HK(0); }
    __syncthreads();
}
template <class TIn, class TOut>
__device__ __forceinline__ void causal_swa_block(const BlockRef<TIn, TOut>& cur, const BlockRef<TIn, TOut>& nxt, int skv, int W, char* lds, Seam<TIn>& S, float thr, float kn) {
    constexpr bool F32 = same_t<TIn, float>::v;
    const int tid = threadIdx.x, wid = __builtin_amdgcn_readfirstlane(tid >> 6), lane = tid & 63, r32 = lane & 31, hi = lane >> 5;
    int j_hi = (cur.P0 + QB - 1) / KVBLK + 1; if (j_hi > skv / KVBLK) j_hi = skv / KVBLK;
    const int kbn = (swa_jhi(nxt.P0, skv) - 1) * KVBLK;
    const int qlo = cur.P0 + wid * QBLK, qm = qlo + r32 - 4 * hi;
    char* V_lds = lds; char* K_lds = lds + 2 * SHM_V;
    const float* cl = (const float*)(lds + C_OFF);
    int j_lo; { const int lastk = 64 * lane + 63; const bool skip = (lastk < cur.P0) && (cl[cur.P0] - cl[lastk] < -thr);
        const unsigned long long keep = __ballot(!skip); j_lo = keep ? (int)__builtin_ctzll(keep) : 0; (void)W; }
    const int NT = j_hi - j_lo;
    float* ws = (float*)(lds + 2 * SHM_V + 2 * SHM_K) + wid * 64; float* li_l = ws, * al_l = ws + 32;
    float l_reg = 0; f32x16 o[4] = {};
    float mnL; { float q2 = 0.f;
#pragma unroll
        for (int d0 = 0; d0 < 8; ++d0)
#pragma unroll
            for (int j = 0; j < 8; ++j) { const float v = __uint_as_float(((unsigned)(unsigned short)S.qr[d0][j]) << 16); q2 = fmaf(v, v, q2); }
        { auto rr = __builtin_amdgcn_permlane32_swap(__float_as_uint(q2), __float_as_uint(q2), false, false); q2 = __uint_as_float(rr[0]) + __uint_as_float(rr[1]); }
        const float Mt = fminf(SCALE * sqrtf(q2) * kn, 42.0f);
        int ci = wid * QBLK + r32; asm volatile("" : "+v"(ci));
        mnL = -(Mt - cl[cur.P0 + ci]) * 1.4426950408889634f; }
    const int sr = tid >> 4, sc = (tid & 15) * 8, vst0 = v_st(sr, sc), vst1 = v_st(32 + sr, sc), kws = KSWZ(sr, sc * 2);
    const unsigned svoff = (unsigned)(sr * LDQ + sc) * 2u, qvoff = (unsigned)(r32 * LDQ + hi * 8) * 2u;
    const int vb0 = (int)(uintptr_t)V_lds + v_rd_base(lane);
    const TIn* Kh = cur.K; const TIn* Vh = cur.V;
#define KBASE(t) ((j_hi - 1 - (t)) * KVBLK)
#define ACT(t) (KBASE(t) <= qlo + QBLK - 1 && KBASE(t) + KVBLK - 1 >= qlo - W + 1)
#define MASKT(P0_, P1_, t) do { const int kb_ = KBASE(t); bias_tile(P0_, P1_, cl, kb_, hi); if ((!SK || ACT(t)) && (kb_ + KVBLK - 1 > qlo || kb_ <= qlo + QBLK - 1 - W)) mask_tile(P0_, P1_, qm - kb_, (unsigned)W); } while (0)
    constexpr int NQL = F32 ? 16 : 8;
    constexpr bool SK = WSKIP && !F32;
#define SEAM_K0() do { VMWN(NQL); if constexpr (F32) { SWRITE_KF(0); SBAR(); SLOAD_F((const float*)nxt.V, kbn); } else { SWRITE_HK(0); } SBAR(); } while (0)
    f32x16 pA0, pA1, pB0, pB1; bf16x8 pa0, pa1, pa2, pa3;
    if constexpr (F32) { VMW(); SWRITE_VF(0); SBAR(); } else { SWRITE_HV(0); SBAR(); }
    if (NT > 1) { if constexpr (F32) SLOAD_F((const float*)Kh, KBASE(1)); else SLOAD_H(Kh, Vh, KBASE(1)); }
    SBAR(); qkt<0, SK>(pA0, pA1, K_lds, r32, hi, S.qr, ACT(0));
    if constexpr (F32) { if (NT > 1) { VMW(); SWRITE_KF(1); SBAR(); SLOAD_F((const float*)Vh, KBASE(1)); } }
    MASKT(pA0, pA1, 0); partialSM(pA0, pA1, mnL);
    if (NT > 1) { VMW(); if constexpr (F32) { SWRITE_VF(1); SBAR(); if (NT > 2) SLOAD_F((const float*)Kh, KBASE(2)); } else SWRITE_H(1); }
    __syncthreads();
#define HALF_STEP(PX0, PX1, PY0, PY1, t, KB, VB, SB) do {                                                      \
        SBAR(); qkt<KB, SK>(PX0, PX1, K_lds, r32, hi, S.qr, ACT(t));                                             \
        finishSM(PY0, PY1, l_reg, pa0, pa1, pa2, pa3); SBAR();                                                                \
        if ((t) + 1 < NT) { if constexpr (F32) { VMW(); SWRITE_KF(SB); SBAR(); SLOAD_F((const float*)Vh, KBASE((t) + 1)); }  \
                            else { SLOAD_H(Kh, Vh, KBASE((t) + 1)); } SBAR(); }                                               \
        pv_tile<VB, SK>(o, vb0, pa0, pa1, pa2, pa3, ACT((t) - 1)); MASKT(PX0, PX1, (t)); partialSM(PX0, PX1, mnL);                                        \
        __syncthreads();                                                                                                      \
        if ((t) + 1 < NT) { VMW(); if constexpr (F32) { SWRITE_VF(SB); SBAR(); if ((t) + 2 < NT) SLOAD_F((const float*)Kh, KBASE((t) + 2)); } \
                            else { SWRITE_H(SB); } }                                                                          \
        __syncthreads(); } while (0)
    for (int t = 1; t + 1 < NT; t += 2) {
        HALF_STEP(pB0, pB1, pA0, pA1, t, 1, 0, 0);
        HALF_STEP(pA0, pA1, pB0, pB1, t + 1, 0, 1, 1);
    }
    const bool even = (NT & 1) == 0;
    if (even) { SBAR(); qkt<1, SK>(pB0, pB1, K_lds, r32, hi, S.qr, ACT(NT - 1)); SBAR(); }
#define QROW(e) (nxt.Q + (size_t)(wid * QBLK + r32) * LDQ + ((e) >> 1) * 16 + hi * 8 + ((e) & 1) * 4)
    if constexpr (F32) { SLOAD_F((const float*)nxt.K, kbn); SBAR();
#pragma unroll
        for (int e = 0; e < 8; ++e) S.tq[e] = *(const f32x4*)QROW(e); }
    else { SLOAD_H(nxt.K, nxt.V, kbn); SBAR();
#pragma unroll
        for (int d0 = 0; d0 < 8; ++d0) S.qr[d0] = *(const bf16x8*)((const char*)(nxt.Q + (size_t)(wid * QBLK) * LDQ) + d0 * 32 + qvoff); }
    SBAR();
    finishSM(pA0, pA1, l_reg, pa0, pa1, pa2, pa3); SBAR();
    if constexpr (F32) {
#pragma unroll
        for (int e = 8; e < 16; ++e) S.tq[e] = *(const f32x4*)QROW(e); SBAR(); }
#undef QROW
    pv_tile<0, SK>(o, vb0, pa0, pa1, pa2, pa3, ACT(even ? NT - 2 : NT - 1));
    if (even) { MASKT(pB0, pB1, NT - 1); partialSM(pB0, pB1, mnL); __syncthreads();
        finishSM(pB0, pB1, l_reg, pa0, pa1, pa2, pa3); SBAR(); pv_tile<1, SK>(o, vb0, pa0, pa1, pa2, pa3, ACT(NT - 1)); }
    SBAR(); SEAM_K0();
    if (hi == 0) li_l[r32] = l_reg; asm volatile("s_waitcnt lgkmcnt(0)" ::: "memory");
    float rli[16];
#pragma unroll
    for (int r = 0; r < 16; ++r) rli[r] = __builtin_amdgcn_rcpf(li_l[crow(r, hi)]);
    { char* stg = lds + STG_OFF + wid * (QBLK * STG_ROW);
      int loff = (lane >> 4) * LDQ + (lane & 15) * 8, yoff = (lane >> 4) * LDO + (lane & 15) * 8;
      asm volatile("" : "+v"(loff), "+v"(yoff));
      const TIn* Gw = cur.G + (size_t)(wid * QBLK) * LDQ + loff; TOut* Ow = cur.O + (size_t)(wid * QBLK) * LDO + yoff;
#pragma unroll
      for (int r = 0; r < 16; ++r) { const int orow = crow(r, hi);
#pragma unroll
          for (int d0 = 0; d0 < 4; ++d0) { const float v = o[d0][r] * rli[r]; const float vn = __shfl_xor(v, 1);
              if ((r32 & 1) == 0) *(unsigned*)(stg + orow * STG_ROW + (d0 * 32 + r32) * 2) = cvtpk(v, vn); } }
      asm volatile("s_waitcnt lgkmcnt(0)" ::: "memory");
#pragma unroll
      for (int hf = 0; hf < 2; ++hf) { u32x4 gv[4];
#pragma unroll
          for (int i = 0; i < 4; ++i) gv[i] = *(const u32x4*)(Gw + (size_t)(16 * hf + 4 * i) * LDQ);
#pragma unroll
          for (int i = 0; i < 4; ++i) { const u32x4 ov = *(const u32x4*)(stg + (16 * hf + 4 * i + (lane >> 4)) * STG_ROW + (lane & 15) * 16); const u32x4 g4 = gv[i]; u32x4 w;
#pragma unroll
              for (int e = 0; e < 4; ++e) w[e] = cvtpk(__uint_as_float(ov[e] << 16) * __uint_as_float(g4[e] << 16), __uint_as_float(ov[e] & 0xffff0000u) * __uint_as_float(g4[e] & 0xffff0000u));
              *(u32x4*)(Ow + (size_t)(16 * hf + 4 * i) * LDO) = w; }
          asm volatile("" ::: "memory"); } }
    if constexpr (F32) {
#pragma unroll
        for (int d0 = 0; d0 < 8; ++d0) S.qr[d0] = pack8(S.tq[2 * d0], S.tq[2 * d0 + 1]); }
    __syncthreads();
#undef KBASE
#undef ACT
#undef MASKT
#undef SEAM_K0
#undef HALF_STEP
}

__device__ __forceinline__ void fox_block2(const BlockRef<bf16, bf16>& cur, int skv, char* lds, float thr, float kn) {
    const int tid = threadIdx.x, wid = __builtin_amdgcn_readfirstlane(tid >> 6), lane = tid & 63, r32 = lane & 31, hi = lane >> 5;
    const bool lead = wid < 4;
    int j_hi = (cur.P0 + QB - 1) / KVBLK + 1; if (j_hi > skv / KVBLK) j_hi = skv / KVBLK;
    const int qlo = cur.P0 + wid * QBLK, qm = qlo + r32 - 4 * hi;
    char* V_lds = lds; char* K_lds = lds + 2 * SHM_V;
    const float* cl = (const float*)(lds + C_OFF);
    int j_lo; { const int lastk = 64 * lane + 63; const bool skip = (lastk < cur.P0) && (cl[cur.P0] - cl[lastk] < -thr);
        const unsigned long long keep = __ballot(!skip); j_lo = keep ? (int)__builtin_ctzll(keep) : 0; }
    const int NT = j_hi - j_lo;
    float* li_l = (float*)(lds + 2 * SHM_V + 2 * SHM_K) + wid * 64;
    const int sr = tid >> 4, sc = (tid & 15) * 8, vst0 = v_st(sr, sc), vst1 = v_st(32 + sr, sc), kws = KSWZ(sr, sc * 2);
    const unsigned svoff = (unsigned)(sr * LDQ + sc) * 2u, qvoff = (unsigned)(r32 * LDQ + hi * 8) * 2u;
    const int vb0 = (int)(uintptr_t)V_lds + v_rd_base(lane);
#define KB2(t) ((j_hi - 1 - (t)) * KVBLK)
#define LOADK2(t, K0, K1) do { const char* kb__ = (const char*)(cur.K + (size_t)KB2(t) * LDQ); K0 = *(const bf16x8*)(kb__ + svoff); K1 = *(const bf16x8*)(kb__ + (size_t)32 * LDQ * 2 + svoff); } while (0)
#define LOADV2(t, V0, V1) do { const char* vb__ = (const char*)(cur.V + (size_t)KB2(t) * LDQ); V0 = *(const bf16x8*)(vb__ + svoff); V1 = *(const bf16x8*)(vb__ + (size_t)32 * LDQ * 2 + svoff); } while (0)
#define WRITEK2(t, K0, K1) do { char* kd__ = K_lds + ((t) & 1) * SHM_K + kws; *(bf16x8*)kd__ = K0; *(bf16x8*)(kd__ + 32 * 256) = K1; } while (0)
#define WRITEV2(t, V0, V1) do { char* vd__ = V_lds + ((t) & 1) * SHM_V; *(bf16x8*)(vd__ + vst0) = V0; *(bf16x8*)(vd__ + vst1) = V1; } while (0)
#define BAR2() do { asm volatile("s_waitcnt lgkmcnt(0)" ::: "memory"); __builtin_amdgcn_s_barrier(); asm volatile("" ::: "memory"); } while (0)
    bf16x8 qr[8], ska0, ska1, sva0, sva1, skb0, skb1, svb0, svb1;
#pragma unroll
    for (int d0 = 0; d0 < 8; ++d0) qr[d0] = *(const bf16x8*)((const char*)(cur.Q + (size_t)(wid * QBLK) * LDQ) + d0 * 32 + qvoff);
    LOADK2(0, ska0, ska1); LOADV2(0, sva0, sva1);
    { bf16x8 t0, t1; { const char* kb__ = (const char*)(cur.K + (size_t)KB2(1) * LDQ); t0 = *(const bf16x8*)(kb__ + svoff); t1 = *(const bf16x8*)(kb__ + (size_t)32 * LDQ * 2 + svoff); }
      asm volatile("s_waitcnt vmcnt(0)" ::: "memory");
      WRITEK2(0, ska0, ska1); WRITEV2(0, sva0, sva1); { char* kd__ = K_lds + SHM_K + kws; *(bf16x8*)kd__ = t0; *(bf16x8*)(kd__ + 32 * 256) = t1; } }
    { const int kt0 = lead ? 1 : 2, vt0 = lead ? 0 : 1;
      LOADK2(kt0 < NT ? kt0 : NT - 1, ska0, ska1); LOADV2(vt0, sva0, sva1);
      LOADK2(kt0 + 1 < NT ? kt0 + 1 : NT - 1, skb0, skb1); LOADV2(vt0 + 1 < NT ? vt0 + 1 : NT - 1, svb0, svb1); }
    float l_reg = 0; f32x16 o[4] = {}; f32x16 p0, p1; bf16x8 pa0, pa1, pa2, pa3;
    float mnL; { float q2 = 0.f;
#pragma unroll
        for (int d0 = 0; d0 < 8; ++d0)
#pragma unroll
            for (int j = 0; j < 8; ++j) { const float v = __uint_as_float(((unsigned)(unsigned short)qr[d0][j]) << 16); q2 = fmaf(v, v, q2); }
        { auto rr = __builtin_amdgcn_permlane32_swap(__float_as_uint(q2), __float_as_uint(q2), false, false); q2 = __uint_as_float(rr[0]) + __uint_as_float(rr[1]); }
        const float Mt = fminf(SCALE * sqrtf(q2) * kn, 42.0f);
        int ci = wid * QBLK + r32; asm volatile("" : "+v"(ci));
        mnL = -(Mt - cl[cur.P0 + ci]) * 1.4426950408889634f; }
    BAR2();
    if (!lead) BAR2();
#define STEP2(u_, KBI, VBP, K0, K1, V0, V1) do { const int u = (u_); \
        ATT_PRIO(1); \
        qkt<KBI, false>(p0, p1, K_lds, r32, hi, qr, true); \
        if (u > 0) pv_tile<VBP, false>(o, vb0, pa0, pa1, pa2, pa3, true); \
        ATT_PRIO(0); \
        BAR2(); \
        { const int kb_ = KB2(u); bias_tile(p0, p1, cl, kb_, hi); if (kb_ + KVBLK - 1 > qlo) mask_tile(p0, p1, qm - kb_, (unsigned)WINDOW); } \
        partialSM(p0, p1, mnL); finishSM(p0, p1, l_reg, pa0, pa1, pa2, pa3); \
        { const int kt = u + (lead ? 1 : 2), vt = u + (lead ? 0 : 1); const bool wk = kt >= 2 && kt < NT, wv = vt >= 1 && vt < NT; \
          if (wk) WRITEK2(kt, K0, K1); if (wv) WRITEV2(vt, V0, V1);     \
          { const int kl = kt + 2 < NT ? kt + 2 : NT - 1, vl = vt + 2 < NT ? vt + 2 : NT - 1; LOADK2(kl, K0, K1); LOADV2(vl, V0, V1); } } \
        BAR2(); } while (0)
    for (int u2 = 0; u2 < NT; u2 += 2) { STEP2(u2, 0, 1, ska0, ska1, sva0, sva1); if (u2 + 1 < NT) STEP2(u2 + 1, 1, 0, skb0, skb1, svb0, svb1); }
    if ((NT - 1) & 1) pv_tile<1, false>(o, vb0, pa0, pa1, pa2, pa3, true); else pv_tile<0, false>(o, vb0, pa0, pa1, pa2, pa3, true);
    if (lead) BAR2();
    if (hi == 0) li_l[r32] = l_reg; asm volatile("s_waitcnt lgkmcnt(0)" ::: "memory");
    float rli[16];
#pragma unroll
    for (int r = 0; r < 16; ++r) rli[r] = __builtin_amdgcn_rcpf(li_l[crow(r, hi)]);
    { char* stg = lds + STG_OFF + wid * (QBLK * STG_ROW);
      int loff = (lane >> 4) * LDQ + (lane & 15) * 8, yoff = (lane >> 4) * LDO + (lane & 15) * 8;
      asm volatile("" : "+v"(loff), "+v"(yoff));
      const bf16* Gw = cur.G + (size_t)(wid * QBLK) * LDQ + loff; bf16* Ow = cur.O + (size_t)(wid * QBLK) * LDO + yoff;
#pragma unroll
      for (int r = 0; r < 16; ++r) { const int orow = crow(r, hi);
#pragma unroll
          for (int d0 = 0; d0 < 4; ++d0) { const float v = o[d0][r] * rli[r]; const float vn = __shfl_xor(v, 1);
              if ((r32 & 1) == 0) *(unsigned*)(stg + orow * STG_ROW + (d0 * 32 + r32) * 2) = cvtpk(v, vn); } }
      asm volatile("s_waitcnt lgkmcnt(0)" ::: "memory");
#pragma unroll
      for (int hf = 0; hf < 2; ++hf) { u32x4 gv[4];
#pragma unroll
          for (int i = 0; i < 4; ++i) gv[i] = *(const u32x4*)(Gw + (size_t)(16 * hf + 4 * i) * LDQ);
#pragma unroll
          for (int i = 0; i < 4; ++i) { const u32x4 ov = *(const u32x4*)(stg + (16 * hf + 4 * i + (lane >> 4)) * STG_ROW + (lane & 15) * 16); const u32x4 g4 = gv[i]; u32x4 w;
#pragma unroll
              for (int e = 0; e < 4; ++e) w[e] = cvtpk(__uint_as_float(ov[e] << 16) * __uint_as_float(g4[e] << 16), __uint_as_float(ov[e] & 0xffff0000u) * __uint_as_float(g4[e] & 0xffff0000u));
              *(u32x4*)(Ow + (size_t)(16 * hf + 4 * i) * LDO) = w; }
          asm volatile("" ::: "memory"); } }
    __syncthreads();
#undef KB2
#undef LOADK2
#undef LOADV2
#undef WRITEK2
#undef WRITEV2
#undef BAR2
#undef STEP2
}

struct LsRegs { f32x4 a, b; };
__device__ __forceinline__ void scan_c(char* lds, const LsRegs& r); __device__ __forceinline__ void load_ls(LsRegs& r, const float* LS, int bh);
#define LBAR() do { asm volatile("s_waitcnt lgkmcnt(0)" ::: "memory"); __builtin_amdgcn_s_barrier(); asm volatile("" ::: "memory"); } while (0)
template <class LSR> __device__ __forceinline__ void fox_block3(const BlockRef<bf16, bf16>& cur, int skv, char* lds, LAS unsigned char* lds3, float thr, float kn, LSR& ls, const float* lsn, int probe_diag = 0) {
    const int tid = threadIdx.x, wid = __builtin_amdgcn_readfirstlane(tid >> 6), lane = tid & 63, r32 = lane & 31, hi = lane >> 5;
    const bool lead = wid < 4;
    int j_hi = (cur.P0 + QB - 1) / KVBLK + 1; if (j_hi > skv / KVBLK) j_hi = skv / KVBLK;
    const int qlo = cur.P0 + wid * QBLK, qm = qlo + r32 - 4 * hi;
    char* V_lds = lds; char* K_lds = lds + RING * SHM_V;
    const float* cl = (const float*)(lds + C_OFF);
    float* li_l = (float*)(lds + 2 * RING * SHM_V) + wid * 64;
    const unsigned qvoff = (unsigned)(r32 * LDQ + hi * 8) * 2u;
    const int vb0 = (int)(uintptr_t)V_lds + v_rd_base(lane);
    const int kab = (int)(uintptr_t)K_lds, ka0 = kab + KSWZ(r32, (0 * 16 + hi * 8) * 2), ka1 = kab + KSWZ(r32, (1 * 16 + hi * 8) * 2), ka2 = kab + KSWZ(r32, (2 * 16 + hi * 8) * 2), ka3 = kab + KSWZ(r32, (3 * 16 + hi * 8) * 2);
    unsigned ksrc[2], vsrc[2];
#pragma unroll
    for (int i = 0; i < 2; ++i) { const int p = 2 * wid + i;
        { const int row = 4 * p + (lane >> 4), ch = (lane & 15) ^ (row & 7); ksrc[i] = (unsigned)(row * LDQ * 2 + ch * 16); }
        { const int s = 2 * p + (lane >> 5), w_ = (lane & 31) * 16, kk = (s >> 2) * 8 + (w_ >> 6), k = (kk & ~0xC) | ((kk & 4) << 1) | ((kk & 8) >> 1), c = (s & 3) * 32 + (w_ & 63) / 2;
          vsrc[i] = (unsigned)(k * LDQ * 2 + c * 2); } }
#define KB3(t) ((j_hi - 1 - (t)) * KVBLK)
#define DMA3(t_) do { const int tc_ = (t_) < NT ? (t_) : NT - 1; DMA3U(t_, tc_); } while (0)
#define DMA3U(t_, tt_) do { const int sl_ = (t_) & (RING - 1); \
        const char* kb__ = (const char*)(cur.K + (size_t)KB3(tt_) * LDQ); const char* vb__ = (const char*)(cur.V + (size_t)KB3(tt_) * LDQ); \
        _Pragma("unroll") for (int i_ = 0; i_ < 2; ++i_) { \
            __builtin_amdgcn_global_load_lds((const unsigned*)(kb__ + ksrc[i_]), (LAS unsigned*)(lds3 + RING * SHM_V + sl_ * SHM_K + (2 * wid + i_) * 1024), 16, 0, 0); \
            __builtin_amdgcn_global_load_lds((const unsigned*)(vb__ + vsrc[i_]), (LAS unsigned*)(lds3 + sl_ * SHM_V + (2 * wid + i_) * 1024), 16, 0, 0); } } while (0)
#define BAR3() do { asm volatile("s_waitcnt vmcnt(4) lgkmcnt(0)" ::: "memory"); __builtin_amdgcn_s_barrier(); asm volatile("" ::: "memory"); } while (0)
    DMA3U(0, 0); DMA3U(1, 1); DMA3U(2, 2); DMA3U(3, 3);
    bf16x8 qr[8];
#pragma unroll
    for (int d0 = 0; d0 < 8; ++d0) qr[d0] = *(const bf16x8*)((const char*)(cur.Q + (size_t)(wid * QBLK) * LDQ) + d0 * 32 + qvoff);
    scan_c(lds, ls); LBAR();
    int j_lo; { const int lastk = 64 * lane + 63; const bool skip = (lastk < cur.P0) && (cl[cur.P0] - cl[lastk] < -thr);
        const unsigned long long keep = __ballot(!skip); j_lo = keep ? (int)__builtin_ctzll(keep) : 0; }
    if (probe_diag == 1) j_lo = j_hi - 4;
    const int NT = j_hi - j_lo;
    float l_reg = 0; f32x16 o[4] = {}; f32x16 p0, p1; bf16x8 pa0, pa1, pa2, pa3;
    float mnL; { float q2 = 0.f;
#pragma unroll
        for (int d0 = 0; d0 < 8; ++d0)
#pragma unroll
            for (int j = 0; j < 8; ++j) { const float v = __uint_as_float(((unsigned)(unsigned short)qr[d0][j]) << 16); q2 = fmaf(v, v, q2); }
        { auto rr = __builtin_amdgcn_permlane32_swap(__float_as_uint(q2), __float_as_uint(q2), false, false); q2 = __uint_as_float(rr[0]) + __uint_as_float(rr[1]); }
        const float Mt = fminf(SCALE * sqrtf(q2) * kn, 42.0f);
        int ci = wid * QBLK + r32; asm volatile("" : "+v"(ci));
        mnL = -(Mt - cl[cur.P0 + ci]) * 1.4426950408889634f; }
    asm volatile("s_waitcnt vmcnt(8)" ::: "memory");
    BAR3();
    if (!lead) BAR3();
#define STEP3(u_, SLK, SLVP) do { const int u = (u_); \
        if (u >= 2 && probe_diag != 2) DMA3(u + 2); \
        const bool live_ = KB3(u) <= qlo + QBLK - 1;                            \
        ATT_PRIO(1); \
        if (live_) qkt3<SLK>(p0, p1, ka0, ka1, ka2, ka3, qr); \
        if (u > 0 && KB3(u - 1) <= qlo + QBLK - 1) pv_tile<SLVP, false>(o, vb0, pa0, pa1, pa2, pa3, true); \
        ATT_PRIO(0); \
        BAR3(); \
        if (live_) { const int kb_ = KB3(u); bias_tile(p0, p1, cl, kb_, hi); if (kb_ + KVBLK - 1 > qlo) mask_tile(p0, p1, qm - kb_, (unsigned)WINDOW); \
            partialSM(p0, p1, mnL); finishSM(p0, p1, l_reg, pa0, pa1, pa2, pa3); } \
        BAR3(); } while (0)
    for (int u4 = 0; u4 < NT; u4 += 4) { STEP3(u4, 0, 3); if (u4 + 1 < NT) STEP3(u4 + 1, 1, 0); if (u4 + 2 < NT) STEP3(u4 + 2, 2, 1); if (u4 + 3 < NT) STEP3(u4 + 3, 3, 2); }
    u32x4 gv[8];
    int loff = (lane >> 4) * LDQ + (lane & 15) * 8, yoff = (lane >> 4) * LDO + (lane & 15) * 8;
    asm volatile("" : "+v"(loff), "+v"(yoff));
    { const bf16* Gw = cur.G + (size_t)(wid * QBLK) * LDQ + loff;
#pragma unroll
      for (int i = 0; i < 8; ++i) gv[i] = *(const u32x4*)(Gw + (size_t)(4 * i) * LDQ);
      load_ls(ls, lsn, 0); }
    { const int sv = (NT - 1) & 3;
      if (sv == 0) pv_tile<0, false>(o, vb0, pa0, pa1, pa2, pa3, true); else if (sv == 1) pv_tile<1, false>(o, vb0, pa0, pa1, pa2, pa3, true);
      else if (sv == 2) pv_tile<2, false>(o, vb0, pa0, pa1, pa2, pa3, true); else pv_tile<3, false>(o, vb0, pa0, pa1, pa2, pa3, true); }
    if (lead) LBAR();
    asm volatile("s_waitcnt vmcnt(10) lgkmcnt(0)" ::: "memory"); __builtin_amdgcn_s_barrier(); asm volatile("" ::: "memory");
    if (hi == 0) li_l[r32] = l_reg; asm volatile("s_waitcnt lgkmcnt(0)" ::: "memory");
    float rli[16];
#pragma unroll
    for (int r = 0; r < 16; ++r) rli[r] = __builtin_amdgcn_rcpf(li_l[crow(r, hi)]);
    { char* stg = lds + STG_OFF + wid * (QBLK * STG_ROW);
      bf16* Ow = cur.O + (size_t)(wid * QBLK) * LDO + yoff;
      const bool odd = (r32 & 1) != 0; int pko = odd ? (32 + r32 - 1) * 2 : r32 * 2; asm volatile("" : "+v"(pko));
#pragma unroll
      for (int r = 0; r < 16; ++r) { const int orow = crow(r, hi);
#pragma unroll
          for (int d0 = 0; d0 < 4; d0 += 2) { const float va = o[d0][r] * rli[r], vb = o[d0 + 1][r] * rli[r];
              const float rc = __shfl_xor(odd ? va : vb, 1);
              *(unsigned*)(stg + orow * STG_ROW + pko + d0 * 64) = odd ? cvtpk(rc, vb) : cvtpk(va, rc); } }
      asm volatile("s_waitcnt lgkmcnt(0)" ::: "memory");
#pragma unroll
      for (int hf = 0; hf < 2; ++hf) {
#pragma unroll
          for (int i = 0; i < 4; ++i) { const u32x4 ov = *(const u32x4*)(stg + (16 * hf + 4 * i + (lane >> 4)) * STG_ROW + (lane & 15) * 16); const u32x4 g4 = gv[4 * hf + i]; u32x4 w;
#pragma unroll
              for (int e = 0; e < 4; ++e) w[e] = cvtpk(__uint_as_float(ov[e] << 16) * __uint_as_float(g4[e] << 16), __uint_as_float(ov[e] & 0xffff0000u) * __uint_as_float(g4[e] & 0xffff0000u));
              *(u32x4*)(Ow + (size_t)(16 * hf + 4 * i) * LDO) = w; }
          asm volatile("" ::: "memory"); } }
    LBAR();
#undef KB3
#undef DMA3
#undef DMA3U
#undef BAR3
#undef STEP3
}
#undef ROW
#undef VMW
#undef VMWN
#undef SLOAD_H
#undef SWRITE_HK
#undef SWRITE_HV
#undef SWRITE_H
#undef SLOAD_F
#undef SWRITE_KF
#undef SWRITE_VF

__host__ __device__ inline int swa_nramp(int nqb, int W, int qoff) { const int t = W - 1 - qoff; const int n = t < 0 ? 0 : t / QB + 1; return n > nqb ? nqb : n; }
__host__ __device__ inline int swa_nx(int nqb, int nramp, int order) { return (order & ORDER_PAIRED) ? (nramp + 1) / 2 + (nqb - nramp) : nqb; }
struct SwaItem { int bh, qb0, qb1; };
__device__ __forceinline__ SwaItem swa_decode(int L, int nb, int nh, int nhkv, int nqb, int nx, int nramp, int order) {
    const int G = nh / nhkv; SwaItem it; int x;
    if ((order & ORDER_XCD) && (nb * nhkv) % 8 == 0) { const int xcd = L & 7, k = L >> 3, per = G * nx, gi = k / per, r = k - gi * per;
        it.bh = (gi * 8 + xcd) * G + r / nx; x = r % nx; }
    else { it.bh = L / nx; x = L - it.bh * nx; }
    if (order & ORDER_PAIRED) { const int ns = nqb - nramp;
        if (x < ns) { it.qb0 = it.qb1 = nqb - 1 - x; } else { it.qb0 = x - ns; it.qb1 = nramp - 1 - it.qb0; } }
    else { it.qb0 = it.qb1 = ((order & 3) == ORDER_REVERSED) ? nqb - 1 - x : x; }
    return it;
}
template <class TIn, class TOut>
__device__ __forceinline__ BlockRef<TIn, TOut> swa_ref(const SwaItem& it, int pass, const TIn* Q, const TIn* K, const TIn* V, TOut* O,
                                                    int nh, int nhkv, int sq, int skv, int qoff) {
    const int qb = pass ? it.qb1 : it.qb0, kvh = it.bh / (nh / nhkv);
    BlockRef<TIn, TOut> r;
    const int b_ = it.bh / nh, h_ = it.bh % nh; (void)kvh; (void)K; (void)V;
    const TIn* rowb = Q + (size_t)(b_ * nh + h_) * sq * LDQ;
    r.Q = rowb + (size_t)qb * QB * LDQ; r.K = rowb + SECSZ; r.V = rowb + 2 * SECSZ; r.G = r.Q + 3 * SECSZ;
    r.O = O + ((size_t)b_ * sq + (size_t)qb * QB) * LDO + h_ * D; r.P0 = qoff + qb * QB;
    return r;
}

constexpr int WT_OFF = (ATT_BODY == 3) ? C_OFF + SEQ * 4 : STG_OFF + NW * QBLK * STG_ROW, ATT_LDS = WT_OFF + 64;
__device__ __forceinline__ void load_ls(LsRegs& r, const float* LS, int bh) { int tid = threadIdx.x; asm volatile("" : "+v"(tid)); const f32x4* src = (const f32x4*)(LS + (size_t)bh * SEQ) + 2 * tid; r.a = src[0]; r.b = src[1]; }
__device__ __forceinline__ void scan_c(char* lds, const LsRegs& r);
__device__ __forceinline__ void load_c(char* lds, const float* LS, int bh) { LsRegs r; load_ls(r, LS, bh); scan_c(lds, r); }
__device__ __forceinline__ void scan_c(char* lds, const LsRegs& r) {
    int tid = threadIdx.x; asm volatile("" : "+v"(tid));
    const int lane = tid & 63, wv = tid >> 6;
    const f32x4 a = r.a, b = r.b;
    float v[8]; v[0] = a[0]; v[1] = v[0] + a[1]; v[2] = v[1] + a[2]; v[3] = v[2] + a[3]; v[4] = v[3] + b[0]; v[5] = v[4] + b[1]; v[6] = v[5] + b[2]; v[7] = v[6] + b[3];
    float inc = v[7];
#pragma unroll
    for (int o = 1; o < 64; o <<= 1) { const float t = __uint_as_float(__builtin_amdgcn_ds_bpermute(((lane - o) & 63) << 2, __float_as_uint(inc))); if (lane >= o) inc += t; }
    float* wt = (float*)(lds + WT_OFF);
    if (lane == 63) wt[wv] = inc;
    asm volatile("s_waitcnt lgkmcnt(0)" ::: "memory"); __builtin_amdgcn_s_barrier(); asm volatile("" ::: "memory");
    float base = inc - v[7];
#pragma unroll
    for (int w = 0; w < 7; ++w) if (w < wv) base += wt[w];
    f32x4* dst = (f32x4*)(lds + C_OFF) + 2 * tid;
    dst[0] = (f32x4){base + v[0], base + v[1], base + v[2], base + v[3]}; dst[1] = (f32x4){base + v[4], base + v[5], base + v[6], base + v[7]};
}
__device__ __forceinline__ BlockRef<bf16, bf16> blk_ref(int id, const bf16* P, bf16* Y, int& bh) {
    constexpr int nqb = SQ / QB; bh = id % (B * H); const int qb = nqb - 1 - id / (B * H);
    SwaItem it; it.bh = bh; it.qb0 = it.qb1 = qb;
    return swa_ref<bf16, bf16>(it, 0, P, P, P, Y, H, HKV, SQ, SKV, QOFF);
}
__device__ __forceinline__ void head_bounds(const float* NRM, int bh, float& thr, float& kn) {
    const float* nq = NRM + (size_t)bh * 4; const float* nk = NRM + (size_t)(B * H + bh) * 4;
    const float q2 = (nq[0] + nq[1]) + (nq[2] + nq[3]), k2 = (nk[0] + nk[1]) + (nk[2] + nk[3]);
    kn = 1.01f * sqrtf(k2);
    thr = 110.0f + fmaxf(0.f, 1.01f * SCALE * sqrtf(q2) * kn - 42.0f);
}
__device__ __forceinline__ void attn_phase(char* lds, LAS unsigned char* lds3, const bf16* P, const float* LS, const float* NRM, bf16* Y, unsigned* qctr, int blk, int nblk, int probe_diag = 0) {
    constexpr int total = B * H * (SQ / QB);
    volatile int* qslot = (volatile int*)(lds + WT_OFF + 32);
    (void)blk; (void)nblk;
    if (threadIdx.x == 0) { qslot[0] = (int)atomicAdd(qctr, 1u); qslot[1] = (int)atomicAdd(qctr, 1u); }
    __syncthreads();
    int id0 = __builtin_amdgcn_readfirstlane(qslot[0]), id1 = __builtin_amdgcn_readfirstlane(qslot[1]);
    if (id0 >= total) return;
#if ATT_BODY >= 2
#if ATT_BODY == 3
    LsRegs ls; load_ls(ls, LS, id0 % (B * H));
#endif
    for (;;) {
        int bh0; const BlockRef<bf16, bf16> cur = blk_ref(id0, P, Y, bh0);
        int id2 = total;
        if (threadIdx.x == 0 && id1 < total) id2 = (int)atomicAdd(qctr, 1u);
        float thr, kn; head_bounds(NRM, bh0, thr, kn);
#if ATT_BODY == 3
        fox_block3(cur, SKV, lds, lds3, thr, kn, ls, LS + (size_t)((id1 < total ? id1 : id0) % (B * H)) * SEQ, probe_diag);
        if (id1 >= total) break;
        if (threadIdx.x == 0) qslot[0] = id2;
        LBAR();
#else
        load_c(lds, LS, bh0); __syncthreads();
        (void)lds3; fox_block2(cur, SKV, lds, thr, kn);
        if (id1 >= total) break;
        if (threadIdx.x == 0) qslot[0] = id2;
        __syncthreads();
#endif
        id0 = id1; id1 = __builtin_amdgcn_readfirstlane(qslot[0]);
    }
#else
    int bh0, bh1 = 0;
    BlockRef<bf16, bf16> cur = blk_ref(id0, P, Y, bh0);
    Seam<bf16> S;
    load_c(lds, LS, bh0);
    causal_swa_prime<bf16, bf16>(cur, SKV, WINDOW, lds, S);
    for (;;) {
        const bool last = id1 >= total;
        const BlockRef<bf16, bf16> nxt = last ? cur : blk_ref(id1, P, Y, bh1);
        int id2 = total;
        if (threadIdx.x == 0 && !last) id2 = (int)atomicAdd(qctr, 1u);
        float thr, kn; head_bounds(NRM, bh0, thr, kn);
        causal_swa_block<bf16, bf16>(cur, nxt, SKV, WINDOW, lds, S, thr, kn);
        if (last) { __builtin_amdgcn_s_setprio(0); break; }
        if (threadIdx.x == 0) qslot[0] = id2;
        load_c(lds, LS, bh1); __syncthreads();
        id1 = __builtin_amdgcn_readfirstlane(qslot[0]);
        cur = nxt; bh0 = bh1;
    }
#endif
}
}

__device__ __forceinline__ void flogit_phase(const bf16* __restrict__ HB, const bf16* __restrict__ WF, const float* __restrict__ b_f, float* __restrict__ LS, int blk, int nblk) {
    typedef short bf16x8_t __attribute__((ext_vector_type(8)));
    const int tid = threadIdx.x, wid = __builtin_amdgcn_readfirstlane(tid >> 6), lane = tid & 63, n = lane & 15, g = lane >> 4;
    for (int rb = blk; rb < M / 32; rb += nblk) {
        const int r0 = rb * 32 + (wid >> 2) * 16, h0 = (wid & 3) * 16;
        const bf16x8_t* ap = (const bf16x8_t*)(HB + (size_t)(r0 + n) * D + 8 * g);
        const bf16x8_t* bp = (const bf16x8_t*)(WF + (size_t)(h0 + n) * D + 8 * g);
        f32x4 acc = (f32x4){0.f, 0.f, 0.f, 0.f};
#pragma unroll 8
        for (int k = 0; k < D / 32; ++k) acc = __builtin_amdgcn_mfma_f32_16x16x32_bf16(ap[4 * k], bp[4 * k], acc, 0, 0, 0);
        const float bias = b_f[h0 + n];
        f32x4 o;
#pragma unroll
        for (int j = 0; j < 4; ++j) { const float z = acc[j] + bias; const float e = __builtin_amdgcn_exp2f(-1.4426950408889634f * fabsf(z));
            o[j] = fminf(z, 0.f) - 0.6931471805599453f * __builtin_amdgcn_logf(1.0f + e); }
        const int row = r0 + 4 * g, b = row / SEQ, s = row % SEQ;
        *(f32x4*)(LS + ((size_t)b * NH + h0 + n) * SEQ + s) = o;
    }
}

#define XB_TMO      128
#define XB_XCNT(j)  (256  + 64 * (j))
#define XB_XSUB(j)  (1280 + 64 * (j))
#define XB_XGEN(j)  (2304 + 64 * (j))
#define XB_TOP      3328
#define XB_TOPGEN   3392
#define XCD_BAR_WORDS 3456
#define XB_SPIN_CAP (1u << 18)

__device__ __forceinline__ unsigned xb_ld(unsigned* p)              { return __hip_atomic_load(p, __ATOMIC_RELAXED, __HIP_MEMORY_SCOPE_AGENT); }
__device__ __forceinline__ unsigned xb_add(unsigned* p, unsigned v) { return __hip_atomic_fetch_add(p, v, __ATOMIC_RELAXED, __HIP_MEMORY_SCOPE_AGENT); }
__device__ __forceinline__ unsigned xb_xcc_id() { return (unsigned)__builtin_amdgcn_s_getreg((3 << 11) | 20) & 0xFu; }
#define XB_SPIN(cond, bar) do { unsigned _sp = 0; while (cond) { __builtin_amdgcn_s_sleep(1); \
    if ((++_sp & 255u) == 0u) { if (xb_ld(&(bar)[XB_TMO])) break; if (_sp > XB_SPIN_CAP) { atomicAdd(&(bar)[XB_TMO], 1u); break; } } } } while (0)

struct XcdBarrier {
    unsigned* bar; unsigned x;
    volatile LAS unsigned* st;
};

__device__ __forceinline__ XcdBarrier xcd_barrier_post(unsigned* bar, volatile LAS unsigned* st) {
    XcdBarrier b; b.bar = bar; b.x = xb_xcc_id(); b.st = st;
    if (threadIdx.x == 0) (void)xb_add(&bar[XB_XCNT(b.x)], 1u);
    return b;
}
__device__ __forceinline__ void xcd_barrier_complete(unsigned* bar, unsigned x, unsigned& nloc, unsigned& nx) {
    const unsigned G = gridDim.x * gridDim.y * gridDim.z;
    unsigned sum, cnt, mine, sp = 0u;
    for (;;) {
        sum = 0u; cnt = 0u; mine = 0u;
#pragma unroll
        for (unsigned j = 0; j < 16; ++j) { const unsigned c = xb_ld(&bar[XB_XCNT(j)]); sum += c; cnt += (c > 0u) ? 1u : 0u; mine = (j == x) ? c : mine; }
        if (sum == G) break;
        __builtin_amdgcn_s_sleep(1);
        if ((++sp & 255u) == 0u) { if (xb_ld(&bar[XB_TMO])) break; if (sp > XB_SPIN_CAP) { atomicAdd(&bar[XB_TMO], 1u); break; } }
    }
    nloc = mine > 0u ? mine : 1u; nx = cnt > 0u ? cnt : 1u;
}

__device__ __forceinline__ void xcd_barrier(const XcdBarrier& b) {
    asm volatile("s_waitcnt vmcnt(0)" ::: "memory");
    __syncthreads();
    if (threadIdx.x == 0) {
        unsigned* bar = b.bar;
        __builtin_amdgcn_s_waitcnt(0);
        unsigned nloc = b.st[0], nx = b.st[1];
        if (nloc == 0u) { xcd_barrier_complete(bar, b.x, nloc, nx); b.st[0] = nloc; b.st[1] = nx; }
        const unsigned old = xb_add(&bar[XB_XSUB(b.x)], 1u);
        const unsigned gen = old / nloc;
        if (old + 1u == (gen + 1u) * nloc) {
            __builtin_amdgcn_fence(__ATOMIC_RELEASE, "agent");
            asm volatile("s_waitcnt vmcnt(0)" ::: "memory");
            const unsigned og = xb_add(&bar[XB_TOP], 1u);
            const unsigned tg = og / nx;
            if (og + 1u == (tg + 1u) * nx) xb_add(&bar[XB_TOPGEN], 1u);
            else XB_SPIN(xb_ld(&bar[XB_TOPGEN]) == tg, bar);
            __builtin_amdgcn_fence(__ATOMIC_ACQUIRE, "agent");
            xb_add(&bar[XB_XGEN(b.x)], 1u);
            asm volatile("s_waitcnt vmcnt(0)" ::: "memory");
        } else {
            XB_SPIN(xb_ld(&bar[XB_XGEN(b.x)]) == gen, bar);
            __builtin_amdgcn_fence(__ATOMIC_ACQUIRE, "agent");
            asm volatile("s_waitcnt vmcnt(0)" ::: "memory");
        }
    }
    __syncthreads();
}

constexpr int CW_BAR = 1024;
constexpr size_t CTL_ZERO_BYTES = 32768;
constexpr size_t QCTR_OFF = 28672;
constexpr size_t NRM_OFF = 24576;
constexpr int LDS_TOTAL = 163840;
constexpr int MISC_OFF = LDS_TOTAL - 64;
static_assert(fox::ATT_LDS <= MISC_OFF && scan::LDS_BYTES <= MISC_OFF && pg8::STAGE_BYTES <= MISC_OFF && 8 * 8448 <= MISC_OFF, "LDS map");
#ifndef MK_N_LAUNCHES
#define MK_N_LAUNCHES 1
#endif
constexpr int N_PHASES = 9;
struct Args { const float* in[10]; float* out; unsigned char* ws; int ph_lo, ph_hi; };
__global__ void __launch_bounds__(512, 2) mega_fwd(Args args) {
    extern __shared__ __attribute__((aligned(16))) unsigned char lds[];
    LAS unsigned char* L = (LAS unsigned char*)lds;
    volatile LAS unsigned* MISC = (volatile LAS unsigned*)(L + MISC_OFF);
    const int tid = threadIdx.x, lane = tid & 63, wave = __builtin_amdgcn_readfirstlane(tid >> 6);
    const int G = gridDim.x, bx = blockIdx.x;
    if (tid < 16) MISC[tid] = 0u;
    __syncthreads();
    unsigned char* ws = args.ws;
    XcdBarrier bar; bar.bar = (unsigned*)(ws + WS_CTL) + CW_BAR; bar.x = 0; bar.st = nullptr;
    if (MK_N_LAUNCHES != N_PHASES) bar = xcd_barrier_post((unsigned*)(ws + WS_CTL) + CW_BAR, MISC + 8);
    const float* x = args.in[0]; const float* norm_w = args.in[1]; const float* w_in_a = args.in[2]; const float* lb_logits = args.in[3]; const float* o_norm_a = args.in[4];
    const float* w_out_a = args.in[5]; const float* w_in_b = args.in[6]; const float* b_f = args.in[7]; const float* w_out_b = args.in[8]; const float* final_norm = args.in[9];
    float* out = args.out;
    bf16* WA = (bf16*)(ws + WS_WA); bf16* WB = (bf16*)(ws + WS_WB); bf16* WF = (bf16*)(ws + WS_WF); bf16* WOA = (bf16*)(ws + WS_WOA); bf16* WOB = (bf16*)(ws + WS_WOB);
    bf16* HB = (bf16*)(ws + WS_HB); float* X1 = (float*)(ws + WS_X1); bf16* P = (bf16*)(ws + WS_P); bf16* Y = (bf16*)(ws + WS_Y); float* LS = (float*)(ws + WS_LS);
    const int lo = args.ph_lo, hi = args.ph_hi;
#define IN(k) (lo <= (k) && (k) < hi)
#define SEAM(k) do { if (IN(k) && IN((k) + 1)) xcd_barrier(bar); } while (0)
#define RUN(k, ...) do { if (IN(k)) { __VA_ARGS__ } } while (0)

    RUN(0, { prologue_phase(L, 0, x, norm_w, w_in_a, w_out_a, w_in_b, w_out_b, ws, bx, G, wave, lane); } );
    SEAM(0);
#ifdef GEMM_DESYNC_TICKS
    if (IN(1)) { const unsigned long long t0 = __builtin_amdgcn_s_memrealtime(); const unsigned long long dl = (unsigned long long)(((unsigned)bx >> 3) & 3u) * GEMM_DESYNC_TICKS;
        while (__builtin_amdgcn_s_memrealtime() - t0 < dl) __builtin_amdgcn_s_sleep(8); }
#endif
    RUN(1, { pg8::Gemm g{HB, WA, M, LDP, D, 0}; pg8::StaticOrder S; S.init(M, LDP, G, bx); pg8::EpiAct<0> E{P, lb_logits, nullptr, LDP, 0};
        pg8::gemm_phase<pg8::EpiAct<0>, pg8::StaticOrder, true, true>(L, g, S, E); } );
    SEAM(1);
    RUN(2, { if (G >= 2 * NB * NH) { if (bx < NB * NH) scan::scan_unit(L, P, o_norm_a, Y, bx); else prologue_phase(L, 1, x, norm_w, w_in_a, w_out_a, w_in_b, w_out_b, ws, bx - NB * NH, G - NB * NH, wave, lane); }
              else { for (int bh = bx; bh < NB * NH; bh += G) scan::scan_unit(L, P, o_norm_a, Y, bh); prologue_phase(L, 1, x, norm_w, w_in_a, w_out_a, w_in_b, w_out_b, ws, bx, G, wave, lane); } } );
#ifdef PROBE_CONV128
    if (IN(2)) { xcd_barrier(bar); if (bx >= NB * NH) prologue_phase(L, 1, x, norm_w, w_in_a, w_out_a, w_in_b, w_out_b, ws, bx - NB * NH, G - NB * NH, wave, lane); }
#endif
#ifdef PROBE_SCAN128
    if (IN(2)) { xcd_barrier(bar); if (bx < NB * NH) scan::scan_unit(L, P, o_norm_a, Y, bx); }
#endif
    SEAM(2);
    RUN(3, { pg8::Gemm g{Y, WOA, M, D, DI, 0}; pg8::StaticOrder S; S.init(M, D, G, bx); pg8::EpiRes E{x, X1, D, 0};
        pg8::gemm_phase<pg8::EpiRes, pg8::StaticOrder, true, true>(L, g, S, E); } );
    SEAM(3);
    RUN(4, { const int gw = bx * 8 + wave, NGW = G * 8; for (int m = gw; m < M; m += NGW) rms_row_bf16(X1 + (size_t)m * D, norm_w + D, HB + (size_t)m * D, lane); } );
    SEAM(4);
    RUN(5, { flogit_phase(HB, WF, b_f, LS, bx, G);
        pg8::Gemm g{HB, WB, M, LDP, D, 0}; pg8::StaticOrder S; S.init(M, LDP, G, bx); pg8::EpiAct<1> E{P, nullptr, (unsigned*)(ws + WS_CTL + NRM_OFF), LDP, 0};
        pg8::gemm_phase<pg8::EpiAct<1>, pg8::StaticOrder, true, true>(L, g, S, E); } );
    SEAM(5);
    RUN(6, { fox::attn_phase((char*)lds, L, P, LS, (const float*)(ws + WS_CTL + NRM_OFF), Y, (unsigned*)(ws + WS_CTL + QCTR_OFF), bx, G); } );
#ifdef PROBE_ATTN_JUNK
    if (IN(6)) { xcd_barrier(bar); fox::attn_phase((char*)lds, L, P, LS, (const float*)(ws + WS_CTL + NRM_OFF), (bf16*)(ws + WS_WB), (unsigned*)(ws + WS_CTL + QCTR_OFF + 256), bx, G, PROBE_ATTN_JUNK - 1); }
#endif
#ifdef PROBE_ATTN2
    if (IN(6)) { xcd_barrier(bar); fox::attn_phase((char*)lds, L, P, LS, (const float*)(ws + WS_CTL + NRM_OFF), Y, (unsigned*)(ws + WS_CTL + QCTR_OFF + 256), bx, G); }
#endif
    SEAM(6);
    RUN(7, { pg8::Gemm g{Y, WOB, M, D, DI, 0}; pg8::StaticOrder S; S.init(M, D, G, bx); pg8::EpiRes E{X1, out, D, 0};
        pg8::gemm_phase<pg8::EpiRes, pg8::StaticOrder, true, true>(L, g, S, E); } );
    SEAM(7);
    RUN(8, { const int gw = bx * 8 + wave, NGW = G * 8; for (int m = gw; m < M; m += NGW) rms_row_f32(out + (size_t)m * D, final_norm, out + (size_t)m * D, lane); } );
#undef IN
#undef SEAM
}

extern "C" void kernel_launch(void* const* d_in, const int* in_sizes, int n_in, void* d_out, int out_size, void* d_ws, size_t ws_size, hipStream_t stream) {
    static int grid = 0;
    if (grid == 0) {
        if (n_in != 10 || in_sizes[0] != M * D || out_size != M * D || ws_size < WS_END) { fprintf(stderr, "kernel_launch: unexpected shapes (n_in %d, in0 %d, out %d, ws %zu < %zu); nothing launched\n", n_in, n_in > 0 ? in_sizes[0] : -1, out_size, ws_size, (size_t)WS_END); grid = -1; return; }
        int dev = 0, cus = 0, per_cu = 0;
        if (hipGetDevice(&dev) != hipSuccess || hipDeviceGetAttribute(&cus, hipDeviceAttributeMultiprocessorCount, dev) != hipSuccess) { fprintf(stderr, "kernel_launch: device query failed\n"); grid = -1; return; }
        if (hipFuncSetAttribute((const void*)mega_fwd, hipFuncAttributeMaxDynamicSharedMemorySize, LDS_TOTAL) != hipSuccess) { fprintf(stderr, "kernel_launch: hipFuncSetAttribute(%d B LDS) failed\n", LDS_TOTAL); grid = -1; return; }
        if (hipOccupancyMaxActiveBlocksPerMultiprocessor(&per_cu, (const void*)mega_fwd, 512, LDS_TOTAL) != hipSuccess || per_cu < 1)
            fprintf(stderr, "kernel_launch: note: occupancy query reports %d workgroups per CU\n", per_cu);
        (void)hipGetLastError();
        grid = cus;
    }
    if (grid < 0) return;
    if (hipMemsetAsync((char*)d_ws + WS_CTL, 0, CTL_ZERO_BYTES, stream) != hipSuccess) { fprintf(stderr, "kernel_launch: hipMemsetAsync failed\n"); return; }
    Args a{};
    for (int i = 0; i < 10; ++i) a.in[i] = (const float*)d_in[i];
    a.out = (float*)d_out; a.ws = (unsigned char*)d_ws;
#if MK_N_LAUNCHES == 1
    a.ph_lo = 0; a.ph_hi = N_PHASES;
    hipLaunchKernelGGL(mega_fwd, dim3(grid), dim3(512), LDS_TOTAL, stream, a);
#else
    for (int p = 0; p < N_PHASES; ++p) { a.ph_lo = p; a.ph_hi = p + 1; hipLaunchKernelGGL(mega_fwd, dim3(grid), dim3(512), LDS_TOTAL, stream, a); }
#endif
    const hipError_t le = hipPeekAtLastError();
    if (le != hipSuccess) fprintf(stderr, "kernel_launch: launch failed: %s\n", hipGetErrorName(le));
}
```

```cpp
#include <hip/hip_runtime.h>
#include <cstdio>
#include <cstdint>

constexpr int NB = 2, SEQ = 4096, D = 4096, DI = 8192, NH = 64, HD = 128;
constexpr int M = NB * SEQ;
constexpr int LDP = 4 * DI;
constexpr int NWB = 4 * DI + NH;
constexpr float EPS = 1e-6f;
namespace pg8 {
#define PG8_LAS __attribute__((address_space(3)))
typedef unsigned short bf16_t;
typedef short bf16x8 __attribute__((ext_vector_type(8)));
typedef float f32x4 __attribute__((ext_vector_type(4)));
typedef unsigned u32x4 __attribute__((ext_vector_type(4)));
constexpr int BM = 256, BK = 64, HALF = 128, HTB = HALF * BK * 2  , STAGE_BYTES = 8 * HTB, NXCD = 8, WGM = 8;

__host__ __device__ __forceinline__ int lds_byte(int r, int c) { const int st = (r >> 4) * 2 + (c >> 5), rr = r & 15, cc = c & 31, ob = rr * 64 + cc * 2; return st * 1024 + (ob ^ (((ob >> 9) & 1) << 5)); }
__host__ __device__ __forceinline__ void stage_rc(int b, int& R, int& C) { const int st = b / 1024, sb = b % 1024, swz = sb ^ (((sb >> 9) & 1) << 5); R = (st >> 1) * 16 + swz / 64; C = (st & 1) * 32 + (swz % 64) / 2; }
__host__ __device__ __forceinline__ int perm32(int rho) { const int n = rho >> 4, i = rho & 15; return 8 * (i >> 2) + 4 * n + (i & 3); }

struct Unit { int pm, pn; };
struct Gemm { const bf16_t* A; const bf16_t* Bt; int M, N, K, pad; };

struct StaticOrder {
    int nM, nN, nwg, G, c;
    __host__ __device__ void init(int M, int N, int G_, int c_) { nM = M / BM; nN = N / BM; nwg = nM * nN; G = G_; c = c_; }
    __host__ __device__ bool next(int i, Unit& u) const {
        const long L = (long)i * G + c; if (L >= nwg) return false;
        int wgid = (int)L; { const int q = nwg / NXCD, r = nwg % NXCD, xcd = wgid % NXCD, off = wgid / NXCD; wgid = (xcd < r ? xcd * (q + 1) : r * (q + 1) + (xcd - r) * q) + off; }
        const int nig = WGM * nN, gid = wgid / nig, fm = gid * WGM, gsz = (nM - fm) < WGM ? (nM - fm) : WGM;
        u.pm = fm + ((wgid % nig) % gsz); u.pn = (wgid % nig) / gsz; return true;
    }
    __device__ __forceinline__ void a_ready(const Unit&) const {}
    __device__ __forceinline__ void done(const Unit&) const {}
};

typedef float f32x2_t __attribute__((ext_vector_type(2)));
typedef __bf16 bf16x2_t __attribute__((ext_vector_type(2)));
__device__ __forceinline__ unsigned cvt_pk_bf16(float lo, float hi) { f32x2_t v = {lo, hi}; bf16x2_t b = __builtin_convertvector(v, bf16x2_t); return __builtin_bit_cast(unsigned, b); }
__device__ __forceinline__ float silu_f(float x) { return x * __builtin_amdgcn_rcpf(1.0f + __builtin_amdgcn_exp2f(-1.4426950408889634f * x)); }

#define PG8_PSTORE(p, v) (*(p) = (v))
template <int LAYER> struct EpiAct {
    static constexpr bool PERM = true, AFTER_DRAIN = false;
    bf16_t* O; const float* lbl; unsigned* nrm; int ldc, pad;
    __device__ __forceinline__ void operator()(const f32x4 (&acc)[2][2][4][2], const Unit& u, int wr, int wc, int fr, int fq) const {
        const int sec = u.pn >> 5;
        const int row0 = u.pm * BM + wr * 64 + fr, col0 = u.pn * BM + wc * 32 + 8 * fq;
        const int mode = (LAYER == 0) ? ((sec == 0 || sec == 3) ? 1 : (sec == 1 ? 2 : 0)) : (sec == 3 ? 1 : 0);
        const int rb = row0 >> 12, rs = row0 & 4095, hh = (2 * u.pn) & 63;
        bf16_t* hm = O + ((size_t)((sec * 2 + rb) * 64 + hh) * 4096 + rs) * 128 + wc * 32 + 8 * fq;
        if (mode == 2) {
            float lb[2][8], om[2][8];
#pragma unroll
            for (int bj = 0; bj < 2; ++bj) { const int c = col0 + bj * HALF - 8192;
                const f32x4 a0 = *(const f32x4*)(lbl + c), a1 = *(const f32x4*)(lbl + c + 4), b0 = *(const f32x4*)(lbl + 8192 + c), b1 = *(const f32x4*)(lbl + 8192 + c + 4);
#pragma unroll
                for (int e = 0; e < 4; ++e) { const float x0 = __builtin_amdgcn_rcpf(1.0f + __builtin_amdgcn_exp2f(1.4426950408889634f * (b0[e] - a0[e]))), x1 = __builtin_amdgcn_rcpf(1.0f + __builtin_amdgcn_exp2f(1.4426950408889634f * (b1[e] - a1[e])));
                    lb[bj][e] = x0; om[bj][e] = 1.0f - x0; lb[bj][4 + e] = x1; om[bj][4 + e] = 1.0f - x1; } }
#pragma unroll
            for (int ai = 0; ai < 2; ++ai)
#pragma unroll
                for (int m = 0; m < 4; ++m) { bf16_t* rowp = hm + (size_t)(ai * HALF + m * 16) * 128;
#pragma unroll
                    for (int bj = 0; bj < 2; ++bj) { float v[8];
#pragma unroll
                        for (int e = 0; e < 8; ++e) { const float f = acc[ai][bj][m][e >> 2][e & 3];
                            const float sg = __builtin_amdgcn_rcpf(1.0f + __builtin_amdgcn_exp2f(-1.4426950408889634f * f));
                            v[e] = __builtin_amdgcn_logf(lb[bj][e] + om[bj][e] * sg); }
                        u32x4 w; w.x = cvt_pk_bf16(v[0], v[1]); w.y = cvt_pk_bf16(v[2], v[3]); w.z = cvt_pk_bf16(v[4], v[5]); w.w = cvt_pk_bf16(v[6], v[7]);
                        PG8_PSTORE((u32x4*)(rowp + (size_t)bj * (4096 * 128)), w); } }
        } else if (mode == 1) {
#pragma unroll
            for (int ai = 0; ai < 2; ++ai)
#pragma unroll
                for (int m = 0; m < 4; ++m) { bf16_t* rowp = hm + (size_t)(ai * HALF + m * 16) * 128;
#pragma unroll
                    for (int bj = 0; bj < 2; ++bj) { float v[8];
#pragma unroll
                        for (int e = 0; e < 8; ++e) v[e] = silu_f(acc[ai][bj][m][e >> 2][e & 3]);
                        u32x4 w; w.x = cvt_pk_bf16(v[0], v[1]); w.y = cvt_pk_bf16(v[2], v[3]); w.z = cvt_pk_bf16(v[4], v[5]); w.w = cvt_pk_bf16(v[6], v[7]);
                        PG8_PSTORE((u32x4*)(rowp + (size_t)bj * (4096 * 128)), w); } }
        } else {
            float nmax[2] = {0.f, 0.f};
#pragma unroll
            for (int ai = 0; ai < 2; ++ai)
#pragma unroll
                for (int m = 0; m < 4; ++m) { bf16_t* rowp = hm + (size_t)(ai * HALF + m * 16) * 128;
#pragma unroll
                    for (int bj = 0; bj < 2; ++bj) { const f32x4 v0 = acc[ai][bj][m][0], v1 = acc[ai][bj][m][1];
                        u32x4 w; w.x = cvt_pk_bf16(v0[0], v0[1]); w.y = cvt_pk_bf16(v0[2], v0[3]); w.z = cvt_pk_bf16(v1[0], v1[1]); w.w = cvt_pk_bf16(v1[2], v1[3]);
                        PG8_PSTORE((u32x4*)(rowp + (size_t)bj * (4096 * 128)), w);
                        if (LAYER == 1 && sec < 2) { float ss = (v0[0] * v0[0] + v0[1] * v0[1]) + (v0[2] * v0[2] + v0[3] * v0[3]) + (v1[0] * v1[0] + v1[1] * v1[1]) + (v1[2] * v1[2] + v1[3] * v1[3]);
                            ss += __shfl_xor(ss, 16); ss += __shfl_xor(ss, 32); nmax[bj] = fmaxf(nmax[bj], ss); } } }
            if (LAYER == 1 && sec < 2) {
#pragma unroll
                for (int bj = 0; bj < 2; ++bj) { float v = nmax[bj];
#pragma unroll
                    for (int o = 1; o < 16; o <<= 1) v = fmaxf(v, __shfl_xor(v, o));
                    if (fr == 0 && fq == 0) atomicMax(nrm + ((size_t)(sec * 128 + rb * 64 + hh + bj)) * 4 + wc, __float_as_uint(v)); }
            }
        }
    }
};
struct EpiRes {
    static constexpr bool PERM = false, AFTER_DRAIN = false;
    const float* base; float* out; int ldc, pad;
    __device__ __forceinline__ void operator()(const f32x4 (&acc)[2][2][4][2], const Unit& u, int wr, int wc, int fr, int fq) const {
        const int row0 = u.pm * BM + wr * 64 + fr, col0 = u.pn * BM + wc * 32 + 4 * fq;
#pragma unroll
        for (int ai = 0; ai < 2; ++ai)
#pragma unroll
            for (int m = 0; m < 4; ++m) { const size_t off = (size_t)(row0 + ai * HALF + m * 16) * ldc + col0;
#pragma unroll
                for (int bj = 0; bj < 2; ++bj)
#pragma unroll
                    for (int n = 0; n < 2; ++n) { const f32x4 bs = *(const f32x4*)(base + off + bj * HALF + n * 16); *(f32x4*)(out + off + bj * HALF + n * 16) = bs + acc[ai][bj][m][n]; }
                }
    }
};

template <class Epi, class Sched, bool ALIGN_EPI = false, bool SP2 = false>
__device__ __forceinline__ void gemm_phase(PG8_LAS unsigned char* lds, const Gemm g, const Sched& S, const Epi& E) {
    const int tid = threadIdx.x, wid = __builtin_amdgcn_readfirstlane(tid >> 6), lane = tid & 63, wr = wid >> 2, wc = wid & 3, fr = lane & 15, fq = lane >> 4;
    const int K = g.K, nt = K / BK;
    unsigned voffA[2], voffB[2];
#pragma unroll
    for (int i = 0; i < 2; ++i) { int R, C; stage_rc(tid * 16 + i * 8192, R, C); const int Rb = Epi::PERM ? ((R & ~31) + perm32(R & 31)) : R;
        voffA[i] = (unsigned)(R * K + C) * 2u; voffB[i] = (unsigned)(Rb * K + C) * 2u; }
    const size_t kstep = (size_t)(BK * 2);
    const size_t hstep = (size_t)HALF * K * 2;
    const size_t tstep = 2 * hstep;
    const unsigned ldsw = (unsigned)wid * 1024u;
    const int aoff = lds_byte(wr * 64 + fr, fq * 8), boff = lds_byte(wc * 32 + fr, fq * 8);
#define PG8_SA(b, h) (((b) * 2 + (h)) * HTB)
#define PG8_SB(b, h) ((4 + (b) * 2 + (h)) * HTB)
#define PG8_STAGE(bufoff, gbase, voff) do { _Pragma("unroll") for (int _i = 0; _i < 2; ++_i) \
        __builtin_amdgcn_global_load_lds((const unsigned*)((const char*)(gbase) + (voff)[_i]), (PG8_LAS unsigned*)(lds + (bufoff) + ldsw + _i * 8192), 16, 0, 0); } while (0)
#define PG8_LDA(dst, b, h) do { _Pragma("unroll") for (int m = 0; m < 4; ++m) _Pragma("unroll") for (int k = 0; k < 2; ++k) dst[m][k] = *(const PG8_LAS bf16x8*)(lds + PG8_SA(b, h) + aoff + m * 2048 + k * 1024); } while (0)
#define PG8_LDB(dst, b, h) do { _Pragma("unroll") for (int n = 0; n < 2; ++n) _Pragma("unroll") for (int k = 0; k < 2; ++k) dst[n][k] = *(const PG8_LAS bf16x8*)(lds + PG8_SB(b, h) + boff + n * 2048 + k * 1024); } while (0)
#define PG8_MMA(ai, bj, At, Bt) do { __builtin_amdgcn_s_setprio(1); _Pragma("unroll") for (int m = 0; m < 4; ++m) _Pragma("unroll") for (int n = 0; n < 2; ++n) _Pragma("unroll") for (int k = 0; k < 2; ++k) \
        acc[ai][bj][m][n] = __builtin_amdgcn_mfma_f32_16x16x32_bf16(Bt[n][k], At[m][k], acc[ai][bj][m][n], 0, 0, 0); __builtin_amdgcn_s_setprio(0); } while (0)
#define PG8_WAIT_V(n) asm volatile("s_waitcnt vmcnt(" #n ")" ::: "memory")
#define PG8_WAIT_L(n) asm volatile("s_waitcnt lgkmcnt(" #n ")" ::: "memory")
#define PG8_BAR __builtin_amdgcn_s_barrier()
#define PG8_SCHED __builtin_amdgcn_sched_barrier(0)
    Unit cur, nxt; int ui = 0;
    if (!S.next(0, cur)) return;
    f32x4 acc[2][2][4][2];
#pragma unroll
    for (int a = 0; a < 2; ++a)
#pragma unroll
        for (int b = 0; b < 2; ++b)
#pragma unroll
            for (int m = 0; m < 4; ++m)
#pragma unroll
                for (int n = 0; n < 2; ++n) acc[a][b][m][n] = (f32x4){0.f, 0.f, 0.f, 0.f};
    bf16x8 At[4][2], B0[2][2], B1[2][2];
    const char* cA = (const char*)g.A + (size_t)cur.pm * tstep; const char* cB = (const char*)g.Bt + (size_t)cur.pn * tstep;
    S.a_ready(cur);
    if constexpr (SP2) {
        PG8_STAGE(PG8_SB(0, 0), cB, voffB); PG8_STAGE(PG8_SB(0, 1), cB + hstep, voffB); PG8_STAGE(PG8_SA(0, 0), cA, voffA); PG8_STAGE(PG8_SA(0, 1), cA + hstep, voffA);
        if (wr == 1) PG8_BAR;
        PG8_WAIT_V(2); PG8_BAR;
        PG8_STAGE(PG8_SB(1, 0), cB + kstep, voffB); PG8_STAGE(PG8_SA(1, 0), cA + kstep, voffA); PG8_STAGE(PG8_SB(1, 1), cB + hstep + kstep, voffB);
        PG8_WAIT_V(6); PG8_BAR;
    } else {
        PG8_STAGE(PG8_SB(0, 0), cB, voffB); PG8_STAGE(PG8_SA(0, 0), cA, voffA); PG8_STAGE(PG8_SB(0, 1), cB + hstep, voffB); PG8_STAGE(PG8_SA(0, 1), cA + hstep, voffA);
        if (wr == 1) PG8_BAR;
        PG8_WAIT_V(4); PG8_BAR;
        PG8_STAGE(PG8_SB(1, 0), cB + kstep, voffB); PG8_STAGE(PG8_SA(1, 0), cA + kstep, voffA); PG8_STAGE(PG8_SB(1, 1), cB + hstep + kstep, voffB);
        PG8_WAIT_V(6); PG8_BAR;
    }
    for (;;) {
        const bool has_next = S.next(ui + 1, nxt);
        const char* nA = has_next ? (const char*)g.A + (size_t)nxt.pm * tstep : cA; const char* nB = has_next ? (const char*)g.Bt + (size_t)nxt.pn * tstep : cB;
        for (int t = 0; t < nt; t += 2) {
            const bool last = (t == nt - 2);
            const char* a1 = cA + (size_t)(t + 1) * kstep;
            const char* a2 = last ? nA : cA + (size_t)(t + 2) * kstep; const char* b2 = last ? nB : cB + (size_t)(t + 2) * kstep;
            const char* a3 = a2 + kstep; const char* b3 = b2 + kstep;
            if (last && has_next) S.a_ready(nxt);
            if constexpr (SP2) {
            PG8_LDB(B0, 0, 0); PG8_LDB(B1, 0, 1); PG8_SCHED; PG8_LDA(At, 0, 0); PG8_STAGE(PG8_SA(1, 1), a1 + hstep, voffA);
            PG8_WAIT_V(8); PG8_WAIT_L(0); PG8_BAR; PG8_MMA(0, 0, At, B0); PG8_MMA(0, 1, At, B1); PG8_BAR; PG8_SCHED;
            PG8_LDA(At, 0, 1); PG8_STAGE(PG8_SB(0, 0), b2, voffB); PG8_STAGE(PG8_SB(0, 1), b2 + hstep, voffB); PG8_STAGE(PG8_SA(0, 0), a2, voffA);
            PG8_WAIT_V(8); PG8_WAIT_L(0); PG8_BAR; PG8_MMA(1, 0, At, B0); PG8_MMA(1, 1, At, B1); PG8_BAR; PG8_SCHED;
            PG8_LDB(B0, 1, 0); PG8_LDB(B1, 1, 1); PG8_SCHED; PG8_LDA(At, 1, 0); PG8_STAGE(PG8_SA(0, 1), a2 + hstep, voffA);
            PG8_WAIT_V(8); PG8_WAIT_L(0); PG8_BAR; PG8_MMA(0, 0, At, B0); PG8_MMA(0, 1, At, B1); PG8_BAR; PG8_SCHED;
            PG8_LDA(At, 1, 1); PG8_STAGE(PG8_SB(1, 0), b3, voffB); PG8_STAGE(PG8_SB(1, 1), b3 + hstep, voffB); PG8_STAGE(PG8_SA(1, 0), a3, voffA);
            PG8_WAIT_V(8); PG8_WAIT_L(0); PG8_BAR; PG8_MMA(1, 0, At, B0); PG8_MMA(1, 1, At, B1); PG8_BAR; PG8_SCHED;
            } else {
            PG8_LDB(B0, 0, 0); PG8_SCHED; PG8_LDA(At, 0, 0); PG8_STAGE(PG8_SA(1, 1), a1 + hstep, voffA);
            PG8_WAIT_L(8); PG8_BAR; PG8_WAIT_L(0); PG8_MMA(0, 0, At, B0); PG8_BAR; PG8_SCHED;
            PG8_LDB(B1, 0, 1); PG8_STAGE(PG8_SB(0, 0), b2, voffB);
            PG8_BAR; PG8_WAIT_L(0); PG8_MMA(0, 1, At, B1); PG8_BAR;
            PG8_LDA(At, 0, 1); PG8_STAGE(PG8_SA(0, 0), a2, voffA);
            PG8_BAR; PG8_WAIT_L(0); PG8_MMA(1, 0, At, B0); PG8_BAR; PG8_SCHED;
            PG8_STAGE(PG8_SB(0, 1), b2 + hstep, voffB);
            PG8_WAIT_V(6); PG8_BAR; PG8_MMA(1, 1, At, B1); PG8_BAR;
            PG8_LDB(B0, 1, 0); PG8_SCHED; PG8_LDA(At, 1, 0); PG8_STAGE(PG8_SA(0, 1), a2 + hstep, voffA);
            PG8_WAIT_L(8); PG8_BAR; PG8_WAIT_L(0); PG8_MMA(0, 0, At, B0); PG8_BAR; PG8_SCHED;
            PG8_LDB(B1, 1, 1); PG8_STAGE(PG8_SB(1, 0), b3, voffB);
            PG8_BAR; PG8_WAIT_L(0); PG8_MMA(0, 1, At, B1); PG8_BAR;
            PG8_LDA(At, 1, 1); PG8_STAGE(PG8_SA(1, 0), a3, voffA);
            PG8_BAR; PG8_WAIT_L(0); PG8_MMA(1, 0, At, B0); PG8_BAR; PG8_SCHED;
            PG8_STAGE(PG8_SB(1, 1), b3 + hstep, voffB);
            PG8_WAIT_V(6); PG8_BAR; PG8_MMA(1, 1, At, B1); PG8_BAR;
            }
        }
        if constexpr (ALIGN_EPI) { if (wr == 0) PG8_BAR; }
        if constexpr (!Epi::AFTER_DRAIN) { E(acc, cur, wr, wc, fr, fq); S.done(cur); }
        if (!has_next) break;
#pragma unroll
        for (int a = 0; a < 2; ++a)
#pragma unroll
            for (int b = 0; b < 2; ++b)
#pragma unroll
                for (int m = 0; m < 4; ++m)
#pragma unroll
                    for (int n = 0; n < 2; ++n) acc[a][b][m][n] = (f32x4){0.f, 0.f, 0.f, 0.f};
        cur = nxt; cA = nA; cB = nB; ++ui;
        if constexpr (ALIGN_EPI) { if (wr == 1) PG8_BAR; }
    }
    PG8_WAIT_V(0);
    if constexpr (!ALIGN_EPI) { if (wr == 0) PG8_BAR; }
    PG8_BAR;
    if constexpr (Epi::AFTER_DRAIN) { E.fused(acc, cur, wr, wc, fr, fq, lds, wid, lane); S.done(cur); }
#undef PG8_SA
#undef PG8_SB
#undef PG8_STAGE
#undef PG8_LDA
#undef PG8_LDB
#undef PG8_MMA
#undef PG8_WAIT_V
#undef PG8_WAIT_L
#undef PG8_BAR
#undef PG8_SCHED
}
}

#define LAS __attribute__((address_space(3)))
typedef unsigned short bf16;
typedef unsigned v4u __attribute__((ext_vector_type(4)));
typedef unsigned v2u __attribute__((ext_vector_type(2)));
typedef float f32x4 __attribute__((ext_vector_type(4)));
__device__ __forceinline__ unsigned pk2(float lo, float hi) { return pg8::cvt_pk_bf16(lo, hi); }
__device__ __forceinline__ float bf2f(unsigned short b) { return __uint_as_float(((unsigned)b) << 16); }
__device__ __forceinline__ float bflo(unsigned w) { return __uint_as_float(w << 16); }
__device__ __forceinline__ float bfhi(unsigned w) { return __uint_as_float(w & 0xffff0000u); }
__device__ __forceinline__ float wave_sum(float v) {
#pragma unroll
    for (int o = 1; o < 64; o <<= 1) v += __shfl_xor(v, o);
    return v;
}
__device__ __forceinline__ float wave_max(float v) {
#pragma unroll
    for (int o = 1; o < 64; o <<= 1) v = fmaxf(v, __shfl_xor(v, o));
    return v;
}

#define WLOAD(p) __builtin_nontemporal_load(p)
struct TileDesc { const float* W; size_t ldw; int K, k0, n0; bf16* WT; int nbase; };
__device__ __forceinline__ void tile_load(const TileDesc& d, f32x4 (&ra)[8], f32x4 (&rb)[8], int lane) {
    const int g = lane & 15, ks = lane >> 4;
#pragma unroll
    for (int i = 0; i < 8; ++i) { const int k = d.k0 + 8 * i + 2 * ks;
        ra[i] = WLOAD((const f32x4*)(d.W + (size_t)k * d.ldw + d.n0 + 4 * g)); rb[i] = WLOAD((const f32x4*)(d.W + (size_t)(k + 1) * d.ldw + d.n0 + 4 * g)); }
}
__device__ __forceinline__ void tile_store(const TileDesc& d, const f32x4 (&ra)[8], const f32x4 (&rb)[8], LAS unsigned* scr, int lane) {
    const int g = lane & 15, ks = lane >> 4;
#pragma unroll
    for (int i = 0; i < 8; ++i)
#pragma unroll
        for (int j = 0; j < 4; ++j) scr[(4 * g + j) * 33 + 4 * i + ks] = pk2(ra[i][j], rb[i][j]);
    asm volatile("s_waitcnt lgkmcnt(0)" ::: "memory");
    const int c = lane & 7;
#pragma unroll
    for (int r = 0; r < 8; ++r) { const int n = 8 * r + (lane >> 3);
        v4u o; o.x = scr[n * 33 + 4 * c]; o.y = scr[n * 33 + 4 * c + 1]; o.z = scr[n * 33 + 4 * c + 2]; o.w = scr[n * 33 + 4 * c + 3];
        *(v4u*)(d.WT + (size_t)(d.n0 - d.nbase + n) * d.K + d.k0 + 8 * c) = o; }
    asm volatile("s_waitcnt lgkmcnt(0)" ::: "memory");
}
__device__ __forceinline__ void rms_row_bf16(const float* xrow, const float* w, bf16* orow, int lane) {
    const f32x4* xr = (const f32x4*)xrow + lane; const f32x4* wr = (const f32x4*)w + lane;
    f32x4 v[16]; float s = 0.f;
#pragma unroll
    for (int j = 0; j < 16; ++j) { v[j] = xr[64 * j]; s += (v[j].x * v[j].x + v[j].y * v[j].y) + (v[j].z * v[j].z + v[j].w * v[j].w); }
    const float rs = 1.0f / sqrtf(wave_sum(s) * (1.0f / D) + EPS);
    v2u* o8 = (v2u*)orow + lane;
#pragma unroll
    for (int j = 0; j < 16; ++j) { const f32x4 g = wr[64 * j]; v2u o; o.x = pk2(v[j].x * rs * g.x, v[j].y * rs * g.y); o.y = pk2(v[j].z * rs * g.z, v[j].w * rs * g.w); o8[64 * j] = o; }
}
__device__ __forceinline__ void rms_row_f32(const float* xrow, const float* w, float* orow, int lane) {
    const f32x4* xr = (const f32x4*)xrow + lane; const f32x4* wr = (const f32x4*)w + lane;
    f32x4 v[16]; float s = 0.f;
#pragma unroll
    for (int j = 0; j < 16; ++j) { v[j] = xr[64 * j]; s += (v[j].x * v[j].x + v[j].y * v[j].y) + (v[j].z * v[j].z + v[j].w * v[j].w); }
    const float rs = 1.0f / sqrtf(wave_sum(s) * (1.0f / D) + EPS);
    f32x4* o = (f32x4*)orow + lane;
#pragma unroll
    for (int j = 0; j < 16; ++j) { const f32x4 g = wr[64 * j]; o[64 * j] = (f32x4){v[j].x * rs * g.x, v[j].y * rs * g.y, v[j].z * rs * g.z, v[j].w * rs * g.w}; }
}

constexpr size_t MiB = 1u << 20;
constexpr size_t WS_CTL = 0;
constexpr size_t WS_WA  = 1 * MiB;
constexpr size_t WS_WB  = WS_WA + 256 * MiB;
constexpr size_t WS_WF  = WS_WB + 256 * MiB;
constexpr size_t WS_WOA = WS_WF + 1 * MiB;
constexpr size_t WS_WOB = WS_WOA + 64 * MiB;
constexpr size_t WS_HB  = WS_WOB + 64 * MiB;
constexpr size_t WS_X1  = WS_HB + 64 * MiB;
constexpr size_t WS_P   = WS_X1 + 128 * MiB;
constexpr size_t WS_Y   = WS_P + 512 * MiB;
constexpr size_t WS_LS  = WS_Y + 128 * MiB;
constexpr size_t WS_END = WS_LS + 2 * MiB;

#ifndef CONV_P0_PCT
#define CONV_P0_PCT 0
#endif
__device__ __forceinline__ void prologue_phase(LAS unsigned char* lds, int part, const float* x, const float* norm_w, const float* w_in_a, const float* w_out_a, const float* w_in_b, const float* w_out_b,
                                               unsigned char* ws, int vcu, int G, int wave, int lane) {
    LAS unsigned* scr = (LAS unsigned*)(lds + wave * 8448);
    const int gw = vcu * 8 + wave, NGW = G * 8;
    bf16* WA = (bf16*)(ws + WS_WA); bf16* WB = (bf16*)(ws + WS_WB); bf16* WF = (bf16*)(ws + WS_WF); bf16* WOA = (bf16*)(ws + WS_WOA); bf16* WOB = (bf16*)(ws + WS_WOB);
    constexpr int T_IN = (D / 64) * (LDP / 64);
    constexpr int T_F = (D / 64) * 1;
    constexpr int T_OUT = (DI / 64) * (D / 64);
    constexpr int T_DEF = T_OUT + T_IN + T_F + T_OUT, SPLIT = (int)((long)T_DEF * CONV_P0_PCT / 100);
    f32x4 a0[8], b0[8], a1[8], b1[8];
    if (part == 0) {
        auto dsc = [=](int it) { TileDesc d; d.W = w_in_a; d.ldw = LDP; d.K = D; d.k0 = (it / (LDP / 64)) * 64; d.n0 = (it % (LDP / 64)) * 64; d.WT = WA; d.nbase = 0; return d; };
        int it = gw;
        if (it < T_IN) { TileDesc d0 = dsc(it); tile_load(d0, a0, b0, lane);
            for (;;) {
                const int i1 = it + NGW; const bool m1 = i1 < T_IN; TileDesc d1 = dsc(m1 ? i1 : it); if (m1) tile_load(d1, a1, b1, lane);
                tile_store(d0, a0, b0, scr, lane); if (!m1) break;
                const int i2 = i1 + NGW; const bool m2 = i2 < T_IN; d0 = dsc(m2 ? i2 : i1); if (m2) tile_load(d0, a0, b0, lane);
                tile_store(d1, a1, b1, scr, lane); if (!m2) break;
                it = i2;
            } }
        bf16* HB = (bf16*)(ws + WS_HB);
        for (int m = gw; m < M; m += NGW) rms_row_bf16(x + (size_t)m * D, norm_w, HB + (size_t)m * D, lane);
    }
    {
        const int i0 = (part == 0) ? 0 : SPLIT, i1e = (part == 0) ? SPLIT : T_DEF;
        auto dsc = [=](int r) { TileDesc d; d.nbase = 0;
            if (r < T_OUT) { d.W = w_out_a; d.ldw = D; d.K = DI; d.k0 = (r / (D / 64)) * 64; d.n0 = (r % (D / 64)) * 64; d.WT = WOA; return d; } r -= T_OUT;
            if (r < T_OUT) { d.W = w_out_b; d.ldw = D; d.K = DI; d.k0 = (r / (D / 64)) * 64; d.n0 = (r % (D / 64)) * 64; d.WT = WOB; return d; } r -= T_OUT;
            if (r < T_F) { d.W = w_in_b; d.ldw = NWB; d.K = D; d.k0 = r * 64; d.n0 = LDP; d.WT = WF; d.nbase = LDP; return d; } r -= T_F;
            d.W = w_in_b; d.ldw = NWB; d.K = D; d.k0 = (r / (LDP / 64)) * 64; d.n0 = (r % (LDP / 64)) * 64; d.WT = WB; return d; };
        int it = i0 + gw;
#ifndef CONV_SLEEP
#define CONV_SLEEP 0
#endif
        if (it < i1e) { TileDesc d0 = dsc(it); tile_load(d0, a0, b0, lane);
            for (;;) {
                const int i1 = it + NGW; const bool m1 = i1 < i1e; TileDesc d1 = dsc(m1 ? i1 : it); if (m1) tile_load(d1, a1, b1, lane);
                tile_store(d0, a0, b0, scr, lane); if (!m1) break;
                if (CONV_SLEEP > 0 && part == 1) __builtin_amdgcn_s_sleep(CONV_SLEEP);
                const int i2 = i1 + NGW; const bool m2 = i2 < i1e; d0 = dsc(m2 ? i2 : i1); if (m2) tile_load(d0, a0, b0, lane);
                tile_store(d1, a1, b1, scr, lane); if (!m2) break;
                if (CONV_SLEEP > 0 && part == 1) __builtin_amdgcn_s_sleep(CONV_SLEEP);
                it = i2;
            } }
    }
}

namespace scan {
typedef short s16x4 __attribute__((ext_vector_type(4)));
typedef short bf16x8 __attribute__((ext_vector_type(8)));
typedef float f32x4 __attribute__((ext_vector_type(4)));
typedef unsigned u32x2 __attribute__((ext_vector_type(2)));
#ifndef SCAN_DMA_AUX
#define SCAN_DMA_AUX 2
#endif
#ifndef SCAN_STAGGER
#define SCAN_STAGGER 1
#endif
constexpr int R = 8, NSTEP = SEQ / 16;
constexpr int RAW = 0, PRD = R * 16384, PRD_SZ = 3 * 4096 + 512, QDT = 0, KIT = 4096, KE = 8192, DEC = 12288, SSQ = PRD + 2 * PRD_SZ, LDS_BYTES = SSQ + 1024;
__device__ __forceinline__ s16x4 trd(LAS const unsigned char* p) { return __builtin_bit_cast(s16x4, __builtin_amdgcn_ds_read_tr16_b64_v4i16((LAS s16x4*)p)); }
__device__ __forceinline__ s16x4 pk4(float a, float b, float c, float d) { u32x2 w; w.x = pk2(a, b); w.y = pk2(c, d); return __builtin_bit_cast(s16x4, w); }
__device__ __forceinline__ bf16x8 cat8(s16x4 a, s16x4 b) { return __builtin_shufflevector(a, b, 0, 1, 2, 3, 4, 5, 6, 7); }
#define SC_BAR() do { asm volatile("" ::: "memory"); __builtin_amdgcn_s_barrier(); asm volatile("" ::: "memory"); } while (0)

__device__ __forceinline__ void scan_unit(LAS unsigned char* lds, const bf16* __restrict__ P, const float* __restrict__ onw, bf16* __restrict__ Y, int bh) {
    const int tid = threadIdx.x, wid = __builtin_amdgcn_readfirstlane(tid >> 6), lane = tid & 63, n = lane & 15, g = lane >> 4, tq = n >> 2, tp = n & 3;
    const int b = bh / NH, h = bh % NH;
    const bf16* base = P + (size_t)(b * NH + h) * SEQ * HD;
    size_t goff[2]; int ldst[2];
#pragma unroll
    for (int ii = 0; ii < 2; ++ii) { const int i = 2 * wid + ii, ti = i >> 2, rg = i & 3, row = 4 * rg + (lane >> 4), pc = lane & 15, c = pc ^ ((row & 7) << 1);
        const int sec = (ti == 0) ? 1 : ((ti == 1) ? 0 : ti);
        goff[ii] = (size_t)row * HD + (size_t)sec * ((size_t)NB * NH * SEQ * HD) + c * 8; ldst[ii] = ti * 4096 + rg * 1024; }
#define SC_DMA(step) do { const int st_ = (step) < NSTEP ? (step) : NSTEP - 1; const int sl_ = ((step) & (R - 1)) * 16384; _Pragma("unroll") for (int ii = 0; ii < 2; ++ii) \
        __builtin_amdgcn_global_load_lds((const unsigned*)(base + (size_t)st_ * 16 * HD + goff[ii]), (LAS unsigned*)(lds + RAW + sl_ + ldst[ii]), 16, 0, SCAN_DMA_AUX); } while (0)
    const int rrow = 4 * g + tq;
    const int rtr = rrow * 256 + ((2 * wid + (tp >> 1)) ^ ((rrow & 7) << 1)) * 16 + 8 * (tp & 1);
    const int rsg = n * 256 + ((2 * wid + (g >> 1)) ^ ((n & 7) << 1)) * 16 + 8 * (g & 1);
    const int wq = (16 * wid + n) * 32 + g * 8;
    const int wk = (g >> 1) * 2048 + (16 * wid + n) * 16 + (g & 1) * 8;
    const int rqt = (4 * g + tq) * 32 + 8 * tp;
    const int rke = (g >> 1) * 2048 + n * 16 + (g & 1) * 8;
    const int rdec = (4 * g) * 4;
    s16x4 ltri; { short one = (short)0x3F80; ltri[0] = (4 * g + 0 <= n) ? one : (short)0; ltri[1] = (4 * g + 1 <= n) ? one : (short)0; ltri[2] = (4 * g + 2 <= n) ? one : (short)0; ltri[3] = (4 * g + 3 <= n) ? one : (short)0; }
    f32x4 gain = *(const f32x4*)(onw + h * HD + 16 * wid + 4 * g);
    asm volatile("" : "+v"(gain[0]), "+v"(gain[1]), "+v"(gain[2]), "+v"(gain[3]));
    f32x4 S[8];
#pragma unroll
    for (int t = 0; t < 8; ++t) S[t] = (f32x4){0.f, 0.f, 0.f, 0.f};
    f32x4 oprev = (f32x4){0.f, 0.f, 0.f, 0.f};
#define SC_PREP(s_) do { const LAS unsigned char* raw_ = lds + RAW + ((s_) & (R - 1)) * 16384; LAS unsigned char* img_ = lds + PRD + ((s_) & 1) * PRD_SZ; \
        const s16x4 lfB = trd(raw_ + rtr), qsB = trd(raw_ + 4096 + rtr); \
        const f32x4 G = __builtin_amdgcn_mfma_f32_16x16x16bf16_1k(ltri, lfB, (f32x4){0.f, 0.f, 0.f, 0.f}, 0, 0, 0); \
        const float dec_ = __builtin_amdgcn_exp2f(__shfl(G[3], 48 + n)); \
        float qd[4], ki[4], ke[4]; \
        _Pragma("unroll") for (int j = 0; j < 4; ++j) { const float lf = bf2f((unsigned short)lfB[j]), qs = bf2f((unsigned short)qsB[j]); \
            const float E = __builtin_amdgcn_exp2f(G[j]), Ei = __builtin_amdgcn_exp2f(-G[j]); \
            const float kk = 1.0f - __builtin_amdgcn_exp2f(lf); \
            qd[j] = qs * E; ki[j] = kk * Ei; ke[j] = ki[j] * dec_; } \
        *(LAS s16x4*)(img_ + QDT + wq) = pk4(qd[0], qd[1], qd[2], qd[3]); \
        *(LAS s16x4*)(img_ + KIT + wq) = pk4(ki[0], ki[1], ki[2], ki[3]); \
        *(LAS s16x4*)(img_ + KE + wk) = pk4(ke[0], ke[1], ke[2], ke[3]); \
        if (g == 0) *(LAS float*)(img_ + DEC + (16 * wid + n) * 4) = dec_; } while (0)
#define SC_OUT(s_) do { const LAS unsigned char* rawp = lds + RAW + ((s_) & (R - 1)) * 16384; const LAS unsigned char* sq = lds + SSQ + ((s_) & 1) * 512 + n * 32; \
        const f32x4 a = *(const LAS f32x4*)sq, c = *(const LAS f32x4*)(sq + 16); \
        const float tot = ((a[0] + a[1]) + (a[2] + a[3])) + ((c[0] + c[1]) + (c[2] + c[3])); \
        const float rs = __builtin_amdgcn_rsqf(tot * (1.0f / HD) + EPS); \
        const s16x4 sgv = *(const LAS s16x4*)(rawp + 3 * 4096 + rsg); \
        const float y0 = oprev[0] * rs * gain[0] * bf2f((unsigned short)sgv[0]), y1 = oprev[1] * rs * gain[1] * bf2f((unsigned short)sgv[1]); \
        const float y2 = oprev[2] * rs * gain[2] * bf2f((unsigned short)sgv[2]), y3 = oprev[3] * rs * gain[3] * bf2f((unsigned short)sgv[3]); \
        u32x2 w; w.x = pk2(y0, y1); w.y = pk2(y2, y3); \
        *(u32x2*)(Y + (size_t)(b * SEQ + 16 * (s_) + n) * DI + h * HD + 16 * wid + 4 * g) = w; } while (0)
    SC_DMA(0); SC_DMA(1); SC_DMA(2); SC_DMA(3); SC_DMA(4); SC_DMA(5);
    asm volatile("s_waitcnt vmcnt(10)" ::: "memory");
    SC_BAR();
    SC_PREP(0);
    for (int st = 0; st < NSTEP; ++st) {
        asm volatile("s_waitcnt vmcnt(8) lgkmcnt(0)" ::: "memory");
        SC_BAR();
        SC_DMA(st + 6);
        if (SCAN_STAGGER && wid >= 4 && st + 1 < NSTEP) SC_PREP(st + 1);
        if (st > 0) SC_OUT(st - 1);
        {
            const LAS unsigned char* raw = lds + RAW + (st & (R - 1)) * 16384; const LAS unsigned char* img = lds + PRD + (st & 1) * PRD_SZ;
            s16x4 qf[8], kf[8];
#pragma unroll
            for (int t = 0; t < 8; ++t) { qf[t] = trd(img + QDT + rqt + 512 * t); kf[t] = trd(img + KIT + rqt + 512 * t); }
            const s16x4 vf = trd(raw + 2 * 4096 + rtr);
            f32x4 sc = (f32x4){0.f, 0.f, 0.f, 0.f};
#pragma unroll
            for (int u = 0; u < 4; ++u) sc = __builtin_amdgcn_mfma_f32_16x16x32_bf16(cat8(kf[2 * u], kf[2 * u + 1]), cat8(qf[2 * u], qf[2 * u + 1]), sc, 0, 0, 0);
#pragma unroll
            for (int j = 0; j < 4; ++j) sc[j] = (4 * g + j <= n) ? sc[j] : 0.f;
            f32x4 o = (f32x4){0.f, 0.f, 0.f, 0.f};
#pragma unroll
            for (int u = 0; u < 4; ++u) { const s16x4 s0 = pk4(S[2 * u][0], S[2 * u][1], S[2 * u][2], S[2 * u][3]), s1 = pk4(S[2 * u + 1][0], S[2 * u + 1][1], S[2 * u + 1][2], S[2 * u + 1][3]);
                o = __builtin_amdgcn_mfma_f32_16x16x32_bf16(cat8(s0, s1), cat8(qf[2 * u], qf[2 * u + 1]), o, 0, 0, 0); }
            o = __builtin_amdgcn_mfma_f32_16x16x16bf16_1k(vf, pk4(sc[0], sc[1], sc[2], sc[3]), o, 0, 0, 0);
#pragma unroll
            for (int t = 0; t < 8; ++t) { const s16x4 kef = *(const LAS s16x4*)(img + KE + rke + 256 * t); const f32x4 dv = *(const LAS f32x4*)(img + DEC + rdec + 64 * t);
                S[t] = __builtin_amdgcn_mfma_f32_16x16x16bf16_1k(kef, vf, S[t] * dv, 0, 0, 0); }
            float ss = (o[0] * o[0] + o[1] * o[1]) + (o[2] * o[2] + o[3] * o[3]);
            ss += __shfl_xor(ss, 16); ss += __shfl_xor(ss, 32);
            if (g == 0) *(LAS float*)(lds + SSQ + (st & 1) * 512 + (n * 8 + wid) * 4) = ss;
            oprev = o;
        }
        if ((!SCAN_STAGGER || wid < 4) && st + 1 < NSTEP) SC_PREP(st + 1);
    }
    asm volatile("s_waitcnt lgkmcnt(0)" ::: "memory");
    SC_BAR();
    SC_OUT(NSTEP - 1);
    asm volatile("s_waitcnt vmcnt(0) lgkmcnt(0)" ::: "memory");
    SC_BAR();
#undef SC_DMA
#undef SC_PREP
#undef SC_OUT
}
#undef SC_BAR
}

#ifndef ATT_BODY
#define ATT_BODY 3
#endif
#ifdef ATT_USE_SETPRIO
#define ATT_PRIO(x) __builtin_amdgcn_s_setprio(x)
#else
#define ATT_PRIO(x) do { } while (0)
#endif
namespace fox {
enum { ORDER_NATURAL = 0, ORDER_REVERSED = 1, ORDER_PAIRED = 2, ORDER_XCD = 4 };
constexpr int B = NB, H = NH, HKV = NH, SQ = SEQ, SKV = SEQ, D = HD, QOFF = 0, WINDOW = SEQ;
constexpr int LDQ = HD, LDO = DI;
constexpr size_t SECSZ = (size_t)NB * NH * SEQ * HD;
constexpr float THR = 8.f;
constexpr int ORDER = ORDER_PAIRED | ORDER_XCD;
constexpr bool WSKIP = false;
constexpr float ISCALE = 11.313708498984761f;
constexpr int STG_ROW = 272;
constexpr float SCALE = 0.08838834764831845f;
constexpr int NW = 8, QBLK = 32, KVBLK = 64, QB = NW * QBLK;
constexpr int SHM_V = KVBLK * D * 2, SHM_K = KVBLK * D * 2;
constexpr int LDS_BYTES = 2 * SHM_V + 2 * SHM_K + NW * 64 * 4;
constexpr int RING = 4;
constexpr int C_OFF = (ATT_BODY == 3) ? 2 * RING * SHM_V + NW * 64 * 4 : LDS_BYTES, STG_OFF = (ATT_BODY == 3) ? 0 : C_OFF + SEQ * 4;
static_assert(D == 128 && SQ % QB == 0 && SKV % KVBLK == 0 && H % HKV == 0 && QOFF >= 0 && QOFF + SQ <= SKV && WINDOW >= 1, "geometry");

using bf16 = unsigned short;
typedef short bf16x8 __attribute__((ext_vector_type(8)));
typedef short s16x4 __attribute__((ext_vector_type(4)));
typedef float f32x16 __attribute__((ext_vector_type(16)));
typedef float f32x4 __attribute__((ext_vector_type(4)));
typedef unsigned u32x4 __attribute__((ext_vector_type(4)));
template <class A, class Bt> struct same_t { static constexpr bool v = false; };
template <class A> struct same_t<A, A> { static constexpr bool v = true; };

#define KSWZ(row, colB) ((row) * 256 + ((colB) ^ (((row) & 7) << 4)))
#define SBAR() __builtin_amdgcn_sched_barrier(0)
__device__ __forceinline__ int v_st(int k, int c) { const int kk = (k & ~0xC) | ((k & 4) << 1) | ((k & 8) >> 1); return ((kk >> 3) * 4 + (c >> 5)) * 512 + ((kk & 7) * 32 + (c & 31)) * 2; }
__device__ __forceinline__ int v_rd_base(int lane) { return ((lane & 3) << 3) | (((lane >> 2) & 3) << 6) | (((lane >> 4) & 1) << 5) | (((lane >> 5) & 1) << 8); }
constexpr int v_rd_off(int d0, int ks, int half) { return d0 * 512 + ks * 4096 + half * 2048; }
__device__ __forceinline__ int crow(int r, int hi) { return (r & 3) + 8 * (r >> 2) + 4 * hi; }
__device__ __forceinline__ unsigned cvtpk(float lo, float hi) {
    return pg8::cvt_pk_bf16(lo, hi);
}
__device__ __forceinline__ bf16x8 pack8(f32x4 a, f32x4 b) {
    u32x4 w = {cvtpk(a[0], a[1]), cvtpk(a[2], a[3]), cvtpk(b[0], b[1]), cvtpk(b[2], b[3])};
    return *reinterpret_cast<bf16x8*>(&w);
}
template <class T> __device__ __forceinline__ bf16x8 load8(const T* p) {
    if constexpr (same_t<T, float>::v) { return pack8(*(const f32x4*)p, *(const f32x4*)(p + 4)); }
    else { return *reinterpret_cast<const bf16x8*>(p); }
}
__device__ __forceinline__ void mask_tile(f32x16& p0, f32x16& p1, int dq, unsigned W) {
    const float NEG = -__builtin_inff();
#pragma unroll
    for (int r = 0; r < 16; ++r) {
        const int c = (r & 3) + 8 * (r >> 2);
        if ((unsigned)(dq - c) >= W) p0[r] = NEG;
        if ((unsigned)(dq - c - 32) >= W) p1[r] = NEG;
    }
}
__device__ __forceinline__ void partialSM(f32x16& p0, f32x16& p1, float mnL) {
    constexpr float C2 = 1.4426950408889634f * SCALE;
    for (int r = 0; r < 16; ++r) p0[r] = fmaf(p0[r], C2, mnL); for (int r = 0; r < 16; ++r) p1[r] = fmaf(p1[r], C2, mnL);
    for (int r = 0; r < 16; ++r) p0[r] = __builtin_amdgcn_exp2f(p0[r]);
}
__device__ __forceinline__ void finishSM(f32x16& p0, f32x16& p1, float& l_reg, bf16x8& pa0, bf16x8& pa1, bf16x8& pa2, bf16x8& pa3) {
    for (int r = 0; r < 16; ++r) p1[r] = __builtin_amdgcn_exp2f(p1[r]);
    float ps = 0; for (int r = 0; r < 16; ++r) ps += p0[r]; for (int r = 0; r < 16; ++r) ps += p1[r];
    { auto rr = __builtin_amdgcn_permlane32_swap(__float_as_uint(ps), __float_as_uint(ps), false, false);
      ps = __uint_as_float(rr[0]) + __uint_as_float(rr[1]); }
    l_reg += ps;
#define PK4(P, B_, OUT) do { unsigned a0 = cvtpk(P[B_+0], P[B_+1]), a1 = cvtpk(P[B_+2], P[B_+3]);                          \
        unsigned b0 = cvtpk(P[B_+4], P[B_+5]), b1 = cvtpk(P[B_+6], P[B_+7]);                                             \
        auto r0 = __builtin_amdgcn_permlane32_swap(a0, b0, false, false); auto r1 = __builtin_amdgcn_permlane32_swap(a1, b1, false, false); \
        u32x4 w = {r0[0], r1[0], r0[1], r1[1]}; OUT = *reinterpret_cast<bf16x8*>(&w); } while (0)
    PK4(p0, 0, pa0); PK4(p0, 8, pa1); PK4(p1, 0, pa2); PK4(p1, 8, pa3);
#undef PK4
}
__device__ __forceinline__ void bias_tile(f32x16& p0, f32x16& p1, const float* cl, int kb, int hi) {
    const f32x4* cp = (const f32x4*)(cl + kb + 4 * hi);
#pragma unroll
    for (int j = 0; j < 4; ++j) { const f32x4 c0 = cp[2 * j], c1 = cp[8 + 2 * j];
#pragma unroll
        for (int e = 0; e < 4; ++e) { p0[4 * j + e] = fmaf(c0[e], -ISCALE, p0[4 * j + e]); p1[4 * j + e] = fmaf(c1[e], -ISCALE, p1[4 * j + e]); } }
}
template <int KB, bool SK>
__device__ __forceinline__ void qkt(f32x16& p0, f32x16& p1, const char* K_lds, int r32, int hi, const bf16x8* qr, bool act) {
    if (SK && !act) { const float NEG = -__builtin_inff();
#pragma unroll
        for (int r = 0; r < 16; ++r) { p0[r] = NEG; p1[r] = NEG; } return; }
    p0 = f32x16{}; p1 = f32x16{};
    const char* kb[4];
#pragma unroll
    for (int dd = 0; dd < 4; ++dd) kb[dd] = K_lds + KB * SHM_K + KSWZ(r32, (dd * 16 + hi * 8) * 2);
#pragma unroll
    for (int d0 = 0; d0 < 8; ++d0) { const char* a = kb[d0 & 3] + (d0 >> 2) * 128;
        bf16x8 b0 = *reinterpret_cast<const bf16x8*>(a);
        bf16x8 b1 = *reinterpret_cast<const bf16x8*>(a + 32 * 256);
        p0 = __builtin_amdgcn_mfma_f32_32x32x16_bf16(b0, qr[d0], p0, 0, 0, 0);
        p1 = __builtin_amdgcn_mfma_f32_32x32x16_bf16(b1, qr[d0], p1, 0, 0, 0); }
}
template <int KB>
__device__ __forceinline__ void qkt3(f32x16& p0, f32x16& p1, int ka0, int ka1, int ka2, int ka3, const bf16x8* qr) {
#define KRD(dst, a_, off) asm volatile("ds_read_b128 %0, %1 offset:%2" : "=&v"(dst) : "v"(a_), "i"(off) : "memory")
#define KWAIT(n) do { asm volatile("s_waitcnt lgkmcnt(" #n ")" ::: "memory"); SBAR(); } while (0)
#define KMM(fa, fb, d0) do { p0 = __builtin_amdgcn_mfma_f32_32x32x16_bf16(fa, qr[d0], p0, 0, 0, 0); p1 = __builtin_amdgcn_mfma_f32_32x32x16_bf16(fb, qr[d0], p1, 0, 0, 0); SBAR(); } while (0)
    constexpr int o_ = KB * SHM_K, H_ = 32 * 256;
    bf16x8 f0, f1, f2, f3, f4, f5, f6, f7;
    KRD(f0, ka0, o_); KRD(f1, ka0, o_ + H_); KRD(f2, ka1, o_); KRD(f3, ka1, o_ + H_); KRD(f4, ka2, o_); KRD(f5, ka2, o_ + H_); KRD(f6, ka3, o_); KRD(f7, ka3, o_ + H_);
    p0 = f32x16{}; p1 = f32x16{};
    KWAIT(6); KMM(f0, f1, 0); KRD(f0, ka0, o_ + 128); KRD(f1, ka0, o_ + 128 + H_);
    KWAIT(6); KMM(f2, f3, 1); KRD(f2, ka1, o_ + 128); KRD(f3, ka1, o_ + 128 + H_);
    KWAIT(6); KMM(f4, f5, 2); KRD(f4, ka2, o_ + 128); KRD(f5, ka2, o_ + 128 + H_);
    KWAIT(6); KMM(f6, f7, 3); KRD(f6, ka3, o_ + 128); KRD(f7, ka3, o_ + 128 + H_);
    KWAIT(6); KMM(f0, f1, 4);
    KWAIT(4); KMM(f2, f3, 5);
    KWAIT(2); KMM(f4, f5, 6);
    KWAIT(0); KMM(f6, f7, 7);
#undef KRD
#undef KWAIT
#undef KMM
}
template <int VB, bool SK>
__device__ __forceinline__ void pv_tile(f32x16* o, int vb0, bf16x8 pa0, bf16x8 pa1, bf16x8 pa2, bf16x8 pa3, bool act) {
    if (SK && !act) return;
#define TRRD(dst, off) asm volatile("ds_read_b64_tr_b16 %0, %1 offset:%2" : "=&v"(dst) : "v"(vb0), "i"(off) : "memory")
#define PV_D0(d0) do { s16x4 l0, l1, l2, l3, h0, h1, h2, h3; constexpr int b_ = VB * SHM_V + v_rd_off(d0, 0, 0);     \
        TRRD(l0, b_); TRRD(h0, b_ + 2048); TRRD(l1, b_ + 4096); TRRD(h1, b_ + 6144); TRRD(l2, b_ + 8192); TRRD(h2, b_ + 10240); TRRD(l3, b_ + 12288); TRRD(h3, b_ + 14336); \
        asm volatile("s_waitcnt lgkmcnt(0)" ::: "memory"); SBAR();                 \
        o[d0] = __builtin_amdgcn_mfma_f32_32x32x16_bf16(pa0, (bf16x8){l0[0], l0[1], l0[2], l0[3], h0[0], h0[1], h0[2], h0[3]}, o[d0], 0, 0, 0);   \
        o[d0] = __builtin_amdgcn_mfma_f32_32x32x16_bf16(pa1, (bf16x8){l1[0], l1[1], l1[2], l1[3], h1[0], h1[1], h1[2], h1[3]}, o[d0], 0, 0, 0);   \
        o[d0] = __builtin_amdgcn_mfma_f32_32x32x16_bf16(pa2, (bf16x8){l2[0], l2[1], l2[2], l2[3], h2[0], h2[1], h2[2], h2[3]}, o[d0], 0, 0, 0);   \
        o[d0] = __builtin_amdgcn_mfma_f32_32x32x16_bf16(pa3, (bf16x8){l3[0], l3[1], l3[2], l3[3], h3[0], h3[1], h3[2], h3[3]}, o[d0], 0, 0, 0); } while (0)
    PV_D0(0); PV_D0(1); PV_D0(2); PV_D0(3);
#undef PV_D0
#undef TRRD
}

template <class TIn, class TOut> struct BlockRef { const TIn* Q; const TIn* K; const TIn* V; const TIn* G; TOut* O; int P0; };
template <class TIn> struct Seam {
    bf16x8 qr[8];
    bf16x8 st_v0, st_v1, st_k0, st_k1; f32x4 sf0, sf1, sf2, sf3;
    f32x4 tq[16];
};
__device__ __forceinline__ int swa_jlo(int P0, int W) { const int lowk = P0 - W + 1; return lowk > 0 ? lowk / KVBLK : 0; }
__device__ __forceinline__ int swa_jhi(int P0, int skv) { int j = (P0 + QB - 1) / KVBLK + 1; return j > skv / KVBLK ? skv / KVBLK : j; }
#define ROW(p, k0, rr) ((p) + (size_t)((k0) + (rr)) * LDQ + sc)
#define VMW() asm volatile("s_waitcnt vmcnt(0)" ::: "memory")
#define VMWN(n) asm volatile("s_waitcnt vmcnt(%0)" :: "i"(n) : "memory")
#define SLOAD_H(Kp, Vp, k0) do { const char* kb__ = (const char*)((Kp) + (size_t)(k0) * LDQ); const char* vb__ = (const char*)((Vp) + (size_t)(k0) * LDQ);     \
                         S.st_v0 = *(const bf16x8*)(vb__ + svoff); S.st_v1 = *(const bf16x8*)(vb__ + (size_t)32 * LDQ * 2 + svoff);              \
                         S.st_k0 = *(const bf16x8*)(kb__ + svoff); S.st_k1 = *(const bf16x8*)(kb__ + (size_t)32 * LDQ * 2 + svoff); } while (0)
#define SWRITE_HK(bf) do { *(bf16x8*)(K_lds + (bf) * SHM_K + kws) = S.st_k0; *(bf16x8*)(K_lds + (bf) * SHM_K + kws + 32 * 256) = S.st_k1; } while (0)
#define SWRITE_HV(bf) do { *(bf16x8*)(V_lds + (bf) * SHM_V + vst0) = S.st_v0; *(bf16x8*)(V_lds + (bf) * SHM_V + vst1) = S.st_v1; } while (0)
#define SWRITE_H(bf) do { SWRITE_HV(bf); SWRITE_HK(bf); } while (0)
#define SLOAD_F(p, k0) do { S.sf0 = *(const f32x4*)ROW(p, k0, sr); S.sf1 = *(const f32x4*)(ROW(p, k0, sr) + 4);                \
                            S.sf2 = *(const f32x4*)ROW(p, k0, 32 + sr); S.sf3 = *(const f32x4*)(ROW(p, k0, 32 + sr) + 4); } while (0)
#define SWRITE_KF(bf) do { *(bf16x8*)(K_lds + (bf) * SHM_K + kws) = pack8(S.sf0, S.sf1); *(bf16x8*)(K_lds + (bf) * SHM_K + kws + 32 * 256) = pack8(S.sf2, S.sf3); } while (0)
#define SWRITE_VF(bf) do { *(bf16x8*)(V_lds + (bf) * SHM_V + vst0) = pack8(S.sf0, S.sf1); *(bf16x8*)(V_lds + (bf) * SHM_V + vst1) = pack8(S.sf2, S.sf3); } while (0)
template <class TIn, class TOut>
__device__ __forceinline__ void causal_swa_prime(const BlockRef<TIn, TOut>& cur, int skv, int W, char* lds, Seam<TIn>& S) {
    constexpr bool F32 = same_t<TIn, float>::v;
    const int tid = threadIdx.x, wid = __builtin_amdgcn_readfirstlane(tid >> 6), lane = tid & 63, r32 = lane & 31, hi = lane >> 5;
    const int sr = tid >> 4, sc = (tid & 15) * 8, kws = KSWZ(sr, sc * 2); char* K_lds = lds + 2 * SHM_V;
    const unsigned svoff = (unsigned)(sr * LDQ + sc) * 2u, qvoff = (unsigned)(r32 * LDQ + hi * 8) * 2u;
    const int kb0 = (swa_jhi(cur.P0, skv) - 1) * KVBLK; (void)W;
    for (int d0 = 0; d0 < 8; ++d0) S.qr[d0] = *(const bf16x8*)((const char*)(cur.Q + (size_t)(wid * QBLK) * LDQ) + d0 * 32 + qvoff);
    if constexpr (F32) { SLOAD_F((const float*)cur.K, kb0); VMW(); SWRITE_KF(0); SBAR(); SLOAD_F((const float*)cur.V, kb0); }
    else { SLOAD_H(cur.K, cur.V, kb0); VMW(); SWRITE_HK(0); }
    __syncthreads();
}
template <class TIn, class TOut>
__device__ __forceinline__ void causal_swa_block(const BlockRef<TIn, TOut>& cur, const BlockRef<TIn, TOut>& nxt, int skv, int W, char* lds, Seam<TIn>& S, float thr, float kn) {
    constexpr bool F32 = same_t<TIn, float>::v;
    const int tid = threadIdx.x, wid = __builtin_amdgcn_readfirstlane(tid >> 6), lane = tid & 63, r32 = lane & 31, hi = lane >> 5;
    int j_hi = (cur.P0 + QB - 1) / KVBLK + 1; if (j_hi > skv / KVBLK) j_hi = skv / KVBLK;
    const int kbn = (swa_jhi(nxt.P0, skv) - 1) * KVBLK;
    const int qlo = cur.P0 + wid * QBLK, qm = qlo + r32 - 4 * hi;
    char* V_lds = lds; char* K_lds = lds + 2 * SHM_V;
    const float* cl = (const float*)(lds + C_OFF);
    int j_lo; { const int lastk = 64 * lane + 63; const bool skip = (lastk < cur.P0) && (cl[cur.P0] - cl[lastk] < -thr);
        const unsigned long long keep = __ballot(!skip); j_lo = keep ? (int)__builtin_ctzll(keep) : 0; (void)W; }
    const int NT = j_hi - j_lo;
    float* ws = (float*)(lds + 2 * SHM_V + 2 * SHM_K) + wid * 64; float* li_l = ws, * al_l = ws + 32;
    float l_reg = 0; f32x16 o[4] = {};
    float mnL; { float q2 = 0.f;
#pragma unroll
        for (int d0 = 0; d0 < 8; ++d0)
#pragma unroll
            for (int j = 0; j < 8; ++j) { const float v = __uint_as_float(((unsigned)(unsigned short)S.qr[d0][j]) << 16); q2 = fmaf(v, v, q2); }
        { auto rr = __builtin_amdgcn_permlane32_swap(__float_as_uint(q2), __float_as_uint(q2), false, false); q2 = __uint_as_float(rr[0]) + __uint_as_float(rr[1]); }
        const float Mt = fminf(SCALE * sqrtf(q2) * kn, 42.0f);
        int ci = wid * QBLK + r32; asm volatile("" : "+v"(ci));
        mnL = -(Mt - cl[cur.P0 + ci]) * 1.4426950408889634f; }
    const int sr = tid >> 4, sc = (tid & 15) * 8, vst0 = v_st(sr, sc), vst1 = v_st(32 + sr, sc), kws = KSWZ(sr, sc * 2);
    const unsigned svoff = (unsigned)(sr * LDQ + sc) * 2u, qvoff = (unsigned)(r32 * LDQ + hi * 8) * 2u;
    const int vb0 = (int)(uintptr_t)V_lds + v_rd_base(lane);
    const TIn* Kh = cur.K; const TIn* Vh = cur.V;
#define KBASE(t) ((j_hi - 1 - (t)) * KVBLK)
#define ACT(t) (KBASE(t) <= qlo + QBLK - 1 && KBASE(t) + KVBLK - 1 >= qlo - W + 1)
#define MASKT(P0_, P1_, t) do { const int kb_ = KBASE(t); bias_tile(P0_, P1_, cl, kb_, hi); if ((!SK || ACT(t)) && (kb_ + KVBLK - 1 > qlo || kb_ <= qlo + QBLK - 1 - W)) mask_tile(P0_, P1_, qm - kb_, (unsigned)W); } while (0)
    constexpr int NQL = F32 ? 16 : 8;
    constexpr bool SK = WSKIP && !F32;
#define SEAM_K0() do { VMWN(NQL); if constexpr (F32) { SWRITE_KF(0); SBAR(); SLOAD_F((const float*)nxt.V, kbn); } else { SWRITE_HK(0); } SBAR(); } while (0)
    f32x16 pA0, pA1, pB0, pB1; bf16x8 pa0, pa1, pa2, pa3;
    if constexpr (F32) { VMW(); SWRITE_VF(0); SBAR(); } else { SWRITE_HV(0); SBAR(); }
    if (NT > 1) { if constexpr (F32) SLOAD_F((const float*)Kh, KBASE(1)); else SLOAD_H(Kh, Vh, KBASE(1)); }
    SBAR(); qkt<0, SK>(pA0, pA1, K_lds, r32, hi, S.qr, ACT(0));
    if constexpr (F32) { if (NT > 1) { VMW(); SWRITE_KF(1); SBAR(); SLOAD_F((const float*)Vh, KBASE(1)); } }
    MASKT(pA0, pA1, 0); partialSM(pA0, pA1, mnL);
    if (NT > 1) { VMW(); if constexpr (F32) { SWRITE_VF(1); SBAR(); if (NT > 2) SLOAD_F((const float*)Kh, KBASE(2)); } else SWRITE_H(1); }
    __syncthreads();
#define HALF_STEP(PX0, PX1, PY0, PY1, t, KB, VB, SB) do {                                                      \
        SBAR(); qkt<KB, SK>(PX0, PX1, K_lds, r32, hi, S.qr, ACT(t));                                             \
        finishSM(PY0, PY1, l_reg, pa0, pa1, pa2, pa3); SBAR();                                                                \
        if ((t) + 1 < NT) { if constexpr (F32) { VMW(); SWRITE_KF(SB); SBAR(); SLOAD_F((const float*)Vh, KBASE((t) + 1)); }  \
                            else { SLOAD_H(Kh, Vh, KBASE((t) + 1)); } SBAR(); }                                               \
        pv_tile<VB, SK>(o, vb0, pa0, pa1, pa2, pa3, ACT((t) - 1)); MASKT(PX0, PX1, (t)); partialSM(PX0, PX1, mnL);                                        \
        __syncthreads();                                                                                                      \
        if ((t) + 1 < NT) { VMW(); if constexpr (F32) { SWRITE_VF(SB); SBAR(); if ((t) + 2 < NT) SLOAD_F((const float*)Kh, KBASE((t) + 2)); } \
                            else { SWRITE_H(SB); } }                                                                          \
        __syncthreads(); } while (0)
    for (int t = 1; t + 1 < NT; t += 2) {
        HALF_STEP(pB0, pB1, pA0, pA1, t, 1, 0, 0);
        HALF_STEP(pA0, pA1, pB0, pB1, t + 1, 0, 1, 1);
    }
    const bool even = (NT & 1) == 0;
    if (even) { SBAR(); qkt<1, SK>(pB0, pB1, K_lds, r32, hi, S.qr, ACT(NT - 1)); SBAR(); }
#define QROW(e) (nxt.Q + (size_t)(wid * QBLK + r32) * LDQ + ((e) >> 1) * 16 + hi * 8 + ((e) & 1) * 4)
    if constexpr (F32) { SLOAD_F((const float*)nxt.K, kbn); SBAR();
#pragma unroll
        for (int e = 0; e < 8; ++e) S.tq[e] = *(const f32x4*)QROW(e); }
    else { SLOAD_H(nxt.K, nxt.V, kbn); SBAR();
#pragma unroll
        for (int d0 = 0; d0 < 8; ++d0) S.qr[d0] = *(const bf16x8*)((const char*)(nxt.Q + (size_t)(wid * QBLK) * LDQ) + d0 * 32 + qvoff); }
    SBAR();
    finishSM(pA0, pA1, l_reg, pa0, pa1, pa2, pa3); SBAR();
    if constexpr (F32) {
#pragma unroll
        for (int e = 8; e < 16; ++e) S.tq[e] = *(const f32x4*)QROW(e); SBAR(); }
#undef QROW
    pv_tile<0, SK>(o, vb0, pa0, pa1, pa2, pa3, ACT(even ? NT - 2 : NT - 1));
    if (even) { MASKT(pB0, pB1, NT - 1); partialSM(pB0, pB1, mnL); __syncthreads();
        finishSM(pB0, pB1, l_reg, pa0, pa1, pa2, pa3); SBAR(); pv_tile<1, SK>(o, vb0, pa0, pa1, pa2, pa3, ACT(NT - 1)); }
    SBAR(); SEAM_K0();
    if (hi == 0) li_l[r32] = l_reg; asm volatile("s_waitcnt lgkmcnt(0)" ::: "memory");
    float rli[16];
#pragma unroll
    for (int r = 0; r < 16; ++r) rli[r] = __builtin_amdgcn_rcpf(li_l[crow(r, hi)]);
    { char* stg = lds + STG_OFF + wid * (QBLK * STG_ROW);
      int loff = (lane >> 4) * LDQ + (lane & 15) * 8, yoff = (lane >> 4) * LDO + (lane & 15) * 8;
      asm volatile("" : "+v"(loff), "+v"(yoff));
      const TIn* Gw = cur.G + (size_t)(wid * QBLK) * LDQ + loff; TOut* Ow = cur.O + (size_t)(wid * QBLK) * LDO + yoff;
#pragma unroll
      for (int r = 0; r < 16; ++r) { const int orow = crow(r, hi);
#pragma unroll
          for (int d0 = 0; d0 < 4; ++d0) { const float v = o[d0][r] * rli[r]; const float vn = __shfl_xor(v, 1);
              if ((r32 & 1) == 0) *(unsigned*)(stg + orow * STG_ROW + (d0 * 32 + r32) * 2) = cvtpk(v, vn); } }
      asm volatile("s_waitcnt lgkmcnt(0)" ::: "memory");
#pragma unroll
      for (int hf = 0; hf < 2; ++hf) { u32x4 gv[4];
#pragma unroll
          for (int i = 0; i < 4; ++i) gv[i] = *(const u32x4*)(Gw + (size_t)(16 * hf + 4 * i) * LDQ);
#pragma unroll
          for (int i = 0; i < 4; ++i) { const u32x4 ov = *(const u32x4*)(stg + (16 * hf + 4 * i + (lane >> 4)) * STG_ROW + (lane & 15) * 16); const u32x4 g4 = gv[i]; u32x4 w;
#pragma unroll
              for (int e = 0; e < 4; ++e) w[e] = cvtpk(__uint_as_float(ov[e] << 16) * __uint_as_float(g4[e] << 16), __uint_as_float(ov[e] & 0xffff0000u) * __uint_as_float(g4[e] & 0xffff0000u));
              *(u32x4*)(Ow + (size_t)(16 * hf + 4 * i) * LDO) = w; }
          asm volatile("" ::: "memory"); } }
    if constexpr (F32) {
#pragma unroll
        for (int d0 = 0; d0 < 8; ++d0) S.qr[d0] = pack8(S.tq[2 * d0], S.tq[2 * d0 + 1]); }
    __syncthreads();
#undef KBASE
#undef ACT
#undef MASKT
#undef SEAM_K0
#undef HALF_STEP
}

__device__ __forceinline__ void fox_block2(const BlockRef<bf16, bf16>& cur, int skv, char* lds, float thr, float kn) {
    const int tid = threadIdx.x, wid = __builtin_amdgcn_readfirstlane(tid >> 6), lane = tid & 63, r32 = lane & 31, hi = lane >> 5;
    const bool lead = wid < 4;
    int j_hi = (cur.P0 + QB - 1) / KVBLK + 1; if (j_hi > skv / KVBLK) j_hi = skv / KVBLK;
    const int qlo = cur.P0 + wid * QBLK, qm = qlo + r32 - 4 * hi;
    char* V_lds = lds; char* K_lds = lds + 2 * SHM_V;
    const float* cl = (const float*)(lds + C_OFF);
    int j_lo; { const int lastk = 64 * lane + 63; const bool skip = (lastk < cur.P0) && (cl[cur.P0] - cl[lastk] < -thr);
        const unsigned long long keep = __ballot(!skip); j_lo = keep ? (int)__builtin_ctzll(keep) : 0; }
    const int NT = j_hi - j_lo;
    float* li_l = (float*)(lds + 2 * SHM_V + 2 * SHM_K) + wid * 64;
    const int sr = tid >> 4, sc = (tid & 15) * 8, vst0 = v_st(sr, sc), vst1 = v_st(32 + sr, sc), kws = KSWZ(sr, sc * 2);
    const unsigned svoff = (unsigned)(sr * LDQ + sc) * 2u, qvoff = (unsigned)(r32 * LDQ + hi * 8) * 2u;
    const int vb0 = (int)(uintptr_t)V_lds + v_rd_base(lane);
#define KB2(t) ((j_hi - 1 - (t)) * KVBLK)
#define LOADK2(t, K0, K1) do { const char* kb__ = (const char*)(cur.K + (size_t)KB2(t) * LDQ); K0 = *(const bf16x8*)(kb__ + svoff); K1 = *(const bf16x8*)(kb__ + (size_t)32 * LDQ * 2 + svoff); } while (0)
#define LOADV2(t, V0, V1) do { const char* vb__ = (const char*)(cur.V + (size_t)KB2(t) * LDQ); V0 = *(const bf16x8*)(vb__ + svoff); V1 = *(const bf16x8*)(vb__ + (size_t)32 * LDQ * 2 + svoff); } while (0)
#define WRITEK2(t, K0, K1) do { char* kd__ = K_lds + ((t) & 1) * SHM_K + kws; *(bf16x8*)kd__ = K0; *(bf16x8*)(kd__ + 32 * 256) = K1; } while (0)
#define WRITEV2(t, V0, V1) do { char* vd__ = V_lds + ((t) & 1) * SHM_V; *(bf16x8*)(vd__ + vst0) = V0; *(bf16x8*)(vd__ + vst1) = V1; } while (0)
#define BAR2() do { asm volatile("s_waitcnt lgkmcnt(0)" ::: "memory"); __builtin_amdgcn_s_barrier(); asm volatile("" ::: "memory"); } while (0)
    bf16x8 qr[8], ska0, ska1, sva0, sva1, skb0, skb1, svb0, svb1;
#pragma unroll
    for (int d0 = 0; d0 < 8; ++d0) qr[d0] = *(const bf16x8*)((const char*)(cur.Q + (size_t)(wid * QBLK) * LDQ) + d0 * 32 + qvoff);
    LOADK2(0, ska0, ska1); LOADV2(0, sva0, sva1);
    { bf16x8 t0, t1; { const char* kb__ = (const char*)(cur.K + (size_t)KB2(1) * LDQ); t0 = *(const bf16x8*)(kb__ + svoff); t1 = *(const bf16x8*)(kb__ + (size_t)32 * LDQ * 2 + svoff); }
      asm volatile("s_waitcnt vmcnt(0)" ::: "memory");
      WRITEK2(0, ska0, ska1); WRITEV2(0, sva0, sva1); { char* kd__ = K_lds + SHM_K + kws; *(bf16x8*)kd__ = t0; *(bf16x8*)(kd__ + 32 * 256) = t1; } }
    { const int kt0 = lead ? 1 : 2, vt0 = lead ? 0 : 1;
      LOADK2(kt0 < NT ? kt0 : NT - 1, ska0, ska1); LOADV2(vt0, sva0, sva1);
      LOADK2(kt0 + 1 < NT ? kt0 + 1 : NT - 1, skb0, skb1); LOADV2(vt0 + 1 < NT ? vt0 + 1 : NT - 1, svb0, svb1); }
    float l_reg = 0; f32x16 o[4] = {}; f32x16 p0, p1; bf16x8 pa0, pa1, pa2, pa3;
    float mnL; { float q2 = 0.f;
#pragma unroll
        for (int d0 = 0; d0 < 8; ++d0)
#pragma unroll
            for (int j = 0; j < 8; ++j) { const float v = __uint_as_float(((unsigned)(unsigned short)qr[d0][j]) << 16); q2 = fmaf(v, v, q2); }
        { auto rr = __builtin_amdgcn_permlane32_swap(__float_as_uint(q2), __float_as_uint(q2), false, false); q2 = __uint_as_float(rr[0]) + __uint_as_float(rr[1]); }
        const float Mt = fminf(SCALE * sqrtf(q2) * kn, 42.0f);
        int ci = wid * QBLK + r32; asm volatile("" : "+v"(ci));
        mnL = -(Mt - cl[cur.P0 + ci]) * 1.4426950408889634f; }
    BAR2();
    if (!lead) BAR2();
#define STEP2(u_, KBI, VBP, K0, K1, V0, V1) do { const int u = (u_); \
        ATT_PRIO(1); \
        qkt<KBI, false>(p0, p1, K_lds, r32, hi, qr, true); \
        if (u > 0) pv_tile<VBP, false>(o, vb0, pa0, pa1, pa2, pa3, true); \
        ATT_PRIO(0); \
        BAR2(); \
        { const int kb_ = KB2(u); bias_tile(p0, p1, cl, kb_, hi); if (kb_ + KVBLK - 1 > qlo) mask_tile(p0, p1, qm - kb_, (unsigned)WINDOW); } \
        partialSM(p0, p1, mnL); finishSM(p0, p1, l_reg, pa0, pa1, pa2, pa3); \
        { const int kt = u + (lead ? 1 : 2), vt = u + (lead ? 0 : 1); const bool wk = kt >= 2 && kt < NT, wv = vt >= 1 && vt < NT; \
          if (wk) WRITEK2(kt, K0, K1); if (wv) WRITEV2(vt, V0, V1);     \
          { const int kl = kt + 2 < NT ? kt + 2 : NT - 1, vl = vt + 2 < NT ? vt + 2 : NT - 1; LOADK2(kl, K0, K1); LOADV2(vl, V0, V1); } } \
        BAR2(); } while (0)
    for (int u2 = 0; u2 < NT; u2 += 2) { STEP2(u2, 0, 1, ska0, ska1, sva0, sva1); if (u2 + 1 < NT) STEP2(u2 + 1, 1, 0, skb0, skb1, svb0, svb1); }
    if ((NT - 1) & 1) pv_tile<1, false>(o, vb0, pa0, pa1, pa2, pa3, true); else pv_tile<0, false>(o, vb0, pa0, pa1, pa2, pa3, true);
    if (lead) BAR2();
    if (hi == 0) li_l[r32] = l_reg; asm volatile("s_waitcnt lgkmcnt(0)" ::: "memory");
    float rli[16];
#pragma unroll
    for (int r = 0; r < 16; ++r) rli[r] = __builtin_amdgcn_rcpf(li_l[crow(r, hi)]);
    { char* stg = lds + STG_OFF + wid * (QBLK * STG_ROW);
      int loff = (lane >> 4) * LDQ + (lane & 15) * 8, yoff = (lane >> 4) * LDO + (lane & 15) * 8;
      asm volatile("" : "+v"(loff), "+v"(yoff));
      const bf16* Gw = cur.G + (size_t)(wid * QBLK) * LDQ + loff; bf16* Ow = cur.O + (size_t)(wid * QBLK) * LDO + yoff;
#pragma unroll
      for (int r = 0; r < 16; ++r) { const int orow = crow(r, hi);
#pragma unroll
          for (int d0 = 0; d0 < 4; ++d0) { const float v = o[d0][r] * rli[r]; const float vn = __shfl_xor(v, 1);
              if ((r32 & 1) == 0) *(unsigned*)(stg + orow * STG_ROW + (d0 * 32 + r32) * 2) = cvtpk(v, vn); } }
      asm volatile("s_waitcnt lgkmcnt(0)" ::: "memory");
#pragma unroll
      for (int hf = 0; hf < 2; ++hf) { u32x4 gv[4];
#pragma unroll
          for (int i = 0; i < 4; ++i) gv[i] = *(const u32x4*)(Gw + (size_t)(16 * hf + 4 * i) * LDQ);
#pragma unroll
          for (int i = 0; i < 4; ++i) { const u32x4 ov = *(const u32x4*)(stg + (16 * hf + 4 * i + (lane >> 4)) * STG_ROW + (lane & 15) * 16); const u32x4 g4 = gv[i]; u32x4 w;
#pragma unroll
              for (int e = 0; e < 4; ++e) w[e] = cvtpk(__uint_as_float(ov[e] << 16) * __uint_as_float(g4[e] << 16), __uint_as_float(ov[e] & 0xffff0000u) * __uint_as_float(g4[e] & 0xffff0000u));
              *(u32x4*)(Ow + (size_t)(16 * hf + 4 * i) * LDO) = w; }
          asm volatile("" ::: "memory"); } }
    __syncthreads();
#undef KB2
#undef LOADK2
#undef LOADV2
#undef WRITEK2
#undef WRITEV2
#undef BAR2
#undef STEP2
}

struct LsRegs { f32x4 a, b; };
__device__ __forceinline__ void scan_c(char* lds, const LsRegs& r); __device__ __forceinline__ void load_ls(LsRegs& r, const float* LS, int bh);
#define LBAR() do { asm volatile("s_waitcnt lgkmcnt(0)" ::: "memory"); __builtin_amdgcn_s_barrier(); asm volatile("" ::: "memory"); } while (0)
template <class LSR> __device__ __forceinline__ void fox_block3(const BlockRef<bf16, bf16>& cur, int skv, char* lds, LAS unsigned char* lds3, float thr, float kn, LSR& ls, const float* lsn, int probe_diag = 0) {
    const int tid = threadIdx.x, wid = __builtin_amdgcn_readfirstlane(tid >> 6), lane = tid & 63, r32 = lane & 31, hi = lane >> 5;
    const bool lead = wid < 4;
    int j_hi = (cur.P0 + QB - 1) / KVBLK + 1; if (j_hi > skv / KVBLK) j_hi = skv / KVBLK;
    const int qlo = cur.P0 + wid * QBLK, qm = qlo + r32 - 4 * hi;
    char* V_lds = lds; char* K_lds = lds + RING * SHM_V;
    const float* cl = (const float*)(lds + C_OFF);
    float* li_l = (float*)(lds + 2 * RING * SHM_V) + wid * 64;
    const unsigned qvoff = (unsigned)(r32 * LDQ + hi * 8) * 2u;
    const int vb0 = (int)(uintptr_t)V_lds + v_rd_base(lane);
    const int kab = (int)(uintptr_t)K_lds, ka0 = kab + KSWZ(r32, (0 * 16 + hi * 8) * 2), ka1 = kab + KSWZ(r32, (1 * 16 + hi * 8) * 2), ka2 = kab + KSWZ(r32, (2 * 16 + hi * 8) * 2), ka3 = kab + KSWZ(r32, (3 * 16 + hi * 8) * 2);
    unsigned ksrc[2], vsrc[2];
#pragma unroll
    for (int i = 0; i < 2; ++i) { const int p = 2 * wid + i;
        { const int row = 4 * p + (lane >> 4), ch = (lane & 15) ^ (row & 7); ksrc[i] = (unsigned)(row * LDQ * 2 + ch * 16); }
        { const int s = 2 * p + (lane >> 5), w_ = (lane & 31) * 16, kk = (s >> 2) * 8 + (w_ >> 6), k = (kk & ~0xC) | ((kk & 4) << 1) | ((kk & 8) >> 1), c = (s & 3) * 32 + (w_ & 63) / 2;
          vsrc[i] = (unsigned)(k * LDQ * 2 + c * 2); } }
#define KB3(t) ((j_hi - 1 - (t)) * KVBLK)
#define DMA3(t_) do { const int tc_ = (t_) < NT ? (t_) : NT - 1; DMA3U(t_, tc_); } while (0)
#define DMA3U(t_, tt_) do { const int sl_ = (t_) & (RING - 1); \
        const char* kb__ = (const char*)(cur.K + (size_t)KB3(tt_) * LDQ); const char* vb__ = (const char*)(cur.V + (size_t)KB3(tt_) * LDQ); \
        _Pragma("unroll") for (int i_ = 0; i_ < 2; ++i_) { \
            __builtin_amdgcn_global_load_lds((const unsigned*)(kb__ + ksrc[i_]), (LAS unsigned*)(lds3 + RING * SHM_V + sl_ * SHM_K + (2 * wid + i_) * 1024), 16, 0, 0); \
            __builtin_amdgcn_global_load_lds((const unsigned*)(vb__ + vsrc[i_]), (LAS unsigned*)(lds3 + sl_ * SHM_V + (2 * wid + i_) * 1024), 16, 0, 0); } } while (0)
#define BAR3() do { asm volatile("s_waitcnt vmcnt(4) lgkmcnt(0)" ::: "memory"); __builtin_amdgcn_s_barrier(); asm volatile("" ::: "memory"); } while (0)
    DMA3U(0, 0); DMA3U(1, 1); DMA3U(2, 2); DMA3U(3, 3);
    bf16x8 qr[8];
#pragma unroll
    for (int d0 = 0; d0 < 8; ++d0) qr[d0] = *(const bf16x8*)((const char*)(cur.Q + (size_t)(wid * QBLK) * LDQ) + d0 * 32 + qvoff);
    scan_c(lds, ls); LBAR();
    int j_lo; { const int lastk = 64 * lane + 63; const bool skip = (lastk < cur.P0) && (cl[cur.P0] - cl[lastk] < -thr);
        const unsigned long long keep = __ballot(!skip); j_lo = keep ? (int)__builtin_ctzll(keep) : 0; }
    if (probe_diag == 1) j_lo = j_hi - 4;
    const int NT = j_hi - j_lo;
    float l_reg = 0; f32x16 o[4] = {}; f32x16 p0, p1; bf16x8 pa0, pa1, pa2, pa3;
    float mnL; { float q2 = 0.f;
#pragma unroll
        for (int d0 = 0; d0 < 8; ++d0)
#pragma unroll
            for (int j = 0; j < 8; ++j) { const float v = __uint_as_float(((unsigned)(unsigned short)qr[d0][j]) << 16); q2 = fmaf(v, v, q2); }
        { auto rr = __builtin_amdgcn_permlane32_swap(__float_as_uint(q2), __float_as_uint(q2), false, false); q2 = __uint_as_float(rr[0]) + __uint_as_float(rr[1]); }
        const float Mt = fminf(SCALE * sqrtf(q2) * kn, 42.0f);
        int ci = wid * QBLK + r32; asm volatile("" : "+v"(ci));
        mnL = -(Mt - cl[cur.P0 + ci]) * 1.4426950408889634f; }
    asm volatile("s_waitcnt vmcnt(8)" ::: "memory");
    BAR3();
    if (!lead) BAR3();
#define STEP3(u_, SLK, SLVP) do { const int u = (u_); \
        if (u >= 2 && probe_diag != 2) DMA3(u + 2); \
        const bool live_ = KB3(u) <= qlo + QBLK - 1;                            \
        ATT_PRIO(1); \
        if (live_) qkt3<SLK>(p0, p1, ka0, ka1, ka2, ka3, qr); \
        if (u > 0 && KB3(u - 1) <= qlo + QBLK - 1) pv_tile<SLVP, false>(o, vb0, pa0, pa1, pa2, pa3, true); \
        ATT_PRIO(0); \
        BAR3(); \
        if (live_) { const int kb_ = KB3(u); bias_tile(p0, p1, cl, kb_, hi); if (kb_ + KVBLK - 1 > qlo) mask_tile(p0, p1, qm - kb_, (unsigned)WINDOW); \
            partialSM(p0, p1, mnL); finishSM(p0, p1, l_reg, pa0, pa1, pa2, pa3); } \
        BAR3(); } while (0)
    for (int u4 = 0; u4 < NT; u4 += 4) { STEP3(u4, 0, 3); if (u4 + 1 < NT) STEP3(u4 + 1, 1, 0); if (u4 + 2 < NT) STEP3(u4 + 2, 2, 1); if (u4 + 3 < NT) STEP3(u4 + 3, 3, 2); }
    u32x4 gv[8];
    int loff = (lane >> 4) * LDQ + (lane & 15) * 8, yoff = (lane >> 4) * LDO + (lane & 15) * 8;
    asm volatile("" : "+v"(loff), "+v"(yoff));
    { const bf16* Gw = cur.G + (size_t)(wid * QBLK) * LDQ + loff;
#pragma unroll
      for (int i = 0; i < 8; ++i) gv[i] = *(const u32x4*)(Gw + (size_t)(4 * i) * LDQ);
      load_ls(ls, lsn, 0); }
    { const int sv = (NT - 1) & 3;
      if (sv == 0) pv_tile<0, false>(o, vb0, pa0, pa1, pa2, pa3, true); else if (sv == 1) pv_tile<1, false>(o, vb0, pa0, pa1, pa2, pa3, true);
      else if (sv == 2) pv_tile<2, false>(o, vb0, pa0, pa1, pa2, pa3, true); else pv_tile<3, false>(o, vb0, pa0, pa1, pa2, pa3, true); }
    if (lead) LBAR();
    asm volatile("s_waitcnt vmcnt(10) lgkmcnt(0)" ::: "memory"); __builtin_amdgcn_s_barrier(); asm volatile("" ::: "memory");
    if (hi == 0) li_l[r32] = l_reg; asm volatile("s_waitcnt lgkmcnt(0)" ::: "memory");
    float rli[16];
#pragma unroll
    for (int r = 0; r < 16; ++r) rli[r] = __builtin_amdgcn_rcpf(li_l[crow(r, hi)]);
    { char* stg = lds + STG_OFF + wid * (QBLK * STG_ROW);
      bf16* Ow = cur.O + (size_t)(wid * QBLK) * LDO + yoff;
      const bool odd = (r32 & 1) != 0; int pko = odd ? (32 + r32 - 1) * 2 : r32 * 2; asm volatile("" : "+v"(pko));
#pragma unroll
      for (int r = 0; r < 16; ++r) { const int orow = crow(r, hi);
#pragma unroll
          for (int d0 = 0; d0 < 4; d0 += 2) { const float va = o[d0][r] * rli[r], vb = o[d0 + 1][r] * rli[r];
              const float rc = __shfl_xor(odd ? va : vb, 1);
              *(unsigned*)(stg + orow * STG_ROW + pko + d0 * 64) = odd ? cvtpk(rc, vb) : cvtpk(va, rc); } }
      asm volatile("s_waitcnt lgkmcnt(0)" ::: "memory");
#pragma unroll
      for (int hf = 0; hf < 2; ++hf) {
#pragma unroll
          for (int i = 0; i < 4; ++i) { const u32x4 ov = *(const u32x4*)(stg + (16 * hf + 4 * i + (lane >> 4)) * STG_ROW + (lane & 15) * 16); const u32x4 g4 = gv[4 * hf + i]; u32x4 w;
#pragma unroll
              for (int e = 0; e < 4; ++e) w[e] = cvtpk(__uint_as_float(ov[e] << 16) * __uint_as_float(g4[e] << 16), __uint_as_float(ov[e] & 0xffff0000u) * __uint_as_float(g4[e] & 0xffff0000u));
              *(u32x4*)(Ow + (size_t)(16 * hf + 4 * i) * LDO) = w; }
          asm volatile("" ::: "memory"); } }
    LBAR();
#undef KB3
#undef DMA3
#undef DMA3U
#undef BAR3
#undef STEP3
}
#undef ROW
#undef VMW
#undef VMWN
#undef SLOAD_H
#undef SWRITE_HK
#undef SWRITE_HV
#undef SWRITE_H
#undef SLOAD_F
#undef SWRITE_KF
#undef SWRITE_VF

__host__ __device__ inline int swa_nramp(int nqb, int W, int qoff) { const int t = W - 1 - qoff; const int n = t < 0 ? 0 : t / QB + 1; return n > nqb ? nqb : n; }
__host__ __device__ inline int swa_nx(int nqb, int nramp, int order) { return (order & ORDER_PAIRED) ? (nramp + 1) / 2 + (nqb - nramp) : nqb; }
struct SwaItem { int bh, qb0, qb1; };
__device__ __forceinline__ SwaItem swa_decode(int L, int nb, int nh, int nhkv, int nqb, int nx, int nramp, int order) {
    const int G = nh / nhkv; SwaItem it; int x;
    if ((order & ORDER_XCD) && (nb * nhkv) % 8 == 0) { const int xcd = L & 7, k = L >> 3, per = G * nx, gi = k / per, r = k - gi * per;
        it.bh = (gi * 8 + xcd) * G + r / nx; x = r % nx; }
    else { it.bh = L / nx; x = L - it.bh * nx; }
    if (order & ORDER_PAIRED) { const int ns = nqb - nramp;
        if (x < ns) { it.qb0 = it.qb1 = nqb - 1 - x; } else { it.qb0 = x - ns; it.qb1 = nramp - 1 - it.qb0; } }
    else { it.qb0 = it.qb1 = ((order & 3) == ORDER_REVERSED) ? nqb - 1 - x : x; }
    return it;
}
template <class TIn, class TOut>
__device__ __forceinline__ BlockRef<TIn, TOut> swa_ref(const SwaItem& it, int pass, const TIn* Q, const TIn* K, const TIn* V, TOut* O,
                                                    int nh, int nhkv, int sq, int skv, int qoff) {
    const int qb = pass ? it.qb1 : it.qb0, kvh = it.bh / (nh / nhkv);
    BlockRef<TIn, TOut> r;
    const int b_ = it.bh / nh, h_ = it.bh % nh; (void)kvh; (void)K; (void)V;
    const TIn* rowb = Q + (size_t)(b_ * nh + h_) * sq * LDQ;
    r.Q = rowb + (size_t)qb * QB * LDQ; r.K = rowb + SECSZ; r.V = rowb + 2 * SECSZ; r.G = r.Q + 3 * SECSZ;
    r.O = O + ((size_t)b_ * sq + (size_t)qb * QB) * LDO + h_ * D; r.P0 = qoff + qb * QB;
    return r;
}

constexpr int WT_OFF = (ATT_BODY == 3) ? C_OFF + SEQ * 4 : STG_OFF + NW * QBLK * STG_ROW, ATT_LDS = WT_OFF + 64;
__device__ __forceinline__ void load_ls(LsRegs& r, const float* LS, int bh) { int tid = threadIdx.x; asm volatile("" : "+v"(tid)); const f32x4* src = (const f32x4*)(LS + (size_t)bh * SEQ) + 2 * tid; r.a = src[0]; r.b = src[1]; }
__device__ __forceinline__ void scan_c(char* lds, const LsRegs& r);
__device__ __forceinline__ void load_c(char* lds, const float* LS, int bh) { LsRegs r; load_ls(r, LS, bh); scan_c(lds, r); }
__device__ __forceinline__ void scan_c(char* lds, const LsRegs& r) {
    int tid = threadIdx.x; asm volatile("" : "+v"(tid));
    const int lane = tid & 63, wv = tid >> 6;
    const f32x4 a = r.a, b = r.b;
    float v[8]; v[0] = a[0]; v[1] = v[0] + a[1]; v[2] = v[1] + a[2]; v[3] = v[2] + a[3]; v[4] = v[3] + b[0]; v[5] = v[4] + b[1]; v[6] = v[5] + b[2]; v[7] = v[6] + b[3];
    float inc = v[7];
#pragma unroll
    for (int o = 1; o < 64; o <<= 1) { const float t = __uint_as_float(__builtin_amdgcn_ds_bpermute(((lane - o) & 63) << 2, __float_as_uint(inc))); if (lane >= o) inc += t; }
    float* wt = (float*)(lds + WT_OFF);
    if (lane == 63) wt[wv] = inc;
    asm volatile("s_waitcnt lgkmcnt(0)" ::: "memory"); __builtin_amdgcn_s_barrier(); asm volatile("" ::: "memory");
    float base = inc - v[7];
#pragma unroll
    for (int w = 0; w < 7; ++w) if (w < wv) base += wt[w];
    f32x4* dst = (f32x4*)(lds + C_OFF) + 2 * tid;
    dst[0] = (f32x4){base + v[0], base + v[1], base + v[2], base + v[3]}; dst[1] = (f32x4){base + v[4], base + v[5], base + v[6], base + v[7]};
}
__device__ __forceinline__ BlockRef<bf16, bf16> blk_ref(int id, const bf16* P, bf16* Y, int& bh) {
    constexpr int nqb = SQ / QB; bh = id % (B * H); const int qb = nqb - 1 - id / (B * H);
    SwaItem it; it.bh = bh; it.qb0 = it.qb1 = qb;
    return swa_ref<bf16, bf16>(it, 0, P, P, P, Y, H, HKV, SQ, SKV, QOFF);
}
__device__ __forceinline__ void head_bounds(const float* NRM, int bh, float& thr, float& kn) {
    const float* nq = NRM + (size_t)bh * 4; const float* nk = NRM + (size_t)(B * H + bh) * 4;
    const float q2 = (nq[0] + nq[1]) + (nq[2] + nq[3]), k2 = (nk[0] + nk[1]) + (nk[2] + nk[3]);
    kn = 1.01f * sqrtf(k2);
    thr = 110.0f + fmaxf(0.f, 1.01f * SCALE * sqrtf(q2) * kn - 42.0f);
}
__device__ __forceinline__ void attn_phase(char* lds, LAS unsigned char* lds3, const bf16* P, const float* LS, const float* NRM, bf16* Y, unsigned* qctr, int blk, int nblk, int probe_diag = 0) {
    constexpr int total = B * H * (SQ / QB);
    volatile int* qslot = (volatile int*)(lds + WT_OFF + 32);
    (void)blk; (void)nblk;
    if (threadIdx.x == 0) { qslot[0] = (int)atomicAdd(qctr, 1u); qslot[1] = (int)atomicAdd(qctr, 1u); }
    __syncthreads();
    int id0 = __builtin_amdgcn_readfirstlane(qslot[0]), id1 = __builtin_amdgcn_readfirstlane(qslot[1]);
    if (id0 >= total) return;
#if ATT_BODY >= 2
#if ATT_BODY == 3
    LsRegs ls; load_ls(ls, LS, id0 % (B * H));
#endif
    for (;;) {
        int bh0; const BlockRef<bf16, bf16> cur = blk_ref(id0, P, Y, bh0);
        int id2 = total;
        if (threadIdx.x == 0 && id1 < total) id2 = (int)atomicAdd(qctr, 1u);
        float thr, kn; head_bounds(NRM, bh0, thr, kn);
#if ATT_BODY == 3
        fox_block3(cur, SKV, lds, lds3, thr, kn, ls, LS + (size_t)((id1 < total ? id1 : id0) % (B * H)) * SEQ, probe_diag);
        if (id1 >= total) break;
        if (threadIdx.x == 0) qslot[0] = id2;
        LBAR();
#else
        load_c(lds, LS, bh0); __syncthreads();
        (void)lds3; fox_block2(cur, SKV, lds, thr, kn);
        if (id1 >= total) break;
        if (threadIdx.x == 0) qslot[0] = id2;
        __syncthreads();
#endif
        id0 = id1; id1 = __builtin_amdgcn_readfirstlane(qslot[0]);
    }
#else
    int bh0, bh1 = 0;
    BlockRef<bf16, bf16> cur = blk_ref(id0, P, Y, bh0);
    Seam<bf16> S;
    load_c(lds, LS, bh0);
    causal_swa_prime<bf16, bf16>(cur, SKV, WINDOW, lds, S);
    for (;;) {
        const bool last = id1 >= total;
        const BlockRef<bf16, bf16> nxt = last ? cur : blk_ref(id1, P, Y, bh1);
        int id2 = total;
        if (threadIdx.x == 0 && !last) id2 = (int)atomicAdd(qctr, 1u);
        float thr, kn; head_bounds(NRM, bh0, thr, kn);
        causal_swa_block<bf16, bf16>(cur, nxt, SKV, WINDOW, lds, S, thr, kn);
        if (last) { __builtin_amdgcn_s_setprio(0); break; }
        if (threadIdx.x == 0) qslot[0] = id2;
        load_c(lds, LS, bh1); __syncthreads();
        id1 = __builtin_amdgcn_readfirstlane(qslot[0]);
        cur = nxt; bh0 = bh1;
    }
#endif
}
}

__device__ __forceinline__ void flogit_phase(const bf16* __restrict__ HB, const bf16* __restrict__ WF, const float* __restrict__ b_f, float* __restrict__ LS, int blk, int nblk) {
    typedef short bf16x8_t __attribute__((ext_vector_type(8)));
    const int tid = threadIdx.x, wid = __builtin_amdgcn_readfirstlane(tid >> 6), lane = tid & 63, n = lane & 15, g = lane >> 4;
    for (int rb = blk; rb < M / 32; rb += nblk) {
        const int r0 = rb * 32 + (wid >> 2) * 16, h0 = (wid & 3) * 16;
        const bf16x8_t* ap = (const bf16x8_t*)(HB + (size_t)(r0 + n) * D + 8 * g);
        const bf16x8_t* bp = (const bf16x8_t*)(WF + (size_t)(h0 + n) * D + 8 * g);
        f32x4 acc = (f32x4){0.f, 0.f, 0.f, 0.f};
#pragma unroll 8
        for (int k = 0; k < D / 32; ++k) acc = __builtin_amdgcn_mfma_f32_16x16x32_bf16(ap[4 * k], bp[4 * k], acc, 0, 0, 0);
        const float bias = b_f[h0 + n];
        f32x4 o;
#pragma unroll
        for (int j = 0; j < 4; ++j) { const float z = acc[j] + bias; const float e = __builtin_amdgcn_exp2f(-1.4426950408889634f * fabsf(z));
            o[j] = fminf(z, 0.f) - 0.6931471805599453f * __builtin_amdgcn_logf(1.0f + e); }
        const int row = r0 + 4 * g, b = row / SEQ, s = row % SEQ;
        *(f32x4*)(LS + ((size_t)b * NH + h0 + n) * SEQ + s) = o;
    }
}

#define XB_TMO      128
#define XB_XCNT(j)  (256  + 64 * (j))
#define XB_XSUB(j)  (1280 + 64 * (j))
#define XB_XGEN(j)  (2304 + 64 * (j))
#define XB_TOP      3328
#define XB_TOPGEN   3392
#define XCD_BAR_WORDS 3456
#define XB_SPIN_CAP (1u << 18)

__device__ __forceinline__ unsigned xb_ld(unsigned* p)              { return __hip_atomic_load(p, __ATOMIC_RELAXED, __HIP_MEMORY_SCOPE_AGENT); }
__device__ __forceinline__ unsigned xb_add(unsigned* p, unsigned v) { return __hip_atomic_fetch_add(p, v, __ATOMIC_RELAXED, __HIP_MEMORY_SCOPE_AGENT); }
__device__ __forceinline__ unsigned xb_xcc_id() { return (unsigned)__builtin_amdgcn_s_getreg((3 << 11) | 20) & 0xFu; }
#define XB_SPIN(cond, bar) do { unsigned _sp = 0; while (cond) { __builtin_amdgcn_s_sleep(1); \
    if ((++_sp & 255u) == 0u) { if (xb_ld(&(bar)[XB_TMO])) break; if (_sp > XB_SPIN_CAP) { atomicAdd(&(bar)[XB_TMO], 1u); break; } } } } while (0)

struct XcdBarrier {
    unsigned* bar; unsigned x;
    volatile LAS unsigned* st;
};

__device__ __forceinline__ XcdBarrier xcd_barrier_post(unsigned* bar, volatile LAS unsigned* st) {
    XcdBarrier b; b.bar = bar; b.x = xb_xcc_id(); b.st = st;
    if (threadIdx.x == 0) (void)xb_add(&bar[XB_XCNT(b.x)], 1u);
    return b;
}
__device__ __forceinline__ void xcd_barrier_complete(unsigned* bar, unsigned x, unsigned& nloc, unsigned& nx) {
    const unsigned G = gridDim.x * gridDim.y * gridDim.z;
    unsigned sum, cnt, mine, sp = 0u;
    for (;;) {
        sum = 0u; cnt = 0u; mine = 0u;
#pragma unroll
        for (unsigned j = 0; j < 16; ++j) { const unsigned c = xb_ld(&bar[XB_XCNT(j)]); sum += c; cnt += (c > 0u) ? 1u : 0u; mine = (j == x) ? c : mine; }
        if (sum == G) break;
        __builtin_amdgcn_s_sleep(1);
        if ((++sp & 255u) == 0u) { if (xb_ld(&bar[XB_TMO])) break; if (sp > XB_SPIN_CAP) { atomicAdd(&bar[XB_TMO], 1u); break; } }
    }
    nloc = mine > 0u ? mine : 1u; nx = cnt > 0u ? cnt : 1u;
}

__device__ __forceinline__ void xcd_barrier(const XcdBarrier& b) {
    asm volatile("s_waitcnt vmcnt(0)" ::: "memory");
    __syncthreads();
    if (threadIdx.x == 0) {
        unsigned* bar = b.bar;
        __builtin_amdgcn_s_waitcnt(0);
        unsigned nloc = b.st[0], nx = b.st[1];
        if (nloc == 0u) { xcd_barrier_complete(bar, b.x, nloc, nx); b.st[0] = nloc; b.st[1] = nx; }
        const unsigned old = xb_add(&bar[XB_XSUB(b.x)], 1u);
        const unsigned gen = old / nloc;
        if (old + 1u == (gen + 1u) * nloc) {
            __builtin_amdgcn_fence(__ATOMIC_RELEASE, "agent");
            asm volatile("s_waitcnt vmcnt(0)" ::: "memory");
            const unsigned og = xb_add(&bar[XB_TOP], 1u);
            const unsigned tg = og / nx;
            if (og + 1u == (tg + 1u) * nx) xb_add(&bar[XB_TOPGEN], 1u);
            else XB_SPIN(xb_ld(&bar[XB_TOPGEN]) == tg, bar);
            __builtin_amdgcn_fence(__ATOMIC_ACQUIRE, "agent");
            xb_add(&bar[XB_XGEN(b.x)], 1u);
            asm volatile("s_waitcnt vmcnt(0)" ::: "memory");
        } else {
            XB_SPIN(xb_ld(&bar[XB_XGEN(b.x)]) == gen, bar);
            __builtin_amdgcn_fence(__ATOMIC_ACQUIRE, "agent");
            asm volatile("s_waitcnt vmcnt(0)" ::: "memory");
        }
    }
    __syncthreads();
}

constexpr int CW_BAR = 1024;
constexpr size_t CTL_ZERO_BYTES = 32768;
constexpr size_t QCTR_OFF = 28672;
constexpr size_t NRM_OFF = 24576;
constexpr int LDS_TOTAL = 163840;
constexpr int MISC_OFF = LDS_TOTAL - 64;
static_assert(fox::ATT_LDS <= MISC_OFF && scan::LDS_BYTES <= MISC_OFF && pg8::STAGE_BYTES <= MISC_OFF && 8 * 8448 <= MISC_OFF, "LDS map");
#ifndef MK_N_LAUNCHES
#define MK_N_LAUNCHES 1
#endif
constexpr int N_PHASES = 9;
struct Args { const float* in[10]; float* out; unsigned char* ws; int ph_lo, ph_hi; };
__global__ void __launch_bounds__(512, 2) mega_fwd(Args args) {
    extern __shared__ __attribute__((aligned(16))) unsigned char lds[];
    LAS unsigned char* L = (LAS unsigned char*)lds;
    volatile LAS unsigned* MISC = (volatile LAS unsigned*)(L + MISC_OFF);
    const int tid = threadIdx.x, lane = tid & 63, wave = __builtin_amdgcn_readfirstlane(tid >> 6);
    const int G = gridDim.x, bx = blockIdx.x;
    if (tid < 16) MISC[tid] = 0u;
    __syncthreads();
    unsigned char* ws = args.ws;
    XcdBarrier bar; bar.bar = (unsigned*)(ws + WS_CTL) + CW_BAR; bar.x = 0; bar.st = nullptr;
    if (MK_N_LAUNCHES != N_PHASES) bar = xcd_barrier_post((unsigned*)(ws + WS_CTL) + CW_BAR, MISC + 8);
    const float* x = args.in[0]; const float* norm_w = args.in[1]; const float* w_in_a = args.in[2]; const float* lb_logits = args.in[3]; const float* o_norm_a = args.in[4];
    const float* w_out_a = args.in[5]; const float* w_in_b = args.in[6]; const float* b_f = args.in[7]; const float* w_out_b = args.in[8]; const float* final_norm = args.in[9];
    float* out = args.out;
    bf16* WA = (bf16*)(ws + WS_WA); bf16* WB = (bf16*)(ws + WS_WB); bf16* WF = (bf16*)(ws + WS_WF); bf16* WOA = (bf16*)(ws + WS_WOA); bf16* WOB = (bf16*)(ws + WS_WOB);
    bf16* HB = (bf16*)(ws + WS_HB); float* X1 = (float*)(ws + WS_X1); bf16* P = (bf16*)(ws + WS_P); bf16* Y = (bf16*)(ws + WS_Y); float* LS = (float*)(ws + WS_LS);
    const int lo = args.ph_lo, hi = args.ph_hi;
#define IN(k) (lo <= (k) && (k) < hi)
#define SEAM(k) do { if (IN(k) && IN((k) + 1)) xcd_barrier(bar); } while (0)
#define RUN(k, ...) do { if (IN(k)) { __VA_ARGS__ } } while (0)

    RUN(0, { prologue_phase(L, 0, x, norm_w, w_in_a, w_out_a, w_in_b, w_out_b, ws, bx, G, wave, lane); } );
    SEAM(0);
#ifdef GEMM_DESYNC_TICKS
    if (IN(1)) { const unsigned long long t0 = __builtin_amdgcn_s_memrealtime(); const unsigned long long dl = (unsigned long long)(((unsigned)bx >> 3) & 3u) * GEMM_DESYNC_TICKS;
        while (__builtin_amdgcn_s_memrealtime() - t0 < dl) __builtin_amdgcn_s_sleep(8); }
#endif
    RUN(1, { pg8::Gemm g{HB, WA, M, LDP, D, 0}; pg8::StaticOrder S; S.init(M, LDP, G, bx); pg8::EpiAct<0> E{P, lb_logits, nullptr, LDP, 0};
        pg8::gemm_phase<pg8::EpiAct<0>, pg8::StaticOrder, true, true>(L, g, S, E); } );
    SEAM(1);
    RUN(2, { if (G >= 2 * NB * NH) { if (bx < NB * NH) scan::scan_unit(L, P, o_norm_a, Y, bx); else prologue_phase(L, 1, x, norm_w, w_in_a, w_out_a, w_in_b, w_out_b, ws, bx - NB * NH, G - NB * NH, wave, lane); }
              else { for (int bh = bx; bh < NB * NH; bh += G) scan::scan_unit(L, P, o_norm_a, Y, bh); prologue_phase(L, 1, x, norm_w, w_in_a, w_out_a, w_in_b, w_out_b, ws, bx, G, wave, lane); } } );
#ifdef PROBE_CONV128
    if (IN(2)) { xcd_barrier(bar); if (bx >= NB * NH) prologue_phase(L, 1, x, norm_w, w_in_a, w_out_a, w_in_b, w_out_b, ws, bx - NB * NH, G - NB * NH, wave, lane); }
#endif
#ifdef PROBE_SCAN128
    if (IN(2)) { xcd_barrier(bar); if (bx < NB * NH) scan::scan_unit(L, P, o_norm_a, Y, bx); }
#endif
    SEAM(2);
    RUN(3, { pg8::Gemm g{Y, WOA, M, D, DI, 0}; pg8::StaticOrder S; S.init(M, D, G, bx); pg8::EpiRes E{x, X1, D, 0};
        pg8::gemm_phase<pg8::EpiRes, pg8::StaticOrder, true, true>(L, g, S, E); } );
    SEAM(3);
    RUN(4, { const int gw = bx * 8 + wave, NGW = G * 8; for (int m = gw; m < M; m += NGW) rms_row_bf16(X1 + (size_t)m * D, norm_w + D, HB + (size_t)m * D, lane); } );
    SEAM(4);
    RUN(5, { flogit_phase(HB, WF, b_f, LS, bx, G);
        pg8::Gemm g{HB, WB, M, LDP, D, 0}; pg8::StaticOrder S; S.init(M, LDP, G, bx); pg8::EpiAct<1> E{P, nullptr, (unsigned*)(ws + WS_CTL + NRM_OFF), LDP, 0};
        pg8::gemm_phase<pg8::EpiAct<1>, pg8::StaticOrder, true, true>(L, g, S, E); } );
    SEAM(5);
    RUN(6, { fox::attn_phase((char*)lds, L, P, LS, (const float*)(ws + WS_CTL + NRM_OFF), Y, (unsigned*)(ws + WS_CTL + QCTR_OFF), bx, G); } );
#ifdef PROBE_ATTN_JUNK
    if (IN(6)) { xcd_barrier(bar); fox::attn_phase((char*)lds, L, P, LS, (const float*)(ws + WS_CTL + NRM_OFF), (bf16*)(ws + WS_WB), (unsigned*)(ws + WS_CTL + QCTR_OFF + 256), bx, G, PROBE_ATTN_JUNK - 1); }
#endif
#ifdef PROBE_ATTN2
    if (IN(6)) { xcd_barrier(bar); fox::attn_phase((char*)lds, L, P, LS, (const float*)(ws + WS_CTL + NRM_OFF), Y, (unsigned*)(ws + WS_CTL + QCTR_OFF + 256), bx, G); }
#endif
    SEAM(6);
    RUN(7, { pg8::Gemm g{Y, WOB, M, D, DI, 0}; pg8::StaticOrder S; S.init(M, D, G, bx); pg8::EpiRes E{X1, out, D, 0};
        pg8::gemm_phase<pg8::EpiRes, pg8::StaticOrder, true, true>(L, g, S, E); } );
    SEAM(7);
    RUN(8, { const int gw = bx * 8 + wave, NGW = G * 8; for (int m = gw; m < M; m += NGW) rms_row_f32(out + (size_t)m * D, final_norm, out + (size_t)m * D, lane); } );
#undef IN
#undef SEAM
}

extern "C" void kernel_launch(void* const* d_in, const int* in_sizes, int n_in, void* d_out, int out_size, void* d_ws, size_t ws_size, hipStream_t stream) {
    static int grid = 0;
    if (grid == 0) {
        if (n_in != 10 || in_sizes[0] != M * D || out_size != M * D || ws_size < WS_END) { fprintf(stderr, "kernel_launch: unexpected shapes (n_in %d, in0 %d, out %d, ws %zu < %zu); nothing launched\n", n_in, n_in > 0 ? in_sizes[0] : -1, out_size, ws_size, (size_t)WS_END); grid = -1; return; }
        int dev = 0, cus = 0, per_cu = 0;
        if (hipGetDevice(&dev) != hipSuccess || hipDeviceGetAttribute(&cus, hipDeviceAttributeMultiprocessorCount, dev) != hipSuccess) { fprintf(stderr, "kernel_launch: device query failed\n"); grid = -1; return; }
        if (hipFuncSetAttribute((const void*)mega_fwd, hipFuncAttributeMaxDynamicSharedMemorySize, LDS_TOTAL) != hipSuccess) { fprintf(stderr, "kernel_launch: hipFuncSetAttribute(%d B LDS) failed\n", LDS_TOTAL); grid = -1; return; }
        if (hipOccupancyMaxActiveBlocksPerMultiprocessor(&per_cu, (const void*)mega_fwd, 512, LDS_TOTAL) != hipSuccess || per_cu < 1)
            fprintf(stderr, "kernel_launch: note: occupancy query reports %d workgroups per CU\n", per_cu);
        (void)hipGetLastError();
        grid = cus;
    }
    if (grid < 0) return;
    if (hipMemsetAsync((char*)d_ws + WS_CTL, 0, CTL_ZERO_BYTES, stream) != hipSuccess) { fprintf(stderr, "kernel_launch: hipMemsetAsync failed\n"); return; }
    Args a{};
    for (int i = 0; i < 10; ++i) a.in[i] = (const float*)d_in[i];
    a.out = (float*)d_out; a.ws = (unsigned char*)d_ws;
#if MK_N_LAUNCHES == 1
    a.ph_lo = 0; a.ph_hi = N_PHASES;
    hipLaunchKernelGGL(mega_fwd, dim3(grid), dim3(512), LDS_TOTAL, stream, a);
#else
    for (int p = 0; p < N_PHASES; ++p) { a.ph_lo = p; a.ph_hi = p + 1; hipLaunchKernelGGL(mega_fwd, dim3(grid), dim3(512), LDS_TOTAL, stream, a); }
#endif
    const hipError_t le = hipPeekAtLastError();
    if (le != hipSuccess) fprintf(stderr, "kernel_launch: launch failed: %s\n", hipGetErrorName(le));
}
```
